# Optimizing an MI355X kernel written in HIP

```python
import math
import jax, jax.numpy as jnp
from jax import lax
import numpy as np

D_MODEL = 1024
BATCH = 8
SEQ = 4096
DEPTH = 1

MEM_LEN = 256
D_CONV = 512
CONV_HEADS = 8
D_SSM = 512
SSM_GROUP = 16
SSM_GROUPS = D_SSM // SSM_GROUP
SSM_STATE = 64
CONV_WIDTH = 3
D_IN_PROJ = 3 * D_CONV + D_SSM
D_MIX = D_CONV + D_SSM
XATTN_HEADS = 4
XATTN_HEAD_DIM = D_MODEL // XATTN_HEADS
N_EXPERTS = 32
TOP_K = 4
D_EXPERT = D_MODEL
SWIGLU_LIMIT = 7.0
SWIGLU_ALPHA = 1.702
EXPERT_BLOCK = 256
NORM_EPS = 1e-5

kernel_name = "hybrid_conv_s5_xattn_moe"


def _rmsnorm(x, g):
    xf = x.astype(jnp.float32)
    y = xf * lax.rsqrt(jnp.mean(xf * xf, axis=-1, keepdims=True) + NORM_EPS)
    return (y * g.astype(jnp.float32)).astype(x.dtype)


def _conv_mixer(bg, cg, xc, conv_w):
    v = cg * xc
    conv = lax.conv_general_dilated(
        v, conv_w[:, None, :].astype(v.dtype), window_strides=(1,),
        padding=[(CONV_WIDTH - 1, 0)],
        dimension_numbers=("NWC", "WIO", "NWC"),
        feature_group_count=D_CONV)
    return bg * conv


def _cplx_scan_op(e1, e2):
    a1r, a1i, b1r, b1i = e1
    a2r, a2i, b2r, b2i = e2
    ar = a1r * a2r - a1i * a2i
    ai = a1r * a2i + a1i * a2r
    br = a2r * b1r - a2i * b1i + b2r
    bi = a2r * b1i + a2i * b1r + b2i
    return ar, ai, br, bi


def _ssm_mixer(u, a_re, a_im, log_dt, b_re, b_im, c_re, c_im, d, w_glu):
    bsz, seq, _ = u.shape
    f32 = jnp.float32
    uf = u.astype(f32)
    ug = uf.reshape(bsz, seq, SSM_GROUPS, SSM_GROUP)
    a_re = a_re.astype(f32); a_im = a_im.astype(f32)
    b_re = b_re.astype(f32); b_im = b_im.astype(f32)
    dt = jnp.exp(log_dt.astype(f32))[:, None]
    mag = jnp.exp(dt * a_re)
    abar_re = mag * jnp.cos(dt * a_im)
    abar_im = mag * jnp.sin(dt * a_im)
    den = a_re * a_re + a_im * a_im
    p_re = abar_re - 1.0
    p_im = abar_im
    q_re = (p_re * a_re + p_im * a_im) / den
    q_im = (p_im * a_re - p_re * a_im) / den
    bb_re = q_re[..., None] * b_re - q_im[..., None] * b_im
    bb_im = q_re[..., None] * b_im + q_im[..., None] * b_re
    bu_re = jnp.einsum("blgc,gnc->blgn", ug, bb_re)
    bu_im = jnp.einsum("blgc,gnc->blgn", ug, bb_im)
    ar = jnp.broadcast_to(abar_re, bu_re.shape)
    ai = jnp.broadcast_to(abar_im, bu_re.shape)
    _, _, s_re, s_im = lax.associative_scan(_cplx_scan_op, (ar, ai, bu_re, bu_im), axis=1)
    y = (jnp.einsum("blgn,gcn->blgc", s_re, c_re.astype(f32))
         - jnp.einsum("blgn,gcn->blgc", s_im, c_im.astype(f32)))
    y = y.reshape(bsz, seq, D_SSM) + d.astype(f32) * uf
    y = jax.nn.gelu(y)
    y = y * jax.nn.sigmoid(y @ w_glu.astype(f32))
    return y.astype(u.dtype)


def _cross_attn(h, mem_n, w_q, w_kv, w_o):
    bsz, seq, _ = h.shape
    m = mem_n.shape[1]
    q = (h @ w_q).reshape(bsz, seq, XATTN_HEADS, XATTN_HEAD_DIM)
    kv = mem_n @ w_kv
    k = kv[..., :D_MODEL].reshape(bsz, m, XATTN_HEADS, XATTN_HEAD_DIM)
    v = kv[..., D_MODEL:].reshape(bsz, m, XATTN_HEADS, XATTN_HEAD_DIM)
    s = jnp.einsum("blhd,bmhd->bhlm", q, k).astype(jnp.float32) * (XATTN_HEAD_DIM ** -0.5)
    p = jax.nn.softmax(s, axis=-1).astype(h.dtype)
    o = jnp.einsum("bhlm,bmhd->blhd", p, v).reshape(bsz, seq, D_MODEL)
    return o @ w_o


def _moe(h2d, w_router, b_router, w_gu, b_gu, w_down, b_down):
    n_tok = h2d.shape[0]
    logits = (h2d @ w_router + b_router).astype(jnp.float32)
    top_val, top_idx = lax.top_k(logits, TOP_K)
    gates = jax.nn.softmax(top_val, axis=-1)
    n_assign = n_tok * TOP_K
    e_flat = top_idx.reshape(-1)
    tok_flat = jnp.arange(n_assign, dtype=jnp.int32) // TOP_K
    g_flat = gates.reshape(-1)
    order = jnp.argsort(e_flat)
    e_sorted = e_flat[order]
    tok_sorted = tok_flat[order]
    g_sorted = g_flat[order]
    counts = jnp.bincount(e_flat, length=N_EXPERTS)
    starts = jnp.cumsum(counts) - counts
    padded = (counts + EXPERT_BLOCK - 1) // EXPERT_BLOCK * EXPERT_BLOCK
    pends = jnp.cumsum(padded)
    pstarts = pends - padded
    dest = pstarts[e_sorted] + (jnp.arange(n_assign) - starts[e_sorted])
    n_blocks = -(-(n_assign + N_EXPERTS * (EXPERT_BLOCK - 1)) // EXPERT_BLOCK)
    n_rows = n_blocks * EXPERT_BLOCK
    tok_buf = jnp.zeros((n_rows,), jnp.int32).at[dest].set(tok_sorted)
    g_buf = jnp.zeros((n_rows,), h2d.dtype).at[dest].set(g_sorted.astype(h2d.dtype))
    blk_expert = jnp.minimum(
        jnp.searchsorted(pends, jnp.arange(n_blocks) * EXPERT_BLOCK, side="right"),
        N_EXPERTS - 1)

    def run_block(args):
        tok, g, e = args
        xb = h2d[tok]
        gu = xb @ w_gu[e] + b_gu[e]
        x_glu = jnp.minimum(gu[:, :D_EXPERT], SWIGLU_LIMIT)
        x_lin = jnp.clip(gu[:, D_EXPERT:], -SWIGLU_LIMIT, SWIGLU_LIMIT)
        act = x_glu * jax.nn.sigmoid(SWIGLU_ALPHA * x_glu) * (x_lin + 1.0)
        out = act @ w_down[e] + b_down[e]
        return out * g[:, None]

    out_blocks = lax.map(run_block, (tok_buf.reshape(n_blocks, EXPERT_BLOCK),
                                     g_buf.reshape(n_blocks, EXPERT_BLOCK), blk_expert))
    return jnp.zeros_like(h2d).at[tok_buf].add(out_blocks.reshape(n_rows, D_MODEL))


def setup_inputs(seed: int = 0) -> dict:
    key = jax.random.key(seed)
    ks = jax.random.split(key, 32)
    f32 = jnp.float32

    def nrm(k, shape, scale):
        return jax.random.normal(k, shape, f32) * scale

    def gain(k, shape):
        return 1.0 + 0.02 * jax.random.normal(k, shape, f32)

    L, G, N, C = DEPTH, SSM_GROUPS, SSM_STATE, SSM_GROUP
    n_idx = jnp.arange(N, dtype=f32)
    a_re = -0.5 + 0.01 * jax.random.normal(ks[4], (L, G, N), f32)
    a_im = math.pi * n_idx + 0.01 * jax.random.normal(ks[5], (L, G, N), f32)
    log_dt = jax.random.uniform(ks[6], (L, G), f32, math.log(1e-3), math.log(1e-1))
    return {
        "x": nrm(ks[0], (BATCH, SEQ, D_MODEL), 1.0),
        "mem": nrm(ks[1], (BATCH, MEM_LEN, D_MODEL), 1.0),
        "norm_mix": gain(ks[2], (L, D_MODEL)),
        "w_in": nrm(ks[3], (L, D_MODEL, D_IN_PROJ), D_MODEL ** -0.5),
        "conv_w": nrm(ks[7], (L, CONV_WIDTH, D_CONV), CONV_WIDTH ** -0.5),
        "ssm_a_re": a_re,
        "ssm_a_im": a_im,
        "ssm_log_dt": log_dt,
        "ssm_b_re": nrm(ks[8], (L, G, N, C), (2 * C) ** -0.5),
        "ssm_b_im": nrm(ks[9], (L, G, N, C), (2 * C) ** -0.5),
        "ssm_c_re": nrm(ks[10], (L, G, C, N), (2 * N) ** -0.5),
        "ssm_c_im": nrm(ks[11], (L, G, C, N), (2 * N) ** -0.5),
        "ssm_d": nrm(ks[12], (L, D_SSM), 1.0),
        "w_glu": nrm(ks[13], (L, D_SSM, D_SSM), D_SSM ** -0.5),
        "norm_conv_out": gain(ks[14], (L, D_CONV)),
        "norm_ssm_out": gain(ks[15], (L, D_SSM)),
        "w_out": nrm(ks[16], (L, D_MIX, D_MODEL), D_MIX ** -0.5),
        "norm_xattn": gain(ks[17], (L, D_MODEL)),
        "norm_mem": gain(ks[18], (L, D_MODEL)),
        "w_q": nrm(ks[19], (L, D_MODEL, D_MODEL), D_MODEL ** -0.5),
        "w_kv": nrm(ks[20], (L, D_MODEL, 2 * D_MODEL), D_MODEL ** -0.5),
        "w_o": nrm(ks[21], (L, D_MODEL, D_MODEL), D_MODEL ** -0.5),
        "norm_moe": gain(ks[22], (L, D_MODEL)),
        "w_router": nrm(ks[23], (L, D_MODEL, N_EXPERTS), D_MODEL ** -0.5),
        "b_router": nrm(ks[24], (L, N_EXPERTS), 0.01),
        "w_gu": nrm(ks[25], (L, N_EXPERTS, D_MODEL, 2 * D_EXPERT), D_MODEL ** -0.5),
        "b_gu": nrm(ks[26], (L, N_EXPERTS, 2 * D_EXPERT), 0.01),
        "w_down": nrm(ks[27], (L, N_EXPERTS, D_EXPERT, D_MODEL), D_EXPERT ** -0.5),
        "b_down": nrm(ks[28], (L, N_EXPERTS, D_MODEL), 0.01),
        "norm_final": gain(ks[29], (D_MODEL,)),
    }


def reference(x, mem, norm_mix, w_in, conv_w, ssm_a_re, ssm_a_im, ssm_log_dt,
              ssm_b_re, ssm_b_im, ssm_c_re, ssm_c_im, ssm_d, w_glu,
              norm_conv_out, norm_ssm_out, w_out, norm_xattn, norm_mem,
              w_q, w_kv, w_o, norm_moe, w_router, b_router, w_gu, b_gu,
              w_down, b_down, norm_final):
    bsz, seq, _ = x.shape
    for l in range(DEPTH):
        h = _rmsnorm(x, norm_mix[l])
        proj = h @ w_in[l]
        bg = proj[..., :D_CONV]
        cg = proj[..., D_CONV:2 * D_CONV]
        xc = proj[..., 2 * D_CONV:3 * D_CONV]
        u = proj[..., 3 * D_CONV:]
        y_conv = _rmsnorm(_conv_mixer(bg, cg, xc, conv_w[l]), norm_conv_out[l])
        y_ssm = _rmsnorm(_ssm_mixer(u, ssm_a_re[l], ssm_a_im[l], ssm_log_dt[l],
                                    ssm_b_re[l], ssm_b_im[l], ssm_c_re[l], ssm_c_im[l],
                                    ssm_d[l], w_glu[l]), norm_ssm_out[l])
        x = x + jnp.concatenate([y_conv, y_ssm], axis=-1) @ w_out[l]
        h = _rmsnorm(x, norm_xattn[l])
        m = _rmsnorm(mem, norm_mem[l])
        x = x + _cross_attn(h, m, w_q[l], w_kv[l], w_o[l])
        h = _rmsnorm(x, norm_moe[l])
        y = _moe(h.reshape(bsz * seq, D_MODEL), w_router[l], b_router[l],
                 w_gu[l], b_gu[l], w_down[l], b_down[l])
        x = x + y.reshape(bsz, seq, D_MODEL)
    return _rmsnorm(x, norm_final)
```

```cpp
#include <hip/hip_runtime.h>
#include <hip/hip_cooperative_groups.h>
#include <cstdio>
#include <cstdint>
#include <cmath>
namespace cg = cooperative_groups;

#ifndef MK_PER_PHASE
#define MK_PER_PHASE 0
#endif
#ifndef DBG_OUT
#define DBG_OUT 0
#endif

#define LAS __attribute__((address_space(3)))
typedef unsigned short bf16_t;
typedef short bf16x8 __attribute__((ext_vector_type(8)));
typedef float f32x4 __attribute__((ext_vector_type(4)));
typedef float f32x2 __attribute__((ext_vector_type(2)));
typedef unsigned u32x4 __attribute__((ext_vector_type(4)));
typedef unsigned u32x2 __attribute__((ext_vector_type(2)));

constexpr int NTHREADS = 512, NWAVES = 8;
constexpr int DM = 1024, BATCH = 8, SEQ = 4096, NTOK = BATCH * SEQ, MEMLEN = 256, NMEM = BATCH * MEMLEN;
constexpr int NEXP = 32, TOPK = 4, ECAP = NTOK;
constexpr int MAXTILES = (NTOK * TOPK) / 256 + NEXP;
constexpr float EPS = 1e-5f;

constexpr size_t MiB = 1u << 20;
constexpr size_t WS_CNT = 0;
constexpr size_t WS_RSTD1 = 1 * MiB;
constexpr size_t WS_SSQS = WS_RSTD1 + 128 * 1024;
constexpr size_t WS_SSQ2 = WS_SSQS + 128 * 1024;
constexpr size_t WS_SSQ3 = WS_SSQ2 + 128 * 1024;
constexpr size_t WS_GATES = 2 * MiB;
constexpr size_t WS_WR = 3 * MiB;
constexpr size_t WS_TOKL = 4 * MiB;
constexpr size_t WS_SSM = 8 * MiB;
constexpr size_t SSM_STRIDE = 576 * 1024, SSM_KT = 1024, SSM_PT = 64 * 1024, SSM_QT = 320 * 1024;
constexpr size_t WS_WIN = 26 * MiB, WS_WGLU = 30 * MiB, WS_WOUT = 31 * MiB, WS_WQ = 33 * MiB, WS_WK = 35 * MiB, WS_WV = 37 * MiB, WS_WO = 39 * MiB;
constexpr size_t WS_MEMN = 41 * MiB, WS_KMAT = 45 * MiB, WS_VT = 49 * MiB;
constexpr size_t WS_WGU = 56 * MiB, WS_WDN = 184 * MiB;
constexpr size_t WS_YGELU = 248 * MiB;
constexpr size_t WS_X1 = 280 * MiB;
constexpr size_t WS_ACT = 408 * MiB;
constexpr size_t WS_XB = 408 * MiB, WS_PROJ = 472 * MiB, WS_UG = 568 * MiB, WS_YCAT = 600 * MiB;
constexpr size_t WS_SLOTS = 680 * MiB;
constexpr size_t WS_XH = 680 * MiB, WS_QO = 744 * MiB, WS_PBUF = 808 * MiB, WS_O = 872 * MiB;
constexpr size_t WS_END = 936 * MiB;

constexpr int LDS_BYTES = 147456;
constexpr int XL_OFF = 131072;
constexpr int XL_PMAX = 0, XL_PSUM = 4096, XL_TB = 12288, XL_CNT = 12544;

__device__ __forceinline__ float wave_sum(float v) {
#pragma unroll
    for (int o = 1; o < 64; o <<= 1) v += __shfl_xor(v, o);
    return v;
}
__device__ __forceinline__ unsigned f2bf(float f) { unsigned u = __builtin_bit_cast(unsigned, f); return (u + 0x7fffu + ((u >> 16) & 1u)) >> 16; }
__device__ __forceinline__ unsigned pk2(float lo, float hi) { return f2bf(lo) | (f2bf(hi) << 16); }
__device__ __forceinline__ unsigned cvt_pk_bf16(float lo, float hi) { unsigned r; asm volatile("v_cvt_pk_bf16_f32 %0, %1, %2" : "=v"(r) : "v"(lo), "v"(hi)); return r; }
__device__ __forceinline__ float bflo(unsigned w) { return __builtin_bit_cast(float, w << 16); }
__device__ __forceinline__ float bfhi(unsigned w) { return __builtin_bit_cast(float, w & 0xffff0000u); }
__device__ __forceinline__ float bf2f(bf16_t b) { return __builtin_bit_cast(float, (unsigned)b << 16); }
__device__ __forceinline__ float sigmoidf_(float x) { return 1.0f / (1.0f + __expf(-x)); }
__device__ __forceinline__ float gelu_tanh(float y) { const float t = 0.7978845608028654f * (y + 0.044715f * y * y * y); return y * sigmoidf_(2.0f * t); }
__device__ __forceinline__ int ald(const int* p) { return __hip_atomic_load(p, __ATOMIC_RELAXED, __HIP_MEMORY_SCOPE_AGENT); }

namespace g8 {
constexpr int BM = 256, BK = 64, HALF = 128, HTB = HALF * BK * 2, NXCD = 8, WGM = 8;
__device__ __forceinline__ int lds_byte(int r, int c) { const int st = (r >> 4) * 2 + (c >> 5), rr = r & 15, cc = c & 31, ob = rr * 64 + cc * 2; return st * 1024 + (ob ^ (((ob >> 9) & 1) << 5)); }
__device__ __forceinline__ void stage_rc(int b, int& R, int& C) { const int st = b / 1024, sb = b % 1024, swz = sb ^ (((sb >> 9) & 1) << 5); R = (st >> 1) * 16 + swz / 64; C = (st & 1) * 32 + (swz % 64) / 2; }
__device__ __forceinline__ int perm32(int rho) { const int n = rho >> 4, i = rho & 15; return 8 * (i >> 2) + 4 * n + (i & 3); }

struct Unit { const char* A; const char* B; int pm, pn, e, aux, valid, job; };

__device__ __forceinline__ bool tile_order(int i, int G, int c, int nM, int nN, int& pm, int& pn) {
    const int nwg = nM * nN; const long L = (long)i * G + c; if (L >= nwg) return false;
    int wgid = (int)L; { const int q = nwg / NXCD, r = nwg % NXCD, xcd = wgid % NXCD, off = wgid / NXCD; wgid = (xcd < r ? xcd * (q + 1) : r * (q + 1) + (xcd - r) * q) + off; }
    const int nig = WGM * nN, gid = wgid / nig, fm = gid * WGM, gsz = (nM - fm) < WGM ? (nM - fm) : WGM;
    pm = fm + ((wgid % nig) % gsz); pn = (wgid % nig) / gsz; return true;
}

template <class Epi, class Sched>
__device__ __forceinline__ void gemm_phase(LAS unsigned char* lds, const Sched& S, const Epi& E) {
    const int tid = threadIdx.x, wid = __builtin_amdgcn_readfirstlane(tid >> 6), lane = tid & 63, wr = wid >> 2, wc = wid & 3, fr = lane & 15, fq = lane >> 4;
    const int K = S.K, nt = K / BK;
    const unsigned lda2 = S.lda2, ldb2 = S.ldb2;
    int Rr[2], Cc[2]; unsigned voffB[2];
#pragma unroll
    for (int i = 0; i < 2; ++i) { int R, C; stage_rc(tid * 16 + i * 8192, R, C); Rr[i] = R; Cc[i] = C; const int Rb = (R & ~31) + perm32(R & 31); voffB[i] = (unsigned)Rb * ldb2 + (unsigned)C * 2u; }
    const size_t kstep = (size_t)(BK * 2);
    const size_t hstepB = (size_t)HALF * ldb2;
    const unsigned ldsw = (unsigned)wid * 1024u;
    const int aoff = lds_byte(wr * 64 + fr, fq * 8), boff = lds_byte(wc * 32 + fr, fq * 8);
#define G8_SA(b, h) (((b) * 2 + (h)) * HTB)
#define G8_SB(b, h) ((4 + (b) * 2 + (h)) * HTB)
#define G8_STAGE_B(bufoff, gbase) do { _Pragma("unroll") for (int _i = 0; _i < 2; ++_i) \
        __builtin_amdgcn_global_load_lds((const unsigned*)((const char*)(gbase) + voffB[_i]), (LAS unsigned*)(lds + (bufoff) + ldsw + _i * 8192), 16, 0, 0); } while (0)
#define G8_STAGE_A(bufoff, gbase, o0, o1) do { \
        __builtin_amdgcn_global_load_lds((const unsigned*)((const char*)(gbase) + (o0)), (LAS unsigned*)(lds + (bufoff) + ldsw), 16, 0, 0); \
        __builtin_amdgcn_global_load_lds((const unsigned*)((const char*)(gbase) + (o1)), (LAS unsigned*)(lds + (bufoff) + ldsw + 8192), 16, 0, 0); } while (0)
#define G8_LDA(dst, b, h) do { _Pragma("unroll") for (int m = 0; m < 4; ++m) _Pragma("unroll") for (int k = 0; k < 2; ++k) dst[m][k] = *(const LAS bf16x8*)(lds + G8_SA(b, h) + aoff + m * 2048 + k * 1024); } while (0)
#define G8_LDB(dst, b, h) do { _Pragma("unroll") for (int n = 0; n < 2; ++n) _Pragma("unroll") for (int k = 0; k < 2; ++k) dst[n][k] = *(const LAS bf16x8*)(lds + G8_SB(b, h) + boff + n * 2048 + k * 1024); } while (0)
#define G8_MMA(ai, bj, At, Bt) do { __builtin_amdgcn_s_setprio(1); _Pragma("unroll") for (int m = 0; m < 4; ++m) _Pragma("unroll") for (int n = 0; n < 2; ++n) _Pragma("unroll") for (int k = 0; k < 2; ++k) \
        acc[ai][bj][m][n] = __builtin_amdgcn_mfma_f32_16x16x32_bf16(Bt[n][k], At[m][k], acc[ai][bj][m][n], 0, 0, 0); __builtin_amdgcn_s_setprio(0); } while (0)
#define G8_WAIT_V(n) asm volatile("s_waitcnt vmcnt(" #n ")" ::: "memory")
#define G8_WAIT_L(n) asm volatile("s_waitcnt lgkmcnt(" #n ")" ::: "memory")
#define G8_BAR __builtin_amdgcn_s_barrier()
#define G8_SCHED __builtin_amdgcn_sched_barrier(0)
#define G8_SETOFF(o, u) do { _Pragma("unroll") for (int _h = 0; _h < 2; ++_h) _Pragma("unroll") for (int _i = 0; _i < 2; ++_i) \
        o[_h][_i] = (Sched::GATHER ? S.arow_off(u, _h * HALF + Rr[_i]) : (unsigned)(_h * HALF + Rr[_i]) * lda2) + (unsigned)Cc[_i] * 2u; } while (0)
    Unit cur, nxt; int ui = 0;
    if (!S.next(0, cur)) return;
    f32x4 acc[2][2][4][2];
#pragma unroll
    for (int a = 0; a < 2; ++a)
#pragma unroll
        for (int b = 0; b < 2; ++b)
#pragma unroll
            for (int m = 0; m < 4; ++m)
#pragma unroll
                for (int n = 0; n < 2; ++n) acc[a][b][m][n] = (f32x4){0.f, 0.f, 0.f, 0.f};
    bf16x8 At[4][2], B0[2][2], B1[2][2];
    unsigned oa[2][2], on[2][2];
    G8_SETOFF(oa, cur);
    const char* cA = cur.A; const char* cB = cur.B;
    G8_STAGE_B(G8_SB(0, 0), cB); G8_STAGE_B(G8_SB(0, 1), cB + hstepB); G8_STAGE_A(G8_SA(0, 0), cA, oa[0][0], oa[0][1]); G8_STAGE_A(G8_SA(0, 1), cA, oa[1][0], oa[1][1]);
    if (wr == 1) G8_BAR;
    G8_WAIT_V(2); G8_BAR;
    G8_STAGE_B(G8_SB(1, 0), cB + kstep); G8_STAGE_A(G8_SA(1, 0), cA + kstep, oa[0][0], oa[0][1]); G8_STAGE_B(G8_SB(1, 1), cB + hstepB + kstep);
    G8_WAIT_V(6); G8_BAR;
    for (;;) {
        const bool has_next = S.next(ui + 1, nxt);
        const char* nA = has_next ? nxt.A : cA; const char* nB = has_next ? nxt.B : cB;
        if (Sched::GATHER) { if (has_next) { G8_SETOFF(on, nxt); } else {
#pragma unroll
            for (int h = 0; h < 2; ++h) { on[h][0] = oa[h][0]; on[h][1] = oa[h][1]; } } }
#pragma unroll 1
        for (int t = 0; t < nt; t += 2) {
            const bool last = (t == nt - 2);
            const char* a1 = cA + (size_t)(t + 1) * kstep;
            const char* a2 = last ? nA : cA + (size_t)(t + 2) * kstep; const char* b2 = last ? nB : cB + (size_t)(t + 2) * kstep;
            const char* a3 = a2 + kstep; const char* b3 = b2 + kstep;
            unsigned s00, s01, s10, s11;
            if (Sched::GATHER) { s00 = last ? on[0][0] : oa[0][0]; s01 = last ? on[0][1] : oa[0][1]; s10 = last ? on[1][0] : oa[1][0]; s11 = last ? on[1][1] : oa[1][1]; }
            else { s00 = oa[0][0]; s01 = oa[0][1]; s10 = oa[1][0]; s11 = oa[1][1]; }
            G8_LDB(B0, 0, 0); G8_LDB(B1, 0, 1); G8_SCHED; G8_LDA(At, 0, 0); G8_STAGE_A(G8_SA(1, 1), a1, oa[1][0], oa[1][1]);
            G8_WAIT_V(8); G8_WAIT_L(0); G8_BAR; G8_MMA(0, 0, At, B0); G8_MMA(0, 1, At, B1); G8_BAR; G8_SCHED;
            G8_LDA(At, 0, 1); G8_STAGE_B(G8_SB(0, 0), b2); G8_STAGE_B(G8_SB(0, 1), b2 + hstepB); G8_STAGE_A(G8_SA(0, 0), a2, s00, s01);
            G8_WAIT_V(8); G8_WAIT_L(0); G8_BAR; G8_MMA(1, 0, At, B0); G8_MMA(1, 1, At, B1); G8_BAR; G8_SCHED;
            G8_LDB(B0, 1, 0); G8_LDB(B1, 1, 1); G8_SCHED; G8_LDA(At, 1, 0); G8_STAGE_A(G8_SA(0, 1), a2, s10, s11);
            G8_WAIT_V(8); G8_WAIT_L(0); G8_BAR; G8_MMA(0, 0, At, B0); G8_MMA(0, 1, At, B1); G8_BAR; G8_SCHED;
            G8_LDA(At, 1, 1); G8_STAGE_B(G8_SB(1, 0), b3); G8_STAGE_B(G8_SB(1, 1), b3 + hstepB); G8_STAGE_A(G8_SA(1, 0), a3, s00, s01);
            G8_WAIT_V(8); G8_WAIT_L(0); G8_BAR; G8_MMA(1, 0, At, B0); G8_MMA(1, 1, At, B1); G8_BAR; G8_SCHED;
            if (Epi::MID) { int fr_e = fr; asm volatile("" : "+v"(fr_e)); E.mid(acc, cur, t, wr, fr_e); }
        }
        if (wr == 0) G8_BAR;
        { int fr_e = fr, fq_e = fq; asm volatile("" : "+v"(fr_e), "+v"(fq_e));
          E(acc, cur, wr, wc, fr_e, fq_e, lds); }
        if (!has_next) break;
#pragma unroll
        for (int a = 0; a < 2; ++a)
#pragma unroll
            for (int b = 0; b < 2; ++b)
#pragma unroll
                for (int m = 0; m < 4; ++m)
#pragma unroll
                    for (int n = 0; n < 2; ++n) acc[a][b][m][n] = (f32x4){0.f, 0.f, 0.f, 0.f};
        cur = nxt; cA = nA; cB = nB; ++ui;
        if (Sched::GATHER) {
#pragma unroll
            for (int h = 0; h < 2; ++h) { oa[h][0] = on[h][0]; oa[h][1] = on[h][1]; } }
        if (wr == 1) G8_BAR;
    }
    G8_WAIT_V(0);
    G8_BAR;
#undef G8_SA
#undef G8_SB
#undef G8_STAGE_A
#undef G8_STAGE_B
#undef G8_LDA
#undef G8_LDB
#undef G8_MMA
#undef G8_WAIT_V
#undef G8_WAIT_L
#undef G8_BAR
#undef G8_SCHED
#undef G8_SETOFF
}
}
using g8::Unit;

#define EPI_ROWS(ai, m) _Pragma("unroll") for (int ai = 0; ai < 2; ++ai) _Pragma("unroll") for (int m = 0; m < 4; ++m)
__device__ __forceinline__ u32x4 pack8(const f32x4 a, const f32x4 b) { u32x4 w; w.x = cvt_pk_bf16(a[0], a[1]); w.y = cvt_pk_bf16(a[2], a[3]); w.z = cvt_pk_bf16(b[0], b[1]); w.w = cvt_pk_bf16(b[2], b[3]); return w; }
__device__ __forceinline__ float sq8(const f32x4 a, const f32x4 b) { return (a[0] * a[0] + a[1] * a[1]) + (a[2] * a[2] + a[3] * a[3]) + (b[0] * b[0] + b[1] * b[1]) + (b[2] * b[2] + b[3] * b[3]); }
__device__ __forceinline__ void row_atomic(float* p, float s, int fq) { s += __shfl_xor(s, 16); s += __shfl_xor(s, 32); if (fq == 0) atomicAdd(p, s); }

struct SchedDense {
    static constexpr bool GATHER = false;
    const char* A; const char* B; unsigned lda2, ldb2; int K, nM, nN, G, c;
    __device__ __forceinline__ bool next(int i, Unit& u) const {
        int pm, pn; if (!g8::tile_order(i, G, c, nM, nN, pm, pn)) return false;
        u.pm = pm; u.pn = pn; u.A = A + (size_t)pm * 256 * lda2; u.B = B + (size_t)pn * 256 * ldb2; u.e = 0; u.aux = 0; u.valid = 256; u.job = 0; return true;
    }
    __device__ __forceinline__ unsigned arow_off(const Unit&, int) const { return 0u; }
};
struct SchedP1 {
    static constexpr bool GATHER = false;
    const char *xb, *win, *memn, *wk, *wv; unsigned lda2, ldb2; int K, G, c;
    __device__ __forceinline__ bool next(int i, Unit& u) const {
        const int L = i * G + c;
        u.e = 0; u.aux = 0; u.valid = 256;
        if (L < 1024) { int pm, pn; g8::tile_order(i, G, c, 128, 8, pm, pn); u.pm = pm; u.pn = pn; u.job = 0; u.A = xb + (size_t)pm * 256 * 2048; u.B = win + (size_t)pn * 256 * 2048; return true; }
        const int r = L - 1024;
        if (r < 32) { u.pm = r >> 2; u.pn = r & 3; u.job = 1; u.A = memn + (size_t)u.pm * 256 * 2048; u.B = wk + (size_t)u.pn * 256 * 2048; return true; }
        if (r < 64) { const int q = r - 32; u.pm = q >> 3; u.pn = q & 7; u.job = 2; u.A = wv + (size_t)u.pm * 256 * 2048; u.B = memn + (size_t)u.pn * 256 * 2048; return true; }
        return false;
    }
    __device__ __forceinline__ unsigned arow_off(const Unit&, int) const { return 0u; }
};
struct SchedAttn {
    static constexpr bool GATHER = false;
    const char *q, *kmat, *vt, *pbuf; unsigned lda2, ldb2; int K, G, c, npair;
    __device__ __forceinline__ void pair_unit(int j, bool isO, Unit& u) const {
        const int p = c + j * G; const int b = p >> 6, h = (p >> 4) & 3, qb = p & 15;
        u.pm = b * 16 + qb; u.pn = h; u.e = j & 1; u.aux = 0; u.valid = 256; u.job = isO ? 1 : 0;
        if (!isO) { u.A = q + ((size_t)((b * 4 + h) * SEQ + qb * 256)) * 512; u.B = kmat + ((size_t)((b * 4 + h) * 256)) * 512; }
        else      { u.A = pbuf + ((size_t)(c * 2 + (j & 1))) * 256 * 512; u.B = vt + ((size_t)((b * 4 + h) * 256)) * 512; }
    }
    __device__ __forceinline__ bool next(int i, Unit& u) const {
        const int n = npair; if (i >= 2 * n) return false;
        if (i == 0) { pair_unit(0, false, u); return true; }
        const int k = (i - 1) >> 1;
        if (i & 1) { if (k + 1 < n) pair_unit(k + 1, false, u); else pair_unit(n - 1, true, u); }
        else pair_unit(k, true, u);
        return true;
    }
    __device__ __forceinline__ unsigned arow_off(const Unit&, int) const { return 0u; }
};
struct SchedMoe {
    static constexpr bool GATHER_ = true;
    const LAS int* tb; const LAS int* cnt; const int* tokl; const char* A; const char* B; unsigned lda2, ldb2; int K, nN, G, c; size_t bstride; bool gather;
};
template <bool GATH> struct SchedMoeT : SchedMoe {
    static constexpr bool GATHER = GATH;
    __device__ __forceinline__ bool next(int i, Unit& u) const {
        const int nM = tb[NEXP]; int pm, pn; if (!g8::tile_order(i, G, c, nM, nN, pm, pn)) return false;
        int e = 0;
#pragma unroll
        for (int s = 16; s >= 1; s >>= 1) if (tb[e + s] <= pm) e += s;
        u.pm = pm; u.pn = pn; u.e = e; u.aux = (pm - tb[e]) * 256; const int v = cnt[e] - u.aux; u.valid = v < 256 ? v : 256; u.job = 0;
        u.A = GATH ? A : A + (size_t)pm * 256 * lda2; u.B = B + (size_t)e * bstride + (size_t)pn * 256 * ldb2; return true;
    }
    __device__ __forceinline__ unsigned arow_off(const Unit& u, int r) const {
        const int t = (r < u.valid) ? (tokl[(size_t)u.e * ECAP + u.aux + r] >> 2) : 0; return (unsigned)t * lda2;
    }
};

struct EpiP1 {
    static constexpr bool MID = false;
    const float* rstd1; bf16_t *proj, *ug, *kmat, *vt;
    __device__ __forceinline__ void mid(f32x4 (&)[2][2][4][2], const Unit&, int, int, int) const {}
    __device__ __forceinline__ void operator()(const f32x4 (&acc)[2][2][4][2], const Unit& u, int wr, int wc, int fr, int fq, LAS unsigned char*) const {
        const int col0 = u.pn * 256 + wc * 32 + 8 * fq;
        EPI_ROWS(ai, m) {
            const int row = u.pm * 256 + ai * 128 + wr * 64 + m * 16 + fr;
            const float sc = (u.job == 0) ? rstd1[row] : 1.0f;
#pragma unroll
            for (int bj = 0; bj < 2; ++bj) {
                const int col = col0 + bj * 128;
                const u32x4 w = pack8(acc[ai][bj][m][0] * sc, acc[ai][bj][m][1] * sc);
                bf16_t* dst;
                if (u.job == 0) { if (u.pn < 6) dst = proj + (size_t)row * 1536 + col; else { const int cc = col - 1536; dst = ug + ((size_t)((row >> 12) * 32 + (cc >> 4)) * SEQ + (row & 4095)) * 16 + (cc & 15); } }
                else if (u.job == 1) dst = kmat + ((size_t)((u.pm * 4 + u.pn) * 256 + (row & 255))) * 256 + (col & 255);
                else dst = vt + ((size_t)((u.pn * 4 + u.pm) * 256 + (row & 255))) * 256 + (col & 255);
                *(u32x4*)dst = w;
            }
        }
    }
};
struct EpiGlu {
    static constexpr bool MID = false;
    const bf16_t* ygelu; bf16_t* ycat; float* ssqs;
    __device__ __forceinline__ void mid(f32x4 (&)[2][2][4][2], const Unit&, int, int, int) const {}
    __device__ __forceinline__ void operator()(const f32x4 (&acc)[2][2][4][2], const Unit& u, int wr, int wc, int fr, int fq, LAS unsigned char*) const {
        const int col0 = u.pn * 256 + wc * 32 + 8 * fq;
        EPI_ROWS(ai, m) {
            const int row = u.pm * 256 + ai * 128 + wr * 64 + m * 16 + fr; float ss = 0.f;
#pragma unroll
            for (int bj = 0; bj < 2; ++bj) {
                const int col = col0 + bj * 128;
                const u32x4 a = *(const u32x4*)(ygelu + (size_t)row * 512 + col);
                f32x4 z0, z1; const f32x4 g0 = acc[ai][bj][m][0], g1 = acc[ai][bj][m][1];
                z0[0] = bflo(a.x) * sigmoidf_(g0[0]); z0[1] = bfhi(a.x) * sigmoidf_(g0[1]); z0[2] = bflo(a.y) * sigmoidf_(g0[2]); z0[3] = bfhi(a.y) * sigmoidf_(g0[3]);
                z1[0] = bflo(a.z) * sigmoidf_(g1[0]); z1[1] = bfhi(a.z) * sigmoidf_(g1[1]); z1[2] = bflo(a.w) * sigmoidf_(g1[2]); z1[3] = bfhi(a.w) * sigmoidf_(g1[3]);
                ss += sq8(z0, z1);
                *(u32x4*)(ycat + (size_t)row * 1024 + col) = pack8(z0, z1);
            }
            row_atomic(ssqs + row, ss, fq);
        }
    }
};
struct EpiRes {
    static constexpr bool MID = true;
    const float* xi; float* xo; bf16_t* xh; float* ssq; const float* ssqs; int midt;
    __device__ __forceinline__ void mid(f32x4 (&acc)[2][2][4][2], const Unit& u, int t, int wr, int fr) const {
        if (t != midt) return;
        EPI_ROWS(ai, m) {
            const int row = u.pm * 256 + ai * 128 + wr * 64 + m * 16 + fr;
            const float sc = rsqrtf(ssqs[row] * (1.0f / 512.0f) + EPS);
#pragma unroll
            for (int bj = 0; bj < 2; ++bj)
#pragma unroll
                for (int n = 0; n < 2; ++n) acc[ai][bj][m][n] *= sc;
        }
    }
    __device__ __forceinline__ void operator()(const f32x4 (&acc)[2][2][4][2], const Unit& u, int wr, int wc, int fr, int fq, LAS unsigned char*) const {
        const int col0 = u.pn * 256 + wc * 32 + 8 * fq;
        EPI_ROWS(ai, m) {
            const int row = u.pm * 256 + ai * 128 + wr * 64 + m * 16 + fr; float ss = 0.f;
#pragma unroll
            for (int bj = 0; bj < 2; ++bj) {
                const size_t off = (size_t)row * 1024 + col0 + bj * 128;
                const f32x4 r0 = *(const f32x4*)(xi + off), r1 = *(const f32x4*)(xi + off + 4);
                const f32x4 v0 = r0 + acc[ai][bj][m][0], v1 = r1 + acc[ai][bj][m][1];
                ss += sq8(v0, v1);
                *(f32x4*)(xo + off) = v0; *(f32x4*)(xo + off + 4) = v1;
                *(u32x4*)(xh + off) = pack8(v0, v1);
            }
            row_atomic(ssq + row, ss, fq);
            if (m & 1) asm volatile("" ::: "memory");
        }
    }
};
struct EpiQ {
    static constexpr bool MID = false;
    const float* ssq2; bf16_t* q;
    __device__ __forceinline__ void mid(f32x4 (&)[2][2][4][2], const Unit&, int, int, int) const {}
    __device__ __forceinline__ void operator()(const f32x4 (&acc)[2][2][4][2], const Unit& u, int wr, int wc, int fr, int fq, LAS unsigned char*) const {
        const int col0 = u.pn * 256 + wc * 32 + 8 * fq;
        EPI_ROWS(ai, m) {
            const int row = u.pm * 256 + ai * 128 + wr * 64 + m * 16 + fr;
            const float sc = rsqrtf(ssq2[row] * (1.0f / 1024.0f) + EPS) * (1.4426950408889634f / 16.0f);
#pragma unroll
            for (int bj = 0; bj < 2; ++bj) *(u32x4*)(q + ((size_t)(((row >> 12) * 4 + u.pn) * SEQ + (row & 4095))) * 256 + (col0 & 255) + bj * 128) = pack8(acc[ai][bj][m][0] * sc, acc[ai][bj][m][1] * sc);
        }
    }
};
struct EpiAttn {
    static constexpr bool MID = false;
    bf16_t* pbuf; bf16_t* o; int c;
    __device__ __forceinline__ void mid(f32x4 (&)[2][2][4][2], const Unit&, int, int, int) const {}
    __device__ __forceinline__ void operator()(const f32x4 (&acc)[2][2][4][2], const Unit& u, int wr, int wc, int fr, int fq, LAS unsigned char* lds) const {
        LAS float* pmax = (LAS float*)(lds + XL_OFF + XL_PMAX);
        LAS float* psum = (LAS float*)(lds + XL_OFF + XL_PSUM) + u.e * 1024;
        if (u.job == 0) {
            EPI_ROWS(ai, m) {
                const int r = ai * 128 + wr * 64 + m * 16 + fr; float mx = -3.0e38f;
#pragma unroll
                for (int bj = 0; bj < 2; ++bj)
#pragma unroll
                    for (int n = 0; n < 2; ++n)
#pragma unroll
                        for (int i = 0; i < 4; ++i) mx = fmaxf(mx, acc[ai][bj][m][n][i]);
                mx = fmaxf(mx, __shfl_xor(mx, 16)); mx = fmaxf(mx, __shfl_xor(mx, 32));
                if (fq == 0) pmax[r * 4 + wc] = mx;
            }
            asm volatile("s_waitcnt lgkmcnt(0)" ::: "memory"); __builtin_amdgcn_s_barrier(); asm volatile("" ::: "memory");
            bf16_t* P = pbuf + (size_t)(c * 2 + u.e) * 256 * 256;
            EPI_ROWS(ai, m) {
                const int r = ai * 128 + wr * 64 + m * 16 + fr;
                const f32x4 pm4 = *(const LAS f32x4*)(pmax + r * 4);
                const float mx = fmaxf(fmaxf(pm4[0], pm4[1]), fmaxf(pm4[2], pm4[3])); float ss = 0.f;
#pragma unroll
                for (int bj = 0; bj < 2; ++bj) {
                    f32x4 p0, p1;
#pragma unroll
                    for (int i = 0; i < 4; ++i) { p0[i] = __builtin_amdgcn_exp2f(acc[ai][bj][m][0][i] - mx); p1[i] = __builtin_amdgcn_exp2f(acc[ai][bj][m][1][i] - mx); }
                    ss += (p0[0] + p0[1]) + (p0[2] + p0[3]) + (p1[0] + p1[1]) + (p1[2] + p1[3]);
                    *(u32x4*)(P + (size_t)r * 256 + wc * 32 + 8 * fq + bj * 128) = pack8(p0, p1);
                }
                ss += __shfl_xor(ss, 16); ss += __shfl_xor(ss, 32);
                if (fq == 0) psum[r * 4 + wc] = ss;
                asm volatile("" ::: "memory");
            }
            asm volatile("s_waitcnt vmcnt(0) lgkmcnt(0)" ::: "memory"); __builtin_amdgcn_s_barrier(); asm volatile("" ::: "memory");
        } else {
            const int b = u.pm >> 4, qb = u.pm & 15, h = u.pn;
            EPI_ROWS(ai, m) {
                const int r = ai * 128 + wr * 64 + m * 16 + fr;
                const f32x4 ps = *(const LAS f32x4*)(psum + r * 4);
                const float inv = 1.0f / ((ps[0] + ps[1]) + (ps[2] + ps[3]));
                bf16_t* dst = o + (size_t)(b * SEQ + qb * 256 + r) * 1024 + h * 256 + wc * 32 + 8 * fq;
#pragma unroll
                for (int bj = 0; bj < 2; ++bj) *(u32x4*)(dst + bj * 128) = pack8(acc[ai][bj][m][0] * inv, acc[ai][bj][m][1] * inv);
            }
        }
    }
};
struct EpiMoe1 {
    static constexpr bool MID = false;
    const int* tokl; const float* ssq3; const float* bgu; bf16_t* act;
    __device__ __forceinline__ void mid(f32x4 (&)[2][2][4][2], const Unit&, int, int, int) const {}
    __device__ __forceinline__ void operator()(const f32x4 (&acc)[2][2][4][2], const Unit& u, int wr, int wc, int fr, int fq, LAS unsigned char*) const {
        const int cj = u.pn * 128 + wc * 32 + 8 * fq;
        const float* bg = bgu + (size_t)u.e * 2048 + cj;
        const f32x4 bg0 = *(const f32x4*)bg, bg1 = *(const f32x4*)(bg + 4), bl0 = *(const f32x4*)(bg + 1024), bl1 = *(const f32x4*)(bg + 1028);
        EPI_ROWS(ai, m) {
            const int r = ai * 128 + wr * 64 + m * 16 + fr;
            const int tok = (r < u.valid) ? (tokl[(size_t)u.e * ECAP + u.aux + r] >> 2) : 0;
            const float sc = rsqrtf(ssq3[tok] * (1.0f / 1024.0f) + EPS);
            f32x4 a0, a1;
#pragma unroll
            for (int i = 0; i < 4; ++i) {
                float g = fminf(acc[ai][0][m][0][i] * sc + bg0[i], 7.0f), l = fminf(fmaxf(acc[ai][1][m][0][i] * sc + bl0[i], -7.0f), 7.0f);
                a0[i] = g * sigmoidf_(1.702f * g) * (l + 1.0f);
                g = fminf(acc[ai][0][m][1][i] * sc + bg1[i], 7.0f); l = fminf(fmaxf(acc[ai][1][m][1][i] * sc + bl1[i], -7.0f), 7.0f);
                a1[i] = g * sigmoidf_(1.702f * g) * (l + 1.0f);
            }
            *(u32x4*)(act + (size_t)(u.pm * 256 + r) * 1024 + cj) = pack8(a0, a1);
        }
    }
};
struct EpiMoe2 {
    static constexpr bool MID = false;
    const int* tokl; const float* gates; const float* bdn; bf16_t* slots;
    __device__ __forceinline__ void mid(f32x4 (&)[2][2][4][2], const Unit&, int, int, int) const {}
    __device__ __forceinline__ void operator()(const f32x4 (&acc)[2][2][4][2], const Unit& u, int wr, int wc, int fr, int fq, LAS unsigned char*) const {
        const int col0 = u.pn * 256 + wc * 32 + 8 * fq;
        const float* bp = bdn + (size_t)u.e * 1024 + col0;
        f32x4 bv[2][2];
#pragma unroll
        for (int bj = 0; bj < 2; ++bj) { bv[bj][0] = *(const f32x4*)(bp + bj * 128); bv[bj][1] = *(const f32x4*)(bp + bj * 128 + 4); }
        EPI_ROWS(ai, m) {
            const int r = ai * 128 + wr * 64 + m * 16 + fr;
            if (r < u.valid) {
                const int slot = tokl[(size_t)u.e * ECAP + u.aux + r]; const float g = gates[slot];
#pragma unroll
                for (int bj = 0; bj < 2; ++bj) *(u32x4*)(slots + (size_t)slot * 1024 + col0 + bj * 128) = pack8((acc[ai][bj][m][0] + bv[bj][0]) * g, (acc[ai][bj][m][1] + bv[bj][1]) * g);
            }
        }
    }
};

struct Args { const float* in[30]; float* out; unsigned char* ws; int ph_lo, ph_hi; };
enum { I_X = 0, I_MEM, I_NMIX, I_WIN, I_CONVW, I_ARE, I_AIM, I_LOGDT, I_BRE, I_BIM, I_CRE, I_CIM, I_D, I_WGLU, I_NCO, I_NSO, I_WOUT, I_NX, I_NM, I_WQ, I_WKV, I_WO, I_NMOE, I_WR, I_BR, I_WGU, I_BGU, I_WDN, I_BDN, I_NF };

__device__ __forceinline__ void tr_item(const float* W, int ldw, int k0, int n0, bf16_t* WT, int ldt, int drow0, int dk0, const float* scale, LAS float* scr, int lane) {
#pragma unroll 8
    for (int i = 0; i < 32; ++i) { const int kk = 2 * i + (lane >> 5); float v = W[(size_t)(k0 + kk) * ldw + n0 + (lane & 31)]; if (scale) v *= scale[k0 + kk]; scr[kk * 33 + (lane & 31)] = v; }
    asm volatile("s_waitcnt lgkmcnt(0)" ::: "memory");
    const int c = lane & 7;
#pragma unroll
    for (int j = 0; j < 4; ++j) { const int n = (lane >> 3) + 8 * j; const LAS float* s = scr + (8 * c) * 33 + n;
        u32x4 o; o.x = pk2(s[0 * 33], s[1 * 33]); o.y = pk2(s[2 * 33], s[3 * 33]); o.z = pk2(s[4 * 33], s[5 * 33]); o.w = pk2(s[6 * 33], s[7 * 33]);
        *(u32x4*)(WT + (size_t)(drow0 + n) * ldt + dk0 + 8 * c) = o; }
    asm volatile("s_waitcnt lgkmcnt(0)" ::: "memory");
}

__global__ void __launch_bounds__(NTHREADS, 2) mk_fwd(Args args) {
    extern __shared__ __attribute__((aligned(16))) unsigned char lds_raw[];
    LAS unsigned char* lds = (LAS unsigned char*)lds_raw;
    cg::grid_group grid = cg::this_grid();
    const int tid = threadIdx.x, lane = tid & 63, wave = __builtin_amdgcn_readfirstlane(tid >> 6);
    const int G = gridDim.x, bx = blockIdx.x;
    const int vcu = (G % 8 == 0) ? (bx % 8) * (G / 8) + bx / 8 : bx;
    unsigned char* ws = args.ws;
    const int lo = args.ph_lo, hi = args.ph_hi;
#ifndef PH_MASK
#define PH_MASK 0xfff
#endif
#define IN(k) (((PH_MASK >> (k)) & 1) && lo <= (k) && (k) < hi)
#define SEAM(k) do { if (IN(k) && IN((k) + 1)) grid.sync(); } while (0)
    const int gw = vcu * NWAVES + wave, NGW = G * NWAVES;
    int* counts = (int*)(ws + WS_CNT);
    float* rstd1 = (float*)(ws + WS_RSTD1); float* ssqs = (float*)(ws + WS_SSQS); float* ssq2 = (float*)(ws + WS_SSQ2); float* ssq3 = (float*)(ws + WS_SSQ3);
    float* gates = (float*)(ws + WS_GATES); float* wrs = (float*)(ws + WS_WR); int* tokl = (int*)(ws + WS_TOKL);
    bf16_t* xb = (bf16_t*)(ws + WS_XB); bf16_t* proj = (bf16_t*)(ws + WS_PROJ); bf16_t* ug = (bf16_t*)(ws + WS_UG); bf16_t* ycat = (bf16_t*)(ws + WS_YCAT);
    bf16_t* ygelu = (bf16_t*)(ws + WS_YGELU); float* x1 = (float*)(ws + WS_X1); bf16_t* xh = (bf16_t*)(ws + WS_XH); bf16_t* qo = (bf16_t*)(ws + WS_QO);
    bf16_t* pbuf = (bf16_t*)(ws + WS_PBUF); bf16_t* ob = (bf16_t*)(ws + WS_O); bf16_t* act = (bf16_t*)(ws + WS_ACT); bf16_t* slots = (bf16_t*)(ws + WS_SLOTS);
    bf16_t* memn = (bf16_t*)(ws + WS_MEMN); bf16_t* kmat = (bf16_t*)(ws + WS_KMAT); bf16_t* vt = (bf16_t*)(ws + WS_VT);

    if (IN(0)) {
        for (int i = bx * NTHREADS + tid; i < 3 * NTOK; i += G * NTHREADS) ssqs[i] = 0.f;
        if (bx == 0 && tid < NEXP) counts[tid] = 0;
        for (int i = bx * NTHREADS + tid; i < DM * NEXP; i += G * NTHREADS) wrs[i] = args.in[I_WR][i] * args.in[I_NMOE][i >> 5];
        for (int g = bx; g < 32; g += G) {
            LAS float* Wp = (LAS float*)lds;
            LAS float* Bb = Wp + 65 * 128;
            LAS float* Cc = Bb + 64 * 32;
            const float dt = __expf(args.in[I_LOGDT][g]);
            for (int i = tid; i < 65 * 64; i += NTHREADS) { const int p = i >> 6, j = i & 63; const float ar = args.in[I_ARE][g * 64 + j], aim = args.in[I_AIM][g * 64 + j];
                const float mag = expf((float)p * dt * ar); float sn, cs; sincosf((float)p * dt * aim, &sn, &cs); Wp[i * 2] = mag * cs; Wp[i * 2 + 1] = mag * sn; }
            for (int i = tid; i < 64 * 16; i += NTHREADS) { const int j = i >> 4; const float ar = args.in[I_ARE][g * 64 + j], aim = args.in[I_AIM][g * 64 + j];
                float sn, cs; sincosf(dt * aim, &sn, &cs); const float em1 = expm1f(dt * ar); float sh, ch; sincosf(0.5f * dt * aim, &sh, &ch);
                const float pre = em1 * cs - 2.0f * sh * sh, pim = (em1 + 1.0f) * sn, den = ar * ar + aim * aim;
                const float qre = (pre * ar + pim * aim) / den, qim = (pim * ar - pre * aim) / den;
                const float br = args.in[I_BRE][(size_t)g * 1024 + i], bi = args.in[I_BIM][(size_t)g * 1024 + i];
                Bb[i * 2] = qre * br - qim * bi; Bb[i * 2 + 1] = qre * bi + qim * br; }
            for (int i = tid; i < 16 * 64; i += NTHREADS) { Cc[i * 2] = args.in[I_CRE][(size_t)g * 1024 + i]; Cc[i * 2 + 1] = args.in[I_CIM][(size_t)g * 1024 + i]; }
            __syncthreads();
            unsigned char* tab = ws + WS_SSM + (size_t)g * SSM_STRIDE;
            if (tid < 64) { ((float*)tab)[tid * 2] = Wp[(64 * 64 + tid) * 2]; ((float*)tab)[tid * 2 + 1] = Wp[(64 * 64 + tid) * 2 + 1]; }
            bf16_t* Kt = (bf16_t*)(tab + SSM_KT); bf16_t* Pt = (bf16_t*)(tab + SSM_PT); bf16_t* Qt = (bf16_t*)(tab + SSM_QT);
            for (int i = tid; i < 64 * 256; i += NTHREADS) {
                const int lag = i >> 8, c = (i >> 4) & 15, cp = i & 15; float s = 0.f;
                for (int j = 0; j < 64; ++j) { const float wr_ = Wp[(lag * 64 + j) * 2], wi = Wp[(lag * 64 + j) * 2 + 1], cr = Cc[(c * 64 + j) * 2], ci = Cc[(c * 64 + j) * 2 + 1];
                    const float xr = cr * wr_ - ci * wi, xi = cr * wi + ci * wr_; s += xr * Bb[(j * 16 + cp) * 2] - xi * Bb[(j * 16 + cp) * 2 + 1]; }
                Kt[i] = (bf16_t)f2bf(s); }
            for (int i = tid; i < 128 * 1024; i += NTHREADS) {
                const int n = i >> 10, k = i & 1023, ri = n >> 6, j = n & 63, s = k >> 4, cp = k & 15;
                const float wr_ = Wp[((63 - s) * 64 + j) * 2], wi = Wp[((63 - s) * 64 + j) * 2 + 1], br = Bb[(j * 16 + cp) * 2], bi = Bb[(j * 16 + cp) * 2 + 1];
                Pt[i] = (bf16_t)f2bf(ri ? (wr_ * bi + wi * br) : (wr_ * br - wi * bi)); }
            for (int i = tid; i < 1024 * 128; i += NTHREADS) {
                const int tc = i >> 7, n = i & 127, t = tc >> 4, c = tc & 15, ri = n >> 6, j = n & 63;
                const float wr_ = Wp[((t + 1) * 64 + j) * 2], wi = Wp[((t + 1) * 64 + j) * 2 + 1], cr = Cc[(c * 64 + j) * 2], ci = Cc[(c * 64 + j) * 2 + 1];
                Qt[i] = (bf16_t)f2bf(ri ? -(cr * wi + ci * wr_) : (cr * wr_ - ci * wi)); }
            __syncthreads();
        }
        for (int m = gw; m < NTOK + NMEM; m += NGW) {
            const bool isx = m < NTOK; const int r = isx ? m : m - NTOK;
            const f32x4* xr = (const f32x4*)((isx ? args.in[I_X] : args.in[I_MEM]) + (size_t)r * DM) + lane;
            f32x4 v[4]; float ss = 0.f;
#pragma unroll
            for (int j = 0; j < 4; ++j) { v[j] = xr[64 * j]; ss += (v[j][0] * v[j][0] + v[j][1] * v[j][1]) + (v[j][2] * v[j][2] + v[j][3] * v[j][3]); }
            const float rs = rsqrtf(wave_sum(ss) * (1.f / DM) + EPS);
            u32x2* o8 = (u32x2*)((isx ? xb : memn) + (size_t)r * DM) + lane;
            if (isx) { if (lane == 0) rstd1[r] = rs;
#pragma unroll
                for (int j = 0; j < 4; ++j) o8[64 * j] = (u32x2){pk2(v[j][0], v[j][1]), pk2(v[j][2], v[j][3])}; }
            else {
#pragma unroll
                for (int j = 0; j < 4; ++j) { const f32x4 g = ((const f32x4*)args.in[I_NM])[lane + 64 * j]; o8[64 * j] = (u32x2){pk2(v[j][0] * rs * g[0], v[j][1] * rs * g[1]), pk2(v[j][2] * rs * g[2], v[j][3] * rs * g[3])}; } }
        }
        {
            __syncthreads();
            LAS float* scr = (LAS float*)(lds + wave * 16384);
            constexpr int I_IN = 16 * 64, I_GLU = 8 * 16, I_OUT = 16 * 32, I_Q = 16 * 32, I_KV = 16 * 64, I_O = 16 * 32, I_GU = 32 * 16 * 64, I_DN = 32 * 16 * 32;
            constexpr int NIT = I_IN + I_GLU + I_OUT + I_Q + I_KV + I_O + I_GU + I_DN;
            for (int it = gw; it < NIT; it += NGW) {
                int r = it;
                if (r < I_IN) { const int kb = r / 64, nb = r % 64; tr_item(args.in[I_WIN], 2048, kb * 64, nb * 32, (bf16_t*)(ws + WS_WIN), 1024, nb * 32, kb * 64, args.in[I_NMIX], scr, lane); continue; } r -= I_IN;
                if (r < I_GLU) { const int kb = r / 16, nb = r % 16; tr_item(args.in[I_WGLU], 512, kb * 64, nb * 32, (bf16_t*)(ws + WS_WGLU), 512, nb * 32, kb * 64, nullptr, scr, lane); continue; } r -= I_GLU;
                if (r < I_OUT) { const int kb = r / 32, nb = r % 32, k0 = kb * 64;
                    tr_item(args.in[I_WOUT], 1024, k0, nb * 32, (bf16_t*)(ws + WS_WOUT), 1024, nb * 32, (k0 + 512) & 1023, (k0 < 512) ? args.in[I_NCO] : args.in[I_NSO] - 512, scr, lane); continue; } r -= I_OUT;
                if (r < I_Q) { const int kb = r / 32, nb = r % 32; tr_item(args.in[I_WQ], 1024, kb * 64, nb * 32, (bf16_t*)(ws + WS_WQ), 1024, nb * 32, kb * 64, args.in[I_NX], scr, lane); continue; } r -= I_Q;
                if (r < I_KV) { const int kb = r / 64, nb = r % 64, n0 = nb * 32; tr_item(args.in[I_WKV], 2048, kb * 64, n0, (bf16_t*)(ws + (n0 < 1024 ? WS_WK : WS_WV)), 1024, n0 & 1023, kb * 64, nullptr, scr, lane); continue; } r -= I_KV;
                if (r < I_O) { const int kb = r / 32, nb = r % 32; tr_item(args.in[I_WO], 1024, kb * 64, nb * 32, (bf16_t*)(ws + WS_WO), 1024, nb * 32, kb * 64, nullptr, scr, lane); continue; } r -= I_O;
                if (r < I_GU) { const int e = r / 1024, q = r % 1024, kb = q / 64, nb = q % 64, n0 = nb * 32, j = n0 & 1023, lin = n0 >> 10;
                    tr_item(args.in[I_WGU] + (size_t)e * 1024 * 2048, 2048, kb * 64, n0, (bf16_t*)(ws + WS_WGU) + (size_t)e * 2048 * 1024, 1024, 256 * (j >> 7) + 128 * lin + (j & 127), kb * 64, args.in[I_NMOE], scr, lane); continue; } r -= I_GU;
                { const int e = r / 512, q = r % 512, kb = q / 32, nb = q % 32;
                    tr_item(args.in[I_WDN] + (size_t)e * 1024 * 1024, 1024, kb * 64, nb * 32, (bf16_t*)(ws + WS_WDN) + (size_t)e * 1024 * 1024, 1024, nb * 32, kb * 64, nullptr, scr, lane); }
            }
        }
    }
    SEAM(0);
    if (IN(1)) {
        SchedP1 S{(const char*)xb, (const char*)(ws + WS_WIN), (const char*)memn, (const char*)(ws + WS_WK), (const char*)(ws + WS_WV), 2048u, 2048u, 1024, G, bx};
        EpiP1 E{rstd1, proj, ug, kmat, vt};
        g8::gemm_phase(lds, S, E);
    }
    SEAM(1);
    if (IN(2)) {
        constexpr int L_KT = 0, L_SPV = 32768, L_UH = 49152, UROW = 1040, L_STG = 115712;
        const int l15 = lane & 15, lq = lane >> 4;
        for (int item = vcu; item < BATCH * 32; item += G) {
            const int b = item >> 5, g = item & 31;
            const bf16_t* ugp = ug + (size_t)item * SEQ * 16;
            const unsigned char* tab = ws + WS_SSM + (size_t)g * SSM_STRIDE;
            const float* A64 = (const float*)tab; const bf16_t* Kt = (const bf16_t*)(tab + SSM_KT); const bf16_t* Pt = (const bf16_t*)(tab + SSM_PT); const bf16_t* Qt = (const bf16_t*)(tab + SSM_QT);
#define STAGE_U(p) do { _Pragma("unroll") for (int _i = 0; _i < 8; ++_i) { const int _c = wave * 8 + _i; \
                const u32x4 _v = *(const u32x4*)(ugp + ((size_t)_c * 64 + 32 * (p)) * 16 + lane * 8); *(LAS u32x4*)(lds + L_UH + _c * UROW + lane * 16) = _v; } } while (0)
#define UFRAG(mb, kk) (*(const LAS bf16x8*)(lds + L_UH + (16 * (mb) + l15) * UROW + (32 * (kk) + 8 * lq) * 2))
            f32x4 sacc[4];
#pragma unroll
            for (int mb = 0; mb < 4; ++mb) sacc[mb] = (f32x4){0.f, 0.f, 0.f, 0.f};
#pragma unroll 1
            for (int p = 0; p < 2; ++p) {
                __syncthreads(); STAGE_U(p); __syncthreads();
#pragma unroll 1
                for (int kk = 0; kk < 16; ++kk) {
                    const bf16x8 bfr = *(const bf16x8*)(Pt + (size_t)(16 * wave + l15) * 1024 + 32 * (16 * p + kk) + 8 * lq);
#pragma unroll
                    for (int mb = 0; mb < 4; ++mb) sacc[mb] = __builtin_amdgcn_mfma_f32_16x16x32_bf16(UFRAG(mb, kk), bfr, sacc[mb], 0, 0, 0);
                }
            }
            { LAS float* Sl = (LAS float*)(lds + L_KT);
#pragma unroll
              for (int mb = 0; mb < 4; ++mb)
#pragma unroll
                for (int r = 0; r < 4; ++r) Sl[(16 * mb + 4 * lq + r) * 128 + 16 * wave + l15] = sacc[mb][r]; }
            __syncthreads();
            if (wave == 0) {
                const LAS float* Sl = (const LAS float*)(lds + L_KT); LAS bf16_t* Sp = (LAS bf16_t*)(lds + L_SPV);
                const float ar = A64[lane * 2], ai = A64[lane * 2 + 1]; float sr = 0.f, si = 0.f;
#pragma unroll 2
                for (int c = 0; c < 64; ++c) { Sp[c * 128 + lane] = (bf16_t)f2bf(sr); Sp[c * 128 + 64 + lane] = (bf16_t)f2bf(si);
                    const float lr = Sl[c * 128 + lane], li = Sl[c * 128 + 64 + lane]; const float nr = ar * sr - ai * si + lr, ni = ar * si + ai * sr + li; sr = nr; si = ni; }
            }
            __syncthreads();
            { const u32x4* src = (const u32x4*)Kt;
#pragma unroll
              for (int i = 0; i < 4; ++i) *(LAS u32x4*)(lds + L_KT + (tid + i * NTHREADS) * 16) = src[tid + i * NTHREADS]; }
            __syncthreads();
            const f32x4 dv4 = *(const f32x4*)(args.in[I_D] + g * 16 + (lane & 3) * 4);
#pragma unroll 1
            for (int ig = 1; ig >= 0; --ig) {
                f32x4 acc[4][4];
#pragma unroll
                for (int i = 0; i < 4; ++i)
#pragma unroll
                    for (int mb = 0; mb < 4; ++mb) acc[i][mb] = (f32x4){0.f, 0.f, 0.f, 0.f};
                const int tb0 = wave + 32 * ig, tmax = tb0 + 24;
#pragma unroll 1
                for (int p = ig; p >= 0; --p) {
                    if (ig == 1 && p == 0) { __syncthreads(); STAGE_U(0); __syncthreads(); }
#pragma unroll 1
                    for (int kk = 0; kk < 16; ++kk) {
                        const int s0 = 32 * p + 2 * kk; if (s0 > tmax) break;
                        bf16x8 af[4];
#pragma unroll
                        for (int mb = 0; mb < 4; ++mb) af[mb] = UFRAG(mb, kk);
                        const int s = s0 + (lq >> 1);
#pragma unroll
                        for (int i = 0; i < 4; ++i) { const int t = tb0 + 8 * i;
                            if (t >= s0) { const int lag = t - s; bf16x8 bfr = *(const LAS bf16x8*)(lds + L_KT + (((lag < 0 ? 0 : lag) * 16 + l15) * 16 + 8 * (lq & 1)) * 2);
                                if (lag < 0) bfr = (bf16x8){0, 0, 0, 0, 0, 0, 0, 0};
#pragma unroll
                                for (int mb = 0; mb < 4; ++mb) acc[i][mb] = __builtin_amdgcn_mfma_f32_16x16x32_bf16(af[mb], bfr, acc[i][mb], 0, 0, 0); } }
                    }
                }
#pragma unroll 1
                for (int kq = 0; kq < 4; ++kq) {
                    bf16x8 af[4];
#pragma unroll
                    for (int mb = 0; mb < 4; ++mb) af[mb] = *(const LAS bf16x8*)(lds + L_SPV + ((16 * mb + l15) * 128 + 32 * kq + 8 * lq) * 2);
#pragma unroll
                    for (int i = 0; i < 4; ++i) { const int t = tb0 + 8 * i; const bf16x8 bfr = *(const bf16x8*)(Qt + (size_t)(t * 16 + l15) * 128 + 32 * kq + 8 * lq);
#pragma unroll
                        for (int mb = 0; mb < 4; ++mb) acc[i][mb] = __builtin_amdgcn_mfma_f32_16x16x32_bf16(af[mb], bfr, acc[i][mb], 0, 0, 0); }
                }
                LAS float* stg = (LAS float*)(lds + L_STG + wave * 2048);
#pragma unroll
                for (int i = 0; i < 4; ++i) { const int t = tb0 + 8 * i;
#pragma unroll
                    for (int hf = 0; hf < 2; ++hf) {
#pragma unroll
                        for (int ml = 0; ml < 2; ++ml)
#pragma unroll
                            for (int r = 0; r < 4; ++r) stg[(16 * ml + 4 * lq + r) * 16 + l15] = acc[i][2 * hf + ml][r];
                        asm volatile("s_waitcnt lgkmcnt(0)" ::: "memory");
#pragma unroll
                        for (int it = 0; it < 2; ++it) { const int idx = it * 64 + lane, tt = (32 * hf + (idx >> 2)) * 64 + t, c4 = (idx & 3) * 4;
                            const f32x4 yv = *(const LAS f32x4*)(stg + idx * 4); const u32x2 uu = *(const u32x2*)(ugp + (size_t)tt * 16 + c4);
                            const float y0 = gelu_tanh(yv[0] + dv4[0] * bflo(uu.x)), y1 = gelu_tanh(yv[1] + dv4[1] * bfhi(uu.x)), y2 = gelu_tanh(yv[2] + dv4[2] * bflo(uu.y)), y3 = gelu_tanh(yv[3] + dv4[3] * bfhi(uu.y));
                            *(u32x2*)(ygelu + (size_t)(b * SEQ + tt) * 512 + g * 16 + c4) = (u32x2){pk2(y0, y1), pk2(y2, y3)}; }
                        asm volatile("s_waitcnt lgkmcnt(0)" ::: "memory");
                    }
                }
            }
#undef STAGE_U
#undef UFRAG
        }
        {
            const int ch = lane * 8;
            float w0[8], w1[8], w2[8];
#pragma unroll
            for (int i = 0; i < 8; ++i) { w0[i] = args.in[I_CONVW][ch + i]; w1[i] = args.in[I_CONVW][512 + ch + i]; w2[i] = args.in[I_CONVW][1024 + ch + i]; }
            for (int run = gw; run < NTOK / 16; run += NGW) {
                const int r0 = run * 16, tin = r0 & (SEQ - 1);
                float vm2[8], vm1[8];
#pragma unroll
                for (int i = 0; i < 8; ++i) { vm2[i] = 0.f; vm1[i] = 0.f; }
                if (tin > 0) {
#pragma unroll
                    for (int d = 2; d >= 1; --d) { const bf16_t* pr = proj + (size_t)(r0 - d) * 1536;
                        const u32x4 c4 = *(const u32x4*)(pr + 512 + ch), x4 = *(const u32x4*)(pr + 1024 + ch);
                        float v[8]; v[0] = bflo(c4.x) * bflo(x4.x); v[1] = bfhi(c4.x) * bfhi(x4.x); v[2] = bflo(c4.y) * bflo(x4.y); v[3] = bfhi(c4.y) * bfhi(x4.y);
                        v[4] = bflo(c4.z) * bflo(x4.z); v[5] = bfhi(c4.z) * bfhi(x4.z); v[6] = bflo(c4.w) * bflo(x4.w); v[7] = bfhi(c4.w) * bfhi(x4.w);
#pragma unroll
                        for (int i = 0; i < 8; ++i) { if (d == 2) vm2[i] = v[i]; else vm1[i] = v[i]; } }
                }
#pragma unroll 2
                for (int tt = 0; tt < 16; ++tt) {
                    const bf16_t* pr = proj + (size_t)(r0 + tt) * 1536;
                    const u32x4 b4 = *(const u32x4*)(pr + ch), c4 = *(const u32x4*)(pr + 512 + ch), x4 = *(const u32x4*)(pr + 1024 + ch);
                    float v[8], bgv[8], y[8]; v[0] = bflo(c4.x) * bflo(x4.x); v[1] = bfhi(c4.x) * bfhi(x4.x); v[2] = bflo(c4.y) * bflo(x4.y); v[3] = bfhi(c4.y) * bfhi(x4.y);
                    v[4] = bflo(c4.z) * bflo(x4.z); v[5] = bfhi(c4.z) * bfhi(x4.z); v[6] = bflo(c4.w) * bflo(x4.w); v[7] = bfhi(c4.w) * bfhi(x4.w);
                    bgv[0] = bflo(b4.x); bgv[1] = bfhi(b4.x); bgv[2] = bflo(b4.y); bgv[3] = bfhi(b4.y); bgv[4] = bflo(b4.z); bgv[5] = bfhi(b4.z); bgv[6] = bflo(b4.w); bgv[7] = bfhi(b4.w);
                    float ss = 0.f;
#pragma unroll
                    for (int i = 0; i < 8; ++i) { y[i] = bgv[i] * (w0[i] * vm2[i] + w1[i] * vm1[i] + w2[i] * v[i]); ss += y[i] * y[i]; vm2[i] = vm1[i]; vm1[i] = v[i]; }
                    const float rs = rsqrtf(wave_sum(ss) * (1.f / 512.f) + EPS);
                    u32x4 o; o.x = pk2(y[0] * rs, y[1] * rs); o.y = pk2(y[2] * rs, y[3] * rs); o.z = pk2(y[4] * rs, y[5] * rs); o.w = pk2(y[6] * rs, y[7] * rs);
                    *(u32x4*)(ycat + (size_t)(r0 + tt) * 1024 + 512 + ch) = o;
                }
            }
        }
    }
    SEAM(2);
    if (IN(3)) {
        SchedDense S{(const char*)ygelu, (const char*)(ws + WS_WGLU), 1024u, 1024u, 512, NTOK / 256, 2, G, bx};
        EpiGlu E{ygelu, ycat, ssqs};
        g8::gemm_phase(lds, S, E);
    }
    SEAM(3);
    if (IN(4)) {
        SchedDense S{(const char*)ycat, (const char*)(ws + WS_WOUT), 2048u, 2048u, 1024, NTOK / 256, 4, G, bx};
        EpiRes E{args.in[I_X], x1, xh, ssq2, ssqs, 6};
        g8::gemm_phase(lds, S, E);
    }
    SEAM(4);
    if (IN(5)) {
        SchedDense S{(const char*)xh, (const char*)(ws + WS_WQ), 2048u, 2048u, 1024, NTOK / 256, 4, G, bx};
        EpiQ E{ssq2, qo};
        g8::gemm_phase(lds, S, E);
    }
    SEAM(5);
    if (IN(6)) {
        SchedAttn S{(const char*)qo, (const char*)kmat, (const char*)vt, (const char*)pbuf, 512u, 512u, 256, G, bx, (BATCH * 4 * 16) / G};
        EpiAttn E{pbuf, ob, bx};
        g8::gemm_phase(lds, S, E);
    }
    SEAM(6);
    if (IN(7)) {
        SchedDense S{(const char*)ob, (const char*)(ws + WS_WO), 2048u, 2048u, 1024, NTOK / 256, 4, G, bx};
        EpiRes E{x1, args.out, xh, ssq3, ssqs, -1};
        g8::gemm_phase(lds, S, E);
    }
    SEAM(7);
    if (IN(8)) {
        LAS float* Xs = (LAS float*)lds;
        LAS float* Ws = (LAS float*)(lds + 34816);
        LAS float* Lg = (LAS float*)(lds + 43008);
        LAS int* hist = (LAS int*)(lds + 59904);
        LAS int* hbase = (LAS int*)(lds + 60032);
        const int tx = tid & 7, ty = tid >> 3;
        for (int blk = vcu; blk < NTOK / 128; blk += G) {
            const int r0 = blk * 128;
            float ac[2][4];
#pragma unroll
            for (int a = 0; a < 2; ++a)
#pragma unroll
                for (int e = 0; e < 4; ++e) ac[a][e] = 0.f;
            if (tid < 32) hist[tid] = 0;
            for (int kc = 0; kc < 16; ++kc) {
                __syncthreads();
#pragma unroll
                for (int j = 0; j < 4; ++j) { const int row = (tid >> 4) + 32 * j, c4 = tid & 15;
                    *(LAS f32x4*)(Xs + row * 68 + 4 * c4) = *(const f32x4*)(args.out + (size_t)(r0 + row) * DM + kc * 64 + 4 * c4); }
                *(LAS f32x4*)(Ws + (tid >> 3) * 32 + 4 * (tid & 7)) = *(const f32x4*)(wrs + (size_t)(kc * 64 + (tid >> 3)) * 32 + 4 * (tid & 7));
                __syncthreads();
#pragma unroll 4
                for (int k4 = 0; k4 < 16; ++k4) {
                    const f32x4 x0 = *(const LAS f32x4*)(Xs + (2 * ty) * 68 + 4 * k4), x1v = *(const LAS f32x4*)(Xs + (2 * ty + 1) * 68 + 4 * k4);
#pragma unroll
                    for (int kk = 0; kk < 4; ++kk) { const f32x4 w = *(const LAS f32x4*)(Ws + (4 * k4 + kk) * 32 + 4 * tx);
#pragma unroll
                        for (int e = 0; e < 4; ++e) { ac[0][e] += x0[kk] * w[e]; ac[1][e] += x1v[kk] * w[e]; } }
                }
            }
#pragma unroll
            for (int a = 0; a < 2; ++a) { const int row = r0 + 2 * ty + a; const float rs = rsqrtf(ssq3[row] * (1.0f / 1024.0f) + EPS);
#pragma unroll
                for (int e = 0; e < 4; ++e) Lg[(2 * ty + a) * 33 + 4 * tx + e] = ac[a][e] * rs + args.in[I_BR][4 * tx + e]; }
            __syncthreads();
            int ei[4], lp[4]; float gv[4];
            if (tid < 128) {
                unsigned taken = 0u; float tv[4];
#pragma unroll
                for (int k = 0; k < 4; ++k) { float best = -3.0e38f; int bi = 0;
                    for (int e = 0; e < 32; ++e) { const float v = Lg[tid * 33 + e]; if (!((taken >> e) & 1u) && v > best) { best = v; bi = e; } }
                    taken |= 1u << bi; ei[k] = bi; tv[k] = best; }
                float sum = 0.f;
#pragma unroll
                for (int k = 0; k < 4; ++k) { gv[k] = __expf(tv[k] - tv[0]); sum += gv[k]; }
                const float inv = 1.0f / sum;
#pragma unroll
                for (int k = 0; k < 4; ++k) { gv[k] *= inv; lp[k] = __hip_atomic_fetch_add((LAS int*)(hist + ei[k]), 1, __ATOMIC_RELAXED, __HIP_MEMORY_SCOPE_WORKGROUP); }
            }
            __syncthreads();
            if (tid < 32) hbase[tid] = atomicAdd(counts + tid, hist[tid]);
            __syncthreads();
            if (tid < 128) {
                const int tok = r0 + tid;
#pragma unroll
                for (int k = 0; k < 4; ++k) { tokl[(size_t)ei[k] * ECAP + hbase[ei[k]] + lp[k]] = tok * 4 + k; gates[tok * 4 + k] = gv[k]; }
            }
            __syncthreads();
        }
    }
    SEAM(8);
    if (IN(9) || IN(10)) {
        LAS int* tb = (LAS int*)(lds + XL_OFF + XL_TB); LAS int* cn = (LAS int*)(lds + XL_OFF + XL_CNT);
        __syncthreads();
        if (tid == 0) { int a = 0; for (int e = 0; e < NEXP; ++e) { const int c = ald(counts + e); cn[e] = c; tb[e] = a; a += (c + 255) >> 8; } tb[NEXP] = a; }
        __syncthreads();
        if (IN(9)) {
            SchedMoeT<true> S; S.tb = tb; S.cnt = cn; S.tokl = tokl; S.A = (const char*)xh; S.B = (const char*)(ws + WS_WGU); S.lda2 = 2048u; S.ldb2 = 2048u; S.K = 1024; S.nN = 8; S.G = G; S.c = bx; S.bstride = (size_t)2048 * 1024 * 2; S.gather = true;
            EpiMoe1 E{tokl, ssq3, args.in[I_BGU], act};
            g8::gemm_phase(lds, S, E);
        }
    }
    SEAM(9);
    if (IN(10)) {
        LAS int* tb = (LAS int*)(lds + XL_OFF + XL_TB); LAS int* cn = (LAS int*)(lds + XL_OFF + XL_CNT);
        SchedMoeT<false> S; S.tb = tb; S.cnt = cn; S.tokl = tokl; S.A = (const char*)act; S.B = (const char*)(ws + WS_WDN); S.lda2 = 2048u; S.ldb2 = 2048u; S.K = 1024; S.nN = 4; S.G = G; S.c = bx; S.bstride = (size_t)1024 * 1024 * 2; S.gather = false;
        EpiMoe2 E{tokl, gates, args.in[I_BDN], slots};
        g8::gemm_phase(lds, S, E);
    }
    SEAM(10);
    if (IN(11)) {
        const float* xsrc = (DBG_OUT == 1) ? x1 : args.out;
        for (int m = gw; m < NTOK; m += NGW) {
            const f32x4* xr = (const f32x4*)(xsrc + (size_t)m * DM) + lane;
            f32x4 v[4];
#pragma unroll
            for (int j = 0; j < 4; ++j) v[j] = xr[64 * j];
            if (DBG_OUT == 0) {
#pragma unroll
                for (int k = 0; k < 4; ++k) { const u32x2* sr = (const u32x2*)(slots + (size_t)(m * 4 + k) * DM) + lane;
#pragma unroll
                    for (int j = 0; j < 4; ++j) { const u32x2 w = sr[64 * j]; v[j][0] += bflo(w.x); v[j][1] += bfhi(w.x); v[j][2] += bflo(w.y); v[j][3] += bfhi(w.y); } }
            }
            float ss = 0.f;
#pragma unroll
            for (int j = 0; j < 4; ++j) ss += (v[j][0] * v[j][0] + v[j][1] * v[j][1]) + (v[j][2] * v[j][2] + v[j][3] * v[j][3]);
            const float rs = rsqrtf(wave_sum(ss) * (1.f / DM) + EPS);
            f32x4* o = (f32x4*)(args.out + (size_t)m * DM) + lane;
#pragma unroll
            for (int j = 0; j < 4; ++j) { const f32x4 g = ((const f32x4*)args.in[I_NF])[lane + 64 * j]; o[64 * j] = v[j] * rs * g; }
        }
    }
#undef IN
#undef SEAM
}

extern "C" void kernel_launch(void* const* d_in, const int* in_sizes, int n_in, void* d_out, int out_size, void* d_ws, size_t ws_size, hipStream_t stream) {
    static int grid = 0;
    if (grid == 0) {
        if (n_in != 30 || in_sizes[0] != NTOK * DM || out_size != NTOK * DM || ws_size < WS_END) { fprintf(stderr, "kernel_launch: unexpected shapes (n_in %d, in0 %d, out %d, ws %zu < %zu); nothing launched\n", n_in, n_in > 0 ? in_sizes[0] : -1, out_size, ws_size, (size_t)WS_END); grid = -1; return; }
        int dev = 0, cus = 0, per_cu = 0;
        if (hipGetDevice(&dev) != hipSuccess || hipDeviceGetAttribute(&cus, hipDeviceAttributeMultiprocessorCount, dev) != hipSuccess) { grid = -1; return; }
        if (hipFuncSetAttribute((const void*)mk_fwd, hipFuncAttributeMaxDynamicSharedMemorySize, LDS_BYTES) != hipSuccess) { fprintf(stderr, "kernel_launch: hipFuncSetAttribute failed\n"); grid = -1; return; }
        if (hipOccupancyMaxActiveBlocksPerMultiprocessor(&per_cu, (const void*)mk_fwd, NTHREADS, LDS_BYTES) != hipSuccess || per_cu < 1) { fprintf(stderr, "kernel_launch: occupancy query says %d blocks per CU\n", per_cu); per_cu = 1; }
        (void)hipGetLastError();
        grid = cus;
        if (grid != 256) fprintf(stderr, "kernel_launch: %d CUs; the attention phase assumes 256\n", grid);
    }
    if (grid < 0) return;
    Args a{};
    for (int i = 0; i < 30; ++i) a.in[i] = (const float*)d_in[i];
    a.out = (float*)d_out; a.ws = (unsigned char*)d_ws;
#if MK_PER_PHASE
    for (int ph = 0; ph < 12; ++ph) { a.ph_lo = ph; a.ph_hi = ph + 1; hipLaunchKernelGGL(mk_fwd, dim3(grid), dim3(NTHREADS), LDS_BYTES, stream, a); }
#else
    a.ph_lo = 0; a.ph_hi = 12;
    void* kargs[] = {&a};
    hipError_t e = hipLaunchCooperativeKernel((const void*)mk_fwd, dim3(grid), dim3(NTHREADS), kargs, LDS_BYTES, stream);
    if (e != hipSuccess) fprintf(stderr, "kernel_launch: cooperative launch failed: %s (grid %d)\n", hipGetErrorString(e), grid);
#endif
}
```

```cpp
#include <hip/hip_runtime.h>
#include <hip/hip_cooperative_groups.h>
#include <cstdio>
#include <cstdint>
#include <cmath>
namespace cg = cooperative_groups;

#ifndef MK_PER_PHASE
#define MK_PER_PHASE 0
#endif
#ifndef MK_USE_CG
#define MK_USE_CG 0
#endif
#ifndef PROBE_PHASE
#define PROBE_PHASE -1
#endif
#ifndef PROBE_EPI
#define PROBE_EPI -1
#endif
#ifndef PROBE_A
#define PROBE_A -1
#define PROBE_B -1
#endif
#ifndef PROBE_MULT
#define PROBE_MULT 1
#endif
#ifndef DBG_OUT
#define DBG_OUT 0
#endif

#define LAS __attribute__((address_space(3)))
typedef unsigned short bf16_t;
typedef short bf16x8 __attribute__((ext_vector_type(8)));
typedef float f32x4 __attribute__((ext_vector_type(4)));
typedef float f32x2 __attribute__((ext_vector_type(2)));
typedef unsigned u32x4 __attribute__((ext_vector_type(4)));
typedef unsigned u32x2 __attribute__((ext_vector_type(2)));
typedef int i32x4 __attribute__((ext_vector_type(4)));
typedef int i32x8 __attribute__((ext_vector_type(8)));

constexpr int NTHREADS = 512, NWAVES = 8;
constexpr int DM = 1024, BATCH = 8, SEQ = 4096, NTOK = BATCH * SEQ, MEMLEN = 256, NMEM = BATCH * MEMLEN;
constexpr int NEXP = 32, TOPK = 4, ECAP = NTOK;
constexpr int MAXTILES = (NTOK * TOPK) / 256 + NEXP;
constexpr float EPS = 1e-5f;
constexpr float X8S = 16.0f, W8S = 256.0f, A8S = 4.0f, O8S = 64.0f, S8S = 32.0f;

constexpr size_t MiB = 1u << 20;
constexpr size_t WS_CNT = 0;
constexpr size_t WS_BAR = 256 * 1024, BAR_ZERO_BYTES = 16 * 1024;
constexpr size_t WS_STAMP = 512 * 1024;
constexpr size_t WS_RSTD1 = 1 * MiB;
constexpr size_t WS_SSQS = WS_RSTD1 + 128 * 1024;
constexpr size_t WS_SSQ2 = WS_SSQS + 128 * 1024;
constexpr size_t WS_SSQ3 = WS_SSQ2 + 128 * 1024;
constexpr size_t WS_GATES = 2 * MiB;
constexpr size_t WS_WR = 3 * MiB;
constexpr size_t WS_TOKL = 4 * MiB;
constexpr size_t WS_SSM = 8 * MiB;
constexpr size_t SSM_STRIDE = 576 * 1024, SSM_KT = 1024, SSM_PT = 64 * 1024, SSM_QT = 320 * 1024;
constexpr size_t WS_WIN = 26 * MiB, WS_WGLU = 30 * MiB, WS_WOUT = 31 * MiB, WS_WQ = 33 * MiB, WS_WK = 35 * MiB, WS_WV = 37 * MiB, WS_WO = 39 * MiB;
constexpr size_t WS_MEMN = 41 * MiB, WS_KMAT = 45 * MiB, WS_VT = 49 * MiB;
constexpr size_t WS_WGU = 56 * MiB, WS_WDN = 184 * MiB;
constexpr size_t WS_YGELU = 248 * MiB;
constexpr size_t WS_X1 = 280 * MiB;
constexpr size_t WS_ACT = 408 * MiB;
constexpr size_t WS_XB = 408 * MiB, WS_PROJ = 472 * MiB, WS_UG = 568 * MiB, WS_YCAT = 600 * MiB;
constexpr size_t WS_SLOTS = 680 * MiB;
constexpr size_t WS_XH = 312 * MiB  , WS_QO = 744 * MiB, WS_PBUF = 808 * MiB, WS_O = 872 * MiB;
constexpr size_t WS_GATEL = 936 * MiB, WS_RSTDL = 940 * MiB;
constexpr size_t WS_END = 944 * MiB;

constexpr int LDS_BYTES = 147456;
constexpr int XL_OFF = 131072;
constexpr int XL_PMAX = 0, XL_PSUM = 4096, XL_TB = 12288, XL_CNT = 12544, XL_MISC = 13312;

__device__ __forceinline__ float wave_sum(float v) {
#pragma unroll
    for (int o = 1; o < 64; o <<= 1) v += __shfl_xor(v, o);
    return v;
}
__device__ __forceinline__ unsigned f2bf(float f) { unsigned u = __builtin_bit_cast(unsigned, f); return (u + 0x7fffu + ((u >> 16) & 1u)) >> 16; }
__device__ __forceinline__ unsigned pk2(float lo, float hi) { return f2bf(lo) | (f2bf(hi) << 16); }
__device__ __forceinline__ unsigned cvt_pk_bf16(float lo, float hi) { unsigned r; asm volatile("v_cvt_pk_bf16_f32 %0, %1, %2" : "=v"(r) : "v"(lo), "v"(hi)); return r; }
__device__ __forceinline__ unsigned pk4_fp8(float a, float b, float c, float d) { int w = __builtin_amdgcn_cvt_pk_fp8_f32(a, b, 0, false); w = __builtin_amdgcn_cvt_pk_fp8_f32(c, d, w, true); return (unsigned)w; }
__device__ __forceinline__ float clamp448(float v) { return __builtin_amdgcn_fmed3f(v, -448.0f, 448.0f); }
__device__ __forceinline__ float bflo(unsigned w) { return __builtin_bit_cast(float, w << 16); }
__device__ __forceinline__ float bfhi(unsigned w) { return __builtin_bit_cast(float, w & 0xffff0000u); }
__device__ __forceinline__ float bf2f(bf16_t b) { return __builtin_bit_cast(float, (unsigned)b << 16); }
__device__ __forceinline__ float sigmoidf_(float x) { return __builtin_amdgcn_rcpf(1.0f + __builtin_amdgcn_exp2f(-1.4426950408889634f * x)); }
__device__ __forceinline__ f32x2 sigmoid2(f32x2 x) { f32x2 e = x * -1.4426950408889634f; e[0] = __builtin_amdgcn_exp2f(e[0]); e[1] = __builtin_amdgcn_exp2f(e[1]); f32x2 d = e + 1.0f; d[0] = __builtin_amdgcn_rcpf(d[0]); d[1] = __builtin_amdgcn_rcpf(d[1]); return d; }
__device__ __forceinline__ f32x2 gelu_tanh2(f32x2 y) { const f32x2 t = (y * y * 0.044715f + 1.0f) * y * (2.0f * 0.7978845608028654f); return y * sigmoid2(t); }
__device__ __forceinline__ float gelu_tanh(float y) { const float t = 0.7978845608028654f * (y + 0.044715f * y * y * y); return y * sigmoidf_(2.0f * t); }
__device__ __forceinline__ int ald(const int* p) { return __hip_atomic_load(p, __ATOMIC_RELAXED, __HIP_MEMORY_SCOPE_AGENT); }

namespace g8 {
constexpr int BM = 256, BK = 64, HALF = 128, HTB = HALF * BK * 2, NXCD = 8, WGM = 8;
__device__ __forceinline__ int lds_byte(int r, int c) { const int st = (r >> 4) * 2 + (c >> 5), rr = r & 15, cc = c & 31, ob = rr * 64 + cc * 2; return st * 1024 + (ob ^ (((ob >> 9) & 1) << 5)); }
__device__ __forceinline__ void stage_rc(int b, int& R, int& C) { const int st = b / 1024, sb = b % 1024, swz = sb ^ (((sb >> 9) & 1) << 5); R = (st >> 1) * 16 + swz / 64; C = (st & 1) * 32 + (swz % 64) / 2; }
__device__ __forceinline__ int perm32(int rho) { const int n = rho >> 4, i = rho & 15; return 8 * (i >> 2) + 4 * n + (i & 3); }

struct Unit { const char* A; const char* B; int pm, pn, e, aux, valid, job; };

__device__ __forceinline__ bool tile_order(int i, int G, int c, int nM, int nN, int& pm, int& pn) {
    const int nwg = nM * nN; const long L = (long)i * G + c; if (L >= nwg) return false;
    int wgid = (int)L; { const int q = nwg / NXCD, r = nwg % NXCD, xcd = wgid % NXCD, off = wgid / NXCD; wgid = (xcd < r ? xcd * (q + 1) : r * (q + 1) + (xcd - r) * q) + off; }
    const int nig = WGM * nN, gid = wgid / nig, fm = gid * WGM, gsz = (nM - fm) < WGM ? (nM - fm) : WGM;
    pm = fm + ((wgid % nig) % gsz); pn = (wgid % nig) / gsz; return true;
}

__device__ __forceinline__ int lane_id_volatile() { int l; asm volatile("v_mbcnt_lo_u32_b32 %0, -1, 0\n\tv_mbcnt_hi_u32_b32 %0, -1, %0" : "=v"(l)); return l; }
template <class Epi, class Sched>
__device__ __forceinline__ void gemm_phase(LAS unsigned char* lds, const Sched& S, const Epi& E, const int wid) {
    const int lane = lane_id_volatile(), tid = wid * 64 + lane, wr = wid >> 2, wc = wid & 3, fr = lane & 15, fq = lane >> 4;
    const int K = S.K, nt = K / BK;
    const unsigned lda2 = S.lda2, ldb2 = S.ldb2;
    unsigned voffB0, cb0;
    { int R, C; stage_rc(tid * 16, R, C); cb0 = (unsigned)C * 2u; const int Rb = (R & ~31) + perm32(R & 31); voffB0 = (unsigned)Rb * ldb2 + cb0; }
    const size_t pstepA = (size_t)64 * lda2, pstepB = (size_t)64 * ldb2, hstepA = (size_t)HALF * lda2;
    const size_t kstep = (size_t)(BK * 2);
    const size_t hstepB = (size_t)HALF * ldb2;
    const unsigned ldsw = (unsigned)wid * 1024u;
    const int aoff = lds_byte(wr * 64 + fr, fq * 8), boff = lds_byte(wc * 32 + fr, fq * 8);
#define G8_SA(b, h) (((b) * 2 + (h)) * HTB)
#define G8_SB(b, h) ((4 + (b) * 2 + (h)) * HTB)
#define G8_STAGE_B(bufoff, gbase) do { _Pragma("unroll") for (int _i = 0; _i < 2; ++_i) \
        __builtin_amdgcn_global_load_lds((const unsigned*)((const char*)(gbase) + _i * pstepB + voffB0), (LAS unsigned*)(lds + (bufoff) + ldsw + _i * 8192), 16, 0, 0); } while (0)
#define G8_STAGE_A(bufoff, gbase, o0, o1) do { \
        __builtin_amdgcn_global_load_lds((const unsigned*)((const char*)(gbase) + (o0)), (LAS unsigned*)(lds + (bufoff) + ldsw), 16, 0, 0); \
        __builtin_amdgcn_global_load_lds((const unsigned*)((const char*)(gbase) + (o1)), (LAS unsigned*)(lds + (bufoff) + ldsw + 8192), 16, 0, 0); } while (0)
#define G8_LDA(dst, b, h) do { _Pragma("unroll") for (int m = 0; m < 4; ++m) _Pragma("unroll") for (int k = 0; k < 2; ++k) dst[m][k] = *(const LAS bf16x8*)(lds + G8_SA(b, h) + aoff + m * 2048 + k * 1024); } while (0)
#define G8_LDB(dst, b, h) do { _Pragma("unroll") for (int n = 0; n < 2; ++n) _Pragma("unroll") for (int k = 0; k < 2; ++k) dst[n][k] = *(const LAS bf16x8*)(lds + G8_SB(b, h) + boff + n * 2048 + k * 1024); } while (0)
#define G8_MMA(ai, bj, At, Bt) do { __builtin_amdgcn_s_setprio(1); _Pragma("unroll") for (int m = 0; m < 4; ++m) _Pragma("unroll") for (int n = 0; n < 2; ++n) _Pragma("unroll") for (int k = 0; k < 2; ++k) \
        acc[ai][bj][m][n] = __builtin_amdgcn_mfma_f32_16x16x32_bf16(Bt[n][k], At[m][k], acc[ai][bj][m][n], 0, 0, 0); __builtin_amdgcn_s_setprio(0); } while (0)
#define G8_RD16(off) __builtin_bit_cast(i32x4, *(const LAS bf16x8*)(lds + (off)))
#define G8_LDA8(dst, b, h) do { _Pragma("unroll") for (int m = 0; m < 4; ++m) dst[m] = __builtin_shufflevector(G8_RD16(G8_SA(b, h) + aoff + m * 2048), G8_RD16(G8_SA(b, h) + aoff + m * 2048 + 1024), 0, 1, 2, 3, 4, 5, 6, 7); } while (0)
#define G8_LDB8(dst, b, h) do { _Pragma("unroll") for (int n = 0; n < 2; ++n) dst[n] = __builtin_shufflevector(G8_RD16(G8_SB(b, h) + boff + n * 2048), G8_RD16(G8_SB(b, h) + boff + n * 2048 + 1024), 0, 1, 2, 3, 4, 5, 6, 7); } while (0)
#define G8_MMA8(ai, bj, At, Bt) do { __builtin_amdgcn_s_setprio(1); _Pragma("unroll") for (int m = 0; m < 4; ++m) _Pragma("unroll") for (int n = 0; n < 2; ++n) \
        asm volatile("s_nop 1\n\tv_mfma_scale_f32_16x16x128_f8f6f4 %0, %1, %2, %0, %3, %3 op_sel_hi:[0,0,0]" : "+v"(acc[ai][bj][m][n]) : "v"(Bt[n]), "v"(At[m]), "v"(scl8)); __builtin_amdgcn_s_setprio(0); } while (0)
#define G8_MM(ai, bj, X) do { if constexpr (Sched::FP8) G8_MMA8(ai, bj, At8, X##8); else G8_MMA(ai, bj, At, X); } while (0)
#define G8_LA(b, h) do { if constexpr (Sched::FP8) G8_LDA8(At8, b, h); else G8_LDA(At, b, h); } while (0)
#define G8_LB(X, b, h) do { if constexpr (Sched::FP8) G8_LDB8(X##8, b, h); else G8_LDB(X, b, h); } while (0)
#define G8_WAIT_V(n) asm volatile("s_waitcnt vmcnt(" #n ")" ::: "memory")
#define G8_WAIT_L(n) asm volatile("s_waitcnt lgkmcnt(" #n ")" ::: "memory")
#define G8_BAR __builtin_amdgcn_s_barrier()
#define G8_SCHED __builtin_amdgcn_sched_barrier(0)
#define G8_SETOFF(o, u) do { const int _t = wid * 64 + lane_id_volatile(); _Pragma("unroll") for (int _i = 0; _i < 2; ++_i) { int _R, _C; stage_rc(_t * 16 + _i * 8192, _R, _C); \
        _Pragma("unroll") for (int _h = 0; _h < 2; ++_h) { if (Sched::GATHER) { const unsigned _tk = S.arow_tok(u, _h * HALF + _R); if (_i == 0) o[_h][0] = _tk; else o[_h][0] |= _tk << 16; } \
            else if (_h == 0 && _i == 0) o[0][0] = (unsigned)_R * lda2 + (unsigned)_C * 2u; } } } while (0)
#define G8_GOFF0(pk) (((pk) & 0xffffu) * lda2 + cb0)
#define G8_GOFF1(pk) (((pk) >> 16) * lda2 + cb0)
#define G8_STAGE_AH(bufoff, gbase, h, pk) do { if (Sched::GATHER) { G8_STAGE_A(bufoff, gbase, G8_GOFF0(pk), G8_GOFF1(pk)); } \
        else { G8_STAGE_A(bufoff, (const char*)(gbase) + (h) * hstepA, oa[0][0], pstepA + oa[0][0]); } } while (0)
    Unit cur, nxt; int ui = 0;
    if (!S.next(0, cur)) return;
    f32x4 acc[2][2][4][2];
#pragma unroll
    for (int a = 0; a < 2; ++a)
#pragma unroll
        for (int b = 0; b < 2; ++b)
#pragma unroll
            for (int m = 0; m < 4; ++m)
#pragma unroll
                for (int n = 0; n < 2; ++n) acc[a][b][m][n] = (f32x4){0.f, 0.f, 0.f, 0.f};
    bf16x8 At[4][2], B0[2][2], B1[2][2];
    i32x8 At8[4], B08[2], B18[2]; const int scl8 = 0x7F7F7F7F;
    unsigned oa[2][2], on[2][2];
    G8_SETOFF(oa, cur);
    const char* cA = cur.A; const char* cB = cur.B;
    G8_STAGE_B(G8_SB(0, 0), cB); G8_STAGE_B(G8_SB(0, 1), cB + hstepB); G8_STAGE_AH(G8_SA(0, 0), cA, 0, oa[0][0]); G8_STAGE_AH(G8_SA(0, 1), cA, 1, oa[1][0]);
    if (wr == 1) G8_BAR;
    G8_WAIT_V(2); G8_BAR;
    G8_STAGE_B(G8_SB(1, 0), cB + kstep); G8_STAGE_AH(G8_SA(1, 0), cA + kstep, 0, oa[0][0]); G8_STAGE_B(G8_SB(1, 1), cB + hstepB + kstep);
    G8_WAIT_V(6); G8_BAR;
    bool has_next = S.next(1, nxt);
    if (Sched::GATHER) { if (has_next) { G8_SETOFF(on, nxt); } else {
#pragma unroll
        for (int h = 0; h < 2; ++h) on[h][0] = oa[h][0]; } }
    for (;;) {
        const char* nA = has_next ? nxt.A : cA; const char* nB = has_next ? nxt.B : cB;
#pragma unroll 1
        for (int t = 0; t < nt; t += 2) {
            const bool last = (t == nt - 2);
            const char* a1 = cA + (size_t)(t + 1) * kstep;
            const char* a2 = last ? nA : cA + (size_t)(t + 2) * kstep; const char* b2 = last ? nB : cB + (size_t)(t + 2) * kstep;
            const char* a3 = a2 + kstep; const char* b3 = b2 + kstep;
            unsigned p0 = 0, p1 = 0;
            if (Sched::GATHER) { p0 = last ? on[0][0] : oa[0][0]; p1 = last ? on[1][0] : oa[1][0]; }
            G8_LB(B0, 0, 0); G8_LB(B1, 0, 1); G8_SCHED; G8_LA(0, 0); G8_STAGE_AH(G8_SA(1, 1), a1, 1, oa[1][0]);
            G8_WAIT_V(8); G8_WAIT_L(0); G8_BAR; G8_MM(0, 0, B0); G8_MM(0, 1, B1); G8_BAR; G8_SCHED;
            G8_LA(0, 1); G8_STAGE_B(G8_SB(0, 0), b2); G8_STAGE_B(G8_SB(0, 1), b2 + hstepB); G8_STAGE_AH(G8_SA(0, 0), a2, 0, p0);
            G8_WAIT_V(8); G8_WAIT_L(0); G8_BAR; G8_MM(1, 0, B0); G8_MM(1, 1, B1); G8_BAR; G8_SCHED;
            G8_LB(B0, 1, 0); G8_LB(B1, 1, 1); G8_SCHED; G8_LA(1, 0); G8_STAGE_AH(G8_SA(0, 1), a2, 1, p1);
            G8_WAIT_V(8); G8_WAIT_L(0); G8_BAR; G8_MM(0, 0, B0); G8_MM(0, 1, B1); G8_BAR; G8_SCHED;
            G8_LA(1, 1); G8_STAGE_B(G8_SB(1, 0), b3); G8_STAGE_B(G8_SB(1, 1), b3 + hstepB); G8_STAGE_AH(G8_SA(1, 0), a3, 0, p0);
            G8_WAIT_V(8); G8_WAIT_L(0); G8_BAR; G8_MM(1, 0, B0); G8_MM(1, 1, B1); G8_BAR; G8_SCHED;
            if (Epi::MID) { const int fr_e = lane_id_volatile() & 15; E.mid(acc, cur, t, wr, fr_e); }
        }
        if (wr == 0) G8_BAR;
        if constexpr (Sched::FP8) asm volatile("s_nop 15\n\ts_nop 15" ::: "memory");
        Unit n2; bool has2 = false; unsigned tk[2][2] = {{0u, 0u}, {0u, 0u}};
        if (has_next) { has2 = S.next(ui + 2, n2);
            if (Sched::GATHER && has2) { const int _t = wid * 64 + lane_id_volatile();
#pragma unroll
                for (int _i = 0; _i < 2; ++_i) { int _R, _C; stage_rc(_t * 16 + _i * 8192, _R, _C);
#pragma unroll
                    for (int _h = 0; _h < 2; ++_h) tk[_h][_i] = S.arow_tok(n2, _h * HALF + _R); } } }
        { const int l_e = lane_id_volatile(), fr_e = l_e & 15, fq_e = l_e >> 4;
          E(acc, cur, wr, wc, fr_e, fq_e, lds); if constexpr (Epi::PROBE2) { asm volatile("" ::: "memory"); const Epi E2 = E.probe_copy(); E2(acc, cur, wr, wc, fr_e, fq_e, lds); } }
        if (!has_next) break;
#pragma unroll
        for (int a = 0; a < 2; ++a)
#pragma unroll
            for (int b = 0; b < 2; ++b)
#pragma unroll
                for (int m = 0; m < 4; ++m)
#pragma unroll
                    for (int n = 0; n < 2; ++n) acc[a][b][m][n] = (f32x4){0.f, 0.f, 0.f, 0.f};
        cur = nxt; cA = nA; cB = nB; ++ui;
        if (Sched::GATHER) {
#pragma unroll
            for (int h = 0; h < 2; ++h) { oa[h][0] = on[h][0]; if (has2) on[h][0] = tk[h][0] | (tk[h][1] << 16); } }
        nxt = n2; has_next = has2;
        if (wr == 1) G8_BAR;
    }
    G8_WAIT_V(0);
    G8_BAR;
#undef G8_SA
#undef G8_SB
#undef G8_STAGE_A
#undef G8_STAGE_B
#undef G8_LDA
#undef G8_LDB
#undef G8_MMA
#undef G8_MMA8
#undef G8_MM
#undef G8_LA
#undef G8_LB
#undef G8_LDA8
#undef G8_LDB8
#undef G8_RD16
#undef G8_WAIT_V
#undef G8_WAIT_L
#undef G8_BAR
#undef G8_SCHED
#undef G8_SETOFF
#undef G8_GOFF0
#undef G8_GOFF1
#undef G8_STAGE_AH
}
}
using g8::Unit;
using g8::lane_id_volatile;

#define EPI_PROBE_COPY(T) __device__ __forceinline__ T probe_copy() const { return *this; }
#define EPI_ROWS(ai, m) _Pragma("unroll") for (int ai = 0; ai < 2; ++ai) _Pragma("unroll") for (int m = 0; m < 4; ++m)
__device__ __forceinline__ u32x4 pack8(const f32x4 a, const f32x4 b) { u32x4 w; w.x = cvt_pk_bf16(a[0], a[1]); w.y = cvt_pk_bf16(a[2], a[3]); w.z = cvt_pk_bf16(b[0], b[1]); w.w = cvt_pk_bf16(b[2], b[3]); return w; }
__device__ __forceinline__ float sq8(const f32x4 a, const f32x4 b) { return (a[0] * a[0] + a[1] * a[1]) + (a[2] * a[2] + a[3] * a[3]) + (b[0] * b[0] + b[1] * b[1]) + (b[2] * b[2] + b[3] * b[3]); }
__device__ __forceinline__ void row_atomic(float* p, float s, int fq) { s += __shfl_xor(s, 16); s += __shfl_xor(s, 32); if (fq == 0) atomicAdd(p, s); }

template <bool F8> struct SchedDenseT {
    static constexpr bool GATHER = false, FP8 = F8;
    const char* A; const char* B; unsigned lda2, ldb2; int K, nM, nN, G, c;
    __device__ __forceinline__ bool next(int i, Unit& u) const {
        int pm, pn; if (!g8::tile_order(i, G, c, nM, nN, pm, pn)) return false;
        u.pm = pm; u.pn = pn; u.A = A + (size_t)pm * 256 * lda2; u.B = B + (size_t)pn * 256 * ldb2; u.e = 0; u.aux = 0; u.valid = 256; u.job = 0; return true;
    }
    __device__ __forceinline__ unsigned arow_tok(const Unit&, int) const { return 0u; }
};
typedef SchedDenseT<false> SchedDense;
struct SchedP1 {
    static constexpr bool GATHER = false, FP8 = false;
    const char *xb, *win, *memn, *wk, *wv; unsigned lda2, ldb2; int K, G, c;
    __device__ __forceinline__ bool next(int i, Unit& u) const {
        const int L = i * G + c;
        u.e = 0; u.aux = 0; u.valid = 256;
        if (L < 1024) { int pm, pn; g8::tile_order(i, G, c, 128, 8, pm, pn); u.pm = pm; u.pn = pn; u.job = 0; u.A = xb + (size_t)pm * 256 * 2048; u.B = win + (size_t)pn * 256 * 2048; return true; }
        const int r = L - 1024;
        if (r < 32) { u.pm = r >> 2; u.pn = r & 3; u.job = 1; u.A = memn + (size_t)u.pm * 256 * 2048; u.B = wk + (size_t)u.pn * 256 * 2048; return true; }
        if (r < 64) { const int q = r - 32; u.pm = q >> 3; u.pn = q & 7; u.job = 2; u.A = wv + (size_t)u.pm * 256 * 2048; u.B = memn + (size_t)u.pn * 256 * 2048; return true; }
        return false;
    }
    __device__ __forceinline__ unsigned arow_tok(const Unit&, int) const { return 0u; }
};
struct SchedQ {
    static constexpr bool GATHER = false, FP8 = true;
    const char *A, *B; unsigned lda2, ldb2; int K, G, c;
    __device__ __forceinline__ bool next(int i, Unit& u) const {
        const int p = c + i * G; if (p >= BATCH * 4 * 16) return false;
        const int b = p >> 6, h = (p >> 4) & 3, qb = p & 15;
        u.pm = b * 16 + qb; u.pn = h; u.e = 0; u.aux = 0; u.valid = 256; u.job = 0; u.A = A + (size_t)u.pm * 256 * lda2; u.B = B + (size_t)h * 256 * ldb2; return true;
    }
    __device__ __forceinline__ unsigned arow_tok(const Unit&, int) const { return 0u; }
};
struct SchedAttn {
    static constexpr bool GATHER = false, FP8 = false;
    const char *q, *kmat, *vt, *pbuf; unsigned lda2, ldb2; int K, G, c, npair;
    __device__ __forceinline__ void pair_unit(int j, bool isO, Unit& u) const {
        const int p = c + j * G; const int b = p >> 6, h = (p >> 4) & 3, qb = p & 15;
        u.pm = b * 16 + qb; u.pn = h; u.e = j & 1; u.aux = 0; u.valid = 256; u.job = isO ? 1 : 0;
        if (!isO) { u.A = q + ((size_t)((b * 4 + h) * SEQ + qb * 256)) * 512; u.B = kmat + ((size_t)((b * 4 + h) * 256)) * 512; }
        else      { u.A = pbuf + ((size_t)(c * 2 + (j & 1))) * 256 * 512; u.B = vt + ((size_t)((b * 4 + h) * 256)) * 512; }
    }
    __device__ __forceinline__ bool next(int i, Unit& u) const {
        const int n = npair; if (i >= 2 * n) return false;
        if (i == 0) { pair_unit(0, false, u); return true; }
        const int k = (i - 1) >> 1;
        if (i & 1) { if (k + 1 < n) pair_unit(k + 1, false, u); else pair_unit(n - 1, true, u); }
        else pair_unit(k, true, u);
        return true;
    }
    __device__ __forceinline__ unsigned arow_tok(const Unit&, int) const { return 0u; }
};
struct SchedMoe {
    static constexpr bool GATHER_ = true;
    const LAS int* tb; const LAS int* cnt; const int* tl; const char* A; const char* B; unsigned lda2, ldb2; int K, nN, G, c; size_t bstride; bool gather;
};
template <bool GATH> struct SchedMoeT : SchedMoe {
    static constexpr bool GATHER = GATH, FP8 = true;
    __device__ __forceinline__ bool next(int i, Unit& u) const {
        const int nM = __builtin_amdgcn_readfirstlane(tb[NEXP]); int pm, pn; if (!g8::tile_order(i, G, c, nM, nN, pm, pn)) return false;
        int e = 0;
#pragma unroll
        for (int s = 16; s >= 1; s >>= 1) if (__builtin_amdgcn_readfirstlane(tb[e + s]) <= pm) e += s;
        u.pm = pm; u.pn = pn; u.e = e; u.aux = (pm - __builtin_amdgcn_readfirstlane(tb[e])) * 256; const int v = __builtin_amdgcn_readfirstlane(cnt[e]) - u.aux; u.valid = v < 256 ? v : 256; u.job = 0;
        u.A = GATH ? A : A + (size_t)pm * 256 * lda2; u.B = B + (size_t)e * bstride + (size_t)pn * 256 * ldb2; return true;
    }
    __device__ __forceinline__ unsigned arow_tok(const Unit& u, int r) const {
        return (unsigned)((r < u.valid) ? (tl[(size_t)u.e * ECAP + u.aux + r] >> 2) : 0);
    }
};

struct EpiP1 {
    static constexpr bool MID = false; static constexpr bool PROBE2 = false; EPI_PROBE_COPY(EpiP1)
    const float* rstd1; bf16_t *proj, *ug, *kmat, *vt;
    __device__ __forceinline__ void mid(f32x4 (&)[2][2][4][2], const Unit&, int, int, int) const {}
    __device__ __forceinline__ void operator()(const f32x4 (&acc)[2][2][4][2], const Unit& u, int wr, int wc, int fr, int fq, LAS unsigned char*) const {
        const int col0 = u.pn * 256 + wc * 32 + 8 * fq;
        float rs[2][4];
        EPI_ROWS(ai, m) rs[ai][m] = (u.job == 0) ? rstd1[u.pm * 256 + ai * 128 + wr * 64 + m * 16 + fr] : 1.0f;
        EPI_ROWS(ai, m) {
            const int row = u.pm * 256 + ai * 128 + wr * 64 + m * 16 + fr;
            const float sc = rs[ai][m];
#pragma unroll
            for (int bj = 0; bj < 2; ++bj) {
                const int col = col0 + bj * 128;
                const u32x4 w = pack8(acc[ai][bj][m][0] * sc, acc[ai][bj][m][1] * sc);
                bf16_t* dst;
                if (u.job == 0) { if (u.pn < 6) dst = proj + (size_t)row * 1536 + col; else { const int cc = col - 1536; dst = ug + ((size_t)((row >> 12) * 32 + (cc >> 4)) * SEQ + (row & 4095)) * 16 + (cc & 15); } }
                else if (u.job == 1) dst = kmat + ((size_t)((u.pm * 4 + u.pn) * 256 + (row & 255))) * 256 + (col & 255);
                else dst = vt + ((size_t)((u.pn * 4 + u.pm) * 256 + (row & 255))) * 256 + (col & 255);
                *(u32x4*)dst = w;
            }
        }
    }
};
struct EpiGlu {
    static constexpr bool MID = false; static constexpr bool PROBE2 = false; EPI_PROBE_COPY(EpiGlu)
    const bf16_t* ygelu; bf16_t* ycat; float* ssqs;
    __device__ __forceinline__ void mid(f32x4 (&)[2][2][4][2], const Unit&, int, int, int) const {}
    __device__ __forceinline__ void operator()(const f32x4 (&acc)[2][2][4][2], const Unit& u, int wr, int wc, int fr, int fq, LAS unsigned char*) const {
        const int col0 = u.pn * 256 + wc * 32 + 8 * fq;
#pragma unroll
        for (int ai = 0; ai < 2; ++ai) {
            u32x4 aw[4][2];
#pragma unroll
            for (int m = 0; m < 4; ++m)
#pragma unroll
                for (int bj = 0; bj < 2; ++bj) aw[m][bj] = *(const u32x4*)(ygelu + (size_t)(u.pm * 256 + ai * 128 + wr * 64 + m * 16 + fr) * 512 + col0 + bj * 128);
#pragma unroll
            for (int m = 0; m < 4; ++m) {
                const int row = u.pm * 256 + ai * 128 + wr * 64 + m * 16 + fr; float ss = 0.f;
#pragma unroll
                for (int bj = 0; bj < 2; ++bj) {
                    const u32x4 a = aw[m][bj];
                    f32x4 z0, z1; const f32x4 g0 = acc[ai][bj][m][0], g1 = acc[ai][bj][m][1];
                    { const f32x2 s0 = sigmoid2((f32x2){g0[0], g0[1]}) * (f32x2){bflo(a.x), bfhi(a.x)}, s1 = sigmoid2((f32x2){g0[2], g0[3]}) * (f32x2){bflo(a.y), bfhi(a.y)};
                      const f32x2 s2 = sigmoid2((f32x2){g1[0], g1[1]}) * (f32x2){bflo(a.z), bfhi(a.z)}, s3 = sigmoid2((f32x2){g1[2], g1[3]}) * (f32x2){bflo(a.w), bfhi(a.w)};
                      z0 = (f32x4){s0[0], s0[1], s1[0], s1[1]}; z1 = (f32x4){s2[0], s2[1], s3[0], s3[1]}; }
                    ss += sq8(z0, z1);
                    *(u32x4*)(ycat + (size_t)row * 1024 + col0 + bj * 128) = pack8(z0, z1);
                }
                row_atomic(ssqs + row, ss, fq);
            }
            asm volatile("" ::: "memory");
        }
    }
};
struct EpiRes {
    static constexpr bool MID = true; static constexpr bool PROBE2 = (PROBE_EPI == 4); __device__ __forceinline__ EpiRes probe_copy() const { EpiRes e = *this; e.ssq = ssq + 3 * NTOK; e.skip = (midt < 0); return e; }
    const bf16_t* xsrc; bf16_t* xh; unsigned char* x8; float* ssq; const float* ssqs; int midt; float accs; bool skip = false;
    __device__ __forceinline__ void mid(f32x4 (&acc)[2][2][4][2], const Unit& u, int t, int wr, int fr) const {
        if (t != midt) return;
        EPI_ROWS(ai, m) {
            const int row = u.pm * 256 + ai * 128 + wr * 64 + m * 16 + fr;
            const float sc = rsqrtf(ssqs[row] * (1.0f / 512.0f) + EPS);
#pragma unroll
            for (int bj = 0; bj < 2; ++bj)
#pragma unroll
                for (int n = 0; n < 2; ++n) acc[ai][bj][m][n] *= sc;
        }
    }
    __device__ __forceinline__ void operator()(const f32x4 (&acc)[2][2][4][2], const Unit& u, int wr, int wc, int fr, int fq, LAS unsigned char*) const {
        if (skip) return;
        const int col0 = u.pn * 256 + wc * 32 + 8 * fq;
#pragma unroll
        for (int ai = 0; ai < 2; ++ai) {
            u32x4 rw[4][2];
#pragma unroll
            for (int m = 0; m < 4; ++m)
#pragma unroll
                for (int bj = 0; bj < 2; ++bj) rw[m][bj] = *(const u32x4*)(xsrc + (size_t)(u.pm * 256 + ai * 128 + wr * 64 + m * 16 + fr) * 1024 + col0 + bj * 128);
#pragma unroll
            for (int m = 0; m < 4; ++m) {
                const int row = u.pm * 256 + ai * 128 + wr * 64 + m * 16 + fr; float ss = 0.f;
#pragma unroll
                for (int bj = 0; bj < 2; ++bj) {
                    const size_t off = (size_t)row * 1024 + col0 + bj * 128; const u32x4 w = rw[m][bj];
                    const f32x4 r0 = (f32x4){bflo(w.x), bfhi(w.x), bflo(w.y), bfhi(w.y)}, r1 = (f32x4){bflo(w.z), bfhi(w.z), bflo(w.w), bfhi(w.w)};
                    const f32x4 v0 = r0 + acc[ai][bj][m][0] * accs, v1 = r1 + acc[ai][bj][m][1] * accs;
                    ss += sq8(v0, v1);
                    *(u32x4*)(xh + off) = pack8(v0, v1);
                    *(u32x2*)(x8 + off) = (u32x2){pk4_fp8(clamp448(v0[0] * X8S), clamp448(v0[1] * X8S), clamp448(v0[2] * X8S), clamp448(v0[3] * X8S)), pk4_fp8(clamp448(v1[0] * X8S), clamp448(v1[1] * X8S), clamp448(v1[2] * X8S), clamp448(v1[3] * X8S))};
                }
                row_atomic(ssq + row, ss, fq);
            }
            asm volatile("" ::: "memory");
        }
    }
};
struct EpiQ {
    static constexpr bool MID = false; static constexpr bool PROBE2 = false; EPI_PROBE_COPY(EpiQ)
    const float* ssq2; bf16_t* q;
    __device__ __forceinline__ void mid(f32x4 (&)[2][2][4][2], const Unit&, int, int, int) const {}
    __device__ __forceinline__ void operator()(const f32x4 (&acc)[2][2][4][2], const Unit& u, int wr, int wc, int fr, int fq, LAS unsigned char*) const {
        const int col0 = u.pn * 256 + wc * 32 + 8 * fq;
        float sq[2][4];
        EPI_ROWS(ai, m) sq[ai][m] = ssq2[u.pm * 256 + ai * 128 + wr * 64 + m * 16 + fr];
        EPI_ROWS(ai, m) {
            const int row = u.pm * 256 + ai * 128 + wr * 64 + m * 16 + fr;
            const float sc = rsqrtf(sq[ai][m] * (1.0f / 1024.0f) + EPS) * (1.4426950408889634f / 16.0f) * (1.0f / (X8S * W8S));
#pragma unroll
            for (int bj = 0; bj < 2; ++bj) *(u32x4*)(q + ((size_t)(((row >> 12) * 4 + u.pn) * SEQ + (row & 4095))) * 256 + (col0 & 255) + bj * 128) = pack8(acc[ai][bj][m][0] * sc, acc[ai][bj][m][1] * sc);
        }
    }
};
struct EpiAttn {
    static constexpr bool MID = false; static constexpr bool PROBE2 = false; EPI_PROBE_COPY(EpiAttn)
    bf16_t* pbuf; bf16_t* o; int c;
    __device__ __forceinline__ void mid(f32x4 (&)[2][2][4][2], const Unit&, int, int, int) const {}
    __device__ __forceinline__ void operator()(const f32x4 (&acc)[2][2][4][2], const Unit& u, int wr, int wc, int fr, int fq, LAS unsigned char* lds) const {
        LAS float* pmax = (LAS float*)(lds + XL_OFF + XL_PMAX);
        LAS float* psum = (LAS float*)(lds + XL_OFF + XL_PSUM) + u.e * 1024;
        if (u.job == 0) {
            EPI_ROWS(ai, m) {
                const int r = ai * 128 + wr * 64 + m * 16 + fr; float mx = -3.0e38f;
#pragma unroll
                for (int bj = 0; bj < 2; ++bj)
#pragma unroll
                    for (int n = 0; n < 2; ++n)
#pragma unroll
                        for (int i = 0; i < 4; ++i) mx = fmaxf(mx, acc[ai][bj][m][n][i]);
                mx = fmaxf(mx, __shfl_xor(mx, 16)); mx = fmaxf(mx, __shfl_xor(mx, 32));
                if (fq == 0) pmax[r * 4 + wc] = mx;
            }
            asm volatile("s_waitcnt lgkmcnt(0)" ::: "memory"); __builtin_amdgcn_s_barrier(); asm volatile("" ::: "memory");
            bf16_t* P = pbuf + (size_t)(c * 2 + u.e) * 256 * 256;
            EPI_ROWS(ai, m) {
                const int r = ai * 128 + wr * 64 + m * 16 + fr;
                const f32x4 pm4 = *(const LAS f32x4*)(pmax + r * 4);
                const float mx = fmaxf(fmaxf(pm4[0], pm4[1]), fmaxf(pm4[2], pm4[3])); float ss = 0.f;
#pragma unroll
                for (int bj = 0; bj < 2; ++bj) {
                    f32x4 p0, p1;
#pragma unroll
                    for (int i = 0; i < 4; ++i) { p0[i] = __builtin_amdgcn_exp2f(acc[ai][bj][m][0][i] - mx); p1[i] = __builtin_amdgcn_exp2f(acc[ai][bj][m][1][i] - mx); }
                    ss += (p0[0] + p0[1]) + (p0[2] + p0[3]) + (p1[0] + p1[1]) + (p1[2] + p1[3]);
                    *(u32x4*)(P + (size_t)r * 256 + wc * 32 + 8 * fq + bj * 128) = pack8(p0, p1);
                }
                ss += __shfl_xor(ss, 16); ss += __shfl_xor(ss, 32);
                if (fq == 0) psum[r * 4 + wc] = ss;
                asm volatile("" ::: "memory");
            }
            asm volatile("s_waitcnt vmcnt(0) lgkmcnt(0)" ::: "memory"); __builtin_amdgcn_s_barrier(); asm volatile("" ::: "memory");
        } else {
            const int b = u.pm >> 4, qb = u.pm & 15, h = u.pn;
            EPI_ROWS(ai, m) {
                const int r = ai * 128 + wr * 64 + m * 16 + fr;
                const f32x4 ps = *(const LAS f32x4*)(psum + r * 4);
                const float inv = O8S / ((ps[0] + ps[1]) + (ps[2] + ps[3]));
                unsigned char* dst = (unsigned char*)o + (size_t)(b * SEQ + qb * 256 + r) * 1024 + h * 256 + wc * 32 + 8 * fq;
#pragma unroll
                for (int bj = 0; bj < 2; ++bj) { const f32x4 a0 = acc[ai][bj][m][0] * inv, a1 = acc[ai][bj][m][1] * inv;
                    *(u32x2*)(dst + bj * 128) = (u32x2){pk4_fp8(clamp448(a0[0]), clamp448(a0[1]), clamp448(a0[2]), clamp448(a0[3])), pk4_fp8(clamp448(a1[0]), clamp448(a1[1]), clamp448(a1[2]), clamp448(a1[3]))}; }
            }
        }
    }
};
struct EpiMoe1 {
    static constexpr bool MID = false; static constexpr bool PROBE2 = (PROBE_EPI == 9); EPI_PROBE_COPY(EpiMoe1)
    const float* rstdl; const float* bgu; bf16_t* act;
    __device__ __forceinline__ void mid(f32x4 (&)[2][2][4][2], const Unit&, int, int, int) const {}
    __device__ __forceinline__ void operator()(const f32x4 (&acc)[2][2][4][2], const Unit& u, int wr, int wc, int fr, int fq, LAS unsigned char*) const {
        const int cj = u.pn * 128 + wc * 32 + 8 * fq;
        const float* bg = bgu + (size_t)u.e * 2048 + cj;
        float rs[2][4];
        EPI_ROWS(ai, m) { const int r = ai * 128 + wr * 64 + m * 16 + fr; rs[ai][m] = rstdl[(size_t)u.e * ECAP + u.aux + (r < u.valid ? r : 0)]; }
        const f32x4 bgv[2] = {*(const f32x4*)bg, *(const f32x4*)(bg + 4)}, blv[2] = {*(const f32x4*)(bg + 1024), *(const f32x4*)(bg + 1028)};
        EPI_ROWS(ai, m) {
            const int r = ai * 128 + wr * 64 + m * 16 + fr; const float sc = rs[ai][m] * (1.0f / (X8S * W8S));
            unsigned w[2];
#pragma unroll
            for (int n = 0; n < 2; ++n) { f32x2 o2[2];
#pragma unroll
                for (int h = 0; h < 2; ++h) {
                    const f32x2 ag = {acc[ai][0][m][n][2 * h], acc[ai][0][m][n][2 * h + 1]}, al = {acc[ai][1][m][n][2 * h], acc[ai][1][m][n][2 * h + 1]};
                    const f32x2 bg2 = {bgv[n][2 * h], bgv[n][2 * h + 1]}, bl2 = {blv[n][2 * h], blv[n][2 * h + 1]};
                    f32x2 g = ag * sc + bg2, l = al * sc + bl2;
                    g[0] = fminf(g[0], 7.0f); g[1] = fminf(g[1], 7.0f);
                    l[0] = __builtin_amdgcn_fmed3f(l[0], -7.0f, 7.0f); l[1] = __builtin_amdgcn_fmed3f(l[1], -7.0f, 7.0f);
                    f32x2 e = g * (-1.702f * 1.4426950408889634f);
                    e[0] = __builtin_amdgcn_exp2f(e[0]); e[1] = __builtin_amdgcn_exp2f(e[1]);
                    f32x2 d = e + 1.0f;
                    d[0] = __builtin_amdgcn_rcpf(d[0]); d[1] = __builtin_amdgcn_rcpf(d[1]);
                    o2[h] = (g * d) * (l * A8S + A8S);
                }
                w[n] = pk4_fp8(o2[0][0], o2[0][1], o2[1][0], o2[1][1]); }
            *(u32x2*)((unsigned char*)act + (size_t)(u.pm * 256 + r) * 1024 + cj) = (u32x2){w[0], w[1]};
        }
    }
};
struct EpiMoe2 {
    static constexpr bool MID = false; static constexpr bool PROBE2 = (PROBE_EPI == 10); EPI_PROBE_COPY(EpiMoe2)
    const int* tokl; const float* gatel; const float* bdn; bf16_t* slots;
    __device__ __forceinline__ void mid(f32x4 (&)[2][2][4][2], const Unit&, int, int, int) const {}
    __device__ __forceinline__ void operator()(const f32x4 (&acc)[2][2][4][2], const Unit& u, int wr, int wc, int fr, int fq, LAS unsigned char*) const {
        const int col0 = u.pn * 256 + wc * 32 + 8 * fq;
        const float* bp = bdn + (size_t)u.e * 1024 + col0;
        int sl[2][4]; float gt[2][4];
        EPI_ROWS(ai, m) { const int r = ai * 128 + wr * 64 + m * 16 + fr; const size_t idx = (size_t)u.e * ECAP + u.aux + (r < u.valid ? r : 0); sl[ai][m] = tokl[idx]; gt[ai][m] = gatel[idx]; }
        f32x4 bv[2][2];
#pragma unroll
        for (int bj = 0; bj < 2; ++bj) { bv[bj][0] = *(const f32x4*)(bp + bj * 128); bv[bj][1] = *(const f32x4*)(bp + bj * 128 + 4); }
        EPI_ROWS(ai, m) {
            const int r = ai * 128 + wr * 64 + m * 16 + fr;
            if (r < u.valid) {
                const int slot = sl[ai][m]; const float g = gt[ai][m];
#pragma unroll
                for (int bj = 0; bj < 2; ++bj) { const float gs = g * S8S; const f32x4 o0 = (acc[ai][bj][m][0] * (1.0f / (A8S * W8S)) + bv[bj][0]) * gs, o1 = (acc[ai][bj][m][1] * (1.0f / (A8S * W8S)) + bv[bj][1]) * gs;
                    *(u32x2*)((unsigned char*)slots + (size_t)slot * 1024 + col0 + bj * 128) = (u32x2){pk4_fp8(clamp448(o0[0]), clamp448(o0[1]), clamp448(o0[2]), clamp448(o0[3])), pk4_fp8(clamp448(o1[0]), clamp448(o1[1]), clamp448(o1[2]), clamp448(o1[3]))}; }
            }
        }
    }
};

#define XB_TMO      128
#define XB_XCNT(j)  (256  + 64 * (j))
#define XB_XSUB(j)  (1280 + 64 * (j))
#define XB_XGEN(j)  (2304 + 64 * (j))
#define XB_TOP      3328
#define XB_TOPGEN   3392
#define XCD_BAR_WORDS 3456
#define XB_SPIN_CAP (1u << 20)
__device__ __forceinline__ unsigned xb_ld(unsigned* p)              { return __hip_atomic_load(p, __ATOMIC_RELAXED, __HIP_MEMORY_SCOPE_AGENT); }
__device__ __forceinline__ unsigned xb_add(unsigned* p, unsigned v) { return __hip_atomic_fetch_add(p, v, __ATOMIC_RELAXED, __HIP_MEMORY_SCOPE_AGENT); }
__device__ __forceinline__ unsigned xb_xcc_id() { return (unsigned)__builtin_amdgcn_s_getreg((3 << 11) | 20) & 0xFu; }
#define XB_SPIN(cond, bar) do { unsigned _sp = 0; while (cond) { __builtin_amdgcn_s_sleep(1); \
    if ((++_sp & 255u) == 0u) { if (xb_ld(&(bar)[XB_TMO])) break; if (_sp > XB_SPIN_CAP) { atomicAdd(&(bar)[XB_TMO], 1u); break; } } } } while (0)
struct XcdBarrier { unsigned* bar; unsigned x; volatile LAS unsigned* st; };
__device__ __forceinline__ XcdBarrier xcd_barrier_post(unsigned* bar, volatile LAS unsigned* st) {
    XcdBarrier b; b.bar = bar; b.x = xb_xcc_id(); b.st = st;
    if (threadIdx.x == 0) (void)xb_add(&bar[XB_XCNT(b.x)], 1u);
    return b;
}
__device__ __forceinline__ void xcd_barrier_complete(unsigned* bar, unsigned x, unsigned& nloc, unsigned& nx) {
    const unsigned G = gridDim.x * gridDim.y * gridDim.z;
    unsigned sum, cnt, mine, sp = 0u;
    for (;;) {
        sum = 0u; cnt = 0u; mine = 0u;
#pragma unroll
        for (unsigned j = 0; j < 16; ++j) { const unsigned c = xb_ld(&bar[XB_XCNT(j)]); sum += c; cnt += (c > 0u) ? 1u : 0u; mine = (j == x) ? c : mine; }
        if (sum == G) break;
        __builtin_amdgcn_s_sleep(1);
        if ((++sp & 255u) == 0u) { if (xb_ld(&bar[XB_TMO])) break; if (sp > XB_SPIN_CAP) { atomicAdd(&bar[XB_TMO], 1u); break; } }
    }
    nloc = mine > 0u ? mine : 1u; nx = cnt > 0u ? cnt : 1u;
}
__device__ __forceinline__ void xcd_barrier(const XcdBarrier& b) {
    asm volatile("s_waitcnt vmcnt(0)" ::: "memory");
    __syncthreads();
    if (threadIdx.x == 0) {
        unsigned* bar = b.bar;
        __builtin_amdgcn_s_waitcnt(0);
        unsigned nloc = b.st[0], nx = b.st[1];
        if (nloc == 0u) { xcd_barrier_complete(bar, b.x, nloc, nx); b.st[0] = nloc; b.st[1] = nx; }
        const unsigned old = xb_add(&bar[XB_XSUB(b.x)], 1u);
        const unsigned gen = old / nloc;
        if (old + 1u == (gen + 1u) * nloc) {
            __builtin_amdgcn_fence(__ATOMIC_RELEASE, "agent");
            asm volatile("s_waitcnt vmcnt(0)" ::: "memory");
            const unsigned og = xb_add(&bar[XB_TOP], 1u);
            const unsigned tg = og / nx;
            if (og + 1u == (tg + 1u) * nx) xb_add(&bar[XB_TOPGEN], 1u);
            else XB_SPIN(xb_ld(&bar[XB_TOPGEN]) == tg, bar);
            __builtin_amdgcn_fence(__ATOMIC_ACQUIRE, "agent");
            xb_add(&bar[XB_XGEN(b.x)], 1u);
            asm volatile("s_waitcnt vmcnt(0)" ::: "memory");
        } else {
            XB_SPIN(xb_ld(&bar[XB_XGEN(b.x)]) == gen, bar);
            __builtin_amdgcn_fence(__ATOMIC_ACQUIRE, "agent");
            asm volatile("s_waitcnt vmcnt(0)" ::: "memory");
        }
    }
    __syncthreads();
}

struct Args { const float* in[30]; float* out; unsigned char* ws; int ph_lo, ph_hi; };
enum { I_X = 0, I_MEM, I_NMIX, I_WIN, I_CONVW, I_ARE, I_AIM, I_LOGDT, I_BRE, I_BIM, I_CRE, I_CIM, I_D, I_WGLU, I_NCO, I_NSO, I_WOUT, I_NX, I_NM, I_WQ, I_WKV, I_WO, I_NMOE, I_WR, I_BR, I_WGU, I_BGU, I_WDN, I_BDN, I_NF };

struct CvItem { const float* W; const float* scale; unsigned char* WT; int ldw, k0, n0, ldt, drow0, dk0, f8; };
__device__ __forceinline__ void cv_load(const CvItem& c, float (&v)[64], int lane) {
    const float* src = c.W + (size_t)c.k0 * c.ldw + c.n0 + lane;
#pragma unroll
    for (int i = 0; i < 64; ++i) v[i] = src[(size_t)i * c.ldw];
}
__device__ __forceinline__ void cv_store(const CvItem& c, float (&v)[64], int lane, LAS unsigned char* scr) {
    if (c.scale) {
#pragma unroll
        for (int i = 0; i < 64; ++i) v[i] *= c.scale[c.k0 + i];
    }
    if (c.f8) {
#pragma unroll
        for (int q = 0; q < 4; ++q) { u32x4 o; o.x = pk4_fp8(v[16 * q] * W8S, v[16 * q + 1] * W8S, v[16 * q + 2] * W8S, v[16 * q + 3] * W8S); o.y = pk4_fp8(v[16 * q + 4] * W8S, v[16 * q + 5] * W8S, v[16 * q + 6] * W8S, v[16 * q + 7] * W8S);
            o.z = pk4_fp8(v[16 * q + 8] * W8S, v[16 * q + 9] * W8S, v[16 * q + 10] * W8S, v[16 * q + 11] * W8S); o.w = pk4_fp8(v[16 * q + 12] * W8S, v[16 * q + 13] * W8S, v[16 * q + 14] * W8S, v[16 * q + 15] * W8S);
            *(LAS u32x4*)(scr + lane * 80 + 16 * q) = o; }
        asm volatile("s_waitcnt lgkmcnt(0)" ::: "memory");
#pragma unroll
        for (int j = 0; j < 4; ++j) { const int row = 16 * j + (lane >> 2), ch = lane & 3; const u32x4 o = *(const LAS u32x4*)(scr + row * 80 + 16 * ch);
            *(u32x4*)(c.WT + (size_t)(c.drow0 + row) * c.ldt + c.dk0 + 16 * ch) = o; }
    } else {
#pragma unroll
        for (int q = 0; q < 8; ++q) { u32x4 o; o.x = pk2(v[8 * q], v[8 * q + 1]); o.y = pk2(v[8 * q + 2], v[8 * q + 3]); o.z = pk2(v[8 * q + 4], v[8 * q + 5]); o.w = pk2(v[8 * q + 6], v[8 * q + 7]);
            *(LAS u32x4*)(scr + lane * 144 + 16 * q) = o; }
        asm volatile("s_waitcnt lgkmcnt(0)" ::: "memory");
#pragma unroll
        for (int j = 0; j < 8; ++j) { const int row = 8 * j + (lane >> 3), ch = lane & 7; const u32x4 o = *(const LAS u32x4*)(scr + row * 144 + 16 * ch);
            *(u32x4*)(c.WT + (size_t)(c.drow0 + row) * c.ldt + c.dk0 + 16 * ch) = o; }
    }
    asm volatile("s_waitcnt lgkmcnt(0)" ::: "memory");
}

__global__ void __launch_bounds__(NTHREADS, 2) mk_fwd(Args args) {
    extern __shared__ __attribute__((aligned(16))) unsigned char lds_raw[];
    LAS unsigned char* lds = (LAS unsigned char*)lds_raw;
    cg::grid_group grid = cg::this_grid();
    const int wave = __builtin_amdgcn_readfirstlane(threadIdx.x >> 6);
#define PH_IDS const int lane = lane_id_volatile(), tid = wave * 64 + lane; (void)lane; (void)tid
    const int G = gridDim.x, bx = blockIdx.x;
#define vcu ((G % 8 == 0) ? (bx % 8) * (G / 8) + bx / 8 : bx)
    unsigned char* const ws = args.ws;
#define PH_WS __attribute__((address_space(1))) unsigned char* ws_ = (__attribute__((address_space(1))) unsigned char*)args.ws; asm volatile("" : "+s"(ws_)); unsigned char* const ws = (unsigned char*)ws_
    const int lo = MK_PER_PHASE ? args.ph_lo : 0, hi = MK_PER_PHASE ? args.ph_hi : 12;
#ifndef PH_MASK
#define PH_MASK 0xfff
#endif
#define IN(k) (((PH_MASK >> (k)) & 1) && lo <= (k) && (k) < hi)
#if MK_USE_CG
#define SEAM(k) do { if (IN(k) && IN((k) + 1)) grid.sync(); STAMP(k); } while (0)
#else
#define SEAM(k) do { if (IN(k) && IN((k) + 1)) { XcdBarrier xb_; xb_.bar = (unsigned*)(ws + WS_BAR); xb_.x = xb_xcc_id(); xb_.st = (volatile LAS unsigned*)(lds + XL_OFF + XL_MISC); xcd_barrier(xb_); } STAMP(k); } while (0)
#endif
#if PROBE_PHASE >= 0 || PROBE_A >= 0
    unsigned long long* stamps = (unsigned long long*)(ws + WS_STAMP);
#define STAMP(k) do { if (bx == 0 && threadIdx.x == 0) stamps[(k) + 1] = __builtin_amdgcn_s_memrealtime(); } while (0)
    if (bx == 0 && threadIdx.x == 0) stamps[0] = __builtin_amdgcn_s_memrealtime();
#define STAMPX(i) do { if (bx == 0 && threadIdx.x == 0) stamps[(i)] = __builtin_amdgcn_s_memrealtime(); } while (0)
#else
#define STAMP(k) do { } while (0)
#define STAMPX(i) do { } while (0)
#endif
    volatile LAS unsigned* misc = (volatile LAS unsigned*)(lds + XL_OFF + XL_MISC);
    if (threadIdx.x == 0) { misc[0] = 0u; misc[1] = 0u; }
    __syncthreads();
    if (!MK_PER_PHASE && !MK_USE_CG) (void)xcd_barrier_post((unsigned*)(ws + WS_BAR), misc);
#define gw (vcu * NWAVES + wave)
#define NGW (G * NWAVES)
#define counts ((int*)(ws + WS_CNT))
#define rstd1 ((float*)(ws + WS_RSTD1))
#define ssqs ((float*)(ws + WS_SSQS))
#define ssq2 ((float*)(ws + WS_SSQ2))
#define ssq3 ((float*)(ws + WS_SSQ3))
#define gates ((float*)(ws + WS_GATES))
#define gatel ((float*)(ws + WS_GATEL))
#define rstdl ((float*)(ws + WS_RSTDL))
#define wrs ((float*)(ws + WS_WR))
#define tokl ((int*)(ws + WS_TOKL))
#define xb ((bf16_t*)(ws + WS_XB))
#define proj ((bf16_t*)(ws + WS_PROJ))
#define ug ((bf16_t*)(ws + WS_UG))
#define ycat ((bf16_t*)(ws + WS_YCAT))
#define ygelu ((bf16_t*)(ws + WS_YGELU))
#define x8 ((unsigned char*)(ws + WS_X1))
#define xh ((bf16_t*)(ws + WS_XH))
#define qo ((bf16_t*)(ws + WS_QO))
#define pbuf ((bf16_t*)(ws + WS_PBUF))
#define ob ((bf16_t*)(ws + WS_O))
#define act ((bf16_t*)(ws + WS_ACT))
#define slots ((bf16_t*)(ws + WS_SLOTS))
#define memn ((bf16_t*)(ws + WS_MEMN))
#define kmat ((bf16_t*)(ws + WS_KMAT))
#define vt ((bf16_t*)(ws + WS_VT))

    if (IN(0)) {
        PH_WS;
        PH_IDS;
        for (int i = bx * NTHREADS + tid; i < 3 * NTOK; i += G * NTHREADS) ssqs[i] = 0.f;
        if (bx == 0 && tid < NEXP) counts[tid] = 0;
        for (int i = bx * NTHREADS + tid; i < DM * NEXP; i += G * NTHREADS) wrs[i] = args.in[I_WR][i] * args.in[I_NMOE][i >> 5];
        for (int item = bx; item < 256; item += G) {
            const int g = item >> 3, part = item & 7;
            LAS float* Wp = (LAS float*)lds;
            LAS float* Bb = Wp + 65 * 128;
            LAS float* Cc = Bb + 64 * 32;
            const float dt = __expf(args.in[I_LOGDT][g]);
            __syncthreads();
            for (int i = tid; i < 65 * 64; i += NTHREADS) { const int p = i >> 6, j = i & 63; const float ar = args.in[I_ARE][g * 64 + j], aim = args.in[I_AIM][g * 64 + j];
                const float mag = expf((float)p * dt * ar); float sn, cs; sincosf((float)p * dt * aim, &sn, &cs); Wp[i * 2] = mag * cs; Wp[i * 2 + 1] = mag * sn; }
            for (int i = tid; i < 64 * 16; i += NTHREADS) { const int j = i >> 4; const float ar = args.in[I_ARE][g * 64 + j], aim = args.in[I_AIM][g * 64 + j];
                float sn, cs; sincosf(dt * aim, &sn, &cs); const float em1 = expm1f(dt * ar); float sh, ch; sincosf(0.5f * dt * aim, &sh, &ch);
                const float pre = em1 * cs - 2.0f * sh * sh, pim = (em1 + 1.0f) * sn, den = ar * ar + aim * aim;
                const float qre = (pre * ar + pim * aim) / den, qim = (pim * ar - pre * aim) / den;
                const float br = args.in[I_BRE][(size_t)g * 1024 + i], bi = args.in[I_BIM][(size_t)g * 1024 + i];
                Bb[i * 2] = qre * br - qim * bi; Bb[i * 2 + 1] = qre * bi + qim * br; }
            for (int i = tid; i < 16 * 64; i += NTHREADS) { Cc[i * 2] = args.in[I_CRE][(size_t)g * 1024 + i]; Cc[i * 2 + 1] = args.in[I_CIM][(size_t)g * 1024 + i]; }
            __syncthreads();
            unsigned char* tab = ws + WS_SSM + (size_t)g * SSM_STRIDE;
            if (part == 0 && tid < 64) { ((float*)tab)[tid * 2] = Wp[(64 * 64 + tid) * 2]; ((float*)tab)[tid * 2 + 1] = Wp[(64 * 64 + tid) * 2 + 1]; }
            bf16_t* Kt = (bf16_t*)(tab + SSM_KT); bf16_t* Pt = (bf16_t*)(tab + SSM_PT); bf16_t* Qt = (bf16_t*)(tab + SSM_QT);
            {
                const int lag = 8 * part + (tid >> 6), c = (tid >> 2) & 15, cp0 = (tid & 3) * 4; float s0 = 0.f, s1 = 0.f, s2 = 0.f, s3 = 0.f;
#pragma unroll 4
                for (int j = 0; j < 64; ++j) { const f32x2 w = *(const LAS f32x2*)(Wp + (lag * 64 + j) * 2), cc = *(const LAS f32x2*)(Cc + (c * 64 + j) * 2);
                    const float xr = cc[0] * w[0] - cc[1] * w[1], xi = cc[0] * w[1] + cc[1] * w[0];
                    const f32x4 b0 = *(const LAS f32x4*)(Bb + (j * 16 + cp0) * 2), b1 = *(const LAS f32x4*)(Bb + (j * 16 + cp0 + 2) * 2);
                    s0 += xr * b0[0] - xi * b0[1]; s1 += xr * b0[2] - xi * b0[3]; s2 += xr * b1[0] - xi * b1[1]; s3 += xr * b1[2] - xi * b1[3]; }
                *(u32x2*)(Kt + (size_t)lag * 256 + c * 16 + cp0) = (u32x2){pk2(s0, s1), pk2(s2, s3)};
            }
            {
                const int k = 2 * tid, sidx = k >> 4, cp = k & 15;
#pragma unroll 4
                for (int r = 0; r < 16; ++r) { const int n = 16 * part + r, ri = n >> 6, j = n & 63;
                    const f32x2 w = *(const LAS f32x2*)(Wp + ((63 - sidx) * 64 + j) * 2); const f32x4 b = *(const LAS f32x4*)(Bb + (j * 16 + cp) * 2);
                    const float v0 = ri ? (w[0] * b[1] + w[1] * b[0]) : (w[0] * b[0] - w[1] * b[1]), v1 = ri ? (w[0] * b[3] + w[1] * b[2]) : (w[0] * b[2] - w[1] * b[3]);
                    *(unsigned*)(Pt + (size_t)n * 1024 + k) = pk2(v0, v1); }
            }
            {
                const int n = 2 * (tid & 63), ri = n >> 6, j = n & 63;
#pragma unroll 4
                for (int r = 0; r < 16; ++r) { const int tc = 128 * part + (tid >> 6) + 8 * r, t = tc >> 4, c = tc & 15;
                    const f32x4 w = *(const LAS f32x4*)(Wp + ((t + 1) * 64 + j) * 2), cc = *(const LAS f32x4*)(Cc + (c * 64 + j) * 2);
                    const float v0 = ri ? -(cc[0] * w[1] + cc[1] * w[0]) : (cc[0] * w[0] - cc[1] * w[1]), v1 = ri ? -(cc[2] * w[3] + cc[3] * w[2]) : (cc[2] * w[2] - cc[3] * w[3]);
                    *(unsigned*)(Qt + (size_t)tc * 128 + n) = pk2(v0, v1); }
            }
        }
        STAMPX(30);
        for (int m4 = gw * 4; m4 < NTOK + NMEM; m4 += NGW * 4) {
            const bool isx = m4 < NTOK; const int r0 = isx ? m4 : m4 - NTOK;
            const f32x4* xr = (const f32x4*)((isx ? args.in[I_X] : args.in[I_MEM]) + (size_t)r0 * DM) + lane;
            f32x4 v[4][4];
#pragma unroll
            for (int q = 0; q < 4; ++q)
#pragma unroll
                for (int j = 0; j < 4; ++j) v[q][j] = xr[q * 256 + 64 * j];
#pragma unroll
            for (int q = 0; q < 4; ++q) {
                float ss = 0.f;
#pragma unroll
                for (int j = 0; j < 4; ++j) ss += (v[q][j][0] * v[q][j][0] + v[q][j][1] * v[q][j][1]) + (v[q][j][2] * v[q][j][2] + v[q][j][3] * v[q][j][3]);
                const float rs = rsqrtf(wave_sum(ss) * (1.f / DM) + EPS);
                u32x2* o8 = (u32x2*)((isx ? xb : memn) + (size_t)(r0 + q) * DM) + lane;
                if (isx) { if (lane == 0) rstd1[r0 + q] = rs;
#pragma unroll
                    for (int j = 0; j < 4; ++j) o8[64 * j] = (u32x2){pk2(v[q][j][0], v[q][j][1]), pk2(v[q][j][2], v[q][j][3])}; }
                else {
#pragma unroll
                    for (int j = 0; j < 4; ++j) { const f32x4 g = ((const f32x4*)args.in[I_NM])[lane + 64 * j]; o8[64 * j] = (u32x2){pk2(v[q][j][0] * rs * g[0], v[q][j][1] * rs * g[1]), pk2(v[q][j][2] * rs * g[2], v[q][j][3] * rs * g[3])}; } }
            }
        }
        STAMPX(31);
        {
            constexpr int I_IN = 16 * 32, I_GLU = 8 * 8, I_OUT = 16 * 16, I_Q = 16 * 16, I_KV = 16 * 32, I_O = 16 * 16, I_GU = 32 * 16 * 32, I_DN = 32 * 16 * 16;
            constexpr int NIT = I_IN + I_GLU + I_OUT + I_Q + I_KV + I_O + I_GU + I_DN;
#define CV_DECODE(c, it) do { int r = (it); \
                if (r < I_GU) { const int e = r / 512, q = r % 512, kb = q / 32, nb = q % 32, n0 = nb * 64, j = n0 & 1023, lin = n0 >> 10; \
                    c = CvItem{args.in[I_WGU] + (size_t)e * 1024 * 2048, args.in[I_NMOE], ws + WS_WGU + (size_t)e * 2048 * 1024, 2048, kb * 64, n0, 1024, 256 * (j >> 7) + 128 * lin + (j & 127), kb * 64, 1}; break; } r -= I_GU; \
                if (r < I_DN) { const int e = r / 256, q = r % 256, kb = q / 16, nb = q % 16; \
                    c = CvItem{args.in[I_WDN] + (size_t)e * 1024 * 1024, nullptr, ws + WS_WDN + (size_t)e * 1024 * 1024, 1024, kb * 64, nb * 64, 1024, nb * 64, kb * 64, 1}; break; } r -= I_DN; \
                if (r < I_IN) { const int kb = r / 32, nb = r % 32; c = CvItem{args.in[I_WIN], args.in[I_NMIX], ws + WS_WIN, 2048, kb * 64, nb * 64, 2048, nb * 64, kb * 128, 0}; break; } r -= I_IN; \
                if (r < I_GLU) { const int kb = r / 8, nb = r % 8; c = CvItem{args.in[I_WGLU], nullptr, ws + WS_WGLU, 512, kb * 64, nb * 64, 1024, nb * 64, kb * 128, 0}; break; } r -= I_GLU; \
                if (r < I_OUT) { const int kb = r / 16, nb = r % 16, k0 = kb * 64;        \
                    c = CvItem{args.in[I_WOUT], (k0 < 512) ? args.in[I_NCO] : args.in[I_NSO] - 512, ws + WS_WOUT, 1024, k0, nb * 64, 2048, nb * 64, ((k0 + 512) & 1023) * 2, 0}; break; } r -= I_OUT; \
                if (r < I_Q) { const int kb = r / 16, nb = r % 16; c = CvItem{args.in[I_WQ], args.in[I_NX], ws + WS_WQ, 1024, kb * 64, nb * 64, 1024, nb * 64, kb * 64, 1}; break; } r -= I_Q; \
                if (r < I_KV) { const int kb = r / 32, nb = r % 32, n0 = nb * 64; c = CvItem{args.in[I_WKV], nullptr, ws + (n0 < 1024 ? WS_WK : WS_WV), 2048, kb * 64, n0, 2048, n0 & 1023, kb * 128, 0}; break; } r -= I_KV; \
                { const int kb = r / 16, nb = r % 16; c = CvItem{args.in[I_WO], nullptr, ws + WS_WO, 1024, kb * 64, nb * 64, 1024, nb * 64, kb * 64, 1}; } } while (0)
            float va[64], vb[64]; CvItem ca, cb;
            __syncthreads();
            LAS unsigned char* cvscr = lds + wave * 10240;
            int it = gw;
            if (it < NIT) { CV_DECODE(ca, it); cv_load(ca, va, lane); }
            while (it < NIT) {
                int it2 = it + NGW;
                if (it2 < NIT) { CV_DECODE(cb, it2); cv_load(cb, vb, lane); }
                cv_store(ca, va, lane, cvscr);
                it = it2; if (it >= NIT) break;
                it2 = it + NGW;
                if (it2 < NIT) { CV_DECODE(ca, it2); cv_load(ca, va, lane); }
                cv_store(cb, vb, lane, cvscr);
                it = it2;
            }
#undef CV_DECODE
        }
    }
    SEAM(0);
    if (IN(1)) {
        PH_WS;
        SchedP1 S{(const char*)xb, (const char*)(ws + WS_WIN), (const char*)memn, (const char*)(ws + WS_WK), (const char*)(ws + WS_WV), 2048u, 2048u, 1024, G, bx};
        EpiP1 E{rstd1, proj, ug, kmat, vt};
        g8::gemm_phase(lds, S, E, wave);
    }
    SEAM(1);
    if (IN(2)) {
        PH_WS;
        PH_IDS;
        constexpr int L_KT = 0, L_SPV = 32768, L_UH = 49152, UROW = 1040, L_STG = 115712;
        const int l15 = lane & 15, lq = lane >> 4;
        for (int it_ = vcu; it_ < BATCH * 32; it_ += G) {
            const int g = (it_ >> 5) * 4 + (it_ & 3), b = (it_ >> 2) & 7, item = b * 32 + g;
            const bf16_t* ugp = ug + (size_t)item * SEQ * 16;
            const unsigned char* tab = ws + WS_SSM + (size_t)g * SSM_STRIDE;
            const float* A64 = (const float*)tab; const bf16_t* Kt = (const bf16_t*)(tab + SSM_KT); const bf16_t* Pt = (const bf16_t*)(tab + SSM_PT); const bf16_t* Qt = (const bf16_t*)(tab + SSM_QT);
#define STAGE_U(p) do { _Pragma("unroll") for (int _i = 0; _i < 8; ++_i) { const int _c = wave * 8 + _i; \
                const u32x4 _v = *(const u32x4*)(ugp + ((size_t)_c * 64 + 32 * (p)) * 16 + lane * 8); *(LAS u32x4*)(lds + L_UH + _c * UROW + lane * 16) = _v; } } while (0)
#define UFRAG(mb, kk) (*(const LAS bf16x8*)(lds + L_UH + (16 * (mb) + l15) * UROW + (32 * (kk) + 8 * lq) * 2))
            f32x4 sacc[4];
#pragma unroll
            for (int mb = 0; mb < 4; ++mb) sacc[mb] = (f32x4){0.f, 0.f, 0.f, 0.f};
#pragma unroll 1
            for (int p = 0; p < 2; ++p) {
                bf16x8 pf[16];
#pragma unroll
                for (int kk = 0; kk < 16; ++kk) pf[kk] = *(const bf16x8*)(Pt + (size_t)(16 * wave + l15) * 1024 + 32 * (16 * p + kk) + 8 * lq);
                __syncthreads(); STAGE_U(p); __syncthreads();
#pragma unroll
                for (int kk = 0; kk < 16; ++kk) {
#pragma unroll
                    for (int mb = 0; mb < 4; ++mb) sacc[mb] = __builtin_amdgcn_mfma_f32_16x16x32_bf16(UFRAG(mb, kk), pf[kk], sacc[mb], 0, 0, 0);
                }
            }
            STAMPX(20);
            { LAS float* Sl = (LAS float*)(lds + L_KT);
#pragma unroll
              for (int mb = 0; mb < 4; ++mb)
#pragma unroll
                for (int r = 0; r < 4; ++r) Sl[(16 * mb + 4 * lq + r) * 128 + 16 * wave + l15] = sacc[mb][r]; }
            __syncthreads();
            if (wave == 0) {
                const LAS float* Sl = (const LAS float*)(lds + L_KT); LAS bf16_t* Sp = (LAS bf16_t*)(lds + L_SPV);
                const float ar = A64[lane * 2], ai = A64[lane * 2 + 1]; float sr = 0.f, si = 0.f;
#pragma unroll 2
                for (int c = 0; c < 64; ++c) { Sp[c * 128 + lane] = (bf16_t)f2bf(sr); Sp[c * 128 + 64 + lane] = (bf16_t)f2bf(si);
                    const float lr = Sl[c * 128 + lane], li = Sl[c * 128 + 64 + lane]; const float nr = ar * sr - ai * si + lr, ni = ar * si + ai * sr + li; sr = nr; si = ni; }
            }
            __syncthreads();
            { const u32x4* src = (const u32x4*)Kt;
#pragma unroll
              for (int i = 0; i < 4; ++i) *(LAS u32x4*)(lds + L_KT + (tid + i * NTHREADS) * 16) = src[tid + i * NTHREADS]; }
            __syncthreads();
            STAMPX(21);
            const f32x4 dv4 = *(const f32x4*)(args.in[I_D] + g * 16 + (lane & 3) * 4);
#pragma unroll 1
            for (int ig = 1; ig >= 0; --ig) {
                f32x4 acc[4][4];
#pragma unroll
                for (int i = 0; i < 4; ++i)
#pragma unroll
                    for (int mb = 0; mb < 4; ++mb) acc[i][mb] = (f32x4){0.f, 0.f, 0.f, 0.f};
                const int tb0 = wave + 32 * ig, tmax = tb0 + 24;
                bf16x8 qf[4][4];
#pragma unroll
                for (int kq = 0; kq < 4; ++kq)
#pragma unroll
                    for (int i = 0; i < 4; ++i) qf[kq][i] = *(const bf16x8*)(Qt + (size_t)((tb0 + 8 * i) * 16 + l15) * 128 + 32 * kq + 8 * lq);
#pragma unroll 1
                for (int p = ig; p >= 0; --p) {
                    if (ig == 1 && p == 0) { __syncthreads(); STAGE_U(0); __syncthreads(); }
#pragma unroll 1
                    for (int kk = 0; kk < 16; ++kk) {
                        const int s0 = 32 * p + 2 * kk; if (s0 > tmax) break;
                        bf16x8 af[4];
#pragma unroll
                        for (int mb = 0; mb < 4; ++mb) af[mb] = UFRAG(mb, kk);
                        const int s = s0 + (lq >> 1);
#pragma unroll
                        for (int i = 0; i < 4; ++i) { const int t = tb0 + 8 * i;
                            if (t >= s0) { const int lag = t - s; bf16x8 bfr = *(const LAS bf16x8*)(lds + L_KT + (((lag < 0 ? 0 : lag) * 16 + l15) * 16 + 8 * (lq & 1)) * 2);
                                if (lag < 0) bfr = (bf16x8){0, 0, 0, 0, 0, 0, 0, 0};
#pragma unroll
                                for (int mb = 0; mb < 4; ++mb) acc[i][mb] = __builtin_amdgcn_mfma_f32_16x16x32_bf16(af[mb], bfr, acc[i][mb], 0, 0, 0); } }
                    }
                }
#pragma unroll
                for (int kq = 0; kq < 4; ++kq) {
                    bf16x8 af[4];
#pragma unroll
                    for (int mb = 0; mb < 4; ++mb) af[mb] = *(const LAS bf16x8*)(lds + L_SPV + ((16 * mb + l15) * 128 + 32 * kq + 8 * lq) * 2);
#pragma unroll
                    for (int i = 0; i < 4; ++i) {
#pragma unroll
                        for (int mb = 0; mb < 4; ++mb) acc[i][mb] = __builtin_amdgcn_mfma_f32_16x16x32_bf16(af[mb], qf[kq][i], acc[i][mb], 0, 0, 0); }
                }
                LAS float* stg = (LAS float*)(lds + L_STG + wave * 2048);
#pragma unroll
                for (int i = 0; i < 4; ++i) { const int t = tb0 + 8 * i;
                    u32x2 uq[2][2];
#pragma unroll
                    for (int hf = 0; hf < 2; ++hf)
#pragma unroll
                        for (int it = 0; it < 2; ++it) uq[hf][it] = *(const u32x2*)(ugp + (size_t)((32 * hf + ((it * 64 + lane) >> 2)) * 64 + t) * 16 + (lane & 3) * 4);
#pragma unroll
                    for (int hf = 0; hf < 2; ++hf) {
#pragma unroll
                        for (int ml = 0; ml < 2; ++ml)
#pragma unroll
                            for (int r = 0; r < 4; ++r) stg[(16 * ml + 4 * lq + r) * 16 + l15] = acc[i][2 * hf + ml][r];
                        asm volatile("s_waitcnt lgkmcnt(0)" ::: "memory");
#pragma unroll
                        for (int it = 0; it < 2; ++it) { const int idx = it * 64 + lane, tt = (32 * hf + (idx >> 2)) * 64 + t, c4 = (idx & 3) * 4;
                            const f32x4 yv = *(const LAS f32x4*)(stg + idx * 4); const u32x2 uu = uq[hf][it];
                            const f32x2 ya = gelu_tanh2((f32x2){yv[0], yv[1]} + (f32x2){dv4[0], dv4[1]} * (f32x2){bflo(uu.x), bfhi(uu.x)}), yb = gelu_tanh2((f32x2){yv[2], yv[3]} + (f32x2){dv4[2], dv4[3]} * (f32x2){bflo(uu.y), bfhi(uu.y)});
                            *(u32x2*)(ygelu + (size_t)(b * SEQ + tt) * 512 + g * 16 + c4) = (u32x2){cvt_pk_bf16(ya[0], ya[1]), cvt_pk_bf16(yb[0], yb[1])}; }
                        asm volatile("s_waitcnt lgkmcnt(0)" ::: "memory");
                    }
                }
            }
#undef STAGE_U
#undef UFRAG
        }
        STAMPX(22);
        {
            const int ch = lane * 8;
            float w0[8], w1[8], w2[8];
#pragma unroll
            for (int i = 0; i < 8; ++i) { w0[i] = args.in[I_CONVW][ch + i]; w1[i] = args.in[I_CONVW][512 + ch + i]; w2[i] = args.in[I_CONVW][1024 + ch + i]; }
            for (int run = gw; run < NTOK / 16; run += NGW) {
                const int r0 = run * 16, tin = r0 & (SEQ - 1);
                float vm2[8], vm1[8];
#pragma unroll
                for (int i = 0; i < 8; ++i) { vm2[i] = 0.f; vm1[i] = 0.f; }
                if (tin > 0) {
#pragma unroll
                    for (int d = 2; d >= 1; --d) { const bf16_t* pr = proj + (size_t)(r0 - d) * 1536;
                        const u32x4 c4 = *(const u32x4*)(pr + 512 + ch), x4 = *(const u32x4*)(pr + 1024 + ch);
                        float v[8]; v[0] = bflo(c4.x) * bflo(x4.x); v[1] = bfhi(c4.x) * bfhi(x4.x); v[2] = bflo(c4.y) * bflo(x4.y); v[3] = bfhi(c4.y) * bfhi(x4.y);
                        v[4] = bflo(c4.z) * bflo(x4.z); v[5] = bfhi(c4.z) * bfhi(x4.z); v[6] = bflo(c4.w) * bflo(x4.w); v[7] = bfhi(c4.w) * bfhi(x4.w);
#pragma unroll
                        for (int i = 0; i < 8; ++i) { if (d == 2) vm2[i] = v[i]; else vm1[i] = v[i]; } }
                }
#pragma unroll 1
                for (int tb = 0; tb < 16; tb += 8) {
                    u32x4 b4[8], c4[8], x4[8];
#pragma unroll
                    for (int q = 0; q < 8; ++q) { const bf16_t* pr = proj + (size_t)(r0 + tb + q) * 1536; b4[q] = *(const u32x4*)(pr + ch); c4[q] = *(const u32x4*)(pr + 512 + ch); x4[q] = *(const u32x4*)(pr + 1024 + ch); }
#pragma unroll
                    for (int q = 0; q < 8; ++q) {
                        float v[8], bgv[8], y[8]; v[0] = bflo(c4[q].x) * bflo(x4[q].x); v[1] = bfhi(c4[q].x) * bfhi(x4[q].x); v[2] = bflo(c4[q].y) * bflo(x4[q].y); v[3] = bfhi(c4[q].y) * bfhi(x4[q].y);
                        v[4] = bflo(c4[q].z) * bflo(x4[q].z); v[5] = bfhi(c4[q].z) * bfhi(x4[q].z); v[6] = bflo(c4[q].w) * bflo(x4[q].w); v[7] = bfhi(c4[q].w) * bfhi(x4[q].w);
                        bgv[0] = bflo(b4[q].x); bgv[1] = bfhi(b4[q].x); bgv[2] = bflo(b4[q].y); bgv[3] = bfhi(b4[q].y); bgv[4] = bflo(b4[q].z); bgv[5] = bfhi(b4[q].z); bgv[6] = bflo(b4[q].w); bgv[7] = bfhi(b4[q].w);
                        float ss = 0.f;
#pragma unroll
                        for (int i = 0; i < 8; ++i) { y[i] = bgv[i] * (w0[i] * vm2[i] + w1[i] * vm1[i] + w2[i] * v[i]); ss += y[i] * y[i]; vm2[i] = vm1[i]; vm1[i] = v[i]; }
                        const float rs = rsqrtf(wave_sum(ss) * (1.f / 512.f) + EPS);
                        u32x4 o; o.x = pk2(y[0] * rs, y[1] * rs); o.y = pk2(y[2] * rs, y[3] * rs); o.z = pk2(y[4] * rs, y[5] * rs); o.w = pk2(y[6] * rs, y[7] * rs);
                        *(u32x4*)(ycat + (size_t)(r0 + tb + q) * 1024 + 512 + ch) = o;
                    }
                }
            }
        }
    }
    SEAM(2);
    if (IN(3)) {
        PH_WS;
        SchedDense S{(const char*)ygelu, (const char*)(ws + WS_WGLU), 1024u, 1024u, 512, NTOK / 256, 2, G, bx};
        EpiGlu E{ygelu, ycat, ssqs};
        g8::gemm_phase(lds, S, E, wave);
    }
    SEAM(3);
    if (IN(4)) {
        PH_WS;
        SchedDense S{(const char*)ycat, (const char*)(ws + WS_WOUT), 2048u, 2048u, 1024, NTOK / 256, 4, G, bx};
        EpiRes E{xb, xh, x8, ssq2, ssqs, 6, 1.0f};
        g8::gemm_phase(lds, S, E, wave);
    }
    SEAM(4);
    if (IN(5)) {
        PH_WS;
        SchedQ S{(const char*)x8, (const char*)(ws + WS_WQ), 1024u, 1024u, 512, G, bx};
        EpiQ E{ssq2, qo};
        g8::gemm_phase(lds, S, E, wave);
    }
    STAMP(5);
    if (IN(6)) {
        PH_WS;
        SchedAttn S{(const char*)qo, (const char*)kmat, (const char*)vt, (const char*)pbuf, 512u, 512u, 256, G, bx, (BATCH * 4 * 16) / G};
        EpiAttn E{pbuf, ob, bx};
        g8::gemm_phase(lds, S, E, wave);
    }
    SEAM(6);
    if (IN(7)) {
        PH_WS;
        SchedDenseT<true> S{(const char*)ob, (const char*)(ws + WS_WO), 1024u, 1024u, 512, NTOK / 256, 4, G, bx};
        EpiRes E{xh, xh, x8, ssq3, ssqs, -1, 1.0f / (O8S * W8S)};
        g8::gemm_phase(lds, S, E, wave);
    }
    SEAM(7);
    if (IN(8)) {
        PH_WS;
        PH_IDS;
        LAS float* Xs = (LAS float*)lds;
        LAS float* Ws = (LAS float*)(lds + 34816);
        LAS float* Lg = (LAS float*)(lds + 69632);
        LAS int* hist = (LAS int*)(lds + 86528);
        LAS int* hbase = (LAS int*)(lds + 86656);
        const int te = tid & 7, tt = (tid >> 3) & 15, ks = tid >> 7;
        for (int blk = vcu; blk < NTOK / 128; blk += G) {
            const int r0 = blk * 128;
            float ac[8][4];
#pragma unroll
            for (int a = 0; a < 8; ++a)
#pragma unroll
                for (int e = 0; e < 4; ++e) ac[a][e] = 0.f;
            if (tid < 32) hist[tid] = 0;
            u32x2 xa[4], xb_[4]; f32x4 wa, wb;
#define P8_LOAD(xr, wv, kc) do { _Pragma("unroll") for (int j = 0; j < 4; ++j) xr[j] = *(const u32x2*)(xh + (size_t)(r0 + (tid >> 4) + 32 * j) * DM + (kc) * 64 + 4 * (tid & 15)); \
                wv = *(const f32x4*)(wrs + (size_t)((kc) * 64 + (tid >> 3)) * 32 + 4 * (tid & 7)); } while (0)
#define P8_STEP(xr, wv, kc) do { __syncthreads(); \
                _Pragma("unroll") for (int j = 0; j < 4; ++j) *(LAS f32x4*)(Xs + ((tid >> 4) + 32 * j) * 68 + 4 * (tid & 15)) = (f32x4){bflo(xr[j].x), bfhi(xr[j].x), bflo(xr[j].y), bfhi(xr[j].y)}; \
                *(LAS f32x4*)(Ws + (tid >> 3) * 32 + 4 * (tid & 7)) = wv; \
                __syncthreads(); \
                if ((kc) + 2 < 16) P8_LOAD(xr, wv, (kc) + 2); \
                _Pragma("unroll 2") \
                for (int q = 0; q < 4; ++q) { const int k4 = 4 * ks + q; \
                    f32x4 xv[8], w4[4]; \
                _Pragma("unroll") \
                    for (int i = 0; i < 8; ++i) xv[i] = *(const LAS f32x4*)(Xs + (tt + 16 * i) * 68 + 4 * k4); \
                _Pragma("unroll") \
                    for (int kk = 0; kk < 4; ++kk) w4[kk] = *(const LAS f32x4*)(Ws + (4 * k4 + kk) * 32 + 4 * te); \
                _Pragma("unroll") \
                    for (int i = 0; i < 8; ++i) \
                _Pragma("unroll") \
                        for (int kk = 0; kk < 4; ++kk) \
                _Pragma("unroll") \
                            for (int e = 0; e < 4; ++e) ac[i][e] += xv[i][kk] * w4[kk][e]; } \
                } while (0)
            P8_LOAD(xa, wa, 0); P8_LOAD(xb_, wb, 1);
            for (int kc = 0; kc < 16; kc += 2) { P8_STEP(xa, wa, kc); P8_STEP(xb_, wb, kc + 1); }
#undef P8_STEP
#undef P8_LOAD
            __syncthreads();
            { LAS float* Lp = (LAS float*)lds;
#pragma unroll
              for (int i = 0; i < 8; ++i)
#pragma unroll
                for (int e = 0; e < 4; ++e) Lp[(ks * 128 + tt + 16 * i) * 33 + 4 * te + e] = ac[i][e]; }
            __syncthreads();
            for (int o = tid; o < 128 * 32; o += NTHREADS) { const int t = o >> 5, e = o & 31; const LAS float* Lp = (const LAS float*)lds;
                const float sum = (Lp[t * 33 + e] + Lp[(128 + t) * 33 + e]) + (Lp[(256 + t) * 33 + e] + Lp[(384 + t) * 33 + e]);
                Lg[t * 33 + e] = sum * rsqrtf(ssq3[r0 + t] * (1.0f / 1024.0f) + EPS) + args.in[I_BR][e]; }
            __syncthreads();
            int ei[4], lp[4]; float gv[4];
            if (tid < 128) {
                unsigned taken = 0u; float tv[4];
#pragma unroll
                for (int k = 0; k < 4; ++k) { float best = -3.0e38f; int bi = 0;
                    for (int e = 0; e < 32; ++e) { const float v = Lg[tid * 33 + e]; if (!((taken >> e) & 1u) && v > best) { best = v; bi = e; } }
                    taken |= 1u << bi; ei[k] = bi; tv[k] = best; }
                float sum = 0.f;
#pragma unroll
                for (int k = 0; k < 4; ++k) { gv[k] = __expf(tv[k] - tv[0]); sum += gv[k]; }
                const float inv = 1.0f / sum;
#pragma unroll
                for (int k = 0; k < 4; ++k) { gv[k] *= inv; lp[k] = __hip_atomic_fetch_add((LAS int*)(hist + ei[k]), 1, __ATOMIC_RELAXED, __HIP_MEMORY_SCOPE_WORKGROUP); }
            }
            __syncthreads();
            if (tid < 32) hbase[tid] = atomicAdd(counts + tid, hist[tid]);
            __syncthreads();
            if (tid < 128) {
                const int tok = r0 + tid; const float rs = rsqrtf(ssq3[tok] * (1.0f / 1024.0f) + EPS);
#pragma unroll
                for (int k = 0; k < 4; ++k) { const size_t idx = (size_t)ei[k] * ECAP + hbase[ei[k]] + lp[k]; tokl[idx] = tok * 4 + k; gatel[idx] = gv[k]; rstdl[idx] = rs; }
            }
            __syncthreads();
        }
    }
    SEAM(8);
    if (IN(9) || IN(10)) {
        PH_WS;
        PH_IDS;
        LAS int* tb = (LAS int*)(lds + XL_OFF + XL_TB); LAS int* cn = (LAS int*)(lds + XL_OFF + XL_CNT);
        __syncthreads();
        if (tid == 0) { int a = 0; for (int e = 0; e < NEXP; ++e) { const int c = ald(counts + e); cn[e] = c; tb[e] = a; a += (c + 255) >> 8; } tb[NEXP] = a; }
        __syncthreads();
        if (IN(9)) {
        PH_WS;
            SchedMoeT<true> S; S.tb = tb; S.cnt = cn; S.tl = tokl; S.A = (const char*)x8; S.B = (const char*)(ws + WS_WGU); S.lda2 = 1024u; S.ldb2 = 1024u; S.K = 512; S.nN = 8; S.G = G; S.c = bx; S.bstride = (size_t)2048 * 1024; S.gather = true;
            EpiMoe1 E{rstdl, args.in[I_BGU], act};
            g8::gemm_phase(lds, S, E, wave);
        }
    }
    SEAM(9);
    if (IN(10)) {
        PH_WS;
        LAS int* tb = (LAS int*)(lds + XL_OFF + XL_TB); LAS int* cn = (LAS int*)(lds + XL_OFF + XL_CNT);
        SchedMoeT<false> S; S.tb = tb; S.cnt = cn; S.tl = tokl; S.A = (const char*)act; S.B = (const char*)(ws + WS_WDN); S.lda2 = 1024u; S.ldb2 = 1024u; S.K = 512; S.nN = 4; S.G = G; S.c = bx; S.bstride = (size_t)1024 * 1024; S.gather = false;
        EpiMoe2 E{tokl, gatel, args.in[I_BDN], slots};
        g8::gemm_phase(lds, S, E, wave);
    }
    SEAM(10);
    if (IN(11)) {
        PH_WS;
        PH_IDS;
        for (int m = gw; m < NTOK; m += NGW) {
            f32x4 v[4];
            { const u32x2* xr = (const u32x2*)(xh + (size_t)m * DM) + lane;
#pragma unroll
              for (int j = 0; j < 4; ++j) { const u32x2 w = xr[64 * j]; v[j] = (f32x4){bflo(w.x), bfhi(w.x), bflo(w.y), bfhi(w.y)}; } }
            if (DBG_OUT == 0) {
#pragma unroll
                for (int k = 0; k < 4; ++k) { const unsigned* sr = (const unsigned*)((const unsigned char*)slots + (size_t)(m * 4 + k) * DM) + lane;
#pragma unroll
                    for (int j = 0; j < 4; ++j) { const int w = (int)sr[64 * j]; const f32x2 lo = __builtin_amdgcn_cvt_pk_f32_fp8(w, false), hi = __builtin_amdgcn_cvt_pk_f32_fp8(w, true);
                        v[j][0] += lo[0] * (1.0f / S8S); v[j][1] += lo[1] * (1.0f / S8S); v[j][2] += hi[0] * (1.0f / S8S); v[j][3] += hi[1] * (1.0f / S8S); } }
            }
            float ss = 0.f;
#pragma unroll
            for (int j = 0; j < 4; ++j) ss += (v[j][0] * v[j][0] + v[j][1] * v[j][1]) + (v[j][2] * v[j][2] + v[j][3] * v[j][3]);
            const float rs = rsqrtf(wave_sum(ss) * (1.f / DM) + EPS);
            f32x4* o = (f32x4*)(args.out + (size_t)m * DM) + lane;
#pragma unroll
            for (int j = 0; j < 4; ++j) { const f32x4 g = ((const f32x4*)args.in[I_NF])[lane + 64 * j]; o[64 * j] = v[j] * rs * g; }
        }
    }
#if PROBE_PHASE >= 0 || PROBE_A >= 0
    STAMP(11);
    if (bx == 0 && threadIdx.x == 0) {
        const int ia = (PROBE_A >= 0) ? PROBE_A : PROBE_PHASE, ib = (PROBE_A >= 0) ? PROBE_B : PROBE_PHASE + 1;
        const unsigned long long d = (stamps[ib] - stamps[ia]) * (unsigned long long)PROBE_MULT, t0 = __builtin_amdgcn_s_memrealtime();
        while (__builtin_amdgcn_s_memrealtime() - t0 < d) __builtin_amdgcn_s_sleep(16);
    }
#endif
#undef IN
#undef SEAM
#undef vcu
#undef gw
#undef NGW
#undef counts
#undef rstd1
#undef ssqs
#undef ssq2
#undef ssq3
#undef gates
#undef gatel
#undef rstdl
#undef wrs
#undef tokl
#undef xb
#undef proj
#undef ug
#undef ycat
#undef ygelu
#undef x8
#undef xh
#undef qo
#undef pbuf
#undef ob
#undef act
#undef slots
#undef memn
#undef kmat
#undef vt
}

extern "C" void kernel_launch(void* const* d_in, const int* in_sizes, int n_in, void* d_out, int out_size, void* d_ws, size_t ws_size, hipStream_t stream) {
    static int grid = 0;
    if (grid == 0) {
        if (n_in != 30 || in_sizes[0] != NTOK * DM || out_size != NTOK * DM || ws_size < WS_END) { fprintf(stderr, "kernel_launch: unexpected shapes (n_in %d, in0 %d, out %d, ws %zu < %zu); nothing launched\n", n_in, n_in > 0 ? in_sizes[0] : -1, out_size, ws_size, (size_t)WS_END); grid = -1; return; }
        int dev = 0, cus = 0, per_cu = 0;
        if (hipGetDevice(&dev) != hipSuccess || hipDeviceGetAttribute(&cus, hipDeviceAttributeMultiprocessorCount, dev) != hipSuccess) { grid = -1; return; }
        if (hipFuncSetAttribute((const void*)mk_fwd, hipFuncAttributeMaxDynamicSharedMemorySize, LDS_BYTES) != hipSuccess) { fprintf(stderr, "kernel_launch: hipFuncSetAttribute failed\n"); grid = -1; return; }
        if (hipOccupancyMaxActiveBlocksPerMultiprocessor(&per_cu, (const void*)mk_fwd, NTHREADS, LDS_BYTES) != hipSuccess || per_cu < 1) { fprintf(stderr, "kernel_launch: occupancy query says %d blocks per CU\n", per_cu); per_cu = 1; }
        (void)hipGetLastError();
        grid = cus;
        if (grid != 256) fprintf(stderr, "kernel_launch: %d CUs; the attention phase assumes 256\n", grid);
    }
    if (grid < 0) return;
    if (hipMemsetAsync((char*)d_ws + WS_BAR, 0, BAR_ZERO_BYTES, stream) != hipSuccess) { fprintf(stderr, "kernel_launch: hipMemsetAsync failed\n"); return; }
    Args a{};
    for (int i = 0; i < 30; ++i) a.in[i] = (const float*)d_in[i];
    a.out = (float*)d_out; a.ws = (unsigned char*)d_ws;
#if MK_PER_PHASE
    for (int ph = 0; ph < 12; ++ph) { a.ph_lo = ph; a.ph_hi = ph + 1; hipLaunchKernelGGL(mk_fwd, dim3(grid), dim3(NTHREADS), LDS_BYTES, stream, a); }
#else
    a.ph_lo = 0; a.ph_hi = 12;
    void* kargs[] = {&a};
    hipError_t e = hipLaunchCooperativeKernel((const void*)mk_fwd, dim3(grid), dim3(NTHREADS), kargs, LDS_BYTES, stream);
    if (e != hipSuccess) fprintf(stderr, "kernel_launch: cooperative launch failed: %s (grid %d)\n", hipGetErrorString(e), grid);
#endif
}
```

```cpp
#include <hip/hip_runtime.h>
#include <hip/hip_cooperative_groups.h>
#include <cstdio>
#include <cstdint>
#include <cmath>
namespace cg = cooperative_groups;

#ifndef MK_PER_PHASE
#define MK_PER_PHASE 0
#endif
#ifndef MK_USE_CG
#define MK_USE_CG 0
#endif
#ifndef PROBE_PHASE
#define PROBE_PHASE -1
#endif
#ifndef PROBE_EPI
#define PROBE_EPI -1
#endif
#ifndef PROBE_A
#define PROBE_A -1
#define PROBE_B -1
#endif
#ifndef PROBE_MULT
#define PROBE_MULT 1
#endif
#ifndef DBG_OUT
#define DBG_OUT 0
#endif

#define LAS __attribute__((address_space(3)))
typedef unsigned short bf16_t;
typedef short bf16x8 __attribute__((ext_vector_type(8)));
typedef float f32x4 __attribute__((ext_vector_type(4)));
typedef float f32x2 __attribute__((ext_vector_type(2)));
typedef unsigned u32x4 __attribute__((ext_vector_type(4)));
typedef unsigned u32x2 __attribute__((ext_vector_type(2)));
typedef int i32x4 __attribute__((ext_vector_type(4)));
typedef int i32x8 __attribute__((ext_vector_type(8)));

constexpr int NTHREADS = 512, NWAVES = 8;
constexpr int DM = 1024, BATCH = 8, SEQ = 4096, NTOK = BATCH * SEQ, MEMLEN = 256, NMEM = BATCH * MEMLEN;
constexpr int NEXP = 32, TOPK = 4, ECAP = NTOK;
constexpr int MAXTILES = (NTOK * TOPK) / 256 + NEXP;
constexpr float EPS = 1e-5f;
constexpr float X8S = 16.0f, W8S = 256.0f, A8S = 4.0f, O8S = 64.0f, S8S = 32.0f, Q8S = 64.0f, K8S = 16.0f, P8S = 256.0f;

constexpr size_t MiB = 1u << 20;
constexpr size_t WS_CNT = 0;
constexpr size_t WS_BAR = 256 * 1024, BAR_ZERO_BYTES = 16 * 1024;
constexpr size_t WS_STAMP = 512 * 1024;
constexpr size_t WS_RSTD1 = 1 * MiB;
constexpr size_t WS_SSQS = WS_RSTD1 + 128 * 1024;
constexpr size_t WS_SSQ2 = WS_SSQS + 128 * 1024;
constexpr size_t WS_SSQ3 = WS_SSQ2 + 128 * 1024;
constexpr size_t WS_GATES = 2 * MiB;
constexpr size_t WS_WR = 3 * MiB;
constexpr size_t WS_TOKL = 4 * MiB;
constexpr size_t WS_SSM = 8 * MiB;
constexpr size_t SSM_STRIDE = 576 * 1024, SSM_KT = 1024, SSM_PT = 64 * 1024, SSM_QT = 320 * 1024;
constexpr size_t WS_WIN = 26 * MiB, WS_WGLU = 30 * MiB, WS_WOUT = 31 * MiB, WS_WQ = 33 * MiB, WS_WK = 35 * MiB, WS_WV = 37 * MiB, WS_WO = 39 * MiB;
constexpr size_t WS_MEMN = 41 * MiB, WS_KMAT = 45 * MiB, WS_VT = 49 * MiB;
constexpr size_t WS_WGU = 56 * MiB, WS_WDN = 184 * MiB;
constexpr size_t WS_YGELU = 248 * MiB;
constexpr size_t WS_X1 = 280 * MiB;
constexpr size_t WS_ACT = 408 * MiB;
constexpr size_t WS_XB = 408 * MiB, WS_PROJ = 472 * MiB, WS_UG = 568 * MiB, WS_YCAT = 600 * MiB;
constexpr size_t WS_SLOTS = 680 * MiB;
constexpr size_t WS_XH = 312 * MiB  , WS_QO = 744 * MiB, WS_PBUF = 808 * MiB, WS_O = 872 * MiB;
constexpr size_t WS_GATEL = 936 * MiB, WS_RSTDL = 940 * MiB;
constexpr size_t WS_END = 944 * MiB;

constexpr int LDS_BYTES = 147456;
constexpr int XL_OFF = 131072;
constexpr int XL_PMAX = 0, XL_PSUM = 4096, XL_TB = 12288, XL_CNT = 12544, XL_MISC = 13312;

__device__ __forceinline__ float wave_sum(float v) {
#pragma unroll
    for (int o = 1; o < 64; o <<= 1) v += __shfl_xor(v, o);
    return v;
}
__device__ __forceinline__ unsigned f2bf(float f) { unsigned u = __builtin_bit_cast(unsigned, f); return (u + 0x7fffu + ((u >> 16) & 1u)) >> 16; }
__device__ __forceinline__ unsigned pk2(float lo, float hi) { return f2bf(lo) | (f2bf(hi) << 16); }
__device__ __forceinline__ unsigned cvt_pk_bf16(float lo, float hi) { unsigned r; asm volatile("v_cvt_pk_bf16_f32 %0, %1, %2" : "=v"(r) : "v"(lo), "v"(hi)); return r; }
__device__ __forceinline__ unsigned pk4_fp8(float a, float b, float c, float d) { int w = __builtin_amdgcn_cvt_pk_fp8_f32(a, b, 0, false); w = __builtin_amdgcn_cvt_pk_fp8_f32(c, d, w, true); return (unsigned)w; }
__device__ __forceinline__ float clamp448(float v) { return __builtin_amdgcn_fmed3f(v, -448.0f, 448.0f); }
__device__ __forceinline__ float bflo(unsigned w) { return __builtin_bit_cast(float, w << 16); }
__device__ __forceinline__ float bfhi(unsigned w) { return __builtin_bit_cast(float, w & 0xffff0000u); }
__device__ __forceinline__ float bf2f(bf16_t b) { return __builtin_bit_cast(float, (unsigned)b << 16); }
__device__ __forceinline__ float sigmoidf_(float x) { return __builtin_amdgcn_rcpf(1.0f + __builtin_amdgcn_exp2f(-1.4426950408889634f * x)); }
__device__ __forceinline__ f32x2 sigmoid2(f32x2 x) { f32x2 e = x * -1.4426950408889634f; e[0] = __builtin_amdgcn_exp2f(e[0]); e[1] = __builtin_amdgcn_exp2f(e[1]); f32x2 d = e + 1.0f; d[0] = __builtin_amdgcn_rcpf(d[0]); d[1] = __builtin_amdgcn_rcpf(d[1]); return d; }
__device__ __forceinline__ f32x2 gelu_tanh2(f32x2 y) { const f32x2 t = (y * y * 0.044715f + 1.0f) * y * (2.0f * 0.7978845608028654f); return y * sigmoid2(t); }
__device__ __forceinline__ float gelu_tanh(float y) { const float t = 0.7978845608028654f * (y + 0.044715f * y * y * y); return y * sigmoidf_(2.0f * t); }
__device__ __forceinline__ int ald(const int* p) { return __hip_atomic_load(p, __ATOMIC_RELAXED, __HIP_MEMORY_SCOPE_AGENT); }

namespace g8 {
constexpr int BM = 256, BK = 64, HALF = 128, HTB = HALF * BK * 2, NXCD = 8, WGM = 8;
__device__ __forceinline__ int lds_byte(int r, int c) { const int st = (r >> 4) * 2 + (c >> 5), rr = r & 15, cc = c & 31, ob = rr * 64 + cc * 2; return st * 1024 + (ob ^ (((ob >> 9) & 1) << 5)); }
__device__ __forceinline__ void stage_rc(int b, int& R, int& C) { const int st = b / 1024, sb = b % 1024, swz = sb ^ (((sb >> 9) & 1) << 5); R = (st >> 1) * 16 + swz / 64; C = (st & 1) * 32 + (swz % 64) / 2; }
__device__ __forceinline__ int perm32(int rho) { const int n = rho >> 4, i = rho & 15; return 8 * (i >> 2) + 4 * n + (i & 3); }

struct Unit { const char* A; const char* B; int pm, pn, e, aux, valid, job; };

__device__ __forceinline__ bool tile_order(int i, int G, int c, int nM, int nN, int& pm, int& pn) {
    const int nwg = nM * nN; const long L = (long)i * G + c; if (L >= nwg) return false;
    int wgid = (int)L; { const int q = nwg / NXCD, r = nwg % NXCD, xcd = wgid % NXCD, off = wgid / NXCD; wgid = (xcd < r ? xcd * (q + 1) : r * (q + 1) + (xcd - r) * q) + off; }
    const int nig = WGM * nN, gid = wgid / nig, fm = gid * WGM, gsz = (nM - fm) < WGM ? (nM - fm) : WGM;
    pm = fm + ((wgid % nig) % gsz); pn = (wgid % nig) / gsz; return true;
}

__device__ __forceinline__ int lane_id_volatile() { int l; asm volatile("v_mbcnt_lo_u32_b32 %0, -1, 0\n\tv_mbcnt_hi_u32_b32 %0, -1, %0" : "=v"(l)); return l; }
template <class Epi, class Sched>
__device__ __forceinline__ void gemm_phase(LAS unsigned char* lds, const Sched& S, const Epi& E, const int wid) {
    const int lane = lane_id_volatile(), tid = wid * 64 + lane, wr = wid >> 2, wc = wid & 3, fr = lane & 15, fq = lane >> 4;
    const int K = S.K, nt = K / BK;
    const unsigned lda2 = S.lda2, ldb2 = S.ldb2;
    unsigned voffB0, cb0;
    { int R, C; stage_rc(tid * 16, R, C); cb0 = (unsigned)C * 2u; const int Rb = (R & ~31) + perm32(R & 31); voffB0 = (unsigned)Rb * ldb2 + cb0; }
    const size_t pstepA = (size_t)64 * lda2, pstepB = (size_t)64 * ldb2, hstepA = (size_t)HALF * lda2;
    const size_t kstep = (size_t)(BK * 2);
    const size_t hstepB = (size_t)HALF * ldb2;
    const unsigned ldsw = (unsigned)wid * 1024u;
    const int aoff = lds_byte(wr * 64 + fr, fq * 8), boff = lds_byte(wc * 32 + fr, fq * 8);
#define G8_SA(b, h) (((b) * 2 + (h)) * HTB)
#define G8_SB(b, h) ((4 + (b) * 2 + (h)) * HTB)
#define G8_STAGE_B(bufoff, gbase) do { _Pragma("unroll") for (int _i = 0; _i < 2; ++_i) \
        __builtin_amdgcn_global_load_lds((const unsigned*)((const char*)(gbase) + _i * pstepB + voffB0), (LAS unsigned*)(lds + (bufoff) + ldsw + _i * 8192), 16, 0, 0); } while (0)
#define G8_STAGE_A(bufoff, gbase, o0, o1) do { \
        __builtin_amdgcn_global_load_lds((const unsigned*)((const char*)(gbase) + (o0)), (LAS unsigned*)(lds + (bufoff) + ldsw), 16, 0, 0); \
        __builtin_amdgcn_global_load_lds((const unsigned*)((const char*)(gbase) + (o1)), (LAS unsigned*)(lds + (bufoff) + ldsw + 8192), 16, 0, 0); } while (0)
#define G8_LDA(dst, b, h) do { _Pragma("unroll") for (int m = 0; m < 4; ++m) _Pragma("unroll") for (int k = 0; k < 2; ++k) dst[m][k] = *(const LAS bf16x8*)(lds + G8_SA(b, h) + aoff + m * 2048 + k * 1024); } while (0)
#define G8_LDB(dst, b, h) do { _Pragma("unroll") for (int n = 0; n < 2; ++n) _Pragma("unroll") for (int k = 0; k < 2; ++k) dst[n][k] = *(const LAS bf16x8*)(lds + G8_SB(b, h) + boff + n * 2048 + k * 1024); } while (0)
#define G8_MMA(ai, bj, At, Bt) do { __builtin_amdgcn_s_setprio(1); _Pragma("unroll") for (int m = 0; m < 4; ++m) _Pragma("unroll") for (int n = 0; n < 2; ++n) _Pragma("unroll") for (int k = 0; k < 2; ++k) \
        acc[ai][bj][m][n] = __builtin_amdgcn_mfma_f32_16x16x32_bf16(Bt[n][k], At[m][k], acc[ai][bj][m][n], 0, 0, 0); __builtin_amdgcn_s_setprio(0); } while (0)
#define G8_RD16(off) __builtin_bit_cast(i32x4, *(const LAS bf16x8*)(lds + (off)))
#define G8_LDA8(dst, b, h) do { _Pragma("unroll") for (int m = 0; m < 4; ++m) dst[m] = __builtin_shufflevector(G8_RD16(G8_SA(b, h) + aoff + m * 2048), G8_RD16(G8_SA(b, h) + aoff + m * 2048 + 1024), 0, 1, 2, 3, 4, 5, 6, 7); } while (0)
#define G8_LDB8(dst, b, h) do { _Pragma("unroll") for (int n = 0; n < 2; ++n) dst[n] = __builtin_shufflevector(G8_RD16(G8_SB(b, h) + boff + n * 2048), G8_RD16(G8_SB(b, h) + boff + n * 2048 + 1024), 0, 1, 2, 3, 4, 5, 6, 7); } while (0)
#define G8_MMA8(ai, bj, At, Bt) do { __builtin_amdgcn_s_setprio(1); _Pragma("unroll") for (int m = 0; m < 4; ++m) _Pragma("unroll") for (int n = 0; n < 2; ++n) \
        asm volatile("s_nop 1\n\tv_mfma_scale_f32_16x16x128_f8f6f4 %0, %1, %2, %0, %3, %3 op_sel_hi:[0,0,0]" : "+v"(acc[ai][bj][m][n]) : "v"(Bt[n]), "v"(At[m]), "v"(scl8)); __builtin_amdgcn_s_setprio(0); } while (0)
#define G8_MM(ai, bj, X) do { if constexpr (Sched::FP8) G8_MMA8(ai, bj, At8, X##8); else G8_MMA(ai, bj, At, X); } while (0)
#define G8_LA(b, h) do { if constexpr (Sched::FP8) G8_LDA8(At8, b, h); else G8_LDA(At, b, h); } while (0)
#define G8_LB(X, b, h) do { if constexpr (Sched::FP8) G8_LDB8(X##8, b, h); else G8_LDB(X, b, h); } while (0)
#define G8_WAIT_V(n) asm volatile("s_waitcnt vmcnt(" #n ")" ::: "memory")
#define G8_WAIT_L(n) asm volatile("s_waitcnt lgkmcnt(" #n ")" ::: "memory")
#define G8_BAR __builtin_amdgcn_s_barrier()
#define G8_SCHED __builtin_amdgcn_sched_barrier(0)
#define G8_SETOFF(o, u) do { const int _t = wid * 64 + lane_id_volatile(); _Pragma("unroll") for (int _i = 0; _i < 2; ++_i) { int _R, _C; stage_rc(_t * 16 + _i * 8192, _R, _C); \
        _Pragma("unroll") for (int _h = 0; _h < 2; ++_h) { if (Sched::GATHER) { const unsigned _tk = S.arow_tok(u, _h * HALF + _R); if (_i == 0) o[_h][0] = _tk; else o[_h][0] |= _tk << 16; } \
            else if (_h == 0 && _i == 0) o[0][0] = (unsigned)_R * lda2 + (unsigned)_C * 2u; } } } while (0)
#define G8_GOFF0(pk) (((pk) & 0xffffu) * lda2 + cb0)
#define G8_GOFF1(pk) (((pk) >> 16) * lda2 + cb0)
#define G8_STAGE_AH(bufoff, gbase, h, pk) do { if (Sched::GATHER) { G8_STAGE_A(bufoff, gbase, G8_GOFF0(pk), G8_GOFF1(pk)); } \
        else { G8_STAGE_A(bufoff, (const char*)(gbase) + (h) * hstepA, oa[0][0], pstepA + oa[0][0]); } } while (0)
    Unit cur, nxt; int ui = 0;
    if (!S.next(0, cur)) return;
    f32x4 acc[2][2][4][2];
#pragma unroll
    for (int a = 0; a < 2; ++a)
#pragma unroll
        for (int b = 0; b < 2; ++b)
#pragma unroll
            for (int m = 0; m < 4; ++m)
#pragma unroll
                for (int n = 0; n < 2; ++n) acc[a][b][m][n] = (f32x4){0.f, 0.f, 0.f, 0.f};
    bf16x8 At[4][2], B0[2][2], B1[2][2];
    i32x8 At8[4], B08[2], B18[2]; const int scl8 = 0x7F7F7F7F;
    unsigned oa[2][2], on[2][2];
    G8_SETOFF(oa, cur);
    const char* cA = cur.A; const char* cB = cur.B;
    G8_STAGE_B(G8_SB(0, 0), cB); G8_STAGE_B(G8_SB(0, 1), cB + hstepB); G8_STAGE_AH(G8_SA(0, 0), cA, 0, oa[0][0]); G8_STAGE_AH(G8_SA(0, 1), cA, 1, oa[1][0]);
    if (wr == 1) G8_BAR;
    G8_WAIT_V(2); G8_BAR;
    G8_STAGE_B(G8_SB(1, 0), cB + kstep); G8_STAGE_AH(G8_SA(1, 0), cA + kstep, 0, oa[0][0]); G8_STAGE_B(G8_SB(1, 1), cB + hstepB + kstep);
    G8_WAIT_V(6); G8_BAR;
    bool has_next = S.next(1, nxt);
    if (Sched::GATHER) { if (has_next) { G8_SETOFF(on, nxt); } else {
#pragma unroll
        for (int h = 0; h < 2; ++h) on[h][0] = oa[h][0]; } }
    for (;;) {
        const char* nA = has_next ? nxt.A : cA; const char* nB = has_next ? nxt.B : cB;
#pragma unroll 1
        for (int t = 0; t < nt; t += 2) {
            const bool last = (t == nt - 2);
            const char* a1 = cA + (size_t)(t + 1) * kstep;
            const char* a2 = last ? nA : cA + (size_t)(t + 2) * kstep; const char* b2 = last ? nB : cB + (size_t)(t + 2) * kstep;
            const char* a3 = a2 + kstep; const char* b3 = b2 + kstep;
            unsigned p0 = 0, p1 = 0;
            if (Sched::GATHER) { p0 = last ? on[0][0] : oa[0][0]; p1 = last ? on[1][0] : oa[1][0]; }
            G8_LB(B0, 0, 0); G8_LB(B1, 0, 1); G8_SCHED; G8_LA(0, 0); G8_STAGE_AH(G8_SA(1, 1), a1, 1, oa[1][0]);
            G8_WAIT_V(8); G8_WAIT_L(0); G8_BAR; G8_MM(0, 0, B0); G8_MM(0, 1, B1); G8_BAR; G8_SCHED;
            G8_LA(0, 1); G8_STAGE_B(G8_SB(0, 0), b2); G8_STAGE_B(G8_SB(0, 1), b2 + hstepB); G8_STAGE_AH(G8_SA(0, 0), a2, 0, p0);
            G8_WAIT_V(8); G8_WAIT_L(0); G8_BAR; G8_MM(1, 0, B0); G8_MM(1, 1, B1); G8_BAR; G8_SCHED;
            G8_LB(B0, 1, 0); G8_LB(B1, 1, 1); G8_SCHED; G8_LA(1, 0); G8_STAGE_AH(G8_SA(0, 1), a2, 1, p1);
            G8_WAIT_V(8); G8_WAIT_L(0); G8_BAR; G8_MM(0, 0, B0); G8_MM(0, 1, B1); G8_BAR; G8_SCHED;
            G8_LA(1, 1); G8_STAGE_B(G8_SB(1, 0), b3); G8_STAGE_B(G8_SB(1, 1), b3 + hstepB); G8_STAGE_AH(G8_SA(1, 0), a3, 0, p0);
            G8_WAIT_V(8); G8_WAIT_L(0); G8_BAR; G8_MM(1, 0, B0); G8_MM(1, 1, B1); G8_BAR; G8_SCHED;
            if (Epi::MID) { const int fr_e = lane_id_volatile() & 15; E.mid(acc, cur, t, wr, fr_e); }
        }
        if (wr == 0) G8_BAR;
        if constexpr (Sched::FP8) asm volatile("s_nop 15\n\ts_nop 15" ::: "memory");
        Unit n2; bool has2 = false; unsigned tk[2][2] = {{0u, 0u}, {0u, 0u}};
        if (has_next) { has2 = S.next(ui + 2, n2);
            if (Sched::GATHER && has2) { const int _t = wid * 64 + lane_id_volatile();
#pragma unroll
                for (int _i = 0; _i < 2; ++_i) { int _R, _C; stage_rc(_t * 16 + _i * 8192, _R, _C);
#pragma unroll
                    for (int _h = 0; _h < 2; ++_h) tk[_h][_i] = S.arow_tok(n2, _h * HALF + _R); } } }
        { const int l_e = lane_id_volatile(), fr_e = l_e & 15, fq_e = l_e >> 4;
          E(acc, cur, wr, wc, fr_e, fq_e, lds); if constexpr (Epi::PROBE2) { asm volatile("" ::: "memory"); const Epi E2 = E.probe_copy(); E2(acc, cur, wr, wc, fr_e, fq_e, lds); } }
        if (!has_next) break;
#pragma unroll
        for (int a = 0; a < 2; ++a)
#pragma unroll
            for (int b = 0; b < 2; ++b)
#pragma unroll
                for (int m = 0; m < 4; ++m)
#pragma unroll
                    for (int n = 0; n < 2; ++n) acc[a][b][m][n] = (f32x4){0.f, 0.f, 0.f, 0.f};
        cur = nxt; cA = nA; cB = nB; ++ui;
        if (Sched::GATHER) {
#pragma unroll
            for (int h = 0; h < 2; ++h) { oa[h][0] = on[h][0]; if (has2) on[h][0] = tk[h][0] | (tk[h][1] << 16); } }
        nxt = n2; has_next = has2;
        if (wr == 1) G8_BAR;
    }
    G8_WAIT_V(0);
    G8_BAR;
#undef G8_SA
#undef G8_SB
#undef G8_STAGE_A
#undef G8_STAGE_B
#undef G8_LDA
#undef G8_LDB
#undef G8_MMA
#undef G8_MMA8
#undef G8_MM
#undef G8_LA
#undef G8_LB
#undef G8_LDA8
#undef G8_LDB8
#undef G8_RD16
#undef G8_WAIT_V
#undef G8_WAIT_L
#undef G8_BAR
#undef G8_SCHED
#undef G8_SETOFF
#undef G8_GOFF0
#undef G8_GOFF1
#undef G8_STAGE_AH
}
}
using g8::Unit;
using g8::lane_id_volatile;

#define EPI_PROBE_COPY(T) __device__ __forceinline__ T probe_copy() const { return *this; }
#define EPI_ROWS(ai, m) _Pragma("unroll") for (int ai = 0; ai < 2; ++ai) _Pragma("unroll") for (int m = 0; m < 4; ++m)
__device__ __forceinline__ u32x4 pack8(const f32x4 a, const f32x4 b) { u32x4 w; w.x = cvt_pk_bf16(a[0], a[1]); w.y = cvt_pk_bf16(a[2], a[3]); w.z = cvt_pk_bf16(b[0], b[1]); w.w = cvt_pk_bf16(b[2], b[3]); return w; }
__device__ __forceinline__ float sq8(const f32x4 a, const f32x4 b) { return (a[0] * a[0] + a[1] * a[1]) + (a[2] * a[2] + a[3] * a[3]) + (b[0] * b[0] + b[1] * b[1]) + (b[2] * b[2] + b[3] * b[3]); }
__device__ __forceinline__ void row_atomic(float* p, float s, int fq) { s += __shfl_xor(s, 16); s += __shfl_xor(s, 32); if (fq == 0) atomicAdd(p, s); }

template <bool F8> struct SchedDenseT {
    static constexpr bool GATHER = false, FP8 = F8;
    const char* A; const char* B; unsigned lda2, ldb2; int K, nM, nN, G, c;
    __device__ __forceinline__ bool next(int i, Unit& u) const {
        int pm, pn; if (!g8::tile_order(i, G, c, nM, nN, pm, pn)) return false;
        u.pm = pm; u.pn = pn; u.A = A + (size_t)pm * 256 * lda2; u.B = B + (size_t)pn * 256 * ldb2; u.e = 0; u.aux = 0; u.valid = 256; u.job = 0; return true;
    }
    __device__ __forceinline__ unsigned arow_tok(const Unit&, int) const { return 0u; }
};
typedef SchedDenseT<false> SchedDense;
struct SchedP1 {
    static constexpr bool GATHER = false, FP8 = false;
    const char *xb, *win, *memn, *wk, *wv; unsigned lda2, ldb2; int K, G, c;
    __device__ __forceinline__ bool next(int i, Unit& u) const {
        const int L = i * G + c;
        u.e = 0; u.aux = 0; u.valid = 256;
        if (L < 1024) { int pm, pn; g8::tile_order(i, G, c, 128, 8, pm, pn); u.pm = pm; u.pn = pn; u.job = 0; u.A = xb + (size_t)pm * 256 * 2048; u.B = win + (size_t)pn * 256 * 2048; return true; }
        const int r = L - 1024;
        if (r < 32) { u.pm = r >> 2; u.pn = r & 3; u.job = 1; u.A = memn + (size_t)u.pm * 256 * 2048; u.B = wk + (size_t)u.pn * 256 * 2048; return true; }
        if (r < 64) { const int q = r - 32; u.pm = q >> 3; u.pn = q & 7; u.job = 2; u.A = wv + (size_t)u.pm * 256 * 2048; u.B = memn + (size_t)u.pn * 256 * 2048; return true; }
        return false;
    }
    __device__ __forceinline__ unsigned arow_tok(const Unit&, int) const { return 0u; }
};
struct SchedQ {
    static constexpr bool GATHER = false, FP8 = true;
    const char *A, *B; unsigned lda2, ldb2; int K, G, c;
    __device__ __forceinline__ bool next(int i, Unit& u) const {
        const int p = c + i * G; if (p >= BATCH * 4 * 16) return false;
        const int b = p >> 6, h = (p >> 4) & 3, qb = p & 15;
        u.pm = b * 16 + qb; u.pn = h; u.e = 0; u.aux = 0; u.valid = 256; u.job = 0; u.A = A + (size_t)u.pm * 256 * lda2; u.B = B + (size_t)h * 256 * ldb2; return true;
    }
    __device__ __forceinline__ unsigned arow_tok(const Unit&, int) const { return 0u; }
};
struct SchedAttn {
    static constexpr bool GATHER = false, FP8 = true;
    const char *q, *kmat, *vt, *pbuf; unsigned lda2, ldb2; int K, G, c, npair;
    __device__ __forceinline__ void pair_unit(int j, bool isO, Unit& u) const {
        const int p = c + j * G; const int b = p >> 6, h = (p >> 4) & 3, qb = p & 15;
        u.pm = b * 16 + qb; u.pn = h; u.e = j & 1; u.aux = 0; u.valid = 256; u.job = isO ? 1 : 0;
        if (!isO) { u.A = q + ((size_t)((b * 4 + h) * SEQ + qb * 256)) * 256; u.B = kmat + ((size_t)((b * 4 + h) * 256)) * 256; }
        else      { u.A = pbuf + ((size_t)(c * 2 + (j & 1))) * 256 * 256; u.B = vt + ((size_t)((b * 4 + h) * 256)) * 256; }
    }
    __device__ __forceinline__ bool next(int i, Unit& u) const {
        const int n = npair; if (i >= 2 * n) return false;
        if (i == 0) { pair_unit(0, false, u); return true; }
        const int k = (i - 1) >> 1;
        if (i & 1) { if (k + 1 < n) pair_unit(k + 1, false, u); else pair_unit(n - 1, true, u); }
        else pair_unit(k, true, u);
        return true;
    }
    __device__ __forceinline__ unsigned arow_tok(const Unit&, int) const { return 0u; }
};
struct SchedMoe {
    static constexpr bool GATHER_ = true;
    const LAS int* tb; const LAS int* cnt; const int* tl; const char* A; const char* B; unsigned lda2, ldb2; int K, nN, G, c; size_t bstride; bool gather;
};
template <bool GATH> struct SchedMoeT : SchedMoe {
    static constexpr bool GATHER = GATH, FP8 = true;
    __device__ __forceinline__ bool next(int i, Unit& u) const {
        const int nM = __builtin_amdgcn_readfirstlane(tb[NEXP]); int pm, pn; if (!g8::tile_order(i, G, c, nM, nN, pm, pn)) return false;
        int e = 0;
#pragma unroll
        for (int s = 16; s >= 1; s >>= 1) if (__builtin_amdgcn_readfirstlane(tb[e + s]) <= pm) e += s;
        u.pm = pm; u.pn = pn; u.e = e; u.aux = (pm - __builtin_amdgcn_readfirstlane(tb[e])) * 256; const int v = __builtin_amdgcn_readfirstlane(cnt[e]) - u.aux; u.valid = v < 256 ? v : 256; u.job = 0;
        u.A = GATH ? A : A + (size_t)pm * 256 * lda2; u.B = B + (size_t)e * bstride + (size_t)pn * 256 * ldb2; return true;
    }
    __device__ __forceinline__ unsigned arow_tok(const Unit& u, int r) const {
        return (unsigned)((r < u.valid) ? (tl[(size_t)u.e * ECAP + u.aux + r] >> 2) : 0);
    }
};

struct EpiP1 {
    static constexpr bool MID = false; static constexpr bool PROBE2 = false; EPI_PROBE_COPY(EpiP1)
    const float* rstd1; bf16_t *proj, *ug, *kmat, *vt;
    __device__ __forceinline__ void mid(f32x4 (&)[2][2][4][2], const Unit&, int, int, int) const {}
    __device__ __forceinline__ void operator()(const f32x4 (&acc)[2][2][4][2], const Unit& u, int wr, int wc, int fr, int fq, LAS unsigned char*) const {
        const int col0 = u.pn * 256 + wc * 32 + 8 * fq;
        float rs[2][4];
        EPI_ROWS(ai, m) rs[ai][m] = (u.job == 0) ? rstd1[u.pm * 256 + ai * 128 + wr * 64 + m * 16 + fr] : 1.0f;
        EPI_ROWS(ai, m) {
            const int row = u.pm * 256 + ai * 128 + wr * 64 + m * 16 + fr;
            const float sc = rs[ai][m];
#pragma unroll
            for (int bj = 0; bj < 2; ++bj) {
                const int col = col0 + bj * 128;
                if (u.job == 0) { const u32x4 w = pack8(acc[ai][bj][m][0] * sc, acc[ai][bj][m][1] * sc); bf16_t* dst;
                    if (u.pn < 6) dst = proj + (size_t)row * 1536 + col; else { const int cc = col - 1536; dst = ug + ((size_t)((row >> 12) * 32 + (cc >> 4)) * SEQ + (row & 4095)) * 16 + (cc & 15); }
                    *(u32x4*)dst = w; }
                else { const f32x4 a0 = acc[ai][bj][m][0] * K8S, a1 = acc[ai][bj][m][1] * K8S;
                    unsigned char* dst = (u.job == 1) ? (unsigned char*)kmat + ((size_t)((u.pm * 4 + u.pn) * 256 + (row & 255))) * 256 + (col & 255)
                                                      : (unsigned char*)vt + ((size_t)((u.pn * 4 + u.pm) * 256 + (row & 255))) * 256 + (col & 255);
                    *(u32x2*)dst = (u32x2){pk4_fp8(clamp448(a0[0]), clamp448(a0[1]), clamp448(a0[2]), clamp448(a0[3])), pk4_fp8(clamp448(a1[0]), clamp448(a1[1]), clamp448(a1[2]), clamp448(a1[3]))}; }
            }
        }
    }
};
struct EpiGlu {
    static constexpr bool MID = false; static constexpr bool PROBE2 = false; EPI_PROBE_COPY(EpiGlu)
    const bf16_t* ygelu; bf16_t* ycat; float* ssqs;
    __device__ __forceinline__ void mid(f32x4 (&)[2][2][4][2], const Unit&, int, int, int) const {}
    __device__ __forceinline__ void operator()(const f32x4 (&acc)[2][2][4][2], const Unit& u, int wr, int wc, int fr, int fq, LAS unsigned char*) const {
        const int col0 = u.pn * 256 + wc * 32 + 8 * fq;
#pragma unroll
        for (int ai = 0; ai < 2; ++ai) {
            u32x4 aw[4][2];
#pragma unroll
            for (int m = 0; m < 4; ++m)
#pragma unroll
                for (int bj = 0; bj < 2; ++bj) aw[m][bj] = *(const u32x4*)(ygelu + (size_t)(u.pm * 256 + ai * 128 + wr * 64 + m * 16 + fr) * 512 + col0 + bj * 128);
#pragma unroll
            for (int m = 0; m < 4; ++m) {
                const int row = u.pm * 256 + ai * 128 + wr * 64 + m * 16 + fr; float ss = 0.f;
#pragma unroll
                for (int bj = 0; bj < 2; ++bj) {
                    const u32x4 a = aw[m][bj];
                    f32x4 z0, z1; const f32x4 g0 = acc[ai][bj][m][0], g1 = acc[ai][bj][m][1];
                    { const f32x2 s0 = sigmoid2((f32x2){g0[0], g0[1]}) * (f32x2){bflo(a.x), bfhi(a.x)}, s1 = sigmoid2((f32x2){g0[2], g0[3]}) * (f32x2){bflo(a.y), bfhi(a.y)};
                      const f32x2 s2 = sigmoid2((f32x2){g1[0], g1[1]}) * (f32x2){bflo(a.z), bfhi(a.z)}, s3 = sigmoid2((f32x2){g1[2], g1[3]}) * (f32x2){bflo(a.w), bfhi(a.w)};
                      z0 = (f32x4){s0[0], s0[1], s1[0], s1[1]}; z1 = (f32x4){s2[0], s2[1], s3[0], s3[1]}; }
                    ss += sq8(z0, z1);
                    *(u32x4*)(ycat + (size_t)row * 1024 + col0 + bj * 128) = pack8(z0, z1);
                }
                row_atomic(ssqs + row, ss, fq);
            }
            asm volatile("" ::: "memory");
        }
    }
};
struct EpiRes {
    static constexpr bool MID = true; static constexpr bool PROBE2 = (PROBE_EPI == 4); __device__ __forceinline__ EpiRes probe_copy() const { EpiRes e = *this; e.ssq = ssq + 3 * NTOK; e.skip = (midt < 0); return e; }
    const bf16_t* xsrc; bf16_t* xh; unsigned char* x8; float* ssq; const float* ssqs; int midt; float accs; bool skip = false;
    __device__ __forceinline__ void mid(f32x4 (&acc)[2][2][4][2], const Unit& u, int t, int wr, int fr) const {
        if (t != midt) return;
        EPI_ROWS(ai, m) {
            const int row = u.pm * 256 + ai * 128 + wr * 64 + m * 16 + fr;
            const float sc = rsqrtf(ssqs[row] * (1.0f / 512.0f) + EPS);
#pragma unroll
            for (int bj = 0; bj < 2; ++bj)
#pragma unroll
                for (int n = 0; n < 2; ++n) acc[ai][bj][m][n] *= sc;
        }
    }
    __device__ __forceinline__ void operator()(const f32x4 (&acc)[2][2][4][2], const Unit& u, int wr, int wc, int fr, int fq, LAS unsigned char*) const {
        if (skip) return;
        const int col0 = u.pn * 256 + wc * 32 + 8 * fq;
#pragma unroll
        for (int ai = 0; ai < 2; ++ai) {
            u32x4 rw[4][2];
#pragma unroll
            for (int m = 0; m < 4; ++m)
#pragma unroll
                for (int bj = 0; bj < 2; ++bj) rw[m][bj] = *(const u32x4*)(xsrc + (size_t)(u.pm * 256 + ai * 128 + wr * 64 + m * 16 + fr) * 1024 + col0 + bj * 128);
#pragma unroll
            for (int m = 0; m < 4; ++m) {
                const int row = u.pm * 256 + ai * 128 + wr * 64 + m * 16 + fr; float ss = 0.f;
#pragma unroll
                for (int bj = 0; bj < 2; ++bj) {
                    const size_t off = (size_t)row * 1024 + col0 + bj * 128; const u32x4 w = rw[m][bj];
                    const f32x4 r0 = (f32x4){bflo(w.x), bfhi(w.x), bflo(w.y), bfhi(w.y)}, r1 = (f32x4){bflo(w.z), bfhi(w.z), bflo(w.w), bfhi(w.w)};
                    const f32x4 v0 = r0 + acc[ai][bj][m][0] * accs, v1 = r1 + acc[ai][bj][m][1] * accs;
                    ss += sq8(v0, v1);
                    *(u32x4*)(xh + off) = pack8(v0, v1);
                    *(u32x2*)(x8 + off) = (u32x2){pk4_fp8(clamp448(v0[0] * X8S), clamp448(v0[1] * X8S), clamp448(v0[2] * X8S), clamp448(v0[3] * X8S)), pk4_fp8(clamp448(v1[0] * X8S), clamp448(v1[1] * X8S), clamp448(v1[2] * X8S), clamp448(v1[3] * X8S))};
                }
                row_atomic(ssq + row, ss, fq);
            }
            asm volatile("" ::: "memory");
        }
    }
};
struct EpiQ {
    static constexpr bool MID = false; static constexpr bool PROBE2 = false; EPI_PROBE_COPY(EpiQ)
    const float* ssq2; bf16_t* q;
    __device__ __forceinline__ void mid(f32x4 (&)[2][2][4][2], const Unit&, int, int, int) const {}
    __device__ __forceinline__ void operator()(const f32x4 (&acc)[2][2][4][2], const Unit& u, int wr, int wc, int fr, int fq, LAS unsigned char*) const {
        const int col0 = u.pn * 256 + wc * 32 + 8 * fq;
        float sq[2][4];
        EPI_ROWS(ai, m) sq[ai][m] = ssq2[u.pm * 256 + ai * 128 + wr * 64 + m * 16 + fr];
        EPI_ROWS(ai, m) {
            const int row = u.pm * 256 + ai * 128 + wr * 64 + m * 16 + fr;
            const float sc = rsqrtf(sq[ai][m] * (1.0f / 1024.0f) + EPS) * (1.4426950408889634f / 16.0f) * (1.0f / (X8S * W8S));
#pragma unroll
            for (int bj = 0; bj < 2; ++bj) { const f32x4 a0 = acc[ai][bj][m][0] * (sc * Q8S), a1 = acc[ai][bj][m][1] * (sc * Q8S);
                *(u32x2*)((unsigned char*)q + ((size_t)(((row >> 12) * 4 + u.pn) * SEQ + (row & 4095))) * 256 + (col0 & 255) + bj * 128) = (u32x2){pk4_fp8(clamp448(a0[0]), clamp448(a0[1]), clamp448(a0[2]), clamp448(a0[3])), pk4_fp8(clamp448(a1[0]), clamp448(a1[1]), clamp448(a1[2]), clamp448(a1[3]))}; }
        }
    }
};
struct EpiAttn {
    static constexpr bool MID = false; static constexpr bool PROBE2 = false; EPI_PROBE_COPY(EpiAttn)
    bf16_t* pbuf; bf16_t* o; int c;
    __device__ __forceinline__ void mid(f32x4 (&)[2][2][4][2], const Unit&, int, int, int) const {}
    __device__ __forceinline__ void operator()(const f32x4 (&acc)[2][2][4][2], const Unit& u, int wr, int wc, int fr, int fq, LAS unsigned char* lds) const {
        LAS float* pmax = (LAS float*)(lds + XL_OFF + XL_PMAX);
        LAS float* psum = (LAS float*)(lds + XL_OFF + XL_PSUM) + u.e * 1024;
        if (u.job == 0) {
            EPI_ROWS(ai, m) {
                const int r = ai * 128 + wr * 64 + m * 16 + fr; float mx = -3.0e38f;
#pragma unroll
                for (int bj = 0; bj < 2; ++bj)
#pragma unroll
                    for (int n = 0; n < 2; ++n)
#pragma unroll
                        for (int i = 0; i < 4; ++i) mx = fmaxf(mx, acc[ai][bj][m][n][i]);
                mx = fmaxf(mx, __shfl_xor(mx, 16)); mx = fmaxf(mx, __shfl_xor(mx, 32));
                if (fq == 0) pmax[r * 4 + wc] = mx;
            }
            asm volatile("s_waitcnt lgkmcnt(0)" ::: "memory"); __builtin_amdgcn_s_barrier(); asm volatile("" ::: "memory");
            bf16_t* P = (bf16_t*)((unsigned char*)pbuf + (size_t)(c * 2 + u.e) * 256 * 256);
            EPI_ROWS(ai, m) {
                const int r = ai * 128 + wr * 64 + m * 16 + fr;
                const f32x4 pm4 = *(const LAS f32x4*)(pmax + r * 4);
                const float mx = fmaxf(fmaxf(pm4[0], pm4[1]), fmaxf(pm4[2], pm4[3])); float ss = 0.f;
#pragma unroll
                for (int bj = 0; bj < 2; ++bj) {
                    f32x4 p0, p1;
#pragma unroll
                    for (int i = 0; i < 4; ++i) { p0[i] = __builtin_amdgcn_exp2f((acc[ai][bj][m][0][i] - mx) * (1.0f / (Q8S * K8S))); p1[i] = __builtin_amdgcn_exp2f((acc[ai][bj][m][1][i] - mx) * (1.0f / (Q8S * K8S))); }
                    ss += (p0[0] + p0[1]) + (p0[2] + p0[3]) + (p1[0] + p1[1]) + (p1[2] + p1[3]);
                    *(u32x2*)((unsigned char*)P + (size_t)r * 256 + wc * 32 + 8 * fq + bj * 128) = (u32x2){pk4_fp8(p0[0] * P8S, p0[1] * P8S, p0[2] * P8S, p0[3] * P8S), pk4_fp8(p1[0] * P8S, p1[1] * P8S, p1[2] * P8S, p1[3] * P8S)};
                }
                ss += __shfl_xor(ss, 16); ss += __shfl_xor(ss, 32);
                if (fq == 0) psum[r * 4 + wc] = ss;
                asm volatile("" ::: "memory");
            }
            asm volatile("s_waitcnt vmcnt(0) lgkmcnt(0)" ::: "memory"); __builtin_amdgcn_s_barrier(); asm volatile("" ::: "memory");
        } else {
            const int b = u.pm >> 4, qb = u.pm & 15, h = u.pn;
            EPI_ROWS(ai, m) {
                const int r = ai * 128 + wr * 64 + m * 16 + fr;
                const f32x4 ps = *(const LAS f32x4*)(psum + r * 4);
                const float inv = (O8S / (P8S * K8S)) / ((ps[0] + ps[1]) + (ps[2] + ps[3]));
                unsigned char* dst = (unsigned char*)o + (size_t)(b * SEQ + qb * 256 + r) * 1024 + h * 256 + wc * 32 + 8 * fq;
#pragma unroll
                for (int bj = 0; bj < 2; ++bj) { const f32x4 a0 = acc[ai][bj][m][0] * inv, a1 = acc[ai][bj][m][1] * inv;
                    *(u32x2*)(dst + bj * 128) = (u32x2){pk4_fp8(clamp448(a0[0]), clamp448(a0[1]), clamp448(a0[2]), clamp448(a0[3])), pk4_fp8(clamp448(a1[0]), clamp448(a1[1]), clamp448(a1[2]), clamp448(a1[3]))}; }
            }
        }
    }
};
struct EpiMoe1 {
    static constexpr bool MID = false; static constexpr bool PROBE2 = (PROBE_EPI == 9); EPI_PROBE_COPY(EpiMoe1)
    const float* rstdl; const float* bgu; bf16_t* act;
    __device__ __forceinline__ void mid(f32x4 (&)[2][2][4][2], const Unit&, int, int, int) const {}
    __device__ __forceinline__ void operator()(const f32x4 (&acc)[2][2][4][2], const Unit& u, int wr, int wc, int fr, int fq, LAS unsigned char*) const {
        const int cj = u.pn * 128 + wc * 32 + 8 * fq;
        const float* bg = bgu + (size_t)u.e * 2048 + cj;
        float rs[2][4];
        EPI_ROWS(ai, m) { const int r = ai * 128 + wr * 64 + m * 16 + fr; rs[ai][m] = rstdl[(size_t)u.e * ECAP + u.aux + (r < u.valid ? r : 0)]; }
        const f32x4 bgv[2] = {*(const f32x4*)bg, *(const f32x4*)(bg + 4)}, blv[2] = {*(const f32x4*)(bg + 1024), *(const f32x4*)(bg + 1028)};
        EPI_ROWS(ai, m) {
            const int r = ai * 128 + wr * 64 + m * 16 + fr; const float sc = rs[ai][m] * (1.0f / (X8S * W8S));
            unsigned w[2];
#pragma unroll
            for (int n = 0; n < 2; ++n) { f32x2 o2[2];
#pragma unroll
                for (int h = 0; h < 2; ++h) {
                    const f32x2 ag = {acc[ai][0][m][n][2 * h], acc[ai][0][m][n][2 * h + 1]}, al = {acc[ai][1][m][n][2 * h], acc[ai][1][m][n][2 * h + 1]};
                    const f32x2 bg2 = {bgv[n][2 * h], bgv[n][2 * h + 1]}, bl2 = {blv[n][2 * h], blv[n][2 * h + 1]};
                    f32x2 g = ag * sc + bg2, l = al * sc + bl2;
                    g[0] = fminf(g[0], 7.0f); g[1] = fminf(g[1], 7.0f);
                    l[0] = __builtin_amdgcn_fmed3f(l[0], -7.0f, 7.0f); l[1] = __builtin_amdgcn_fmed3f(l[1], -7.0f, 7.0f);
                    f32x2 e = g * (-1.702f * 1.4426950408889634f);
                    e[0] = __builtin_amdgcn_exp2f(e[0]); e[1] = __builtin_amdgcn_exp2f(e[1]);
                    f32x2 d = e + 1.0f;
                    d[0] = __builtin_amdgcn_rcpf(d[0]); d[1] = __builtin_amdgcn_rcpf(d[1]);
                    o2[h] = (g * d) * (l * A8S + A8S);
                }
                w[n] = pk4_fp8(o2[0][0], o2[0][1], o2[1][0], o2[1][1]); }
            *(u32x2*)((unsigned char*)act + (size_t)(u.pm * 256 + r) * 1024 + cj) = (u32x2){w[0], w[1]};
        }
    }
};
struct EpiMoe2 {
    static constexpr bool MID = false; static constexpr bool PROBE2 = (PROBE_EPI == 10); EPI_PROBE_COPY(EpiMoe2)
    const int* tokl; const float* gatel; const float* bdn; bf16_t* slots;
    __device__ __forceinline__ void mid(f32x4 (&)[2][2][4][2], const Unit&, int, int, int) const {}
    __device__ __forceinline__ void operator()(const f32x4 (&acc)[2][2][4][2], const Unit& u, int wr, int wc, int fr, int fq, LAS unsigned char*) const {
        const int col0 = u.pn * 256 + wc * 32 + 8 * fq;
        const float* bp = bdn + (size_t)u.e * 1024 + col0;
        int sl[2][4]; float gt[2][4];
        EPI_ROWS(ai, m) { const int r = ai * 128 + wr * 64 + m * 16 + fr; const size_t idx = (size_t)u.e * ECAP + u.aux + (r < u.valid ? r : 0); sl[ai][m] = tokl[idx]; gt[ai][m] = gatel[idx]; }
        f32x4 bv[2][2];
#pragma unroll
        for (int bj = 0; bj < 2; ++bj) { bv[bj][0] = *(const f32x4*)(bp + bj * 128); bv[bj][1] = *(const f32x4*)(bp + bj * 128 + 4); }
        EPI_ROWS(ai, m) {
            const int r = ai * 128 + wr * 64 + m * 16 + fr;
            if (r < u.valid) {
                const int slot = sl[ai][m]; const float g = gt[ai][m];
#pragma unroll
                for (int bj = 0; bj < 2; ++bj) { const float gs = g * S8S; const f32x4 o0 = (acc[ai][bj][m][0] * (1.0f / (A8S * W8S)) + bv[bj][0]) * gs, o1 = (acc[ai][bj][m][1] * (1.0f / (A8S * W8S)) + bv[bj][1]) * gs;
                    *(u32x2*)((unsigned char*)slots + (size_t)slot * 1024 + col0 + bj * 128) = (u32x2){pk4_fp8(clamp448(o0[0]), clamp448(o0[1]), clamp448(o0[2]), clamp448(o0[3])), pk4_fp8(clamp448(o1[0]), clamp448(o1[1]), clamp448(o1[2]), clamp448(o1[3]))}; }
            }
        }
    }
};

#define XB_TMO      128
#define XB_XCNT(j)  (256  + 64 * (j))
#define XB_XSUB(j)  (1280 + 64 * (j))
#define XB_XGEN(j)  (2304 + 64 * (j))
#define XB_TOP      3328
#define XB_TOPGEN   3392
#define XCD_BAR_WORDS 3456
#define XB_SPIN_CAP (1u << 20)
__device__ __forceinline__ unsigned xb_ld(unsigned* p)              { return __hip_atomic_load(p, __ATOMIC_RELAXED, __HIP_MEMORY_SCOPE_AGENT); }
__device__ __forceinline__ unsigned xb_add(unsigned* p, unsigned v) { return __hip_atomic_fetch_add(p, v, __ATOMIC_RELAXED, __HIP_MEMORY_SCOPE_AGENT); }
__device__ __forceinline__ unsigned xb_xcc_id() { return (unsigned)__builtin_amdgcn_s_getreg((3 << 11) | 20) & 0xFu; }
#define XB_SPIN(cond, bar) do { unsigned _sp = 0; while (cond) { __builtin_amdgcn_s_sleep(1); \
    if ((++_sp & 255u) == 0u) { if (xb_ld(&(bar)[XB_TMO])) break; if (_sp > XB_SPIN_CAP) { atomicAdd(&(bar)[XB_TMO], 1u); break; } } } } while (0)
struct XcdBarrier { unsigned* bar; unsigned x; volatile LAS unsigned* st; };
__device__ __forceinline__ XcdBarrier xcd_barrier_post(unsigned* bar, volatile LAS unsigned* st) {
    XcdBarrier b; b.bar = bar; b.x = xb_xcc_id(); b.st = st;
    if (threadIdx.x == 0) (void)xb_add(&bar[XB_XCNT(b.x)], 1u);
    return b;
}
__device__ __forceinline__ void xcd_barrier_complete(unsigned* bar, unsigned x, unsigned& nloc, unsigned& nx) {
    const unsigned G = gridDim.x * gridDim.y * gridDim.z;
    unsigned sum, cnt, mine, sp = 0u;
    for (;;) {
        sum = 0u; cnt = 0u; mine = 0u;
#pragma unroll
        for (unsigned j = 0; j < 16; ++j) { const unsigned c = xb_ld(&bar[XB_XCNT(j)]); sum += c; cnt += (c > 0u) ? 1u : 0u; mine = (j == x) ? c : mine; }
        if (sum == G) break;
        __builtin_amdgcn_s_sleep(1);
        if ((++sp & 255u) == 0u) { if (xb_ld(&bar[XB_TMO])) break; if (sp > XB_SPIN_CAP) { atomicAdd(&bar[XB_TMO], 1u); break; } }
    }
    nloc = mine > 0u ? mine : 1u; nx = cnt > 0u ? cnt : 1u;
}
__device__ __forceinline__ void xcd_barrier(const XcdBarrier& b) {
    asm volatile("s_waitcnt vmcnt(0)" ::: "memory");
    __syncthreads();
    if (threadIdx.x == 0) {
        unsigned* bar = b.bar;
        __builtin_amdgcn_s_waitcnt(0);
        unsigned nloc = b.st[0], nx = b.st[1];
        if (nloc == 0u) { xcd_barrier_complete(bar, b.x, nloc, nx); b.st[0] = nloc; b.st[1] = nx; }
        const unsigned old = xb_add(&bar[XB_XSUB(b.x)], 1u);
        const unsigned gen = old / nloc;
        if (old + 1u == (gen + 1u) * nloc) {
            __builtin_amdgcn_fence(__ATOMIC_RELEASE, "agent");
            asm volatile("s_waitcnt vmcnt(0)" ::: "memory");
            const unsigned og = xb_add(&bar[XB_TOP], 1u);
            const unsigned tg = og / nx;
            if (og + 1u == (tg + 1u) * nx) xb_add(&bar[XB_TOPGEN], 1u);
            else XB_SPIN(xb_ld(&bar[XB_TOPGEN]) == tg, bar);
            __builtin_amdgcn_fence(__ATOMIC_ACQUIRE, "agent");
            xb_add(&bar[XB_XGEN(b.x)], 1u);
            asm volatile("s_waitcnt vmcnt(0)" ::: "memory");
        } else {
            XB_SPIN(xb_ld(&bar[XB_XGEN(b.x)]) == gen, bar);
            __builtin_amdgcn_fence(__ATOMIC_ACQUIRE, "agent");
            asm volatile("s_waitcnt vmcnt(0)" ::: "memory");
        }
    }
    __syncthreads();
}

struct Args { const float* in[30]; float* out; unsigned char* ws; int ph_lo, ph_hi; };
enum { I_X = 0, I_MEM, I_NMIX, I_WIN, I_CONVW, I_ARE, I_AIM, I_LOGDT, I_BRE, I_BIM, I_CRE, I_CIM, I_D, I_WGLU, I_NCO, I_NSO, I_WOUT, I_NX, I_NM, I_WQ, I_WKV, I_WO, I_NMOE, I_WR, I_BR, I_WGU, I_BGU, I_WDN, I_BDN, I_NF };

struct CvItem { const float* W; const float* scale; unsigned char* WT; int ldw, k0, n0, ldt, drow0, dk0, f8; };
__device__ __forceinline__ void cv_load(const CvItem& c, float (&v)[64], int lane) {
    const float* src = c.W + (size_t)c.k0 * c.ldw + c.n0 + lane;
#pragma unroll
    for (int i = 0; i < 64; ++i) v[i] = src[(size_t)i * c.ldw];
}
__device__ __forceinline__ void cv_store(const CvItem& c, float (&v)[64], int lane, LAS unsigned char* scr) {
    if (c.scale) {
#pragma unroll
        for (int i = 0; i < 64; ++i) v[i] *= c.scale[c.k0 + i];
    }
    if (c.f8) {
#pragma unroll
        for (int q = 0; q < 4; ++q) { u32x4 o; o.x = pk4_fp8(v[16 * q] * W8S, v[16 * q + 1] * W8S, v[16 * q + 2] * W8S, v[16 * q + 3] * W8S); o.y = pk4_fp8(v[16 * q + 4] * W8S, v[16 * q + 5] * W8S, v[16 * q + 6] * W8S, v[16 * q + 7] * W8S);
            o.z = pk4_fp8(v[16 * q + 8] * W8S, v[16 * q + 9] * W8S, v[16 * q + 10] * W8S, v[16 * q + 11] * W8S); o.w = pk4_fp8(v[16 * q + 12] * W8S, v[16 * q + 13] * W8S, v[16 * q + 14] * W8S, v[16 * q + 15] * W8S);
            *(LAS u32x4*)(scr + lane * 80 + 16 * q) = o; }
        asm volatile("s_waitcnt lgkmcnt(0)" ::: "memory");
#pragma unroll
        for (int j = 0; j < 4; ++j) { const int row = 16 * j + (lane >> 2), ch = lane & 3; const u32x4 o = *(const LAS u32x4*)(scr + row * 80 + 16 * ch);
            *(u32x4*)(c.WT + (size_t)(c.drow0 + row) * c.ldt + c.dk0 + 16 * ch) = o; }
    } else {
#pragma unroll
        for (int q = 0; q < 8; ++q) { u32x4 o; o.x = pk2(v[8 * q], v[8 * q + 1]); o.y = pk2(v[8 * q + 2], v[8 * q + 3]); o.z = pk2(v[8 * q + 4], v[8 * q + 5]); o.w = pk2(v[8 * q + 6], v[8 * q + 7]);
            *(LAS u32x4*)(scr + lane * 144 + 16 * q) = o; }
        asm volatile("s_waitcnt lgkmcnt(0)" ::: "memory");
#pragma unroll
        for (int j = 0; j < 8; ++j) { const int row = 8 * j + (lane >> 3), ch = lane & 7; const u32x4 o = *(const LAS u32x4*)(scr + row * 144 + 16 * ch);
            *(u32x4*)(c.WT + (size_t)(c.drow0 + row) * c.ldt + c.dk0 + 16 * ch) = o; }
    }
    asm volatile("s_waitcnt lgkmcnt(0)" ::: "memory");
}

__global__ void __launch_bounds__(NTHREADS, 2) mk_fwd(Args args) {
    extern __shared__ __attribute__((aligned(16))) unsigned char lds_raw[];
    LAS unsigned char* lds = (LAS unsigned char*)lds_raw;
    cg::grid_group grid = cg::this_grid();
    const int wave = __builtin_amdgcn_readfirstlane(threadIdx.x >> 6);
#define PH_IDS const int lane = lane_id_volatile(), tid = wave * 64 + lane; (void)lane; (void)tid
    const int G = gridDim.x, bx = blockIdx.x;
#define vcu ((G % 8 == 0) ? (bx % 8) * (G / 8) + bx / 8 : bx)
    unsigned char* const ws = args.ws;
#define PH_WS __attribute__((address_space(1))) unsigned char* ws_ = (__attribute__((address_space(1))) unsigned char*)args.ws; asm volatile("" : "+s"(ws_)); unsigned char* const ws = (unsigned char*)ws_
    const int lo = MK_PER_PHASE ? args.ph_lo : 0, hi = MK_PER_PHASE ? args.ph_hi : 12;
#ifndef PH_MASK
#define PH_MASK 0xfff
#endif
#define IN(k) (((PH_MASK >> (k)) & 1) && lo <= (k) && (k) < hi)
#if MK_USE_CG
#define SEAM(k) do { if (IN(k) && IN((k) + 1)) grid.sync(); STAMP(k); } while (0)
#else
#define SEAM(k) do { if (IN(k) && IN((k) + 1)) { XcdBarrier xb_; xb_.bar = (unsigned*)(ws + WS_BAR); xb_.x = xb_xcc_id(); xb_.st = (volatile LAS unsigned*)(lds + XL_OFF + XL_MISC); xcd_barrier(xb_); } STAMP(k); } while (0)
#endif
#if PROBE_PHASE >= 0 || PROBE_A >= 0
    unsigned long long* stamps = (unsigned long long*)(ws + WS_STAMP);
#define STAMP(k) do { if (bx == 0 && threadIdx.x == 0) stamps[(k) + 1] = __builtin_amdgcn_s_memrealtime(); } while (0)
    if (bx == 0 && threadIdx.x == 0) stamps[0] = __builtin_amdgcn_s_memrealtime();
#define STAMPX(i) do { if (bx == 0 && threadIdx.x == 0) stamps[(i)] = __builtin_amdgcn_s_memrealtime(); } while (0)
#else
#define STAMP(k) do { } while (0)
#define STAMPX(i) do { } while (0)
#endif
    volatile LAS unsigned* misc = (volatile LAS unsigned*)(lds + XL_OFF + XL_MISC);
    if (threadIdx.x == 0) { misc[0] = 0u; misc[1] = 0u; }
    __syncthreads();
    if (!MK_PER_PHASE && !MK_USE_CG) (void)xcd_barrier_post((unsigned*)(ws + WS_BAR), misc);
#define gw (vcu * NWAVES + wave)
#define NGW (G * NWAVES)
#define counts ((int*)(ws + WS_CNT))
#define rstd1 ((float*)(ws + WS_RSTD1))
#define ssqs ((float*)(ws + WS_SSQS))
#define ssq2 ((float*)(ws + WS_SSQ2))
#define ssq3 ((float*)(ws + WS_SSQ3))
#define gates ((float*)(ws + WS_GATES))
#define gatel ((float*)(ws + WS_GATEL))
#define rstdl ((float*)(ws + WS_RSTDL))
#define wrs ((float*)(ws + WS_WR))
#define tokl ((int*)(ws + WS_TOKL))
#define xb ((bf16_t*)(ws + WS_XB))
#define proj ((bf16_t*)(ws + WS_PROJ))
#define ug ((bf16_t*)(ws + WS_UG))
#define ycat ((bf16_t*)(ws + WS_YCAT))
#define ygelu ((bf16_t*)(ws + WS_YGELU))
#define x8 ((unsigned char*)(ws + WS_X1))
#define xh ((bf16_t*)(ws + WS_XH))
#define qo ((bf16_t*)(ws + WS_QO))
#define pbuf ((bf16_t*)(ws + WS_PBUF))
#define ob ((bf16_t*)(ws + WS_O))
#define act ((bf16_t*)(ws + WS_ACT))
#define slots ((bf16_t*)(ws + WS_SLOTS))
#define memn ((bf16_t*)(ws + WS_MEMN))
#define kmat ((bf16_t*)(ws + WS_KMAT))
#define vt ((bf16_t*)(ws + WS_VT))

    if (IN(0)) {
        PH_WS;
        PH_IDS;
        for (int i = bx * NTHREADS + tid; i < 3 * NTOK; i += G * NTHREADS) ssqs[i] = 0.f;
        if (bx == 0 && tid < NEXP) counts[tid] = 0;
        for (int i = bx * NTHREADS + tid; i < DM * NEXP; i += G * NTHREADS) wrs[i] = args.in[I_WR][i] * args.in[I_NMOE][i >> 5];
        for (int item = bx; item < 256; item += G) {
            const int g = item >> 3, part = item & 7;
            LAS float* Wp = (LAS float*)lds;
            LAS float* Bb = Wp + 65 * 128;
            LAS float* Cc = Bb + 64 * 32;
            const float dt = __expf(args.in[I_LOGDT][g]);
            __syncthreads();
            for (int i = tid; i < 65 * 64; i += NTHREADS) { const int p = i >> 6, j = i & 63; const float ar = args.in[I_ARE][g * 64 + j], aim = args.in[I_AIM][g * 64 + j];
                const float mag = expf((float)p * dt * ar); float sn, cs; sincosf((float)p * dt * aim, &sn, &cs); Wp[i * 2] = mag * cs; Wp[i * 2 + 1] = mag * sn; }
            for (int i = tid; i < 64 * 16; i += NTHREADS) { const int j = i >> 4; const float ar = args.in[I_ARE][g * 64 + j], aim = args.in[I_AIM][g * 64 + j];
                float sn, cs; sincosf(dt * aim, &sn, &cs); const float em1 = expm1f(dt * ar); float sh, ch; sincosf(0.5f * dt * aim, &sh, &ch);
                const float pre = em1 * cs - 2.0f * sh * sh, pim = (em1 + 1.0f) * sn, den = ar * ar + aim * aim;
                const float qre = (pre * ar + pim * aim) / den, qim = (pim * ar - pre * aim) / den;
                const float br = args.in[I_BRE][(size_t)g * 1024 + i], bi = args.in[I_BIM][(size_t)g * 1024 + i];
                Bb[i * 2] = qre * br - qim * bi; Bb[i * 2 + 1] = qre * bi + qim * br; }
            for (int i = tid; i < 16 * 64; i += NTHREADS) { Cc[i * 2] = args.in[I_CRE][(size_t)g * 1024 + i]; Cc[i * 2 + 1] = args.in[I_CIM][(size_t)g * 1024 + i]; }
            __syncthreads();
            unsigned char* tab = ws + WS_SSM + (size_t)g * SSM_STRIDE;
            if (part == 0 && tid < 64) { ((float*)tab)[tid * 2] = Wp[(64 * 64 + tid) * 2]; ((float*)tab)[tid * 2 + 1] = Wp[(64 * 64 + tid) * 2 + 1]; }
            bf16_t* Kt = (bf16_t*)(tab + SSM_KT); bf16_t* Pt = (bf16_t*)(tab + SSM_PT); bf16_t* Qt = (bf16_t*)(tab + SSM_QT);
            {
                const int lag = 8 * part + (tid >> 6), c = (tid >> 2) & 15, cp0 = (tid & 3) * 4; float s0 = 0.f, s1 = 0.f, s2 = 0.f, s3 = 0.f;
#pragma unroll 4
                for (int j = 0; j < 64; ++j) { const f32x2 w = *(const LAS f32x2*)(Wp + (lag * 64 + j) * 2), cc = *(const LAS f32x2*)(Cc + (c * 64 + j) * 2);
                    const float xr = cc[0] * w[0] - cc[1] * w[1], xi = cc[0] * w[1] + cc[1] * w[0];
                    const f32x4 b0 = *(const LAS f32x4*)(Bb + (j * 16 + cp0) * 2), b1 = *(const LAS f32x4*)(Bb + (j * 16 + cp0 + 2) * 2);
                    s0 += xr * b0[0] - xi * b0[1]; s1 += xr * b0[2] - xi * b0[3]; s2 += xr * b1[0] - xi * b1[1]; s3 += xr * b1[2] - xi * b1[3]; }
                *(u32x2*)(Kt + (size_t)lag * 256 + c * 16 + cp0) = (u32x2){pk2(s0, s1), pk2(s2, s3)};
            }
            {
                const int k = 2 * tid, sidx = k >> 4, cp = k & 15;
#pragma unroll 4
                for (int r = 0; r < 16; ++r) { const int n = 16 * part + r, ri = n >> 6, j = n & 63;
                    const f32x2 w = *(const LAS f32x2*)(Wp + ((63 - sidx) * 64 + j) * 2); const f32x4 b = *(const LAS f32x4*)(Bb + (j * 16 + cp) * 2);
                    const float v0 = ri ? (w[0] * b[1] + w[1] * b[0]) : (w[0] * b[0] - w[1] * b[1]), v1 = ri ? (w[0] * b[3] + w[1] * b[2]) : (w[0] * b[2] - w[1] * b[3]);
                    *(unsigned*)(Pt + (size_t)n * 1024 + k) = pk2(v0, v1); }
            }
            {
                const int n = 2 * (tid & 63), ri = n >> 6, j = n & 63;
#pragma unroll 4
                for (int r = 0; r < 16; ++r) { const int tc = 128 * part + (tid >> 6) + 8 * r, t = tc >> 4, c = tc & 15;
                    const f32x4 w = *(const LAS f32x4*)(Wp + ((t + 1) * 64 + j) * 2), cc = *(const LAS f32x4*)(Cc + (c * 64 + j) * 2);
                    const float v0 = ri ? -(cc[0] * w[1] + cc[1] * w[0]) : (cc[0] * w[0] - cc[1] * w[1]), v1 = ri ? -(cc[2] * w[3] + cc[3] * w[2]) : (cc[2] * w[2] - cc[3] * w[3]);
                    *(unsigned*)(Qt + (size_t)tc * 128 + n) = pk2(v0, v1); }
            }
        }
        STAMPX(30);
        for (int m4 = gw * 4; m4 < NTOK + NMEM; m4 += NGW * 4) {
            const bool isx = m4 < NTOK; const int r0 = isx ? m4 : m4 - NTOK;
            const f32x4* xr = (const f32x4*)((isx ? args.in[I_X] : args.in[I_MEM]) + (size_t)r0 * DM) + lane;
            f32x4 v[4][4];
#pragma unroll
            for (int q = 0; q < 4; ++q)
#pragma unroll
                for (int j = 0; j < 4; ++j) v[q][j] = xr[q * 256 + 64 * j];
#pragma unroll
            for (int q = 0; q < 4; ++q) {
                float ss = 0.f;
#pragma unroll
                for (int j = 0; j < 4; ++j) ss += (v[q][j][0] * v[q][j][0] + v[q][j][1] * v[q][j][1]) + (v[q][j][2] * v[q][j][2] + v[q][j][3] * v[q][j][3]);
                const float rs = rsqrtf(wave_sum(ss) * (1.f / DM) + EPS);
                u32x2* o8 = (u32x2*)((isx ? xb : memn) + (size_t)(r0 + q) * DM) + lane;
                if (isx) { if (lane == 0) rstd1[r0 + q] = rs;
#pragma unroll
                    for (int j = 0; j < 4; ++j) o8[64 * j] = (u32x2){pk2(v[q][j][0], v[q][j][1]), pk2(v[q][j][2], v[q][j][3])}; }
                else {
#pragma unroll
                    for (int j = 0; j < 4; ++j) { const f32x4 g = ((const f32x4*)args.in[I_NM])[lane + 64 * j]; o8[64 * j] = (u32x2){pk2(v[q][j][0] * rs * g[0], v[q][j][1] * rs * g[1]), pk2(v[q][j][2] * rs * g[2], v[q][j][3] * rs * g[3])}; } }
            }
        }
        STAMPX(31);
        {
            constexpr int I_IN = 16 * 32, I_GLU = 8 * 8, I_OUT = 16 * 16, I_Q = 16 * 16, I_KV = 16 * 32, I_O = 16 * 16, I_GU = 32 * 16 * 32, I_DN = 32 * 16 * 16;
            constexpr int NIT = I_IN + I_GLU + I_OUT + I_Q + I_KV + I_O + I_GU + I_DN;
#define CV_DECODE(c, it) do { int r = (it); \
                if (r < I_GU) { const int e = r / 512, q = r % 512, kb = q / 32, nb = q % 32, n0 = nb * 64, j = n0 & 1023, lin = n0 >> 10; \
                    c = CvItem{args.in[I_WGU] + (size_t)e * 1024 * 2048, args.in[I_NMOE], ws + WS_WGU + (size_t)e * 2048 * 1024, 2048, kb * 64, n0, 1024, 256 * (j >> 7) + 128 * lin + (j & 127), kb * 64, 1}; break; } r -= I_GU; \
                if (r < I_DN) { const int e = r / 256, q = r % 256, kb = q / 16, nb = q % 16; \
                    c = CvItem{args.in[I_WDN] + (size_t)e * 1024 * 1024, nullptr, ws + WS_WDN + (size_t)e * 1024 * 1024, 1024, kb * 64, nb * 64, 1024, nb * 64, kb * 64, 1}; break; } r -= I_DN; \
                if (r < I_IN) { const int kb = r / 32, nb = r % 32; c = CvItem{args.in[I_WIN], args.in[I_NMIX], ws + WS_WIN, 2048, kb * 64, nb * 64, 2048, nb * 64, kb * 128, 0}; break; } r -= I_IN; \
                if (r < I_GLU) { const int kb = r / 8, nb = r % 8; c = CvItem{args.in[I_WGLU], nullptr, ws + WS_WGLU, 512, kb * 64, nb * 64, 1024, nb * 64, kb * 128, 0}; break; } r -= I_GLU; \
                if (r < I_OUT) { const int kb = r / 16, nb = r % 16, k0 = kb * 64;        \
                    c = CvItem{args.in[I_WOUT], (k0 < 512) ? args.in[I_NCO] : args.in[I_NSO] - 512, ws + WS_WOUT, 1024, k0, nb * 64, 2048, nb * 64, ((k0 + 512) & 1023) * 2, 0}; break; } r -= I_OUT; \
                if (r < I_Q) { const int kb = r / 16, nb = r % 16; c = CvItem{args.in[I_WQ], args.in[I_NX], ws + WS_WQ, 1024, kb * 64, nb * 64, 1024, nb * 64, kb * 64, 1}; break; } r -= I_Q; \
                if (r < I_KV) { const int kb = r / 32, nb = r % 32, n0 = nb * 64; c = CvItem{args.in[I_WKV], nullptr, ws + (n0 < 1024 ? WS_WK : WS_WV), 2048, kb * 64, n0, 2048, n0 & 1023, kb * 128, 0}; break; } r -= I_KV; \
                { const int kb = r / 16, nb = r % 16; c = CvItem{args.in[I_WO], nullptr, ws + WS_WO, 1024, kb * 64, nb * 64, 1024, nb * 64, kb * 64, 1}; } } while (0)
            float va[64], vb[64]; CvItem ca, cb;
            __syncthreads();
            LAS unsigned char* cvscr = lds + wave * 10240;
            int it = gw;
            if (it < NIT) { CV_DECODE(ca, it); cv_load(ca, va, lane); }
            while (it < NIT) {
                int it2 = it + NGW;
                if (it2 < NIT) { CV_DECODE(cb, it2); cv_load(cb, vb, lane); }
                cv_store(ca, va, lane, cvscr);
                it = it2; if (it >= NIT) break;
                it2 = it + NGW;
                if (it2 < NIT) { CV_DECODE(ca, it2); cv_load(ca, va, lane); }
                cv_store(cb, vb, lane, cvscr);
                it = it2;
            }
#undef CV_DECODE
        }
    }
    SEAM(0);
    if (IN(1)) {
        PH_WS;
        SchedP1 S{(const char*)xb, (const char*)(ws + WS_WIN), (const char*)memn, (const char*)(ws + WS_WK), (const char*)(ws + WS_WV), 2048u, 2048u, 1024, G, bx};
        EpiP1 E{rstd1, proj, ug, kmat, vt};
        g8::gemm_phase(lds, S, E, wave);
    }
    SEAM(1);
    if (IN(2)) {
        PH_WS;
        PH_IDS;
        constexpr int L_KT = 0, L_SPV = 32768, L_UH = 49152, UROW = 1040, L_STG = 115712;
        const int l15 = lane & 15, lq = lane >> 4;
        for (int it_ = vcu; it_ < BATCH * 32; it_ += G) {
            const int g = (it_ >> 5) * 4 + (it_ & 3), b = (it_ >> 2) & 7, item = b * 32 + g;
            const bf16_t* ugp = ug + (size_t)item * SEQ * 16;
            const unsigned char* tab = ws + WS_SSM + (size_t)g * SSM_STRIDE;
            const float* A64 = (const float*)tab; const bf16_t* Kt = (const bf16_t*)(tab + SSM_KT); const bf16_t* Pt = (const bf16_t*)(tab + SSM_PT); const bf16_t* Qt = (const bf16_t*)(tab + SSM_QT);
#define STAGE_U(p) do { _Pragma("unroll") for (int _i = 0; _i < 8; ++_i) { const int _c = wave * 8 + _i; \
                const u32x4 _v = *(const u32x4*)(ugp + ((size_t)_c * 64 + 32 * (p)) * 16 + lane * 8); *(LAS u32x4*)(lds + L_UH + _c * UROW + lane * 16) = _v; } } while (0)
#define UFRAG(mb, kk) (*(const LAS bf16x8*)(lds + L_UH + (16 * (mb) + l15) * UROW + (32 * (kk) + 8 * lq) * 2))
            f32x4 sacc[4];
#pragma unroll
            for (int mb = 0; mb < 4; ++mb) sacc[mb] = (f32x4){0.f, 0.f, 0.f, 0.f};
#pragma unroll 1
            for (int p = 0; p < 2; ++p) {
                bf16x8 pf[16];
#pragma unroll
                for (int kk = 0; kk < 16; ++kk) pf[kk] = *(const bf16x8*)(Pt + (size_t)(16 * wave + l15) * 1024 + 32 * (16 * p + kk) + 8 * lq);
                __syncthreads(); STAGE_U(p); __syncthreads();
#pragma unroll
                for (int kk = 0; kk < 16; ++kk) {
#pragma unroll
                    for (int mb = 0; mb < 4; ++mb) sacc[mb] = __builtin_amdgcn_mfma_f32_16x16x32_bf16(UFRAG(mb, kk), pf[kk], sacc[mb], 0, 0, 0);
                }
            }
            STAMPX(20);
            { LAS float* Sl = (LAS float*)(lds + L_KT);
#pragma unroll
              for (int mb = 0; mb < 4; ++mb)
#pragma unroll
                for (int r = 0; r < 4; ++r) Sl[(16 * mb + 4 * lq + r) * 128 + 16 * wave + l15] = sacc[mb][r]; }
            __syncthreads();
            if (wave == 0) {
                const LAS float* Sl = (const LAS float*)(lds + L_KT); LAS bf16_t* Sp = (LAS bf16_t*)(lds + L_SPV);
                const float ar = A64[lane * 2], ai = A64[lane * 2 + 1]; float sr = 0.f, si = 0.f;
#pragma unroll 2
                for (int c = 0; c < 64; ++c) { Sp[c * 128 + lane] = (bf16_t)f2bf(sr); Sp[c * 128 + 64 + lane] = (bf16_t)f2bf(si);
                    const float lr = Sl[c * 128 + lane], li = Sl[c * 128 + 64 + lane]; const float nr = ar * sr - ai * si + lr, ni = ar * si + ai * sr + li; sr = nr; si = ni; }
            }
            __syncthreads();
            { const u32x4* src = (const u32x4*)Kt;
#pragma unroll
              for (int i = 0; i < 4; ++i) *(LAS u32x4*)(lds + L_KT + (tid + i * NTHREADS) * 16) = src[tid + i * NTHREADS]; }
            __syncthreads();
            STAMPX(21);
            const f32x4 dv4 = *(const f32x4*)(args.in[I_D] + g * 16 + (lane & 3) * 4);
#pragma unroll 1
            for (int ig = 1; ig >= 0; --ig) {
                f32x4 acc[4][4];
#pragma unroll
                for (int i = 0; i < 4; ++i)
#pragma unroll
                    for (int mb = 0; mb < 4; ++mb) acc[i][mb] = (f32x4){0.f, 0.f, 0.f, 0.f};
                const int tb0 = wave + 32 * ig, tmax = tb0 + 24;
                bf16x8 qf[4][4];
#pragma unroll
                for (int kq = 0; kq < 4; ++kq)
#pragma unroll
                    for (int i = 0; i < 4; ++i) qf[kq][i] = *(const bf16x8*)(Qt + (size_t)((tb0 + 8 * i) * 16 + l15) * 128 + 32 * kq + 8 * lq);
#pragma unroll 1
                for (int p = ig; p >= 0; --p) {
                    if (ig == 1 && p == 0) { __syncthreads(); STAGE_U(0); __syncthreads(); }
#pragma unroll 1
                    for (int kk = 0; kk < 16; ++kk) {
                        const int s0 = 32 * p + 2 * kk; if (s0 > tmax) break;
                        bf16x8 af[4];
#pragma unroll
                        for (int mb = 0; mb < 4; ++mb) af[mb] = UFRAG(mb, kk);
                        const int s = s0 + (lq >> 1);
#pragma unroll
                        for (int i = 0; i < 4; ++i) { const int t = tb0 + 8 * i;
                            if (t >= s0) { const int lag = t - s; bf16x8 bfr = *(const LAS bf16x8*)(lds + L_KT + (((lag < 0 ? 0 : lag) * 16 + l15) * 16 + 8 * (lq & 1)) * 2);
                                if (lag < 0) bfr = (bf16x8){0, 0, 0, 0, 0, 0, 0, 0};
#pragma unroll
                                for (int mb = 0; mb < 4; ++mb) acc[i][mb] = __builtin_amdgcn_mfma_f32_16x16x32_bf16(af[mb], bfr, acc[i][mb], 0, 0, 0); } }
                    }
                }
#pragma unroll
                for (int kq = 0; kq < 4; ++kq) {
                    bf16x8 af[4];
#pragma unroll
                    for (int mb = 0; mb < 4; ++mb) af[mb] = *(const LAS bf16x8*)(lds + L_SPV + ((16 * mb + l15) * 128 + 32 * kq + 8 * lq) * 2);
#pragma unroll
                    for (int i = 0; i < 4; ++i) {
#pragma unroll
                        for (int mb = 0; mb < 4; ++mb) acc[i][mb] = __builtin_amdgcn_mfma_f32_16x16x32_bf16(af[mb], qf[kq][i], acc[i][mb], 0, 0, 0); }
                }
                LAS float* stg = (LAS float*)(lds + L_STG + wave * 2048);
#pragma unroll
                for (int i = 0; i < 4; ++i) { const int t = tb0 + 8 * i;
                    u32x2 uq[2][2];
#pragma unroll
                    for (int hf = 0; hf < 2; ++hf)
#pragma unroll
                        for (int it = 0; it < 2; ++it) uq[hf][it] = *(const u32x2*)(ugp + (size_t)((32 * hf + ((it * 64 + lane) >> 2)) * 64 + t) * 16 + (lane & 3) * 4);
#pragma unroll
                    for (int hf = 0; hf < 2; ++hf) {
#pragma unroll
                        for (int ml = 0; ml < 2; ++ml)
#pragma unroll
                            for (int r = 0; r < 4; ++r) stg[(16 * ml + 4 * lq + r) * 16 + l15] = acc[i][2 * hf + ml][r];
                        asm volatile("s_waitcnt lgkmcnt(0)" ::: "memory");
#pragma unroll
                        for (int it = 0; it < 2; ++it) { const int idx = it * 64 + lane, tt = (32 * hf + (idx >> 2)) * 64 + t, c4 = (idx & 3) * 4;
                            const f32x4 yv = *(const LAS f32x4*)(stg + idx * 4); const u32x2 uu = uq[hf][it];
                            const f32x2 ya = gelu_tanh2((f32x2){yv[0], yv[1]} + (f32x2){dv4[0], dv4[1]} * (f32x2){bflo(uu.x), bfhi(uu.x)}), yb = gelu_tanh2((f32x2){yv[2], yv[3]} + (f32x2){dv4[2], dv4[3]} * (f32x2){bflo(uu.y), bfhi(uu.y)});
                            *(u32x2*)(ygelu + (size_t)(b * SEQ + tt) * 512 + g * 16 + c4) = (u32x2){cvt_pk_bf16(ya[0], ya[1]), cvt_pk_bf16(yb[0], yb[1])}; }
                        asm volatile("s_waitcnt lgkmcnt(0)" ::: "memory");
                    }
                }
            }
#undef STAGE_U
#undef UFRAG
        }
        STAMPX(22);
        {
            const int ch = lane * 8;
            float w0[8], w1[8], w2[8];
#pragma unroll
            for (int i = 0; i < 8; ++i) { w0[i] = args.in[I_CONVW][ch + i]; w1[i] = args.in[I_CONVW][512 + ch + i]; w2[i] = args.in[I_CONVW][1024 + ch + i]; }
            for (int run = gw; run < NTOK / 16; run += NGW) {
                const int r0 = run * 16, tin = r0 & (SEQ - 1);
                float vm2[8], vm1[8];
#pragma unroll
                for (int i = 0; i < 8; ++i) { vm2[i] = 0.f; vm1[i] = 0.f; }
                if (tin > 0) {
#pragma unroll
                    for (int d = 2; d >= 1; --d) { const bf16_t* pr = proj + (size_t)(r0 - d) * 1536;
                        const u32x4 c4 = *(const u32x4*)(pr + 512 + ch), x4 = *(const u32x4*)(pr + 1024 + ch);
                        float v[8]; v[0] = bflo(c4.x) * bflo(x4.x); v[1] = bfhi(c4.x) * bfhi(x4.x); v[2] = bflo(c4.y) * bflo(x4.y); v[3] = bfhi(c4.y) * bfhi(x4.y);
                        v[4] = bflo(c4.z) * bflo(x4.z); v[5] = bfhi(c4.z) * bfhi(x4.z); v[6] = bflo(c4.w) * bflo(x4.w); v[7] = bfhi(c4.w) * bfhi(x4.w);
#pragma unroll
                        for (int i = 0; i < 8; ++i) { if (d == 2) vm2[i] = v[i]; else vm1[i] = v[i]; } }
                }
#pragma unroll 1
                for (int tb = 0; tb < 16; tb += 8) {
                    u32x4 b4[8], c4[8], x4[8];
#pragma unroll
                    for (int q = 0; q < 8; ++q) { const bf16_t* pr = proj + (size_t)(r0 + tb + q) * 1536; b4[q] = *(const u32x4*)(pr + ch); c4[q] = *(const u32x4*)(pr + 512 + ch); x4[q] = *(const u32x4*)(pr + 1024 + ch); }
#pragma unroll
                    for (int q = 0; q < 8; ++q) {
                        float v[8], bgv[8], y[8]; v[0] = bflo(c4[q].x) * bflo(x4[q].x); v[1] = bfhi(c4[q].x) * bfhi(x4[q].x); v[2] = bflo(c4[q].y) * bflo(x4[q].y); v[3] = bfhi(c4[q].y) * bfhi(x4[q].y);
                        v[4] = bflo(c4[q].z) * bflo(x4[q].z); v[5] = bfhi(c4[q].z) * bfhi(x4[q].z); v[6] = bflo(c4[q].w) * bflo(x4[q].w); v[7] = bfhi(c4[q].w) * bfhi(x4[q].w);
                        bgv[0] = bflo(b4[q].x); bgv[1] = bfhi(b4[q].x); bgv[2] = bflo(b4[q].y); bgv[3] = bfhi(b4[q].y); bgv[4] = bflo(b4[q].z); bgv[5] = bfhi(b4[q].z); bgv[6] = bflo(b4[q].w); bgv[7] = bfhi(b4[q].w);
                        float ss = 0.f;
#pragma unroll
                        for (int i = 0; i < 8; ++i) { y[i] = bgv[i] * (w0[i] * vm2[i] + w1[i] * vm1[i] + w2[i] * v[i]); ss += y[i] * y[i]; vm2[i] = vm1[i]; vm1[i] = v[i]; }
                        const float rs = rsqrtf(wave_sum(ss) * (1.f / 512.f) + EPS);
                        u32x4 o; o.x = pk2(y[0] * rs, y[1] * rs); o.y = pk2(y[2] * rs, y[3] * rs); o.z = pk2(y[4] * rs, y[5] * rs); o.w = pk2(y[6] * rs, y[7] * rs);
                        *(u32x4*)(ycat + (size_t)(r0 + tb + q) * 1024 + 512 + ch) = o;
                    }
                }
            }
        }
    }
    SEAM(2);
    if (IN(3)) {
        PH_WS;
        SchedDense S{(const char*)ygelu, (const char*)(ws + WS_WGLU), 1024u, 1024u, 512, NTOK / 256, 2, G, bx};
        EpiGlu E{ygelu, ycat, ssqs};
        g8::gemm_phase(lds, S, E, wave);
    }
    SEAM(3);
    if (IN(4)) {
        PH_WS;
        SchedDense S{(const char*)ycat, (const char*)(ws + WS_WOUT), 2048u, 2048u, 1024, NTOK / 256, 4, G, bx};
        EpiRes E{xb, xh, x8, ssq2, ssqs, 6, 1.0f};
        g8::gemm_phase(lds, S, E, wave);
    }
    SEAM(4);
    if (IN(5)) {
        PH_WS;
        SchedQ S{(const char*)x8, (const char*)(ws + WS_WQ), 1024u, 1024u, 512, G, bx};
        EpiQ E{ssq2, qo};
        g8::gemm_phase(lds, S, E, wave);
    }
    STAMP(5);
    if (IN(6)) {
        PH_WS;
        SchedAttn S{(const char*)qo, (const char*)kmat, (const char*)vt, (const char*)pbuf, 256u, 256u, 128, G, bx, (BATCH * 4 * 16) / G};
        EpiAttn E{pbuf, ob, bx};
        g8::gemm_phase(lds, S, E, wave);
    }
    SEAM(6);
    if (IN(7)) {
        PH_WS;
        SchedDenseT<true> S{(const char*)ob, (const char*)(ws + WS_WO), 1024u, 1024u, 512, NTOK / 256, 4, G, bx};
        EpiRes E{xh, xh, x8, ssq3, ssqs, -1, 1.0f / (O8S * W8S)};
        g8::gemm_phase(lds, S, E, wave);
    }
    SEAM(7);
    if (IN(8)) {
        PH_WS;
        PH_IDS;
        LAS float* Xs = (LAS float*)lds;
        LAS float* Ws = (LAS float*)(lds + 34816);
        LAS float* Lg = (LAS float*)(lds + 69632);
        LAS int* hist = (LAS int*)(lds + 86528);
        LAS int* hbase = (LAS int*)(lds + 86656);
        const int te = tid & 7, tt = (tid >> 3) & 15, ks = tid >> 7;
        for (int blk = vcu; blk < NTOK / 128; blk += G) {
            const int r0 = blk * 128;
            float ac[8][4];
#pragma unroll
            for (int a = 0; a < 8; ++a)
#pragma unroll
                for (int e = 0; e < 4; ++e) ac[a][e] = 0.f;
            if (tid < 32) hist[tid] = 0;
            u32x2 xa[4], xb_[4]; f32x4 wa, wb;
#define P8_LOAD(xr, wv, kc) do { _Pragma("unroll") for (int j = 0; j < 4; ++j) xr[j] = *(const u32x2*)(xh + (size_t)(r0 + (tid >> 4) + 32 * j) * DM + (kc) * 64 + 4 * (tid & 15)); \
                wv = *(const f32x4*)(wrs + (size_t)((kc) * 64 + (tid >> 3)) * 32 + 4 * (tid & 7)); } while (0)
#define P8_STEP(xr, wv, kc) do { __syncthreads(); \
                _Pragma("unroll") for (int j = 0; j < 4; ++j) *(LAS f32x4*)(Xs + ((tid >> 4) + 32 * j) * 68 + 4 * (tid & 15)) = (f32x4){bflo(xr[j].x), bfhi(xr[j].x), bflo(xr[j].y), bfhi(xr[j].y)}; \
                *(LAS f32x4*)(Ws + (tid >> 3) * 32 + 4 * (tid & 7)) = wv; \
                __syncthreads(); \
                if ((kc) + 2 < 16) P8_LOAD(xr, wv, (kc) + 2); \
                _Pragma("unroll 2") \
                for (int q = 0; q < 4; ++q) { const int k4 = 4 * ks + q; \
                    f32x4 xv[8], w4[4]; \
                _Pragma("unroll") \
                    for (int i = 0; i < 8; ++i) xv[i] = *(const LAS f32x4*)(Xs + (tt + 16 * i) * 68 + 4 * k4); \
                _Pragma("unroll") \
                    for (int kk = 0; kk < 4; ++kk) w4[kk] = *(const LAS f32x4*)(Ws + (4 * k4 + kk) * 32 + 4 * te); \
                _Pragma("unroll") \
                    for (int i = 0; i < 8; ++i) \
                _Pragma("unroll") \
                        for (int kk = 0; kk < 4; ++kk) \
                _Pragma("unroll") \
                            for (int e = 0; e < 4; ++e) ac[i][e] += xv[i][kk] * w4[kk][e]; } \
                } while (0)
            P8_LOAD(xa, wa, 0); P8_LOAD(xb_, wb, 1);
            for (int kc = 0; kc < 16; kc += 2) { P8_STEP(xa, wa, kc); P8_STEP(xb_, wb, kc + 1); }
#undef P8_STEP
#undef P8_LOAD
            __syncthreads();
            { LAS float* Lp = (LAS float*)lds;
#pragma unroll
              for (int i = 0; i < 8; ++i)
#pragma unroll
                for (int e = 0; e < 4; ++e) Lp[(ks * 128 + tt + 16 * i) * 33 + 4 * te + e] = ac[i][e]; }
            __syncthreads();
            for (int o = tid; o < 128 * 32; o += NTHREADS) { const int t = o >> 5, e = o & 31; const LAS float* Lp = (const LAS float*)lds;
                const float sum = (Lp[t * 33 + e] + Lp[(128 + t) * 33 + e]) + (Lp[(256 + t) * 33 + e] + Lp[(384 + t) * 33 + e]);
                Lg[t * 33 + e] = sum * rsqrtf(ssq3[r0 + t] * (1.0f / 1024.0f) + EPS) + args.in[I_BR][e]; }
            __syncthreads();
            int ei[4], lp[4]; float gv[4];
            if (tid < 128) {
                unsigned taken = 0u; float tv[4];
#pragma unroll
                for (int k = 0; k < 4; ++k) { float best = -3.0e38f; int bi = 0;
                    for (int e = 0; e < 32; ++e) { const float v = Lg[tid * 33 + e]; if (!((taken >> e) & 1u) && v > best) { best = v; bi = e; } }
                    taken |= 1u << bi; ei[k] = bi; tv[k] = best; }
                float sum = 0.f;
#pragma unroll
                for (int k = 0; k < 4; ++k) { gv[k] = __expf(tv[k] - tv[0]); sum += gv[k]; }
                const float inv = 1.0f / sum;
#pragma unroll
                for (int k = 0; k < 4; ++k) { gv[k] *= inv; lp[k] = __hip_atomic_fetch_add((LAS int*)(hist + ei[k]), 1, __ATOMIC_RELAXED, __HIP_MEMORY_SCOPE_WORKGROUP); }
            }
            __syncthreads();
            if (tid < 32) hbase[tid] = atomicAdd(counts + tid, hist[tid]);
            __syncthreads();
            if (tid < 128) {
                const int tok = r0 + tid; const float rs = rsqrtf(ssq3[tok] * (1.0f / 1024.0f) + EPS);
#pragma unroll
                for (int k = 0; k < 4; ++k) { const size_t idx = (size_t)ei[k] * ECAP + hbase[ei[k]] + lp[k]; tokl[idx] = tok * 4 + k; gatel[idx] = gv[k]; rstdl[idx] = rs; }
            }
            __syncthreads();
        }
    }
    SEAM(8);
    if (IN(9) || IN(10)) {
        PH_WS;
        PH_IDS;
        LAS int* tb = (LAS int*)(lds + XL_OFF + XL_TB); LAS int* cn = (LAS int*)(lds + XL_OFF + XL_CNT);
        __syncthreads();
        if (tid == 0) { int a = 0; for (int e = 0; e < NEXP; ++e) { const int c = ald(counts + e); cn[e] = c; tb[e] = a; a += (c + 255) >> 8; } tb[NEXP] = a; }
        __syncthreads();
        if (IN(9)) {
        PH_WS;
            SchedMoeT<true> S; S.tb = tb; S.cnt = cn; S.tl = tokl; S.A = (const char*)x8; S.B = (const char*)(ws + WS_WGU); S.lda2 = 1024u; S.ldb2 = 1024u; S.K = 512; S.nN = 8; S.G = G; S.c = bx; S.bstride = (size_t)2048 * 1024; S.gather = true;
            EpiMoe1 E{rstdl, args.in[I_BGU], act};
            g8::gemm_phase(lds, S, E, wave);
        }
    }
    SEAM(9);
    if (IN(10)) {
        PH_WS;
        LAS int* tb = (LAS int*)(lds + XL_OFF + XL_TB); LAS int* cn = (LAS int*)(lds + XL_OFF + XL_CNT);
        SchedMoeT<false> S; S.tb = tb; S.cnt = cn; S.tl = tokl; S.A = (const char*)act; S.B = (const char*)(ws + WS_WDN); S.lda2 = 1024u; S.ldb2 = 1024u; S.K = 512; S.nN = 4; S.G = G; S.c = bx; S.bstride = (size_t)1024 * 1024; S.gather = false;
        EpiMoe2 E{tokl, gatel, args.in[I_BDN], slots};
        g8::gemm_phase(lds, S, E, wave);
    }
    SEAM(10);
    if (IN(11)) {
        PH_WS;
        PH_IDS;
        for (int m = gw; m < NTOK; m += NGW) {
            f32x4 v[4];
            { const u32x2* xr = (const u32x2*)(xh + (size_t)m * DM) + lane;
#pragma unroll
              for (int j = 0; j < 4; ++j) { const u32x2 w = xr[64 * j]; v[j] = (f32x4){bflo(w.x), bfhi(w.x), bflo(w.y), bfhi(w.y)}; } }
            if (DBG_OUT == 0) {
#pragma unroll
                for (int k = 0; k < 4; ++k) { const unsigned* sr = (const unsigned*)((const unsigned char*)slots + (size_t)(m * 4 + k) * DM) + lane;
#pragma unroll
                    for (int j = 0; j < 4; ++j) { const int w = (int)sr[64 * j]; const f32x2 lo = __builtin_amdgcn_cvt_pk_f32_fp8(w, false), hi = __builtin_amdgcn_cvt_pk_f32_fp8(w, true);
                        v[j][0] += lo[0] * (1.0f / S8S); v[j][1] += lo[1] * (1.0f / S8S); v[j][2] += hi[0] * (1.0f / S8S); v[j][3] += hi[1] * (1.0f / S8S); } }
            }
            float ss = 0.f;
#pragma unroll
            for (int j = 0; j < 4; ++j) ss += (v[j][0] * v[j][0] + v[j][1] * v[j][1]) + (v[j][2] * v[j][2] + v[j][3] * v[j][3]);
            const float rs = rsqrtf(wave_sum(ss) * (1.f / DM) + EPS);
            f32x4* o = (f32x4*)(args.out + (size_t)m * DM) + lane;
#pragma unroll
            for (int j = 0; j < 4; ++j) { const f32x4 g = ((const f32x4*)args.in[I_NF])[lane + 64 * j]; o[64 * j] = v[j] * rs * g; }
        }
    }
#if PROBE_PHASE >= 0 || PROBE_A >= 0
    STAMP(11);
    if (bx == 0 && threadIdx.x == 0) {
        const int ia = (PROBE_A >= 0) ? PROBE_A : PROBE_PHASE, ib = (PROBE_A >= 0) ? PROBE_B : PROBE_PHASE + 1;
        const unsigned long long d = (stamps[ib] - stamps[ia]) * (unsigned long long)PROBE_MULT, t0 = __builtin_amdgcn_s_memrealtime();
        while (__builtin_amdgcn_s_memrealtime() - t0 < d) __builtin_amdgcn_s_sleep(16);
    }
#endif
#undef IN
#undef SEAM
#undef vcu
#undef gw
#undef NGW
#undef counts
#undef rstd1
#undef ssqs
#undef ssq2
#undef ssq3
#undef gates
#undef gatel
#undef rstdl
#undef wrs
#undef tokl
#undef xb
#undef proj
#undef ug
#undef ycat
#undef ygelu
#undef x8
#undef xh
#undef qo
#undef pbuf
#undef ob
#undef act
#undef slots
#undef memn
#undef kmat
#undef vt
}

extern "C" void kernel_launch(void* const* d_in, const int* in_sizes, int n_in, void* d_out, int out_size, void* d_ws, size_t ws_size, hipStream_t stream) {
    static int grid = 0;
    if (grid == 0) {
        if (n_in != 30 || in_sizes[0] != NTOK * DM || out_size != NTOK * DM || ws_size < WS_END) { fprintf(stderr, "kernel_launch: unexpected shapes (n_in %d, in0 %d, out %d, ws %zu < %zu); nothing launched\n", n_in, n_in > 0 ? in_sizes[0] : -1, out_size, ws_size, (size_t)WS_END); grid = -1; return; }
        int dev = 0, cus = 0, per_cu = 0;
        if (hipGetDevice(&dev) != hipSuccess || hipDeviceGetAttribute(&cus, hipDeviceAttributeMultiprocessorCount, dev) != hipSuccess) { grid = -1; return; }
        if (hipFuncSetAttribute((const void*)mk_fwd, hipFuncAttributeMaxDynamicSharedMemorySize, LDS_BYTES) != hipSuccess) { fprintf(stderr, "kernel_launch: hipFuncSetAttribute failed\n"); grid = -1; return; }
        if (hipOccupancyMaxActiveBlocksPerMultiprocessor(&per_cu, (const void*)mk_fwd, NTHREADS, LDS_BYTES) != hipSuccess || per_cu < 1) { fprintf(stderr, "kernel_launch: occupancy query says %d blocks per CU\n", per_cu); per_cu = 1; }
        (void)hipGetLastError();
        grid = cus;
        if (grid != 256) fprintf(stderr, "kernel_launch: %d CUs; the attention phase assumes 256\n", grid);
    }
    if (grid < 0) return;
    if (hipMemsetAsync((char*)d_ws + WS_BAR, 0, BAR_ZERO_BYTES, stream) != hipSuccess) { fprintf(stderr, "kernel_launch: hipMemsetAsync failed\n"); return; }
    Args a{};
    for (int i = 0; i < 30; ++i) a.in[i] = (const float*)d_in[i];
    a.out = (float*)d_out; a.ws = (unsigned char*)d_ws;
#if MK_PER_PHASE
    for (int ph = 0; ph < 12; ++ph) { a.ph_lo = ph; a.ph_hi = ph + 1; hipLaunchKernelGGL(mk_fwd, dim3(grid), dim3(NTHREADS), LDS_BYTES, stream, a); }
#else
    a.ph_lo = 0; a.ph_hi = 12;
    void* kargs[] = {&a};
    hipError_t e = hipLaunchCooperativeKernel((const void*)mk_fwd, dim3(grid), dim3(NTHREADS), kargs, LDS_BYTES, stream);
    if (e != hipSuccess) fprintf(stderr, "kernel_launch: cooperative launch failed: %s (grid %d)\n", hipGetErrorString(e), grid);
#endif
}
```

```cpp
#include <hip/hip_runtime.h>
#include <hip/hip_cooperative_groups.h>
#include <cstdio>
#include <cstdint>
#include <cmath>
namespace cg = cooperative_groups;

#ifndef MK_PER_PHASE
#define MK_PER_PHASE 0
#endif
#ifndef MK_USE_CG
#define MK_USE_CG 0
#endif
#ifndef PROBE_PHASE
#define PROBE_PHASE -1
#endif
#ifndef PROBE_EPI
#define PROBE_EPI -1
#endif
#ifndef PROBE_A
#define PROBE_A -1
#define PROBE_B -1
#endif
#ifndef PROBE_MULT
#define PROBE_MULT 1
#endif
#ifndef DBG_OUT
#define DBG_OUT 0
#endif

#define LAS __attribute__((address_space(3)))
typedef unsigned short bf16_t;
typedef short bf16x8 __attribute__((ext_vector_type(8)));
typedef float f32x4 __attribute__((ext_vector_type(4)));
typedef float f32x2 __attribute__((ext_vector_type(2)));
typedef unsigned u32x4 __attribute__((ext_vector_type(4)));
typedef unsigned u32x2 __attribute__((ext_vector_type(2)));
typedef int i32x4 __attribute__((ext_vector_type(4)));
typedef int i32x8 __attribute__((ext_vector_type(8)));

constexpr int NTHREADS = 512, NWAVES = 8;
constexpr int DM = 1024, BATCH = 8, SEQ = 4096, NTOK = BATCH * SEQ, MEMLEN = 256, NMEM = BATCH * MEMLEN;
constexpr int NEXP = 32, TOPK = 4, ECAP = NTOK;
constexpr int MAXTILES = (NTOK * TOPK) / 256 + NEXP;
constexpr float EPS = 1e-5f;
constexpr float X8S = 16.0f, W8S = 256.0f, A8S = 4.0f, O8S = 64.0f, S8S = 32.0f, Q8S = 64.0f, K8S = 16.0f, P8S = 256.0f;

constexpr size_t MiB = 1u << 20;
constexpr size_t WS_CNT = 0;
constexpr size_t WS_BAR = 256 * 1024, BAR_ZERO_BYTES = 16 * 1024;
constexpr size_t WS_STAMP = 512 * 1024;
constexpr size_t WS_RSTD1 = 1 * MiB;
constexpr size_t WS_SSQS = WS_RSTD1 + 128 * 1024;
constexpr size_t WS_SSQ2 = WS_SSQS + 128 * 1024;
constexpr size_t WS_SSQ3 = WS_SSQ2 + 128 * 1024;
constexpr size_t WS_GATES = 2 * MiB;
constexpr size_t WS_WR = 3 * MiB;
constexpr size_t WS_TOKL = 4 * MiB;
constexpr size_t WS_SSM = 8 * MiB;
constexpr size_t SSM_STRIDE = 576 * 1024, SSM_KT = 1024, SSM_PT = 64 * 1024, SSM_QT = 320 * 1024;
constexpr size_t WS_WIN = 26 * MiB, WS_WGLU = 30 * MiB, WS_WOUT = 31 * MiB, WS_WQ = 33 * MiB, WS_WK = 35 * MiB, WS_WV = 37 * MiB, WS_WO = 39 * MiB;
constexpr size_t WS_MEMN = 41 * MiB, WS_KMAT = 45 * MiB, WS_VT = 49 * MiB;
constexpr size_t WS_WGU = 56 * MiB, WS_WDN = 184 * MiB;
constexpr size_t WS_YGELU = 248 * MiB;
constexpr size_t WS_X1 = 280 * MiB;
constexpr size_t WS_ACT = 408 * MiB;
constexpr size_t WS_XB = 408 * MiB, WS_PROJ = 472 * MiB, WS_UG = 568 * MiB, WS_YCAT = 600 * MiB;
constexpr size_t WS_SLOTS = 680 * MiB;
constexpr size_t WS_XH = 312 * MiB  , WS_QO = 744 * MiB, WS_PBUF = 808 * MiB, WS_O = 872 * MiB;
constexpr size_t WS_GATEL = 936 * MiB, WS_RSTDL = 940 * MiB;
constexpr size_t WS_END = 944 * MiB;

constexpr int LDS_BYTES = 147456;
constexpr int XL_OFF = 131072;
constexpr int XL_PMAX = 0, XL_PSUM = 4096, XL_TB = 12288, XL_CNT = 12544, XL_MISC = 13312;

__device__ __forceinline__ float wave_sum(float v) {
#pragma unroll
    for (int o = 1; o < 64; o <<= 1) v += __shfl_xor(v, o);
    return v;
}
__device__ __forceinline__ unsigned f2bf(float f) { unsigned u = __builtin_bit_cast(unsigned, f); return (u + 0x7fffu + ((u >> 16) & 1u)) >> 16; }
__device__ __forceinline__ unsigned pk2(float lo, float hi) { return f2bf(lo) | (f2bf(hi) << 16); }
__device__ __forceinline__ unsigned cvt_pk_bf16(float lo, float hi) { unsigned r; asm volatile("v_cvt_pk_bf16_f32 %0, %1, %2" : "=v"(r) : "v"(lo), "v"(hi)); return r; }
__device__ __forceinline__ unsigned pk4_fp8(float a, float b, float c, float d) { int w = __builtin_amdgcn_cvt_pk_fp8_f32(a, b, 0, false); w = __builtin_amdgcn_cvt_pk_fp8_f32(c, d, w, true); return (unsigned)w; }
__device__ __forceinline__ float clamp448(float v) { return __builtin_amdgcn_fmed3f(v, -448.0f, 448.0f); }
__device__ __forceinline__ float bflo(unsigned w) { return __builtin_bit_cast(float, w << 16); }
__device__ __forceinline__ float bfhi(unsigned w) { return __builtin_bit_cast(float, w & 0xffff0000u); }
__device__ __forceinline__ float bf2f(bf16_t b) { return __builtin_bit_cast(float, (unsigned)b << 16); }
__device__ __forceinline__ float sigmoidf_(float x) { return __builtin_amdgcn_rcpf(1.0f + __builtin_amdgcn_exp2f(-1.4426950408889634f * x)); }
__device__ __forceinline__ f32x2 sigmoid2(f32x2 x) { f32x2 e = x * -1.4426950408889634f; e[0] = __builtin_amdgcn_exp2f(e[0]); e[1] = __builtin_amdgcn_exp2f(e[1]); f32x2 d = e + 1.0f; d[0] = __builtin_amdgcn_rcpf(d[0]); d[1] = __builtin_amdgcn_rcpf(d[1]); return d; }
__device__ __forceinline__ f32x2 gelu_tanh2(f32x2 y) { const f32x2 t = (y * y * 0.044715f + 1.0f) * y * (2.0f * 0.7978845608028654f); return y * sigmoid2(t); }
__device__ __forceinline__ float gelu_tanh(float y) { const float t = 0.7978845608028654f * (y + 0.044715f * y * y * y); return y * sigmoidf_(2.0f * t); }
__device__ __forceinline__ int ald(const int* p) { return __hip_atomic_load(p, __ATOMIC_RELAXED, __HIP_MEMORY_SCOPE_AGENT); }

namespace g8 {
constexpr int BM = 256, BK = 64, HALF = 128, HTB = HALF * BK * 2, NXCD = 8, WGM = 8;
__device__ __forceinline__ int lds_byte(int r, int c) { const int st = (r >> 4) * 2 + (c >> 5), rr = r & 15, cc = c & 31, ob = rr * 64 + cc * 2; return st * 1024 + (ob ^ (((ob >> 9) & 1) << 5)); }
__device__ __forceinline__ void stage_rc(int b, int& R, int& C) { const int st = b / 1024, sb = b % 1024, swz = sb ^ (((sb >> 9) & 1) << 5); R = (st >> 1) * 16 + swz / 64; C = (st & 1) * 32 + (swz % 64) / 2; }
__device__ __forceinline__ int perm32(int rho) { const int n = rho >> 4, i = rho & 15; return 8 * (i >> 2) + 4 * n + (i & 3); }

struct Unit { const char* A; const char* B; int pm, pn, e, aux, valid, job; };

__device__ __forceinline__ bool tile_order(int i, int G, int c, int nM, int nN, int& pm, int& pn) {
    const int nwg = nM * nN; const long L = (long)i * G + c; if (L >= nwg) return false;
    int wgid = (int)L; { const int q = nwg / NXCD, r = nwg % NXCD, xcd = wgid % NXCD, off = wgid / NXCD; wgid = (xcd < r ? xcd * (q + 1) : r * (q + 1) + (xcd - r) * q) + off; }
    const int nig = WGM * nN, gid = wgid / nig, fm = gid * WGM, gsz = (nM - fm) < WGM ? (nM - fm) : WGM;
    pm = fm + ((wgid % nig) % gsz); pn = (wgid % nig) / gsz; return true;
}

__device__ __forceinline__ int lane_id_volatile() { int l; asm volatile("v_mbcnt_lo_u32_b32 %0, -1, 0\n\tv_mbcnt_hi_u32_b32 %0, -1, %0" : "=v"(l)); return l; }
template <class Epi, class Sched>
__device__ __forceinline__ void gemm_phase(LAS unsigned char* lds, const Sched& S, const Epi& E, const int wid) {
    const int lane = lane_id_volatile(), tid = wid * 64 + lane, wr = wid >> 2, wc = wid & 3, fr = lane & 15, fq = lane >> 4;
    const int K = S.K, nt = K / BK;
    const unsigned lda2 = S.lda2, ldb2 = S.ldb2;
    unsigned voffB0, cb0;
    { int R, C; stage_rc(tid * 16, R, C); cb0 = (unsigned)C * 2u; const int Rb = (R & ~31) + perm32(R & 31); voffB0 = (unsigned)Rb * ldb2 + cb0; }
    const size_t pstepA = (size_t)64 * lda2, pstepB = (size_t)64 * ldb2, hstepA = (size_t)HALF * lda2;
    const size_t kstep = (size_t)(BK * 2);
    const size_t hstepB = (size_t)HALF * ldb2;
    const unsigned ldsw = (unsigned)wid * 1024u;
    const int aoff = lds_byte(wr * 64 + fr, fq * 8), boff = lds_byte(wc * 32 + fr, fq * 8);
#define G8_SA(b, h) (((b) * 2 + (h)) * HTB)
#define G8_SB(b, h) ((4 + (b) * 2 + (h)) * HTB)
#define G8_STAGE_B(bufoff, gbase) do { _Pragma("unroll") for (int _i = 0; _i < 2; ++_i) \
        __builtin_amdgcn_global_load_lds((const unsigned*)((const char*)(gbase) + _i * pstepB + voffB0), (LAS unsigned*)(lds + (bufoff) + ldsw + _i * 8192), 16, 0, 0); } while (0)
#define G8_STAGE_A(bufoff, gbase, o0, o1) do { \
        __builtin_amdgcn_global_load_lds((const unsigned*)((const char*)(gbase) + (o0)), (LAS unsigned*)(lds + (bufoff) + ldsw), 16, 0, 0); \
        __builtin_amdgcn_global_load_lds((const unsigned*)((const char*)(gbase) + (o1)), (LAS unsigned*)(lds + (bufoff) + ldsw + 8192), 16, 0, 0); } while (0)
#define G8_LDA(dst, b, h) do { _Pragma("unroll") for (int m = 0; m < 4; ++m) _Pragma("unroll") for (int k = 0; k < 2; ++k) dst[m][k] = *(const LAS bf16x8*)(lds + G8_SA(b, h) + aoff + m * 2048 + k * 1024); } while (0)
#define G8_LDB(dst, b, h) do { _Pragma("unroll") for (int n = 0; n < 2; ++n) _Pragma("unroll") for (int k = 0; k < 2; ++k) dst[n][k] = *(const LAS bf16x8*)(lds + G8_SB(b, h) + boff + n * 2048 + k * 1024); } while (0)
#define G8_MMA(ai, bj, At, Bt) do { __builtin_amdgcn_s_setprio(1); _Pragma("unroll") for (int m = 0; m < 4; ++m) _Pragma("unroll") for (int n = 0; n < 2; ++n) _Pragma("unroll") for (int k = 0; k < 2; ++k) \
        acc[ai][bj][m][n] = __builtin_amdgcn_mfma_f32_16x16x32_bf16(Bt[n][k], At[m][k], acc[ai][bj][m][n], 0, 0, 0); __builtin_amdgcn_s_setprio(0); } while (0)
#define G8_RD16(off) __builtin_bit_cast(i32x4, *(const LAS bf16x8*)(lds + (off)))
#define G8_LDA8(dst, b, h) do { _Pragma("unroll") for (int m = 0; m < 4; ++m) dst[m] = __builtin_shufflevector(G8_RD16(G8_SA(b, h) + aoff + m * 2048), G8_RD16(G8_SA(b, h) + aoff + m * 2048 + 1024), 0, 1, 2, 3, 4, 5, 6, 7); } while (0)
#define G8_LDB8(dst, b, h) do { _Pragma("unroll") for (int n = 0; n < 2; ++n) dst[n] = __builtin_shufflevector(G8_RD16(G8_SB(b, h) + boff + n * 2048), G8_RD16(G8_SB(b, h) + boff + n * 2048 + 1024), 0, 1, 2, 3, 4, 5, 6, 7); } while (0)
#define G8_MMA8(ai, bj, At, Bt) do { __builtin_amdgcn_s_setprio(1); _Pragma("unroll") for (int m = 0; m < 4; ++m) _Pragma("unroll") for (int n = 0; n < 2; ++n) \
        asm volatile("s_nop 1\n\tv_mfma_scale_f32_16x16x128_f8f6f4 %0, %1, %2, %0, %3, %3 op_sel_hi:[0,0,0]" : "+v"(acc[ai][bj][m][n]) : "v"(Bt[n]), "v"(At[m]), "v"(scl8)); __builtin_amdgcn_s_setprio(0); } while (0)
#define G8_MM(ai, bj, X) do { if constexpr (Sched::FP8) G8_MMA8(ai, bj, At8, X##8); else G8_MMA(ai, bj, At, X); } while (0)
#define G8_LA(b, h) do { if constexpr (Sched::FP8) G8_LDA8(At8, b, h); else G8_LDA(At, b, h); } while (0)
#define G8_LB(X, b, h) do { if constexpr (Sched::FP8) G8_LDB8(X##8, b, h); else G8_LDB(X, b, h); } while (0)
#define G8_WAIT_V(n) asm volatile("s_waitcnt vmcnt(" #n ")" ::: "memory")
#define G8_WAIT_L(n) asm volatile("s_waitcnt lgkmcnt(" #n ")" ::: "memory")
#define G8_BAR __builtin_amdgcn_s_barrier()
#define G8_SCHED __builtin_amdgcn_sched_barrier(0)
#define G8_SETOFF(o, u) do { const int _t = wid * 64 + lane_id_volatile(); _Pragma("unroll") for (int _i = 0; _i < 2; ++_i) { int _R, _C; stage_rc(_t * 16 + _i * 8192, _R, _C); \
        _Pragma("unroll") for (int _h = 0; _h < 2; ++_h) { if (Sched::GATHER) { const unsigned _tk = S.arow_tok(u, _h * HALF + _R); if (_i == 0) o[_h][0] = _tk; else o[_h][0] |= _tk << 16; } \
            else if (_h == 0 && _i == 0) o[0][0] = (unsigned)_R * lda2 + (unsigned)_C * 2u; } } } while (0)
#define G8_GOFF0(pk) (((pk) & 0xffffu) * lda2 + cb0)
#define G8_GOFF1(pk) (((pk) >> 16) * lda2 + cb0)
#define G8_STAGE_AH(bufoff, gbase, h, pk) do { if (Sched::GATHER) { G8_STAGE_A(bufoff, gbase, G8_GOFF0(pk), G8_GOFF1(pk)); } \
        else { G8_STAGE_A(bufoff, (const char*)(gbase) + (h) * hstepA, oa[0][0], pstepA + oa[0][0]); } } while (0)
    Unit cur, nxt; int ui = 0;
    if (!S.next(0, cur)) return;
    f32x4 acc[2][2][4][2];
#pragma unroll
    for (int a = 0; a < 2; ++a)
#pragma unroll
        for (int b = 0; b < 2; ++b)
#pragma unroll
            for (int m = 0; m < 4; ++m)
#pragma unroll
                for (int n = 0; n < 2; ++n) acc[a][b][m][n] = (f32x4){0.f, 0.f, 0.f, 0.f};
    bf16x8 At[4][2], B0[2][2], B1[2][2];
    i32x8 At8[4], B08[2], B18[2]; const int scl8 = 0x7F7F7F7F;
    unsigned oa[2][2], on[2][2];
    G8_SETOFF(oa, cur);
    const char* cA = cur.A; const char* cB = cur.B;
    G8_STAGE_B(G8_SB(0, 0), cB); G8_STAGE_B(G8_SB(0, 1), cB + hstepB); G8_STAGE_AH(G8_SA(0, 0), cA, 0, oa[0][0]); G8_STAGE_AH(G8_SA(0, 1), cA, 1, oa[1][0]);
    if (wr == 1) G8_BAR;
    G8_WAIT_V(2); G8_BAR;
    G8_STAGE_B(G8_SB(1, 0), cB + kstep); G8_STAGE_AH(G8_SA(1, 0), cA + kstep, 0, oa[0][0]); G8_STAGE_B(G8_SB(1, 1), cB + hstepB + kstep);
    G8_WAIT_V(6); G8_BAR;
    bool has_next = S.next(1, nxt);
    if (Sched::GATHER) { if (has_next) { G8_SETOFF(on, nxt); } else {
#pragma unroll
        for (int h = 0; h < 2; ++h) on[h][0] = oa[h][0]; } }
    for (;;) {
        const char* nA = has_next ? nxt.A : cA; const char* nB = has_next ? nxt.B : cB;
#pragma unroll 1
        for (int t = 0; t < nt; t += 2) {
            const bool last = (t == nt - 2);
            const char* a1 = cA + (size_t)(t + 1) * kstep;
            const char* a2 = last ? nA : cA + (size_t)(t + 2) * kstep; const char* b2 = last ? nB : cB + (size_t)(t + 2) * kstep;
            const char* a3 = a2 + kstep; const char* b3 = b2 + kstep;
            unsigned p0 = 0, p1 = 0;
            if (Sched::GATHER) { p0 = last ? on[0][0] : oa[0][0]; p1 = last ? on[1][0] : oa[1][0]; }
            G8_LB(B0, 0, 0); G8_LB(B1, 0, 1); G8_SCHED; G8_LA(0, 0); G8_STAGE_AH(G8_SA(1, 1), a1, 1, oa[1][0]);
            G8_WAIT_V(8); G8_WAIT_L(0); G8_BAR; G8_MM(0, 0, B0); G8_MM(0, 1, B1); G8_BAR; G8_SCHED;
            G8_LA(0, 1); G8_STAGE_B(G8_SB(0, 0), b2); G8_STAGE_B(G8_SB(0, 1), b2 + hstepB); G8_STAGE_AH(G8_SA(0, 0), a2, 0, p0);
            G8_WAIT_V(8); G8_WAIT_L(0); G8_BAR; G8_MM(1, 0, B0); G8_MM(1, 1, B1); G8_BAR; G8_SCHED;
            G8_LB(B0, 1, 0); G8_LB(B1, 1, 1); G8_SCHED; G8_LA(1, 0); G8_STAGE_AH(G8_SA(0, 1), a2, 1, p1);
            G8_WAIT_V(8); G8_WAIT_L(0); G8_BAR; G8_MM(0, 0, B0); G8_MM(0, 1, B1); G8_BAR; G8_SCHED;
            G8_LA(1, 1); G8_STAGE_B(G8_SB(1, 0), b3); G8_STAGE_B(G8_SB(1, 1), b3 + hstepB); G8_STAGE_AH(G8_SA(1, 0), a3, 0, p0);
            G8_WAIT_V(8); G8_WAIT_L(0); G8_BAR; G8_MM(1, 0, B0); G8_MM(1, 1, B1); G8_BAR; G8_SCHED;
            if (Epi::MID) { const int fr_e = lane_id_volatile() & 15; E.mid(acc, cur, t, wr, fr_e); }
        }
        if (wr == 0) G8_BAR;
        if constexpr (Sched::FP8) asm volatile("s_nop 15\n\ts_nop 15" ::: "memory");
        Unit n2; bool has2 = false; unsigned tk[2][2] = {{0u, 0u}, {0u, 0u}};
        if (has_next) { has2 = S.next(ui + 2, n2);
            if (Sched::GATHER && has2) { const int _t = wid * 64 + lane_id_volatile();
#pragma unroll
                for (int _i = 0; _i < 2; ++_i) { int _R, _C; stage_rc(_t * 16 + _i * 8192, _R, _C);
#pragma unroll
                    for (int _h = 0; _h < 2; ++_h) tk[_h][_i] = S.arow_tok(n2, _h * HALF + _R); } } }
        { const int l_e = lane_id_volatile(), fr_e = l_e & 15, fq_e = l_e >> 4;
          E(acc, cur, wr, wc, fr_e, fq_e, lds); if constexpr (Epi::PROBE2) { asm volatile("" ::: "memory"); const Epi E2 = E.probe_copy(); E2(acc, cur, wr, wc, fr_e, fq_e, lds); } }
        if (!has_next) break;
#pragma unroll
        for (int a = 0; a < 2; ++a)
#pragma unroll
            for (int b = 0; b < 2; ++b)
#pragma unroll
                for (int m = 0; m < 4; ++m)
#pragma unroll
                    for (int n = 0; n < 2; ++n) acc[a][b][m][n] = (f32x4){0.f, 0.f, 0.f, 0.f};
        cur = nxt; cA = nA; cB = nB; ++ui;
        if (Sched::GATHER) {
#pragma unroll
            for (int h = 0; h < 2; ++h) { oa[h][0] = on[h][0]; if (has2) on[h][0] = tk[h][0] | (tk[h][1] << 16); } }
        nxt = n2; has_next = has2;
        if (wr == 1) G8_BAR;
    }
    G8_WAIT_V(0);
    G8_BAR;
#undef G8_SA
#undef G8_SB
#undef G8_STAGE_A
#undef G8_STAGE_B
#undef G8_LDA
#undef G8_LDB
#undef G8_MMA
#undef G8_MMA8
#undef G8_MM
#undef G8_LA
#undef G8_LB
#undef G8_LDA8
#undef G8_LDB8
#undef G8_RD16
#undef G8_WAIT_V
#undef G8_WAIT_L
#undef G8_BAR
#undef G8_SCHED
#undef G8_SETOFF
#undef G8_GOFF0
#undef G8_GOFF1
#undef G8_STAGE_AH
}
}
using g8::Unit;
using g8::lane_id_volatile;

#define EPI_PROBE_COPY(T) __device__ __forceinline__ T probe_copy() const { return *this; }
#define EPI_ROWS(ai, m) _Pragma("unroll") for (int ai = 0; ai < 2; ++ai) _Pragma("unroll") for (int m = 0; m < 4; ++m)
__device__ __forceinline__ u32x4 pack8(const f32x4 a, const f32x4 b) { u32x4 w; w.x = cvt_pk_bf16(a[0], a[1]); w.y = cvt_pk_bf16(a[2], a[3]); w.z = cvt_pk_bf16(b[0], b[1]); w.w = cvt_pk_bf16(b[2], b[3]); return w; }
__device__ __forceinline__ float sq8(const f32x4 a, const f32x4 b) { return (a[0] * a[0] + a[1] * a[1]) + (a[2] * a[2] + a[3] * a[3]) + (b[0] * b[0] + b[1] * b[1]) + (b[2] * b[2] + b[3] * b[3]); }
__device__ __forceinline__ void row_atomic(float* p, float s, int fq) { s += __shfl_xor(s, 16); s += __shfl_xor(s, 32); if (fq == 0) atomicAdd(p, s); }

template <bool F8> struct SchedDenseT {
    static constexpr bool GATHER = false, FP8 = F8;
    const char* A; const char* B; unsigned lda2, ldb2; int K, nM, nN, G, c;
    __device__ __forceinline__ bool next(int i, Unit& u) const {
        int pm, pn; if (!g8::tile_order(i, G, c, nM, nN, pm, pn)) return false;
        u.pm = pm; u.pn = pn; u.A = A + (size_t)pm * 256 * lda2; u.B = B + (size_t)pn * 256 * ldb2; u.e = 0; u.aux = 0; u.valid = 256; u.job = 0; return true;
    }
    __device__ __forceinline__ unsigned arow_tok(const Unit&, int) const { return 0u; }
};
typedef SchedDenseT<false> SchedDense;
struct SchedP1 {
    static constexpr bool GATHER = false, FP8 = false;
    const char *xb, *win, *memn, *wk, *wv; unsigned lda2, ldb2; int K, G, c;
    __device__ __forceinline__ bool next(int i, Unit& u) const {
        const int L = i * G + c;
        u.e = 0; u.aux = 0; u.valid = 256;
        if (L < 1024) { int pm, pn; g8::tile_order(i, G, c, 128, 8, pm, pn); u.pm = pm; u.pn = pn; u.job = 0; u.A = xb + (size_t)pm * 256 * 2048; u.B = win + (size_t)pn * 256 * 2048; return true; }
        const int r = L - 1024;
        if (r < 32) { u.pm = r >> 2; u.pn = r & 3; u.job = 1; u.A = memn + (size_t)u.pm * 256 * 2048; u.B = wk + (size_t)u.pn * 256 * 2048; return true; }
        if (r < 64) { const int q = r - 32; u.pm = q >> 3; u.pn = q & 7; u.job = 2; u.A = wv + (size_t)u.pm * 256 * 2048; u.B = memn + (size_t)u.pn * 256 * 2048; return true; }
        return false;
    }
    __device__ __forceinline__ unsigned arow_tok(const Unit&, int) const { return 0u; }
};
struct SchedQ {
    static constexpr bool GATHER = false, FP8 = true;
    const char *A, *B; unsigned lda2, ldb2; int K, G, c;
    __device__ __forceinline__ bool next(int i, Unit& u) const {
        const int p = c + i * G; if (p >= BATCH * 4 * 16) return false;
        const int b = p >> 6, h = (p >> 4) & 3, qb = p & 15;
        u.pm = b * 16 + qb; u.pn = h; u.e = 0; u.aux = 0; u.valid = 256; u.job = 0; u.A = A + (size_t)u.pm * 256 * lda2; u.B = B + (size_t)h * 256 * ldb2; return true;
    }
    __device__ __forceinline__ unsigned arow_tok(const Unit&, int) const { return 0u; }
};
struct SchedAttn {
    static constexpr bool GATHER = false, FP8 = true;
    const char *q, *kmat, *vt, *pbuf; unsigned lda2, ldb2; int K, G, c, npair;
    __device__ __forceinline__ void pair_unit(int j, bool isO, Unit& u) const {
        const int p = c + j * G; const int b = p >> 6, h = (p >> 4) & 3, qb = p & 15;
        u.pm = b * 16 + qb; u.pn = h; u.e = j & 1; u.aux = 0; u.valid = 256; u.job = isO ? 1 : 0;
        if (!isO) { u.A = q + ((size_t)((b * 4 + h) * SEQ + qb * 256)) * 256; u.B = kmat + ((size_t)((b * 4 + h) * 256)) * 256; }
        else      { u.A = pbuf + ((size_t)(c * 2 + (j & 1))) * 256 * 256; u.B = vt + ((size_t)((b * 4 + h) * 256)) * 256; }
    }
    __device__ __forceinline__ bool next(int i, Unit& u) const {
        const int n = npair; if (i >= 2 * n) return false;
        if (i == 0) { pair_unit(0, false, u); return true; }
        const int k = (i - 1) >> 1;
        if (i & 1) { if (k + 1 < n) pair_unit(k + 1, false, u); else pair_unit(n - 1, true, u); }
        else pair_unit(k, true, u);
        return true;
    }
    __device__ __forceinline__ unsigned arow_tok(const Unit&, int) const { return 0u; }
};
struct SchedMoe {
    static constexpr bool GATHER_ = true;
    const LAS int* tb; const LAS int* cnt; const int* tl; const char* A; const char* B; unsigned lda2, ldb2; int K, nN, G, c; size_t bstride; bool gather;
};
template <bool GATH> struct SchedMoeT : SchedMoe {
    static constexpr bool GATHER = GATH, FP8 = true;
    __device__ __forceinline__ bool next(int i, Unit& u) const {
        const int nM = __builtin_amdgcn_readfirstlane(tb[NEXP]); int pm, pn; if (!g8::tile_order(i, G, c, nM, nN, pm, pn)) return false;
        int e = 0;
#pragma unroll
        for (int s = 16; s >= 1; s >>= 1) if (__builtin_amdgcn_readfirstlane(tb[e + s]) <= pm) e += s;
        u.pm = pm; u.pn = pn; u.e = e; u.aux = (pm - __builtin_amdgcn_readfirstlane(tb[e])) * 256; const int v = __builtin_amdgcn_readfirstlane(cnt[e]) - u.aux; u.valid = v < 256 ? v : 256; u.job = 0;
        u.A = GATH ? A : A + (size_t)pm * 256 * lda2; u.B = B + (size_t)e * bstride + (size_t)pn * 256 * ldb2; return true;
    }
    __device__ __forceinline__ unsigned arow_tok(const Unit& u, int r) const {
        return (unsigned)((r < u.valid) ? (tl[(size_t)u.e * ECAP + u.aux + r] >> 2) : 0);
    }
};

struct EpiP1 {
    static constexpr bool MID = false; static constexpr bool PROBE2 = false; EPI_PROBE_COPY(EpiP1)
    const float* rstd1; bf16_t *proj, *ug, *kmat, *vt;
    __device__ __forceinline__ void mid(f32x4 (&)[2][2][4][2], const Unit&, int, int, int) const {}
    __device__ __forceinline__ void operator()(const f32x4 (&acc)[2][2][4][2], const Unit& u, int wr, int wc, int fr, int fq, LAS unsigned char*) const {
        const int col0 = u.pn * 256 + wc * 32 + 8 * fq;
        float rs[2][4];
        EPI_ROWS(ai, m) rs[ai][m] = (u.job == 0) ? rstd1[u.pm * 256 + ai * 128 + wr * 64 + m * 16 + fr] : 1.0f;
        EPI_ROWS(ai, m) {
            const int row = u.pm * 256 + ai * 128 + wr * 64 + m * 16 + fr;
            const float sc = rs[ai][m];
#pragma unroll
            for (int bj = 0; bj < 2; ++bj) {
                const int col = col0 + bj * 128;
                if (u.job == 0) { const u32x4 w = pack8(acc[ai][bj][m][0] * sc, acc[ai][bj][m][1] * sc); bf16_t* dst;
                    if (u.pn < 6) dst = proj + (size_t)row * 1536 + col; else { const int cc = col - 1536; dst = ug + ((size_t)((row >> 12) * 32 + (cc >> 4)) * SEQ + (row & 4095)) * 16 + (cc & 15); }
                    *(u32x4*)dst = w; }
                else { const f32x4 a0 = acc[ai][bj][m][0] * K8S, a1 = acc[ai][bj][m][1] * K8S;
                    unsigned char* dst = (u.job == 1) ? (unsigned char*)kmat + ((size_t)((u.pm * 4 + u.pn) * 256 + (row & 255))) * 256 + (col & 255)
                                                      : (unsigned char*)vt + ((size_t)((u.pn * 4 + u.pm) * 256 + (row & 255))) * 256 + (col & 255);
                    *(u32x2*)dst = (u32x2){pk4_fp8(clamp448(a0[0]), clamp448(a0[1]), clamp448(a0[2]), clamp448(a0[3])), pk4_fp8(clamp448(a1[0]), clamp448(a1[1]), clamp448(a1[2]), clamp448(a1[3]))}; }
            }
        }
    }
};
struct EpiGlu {
    static constexpr bool MID = false; static constexpr bool PROBE2 = false; EPI_PROBE_COPY(EpiGlu)
    const bf16_t* ygelu; bf16_t* ycat; float* ssqs;
    __device__ __forceinline__ void mid(f32x4 (&)[2][2][4][2], const Unit&, int, int, int) const {}
    __device__ __forceinline__ void operator()(const f32x4 (&acc)[2][2][4][2], const Unit& u, int wr, int wc, int fr, int fq, LAS unsigned char*) const {
        const int col0 = u.pn * 256 + wc * 32 + 8 * fq;
#pragma unroll
        for (int ai = 0; ai < 2; ++ai) {
            u32x4 aw[4][2];
#pragma unroll
            for (int m = 0; m < 4; ++m)
#pragma unroll
                for (int bj = 0; bj < 2; ++bj) aw[m][bj] = *(const u32x4*)(ygelu + (size_t)(u.pm * 256 + ai * 128 + wr * 64 + m * 16 + fr) * 512 + col0 + bj * 128);
#pragma unroll
            for (int m = 0; m < 4; ++m) {
                const int row = u.pm * 256 + ai * 128 + wr * 64 + m * 16 + fr; float ss = 0.f;
#pragma unroll
                for (int bj = 0; bj < 2; ++bj) {
                    const u32x4 a = aw[m][bj];
                    f32x4 z0, z1; const f32x4 g0 = acc[ai][bj][m][0], g1 = acc[ai][bj][m][1];
                    { const f32x2 s0 = sigmoid2((f32x2){g0[0], g0[1]}) * (f32x2){bflo(a.x), bfhi(a.x)}, s1 = sigmoid2((f32x2){g0[2], g0[3]}) * (f32x2){bflo(a.y), bfhi(a.y)};
                      const f32x2 s2 = sigmoid2((f32x2){g1[0], g1[1]}) * (f32x2){bflo(a.z), bfhi(a.z)}, s3 = sigmoid2((f32x2){g1[2], g1[3]}) * (f32x2){bflo(a.w), bfhi(a.w)};
                      z0 = (f32x4){s0[0], s0[1], s1[0], s1[1]}; z1 = (f32x4){s2[0], s2[1], s3[0], s3[1]}; }
                    ss += sq8(z0, z1);
                    *(u32x4*)(ycat + (size_t)row * 1024 + col0 + bj * 128) = pack8(z0, z1);
                }
                row_atomic(ssqs + row, ss, fq);
            }
            asm volatile("" ::: "memory");
        }
    }
};
struct EpiRes {
    static constexpr bool MID = true; static constexpr bool PROBE2 = (PROBE_EPI == 4); __device__ __forceinline__ EpiRes probe_copy() const { EpiRes e = *this; e.ssq = ssq + 3 * NTOK; e.skip = (midt < 0); return e; }
    const bf16_t* xsrc; bf16_t* xh; unsigned char* x8; float* ssq; const float* ssqs; int midt; float accs; bool skip = false;
    __device__ __forceinline__ void mid(f32x4 (&acc)[2][2][4][2], const Unit& u, int t, int wr, int fr) const {
        if (t != midt) return;
        EPI_ROWS(ai, m) {
            const int row = u.pm * 256 + ai * 128 + wr * 64 + m * 16 + fr;
            const float sc = rsqrtf(ssqs[row] * (1.0f / 512.0f) + EPS);
#pragma unroll
            for (int bj = 0; bj < 2; ++bj)
#pragma unroll
                for (int n = 0; n < 2; ++n) acc[ai][bj][m][n] *= sc;
        }
    }
    __device__ __forceinline__ void operator()(const f32x4 (&acc)[2][2][4][2], const Unit& u, int wr, int wc, int fr, int fq, LAS unsigned char*) const {
        if (skip) return;
        const int col0 = u.pn * 256 + wc * 32 + 8 * fq;
#pragma unroll
        for (int ai = 0; ai < 2; ++ai) {
            u32x4 rw[4][2];
#pragma unroll
            for (int m = 0; m < 4; ++m)
#pragma unroll
                for (int bj = 0; bj < 2; ++bj) rw[m][bj] = *(const u32x4*)(xsrc + (size_t)(u.pm * 256 + ai * 128 + wr * 64 + m * 16 + fr) * 1024 + col0 + bj * 128);
#pragma unroll
            for (int m = 0; m < 4; ++m) {
                const int row = u.pm * 256 + ai * 128 + wr * 64 + m * 16 + fr; float ss = 0.f;
#pragma unroll
                for (int bj = 0; bj < 2; ++bj) {
                    const size_t off = (size_t)row * 1024 + col0 + bj * 128; const u32x4 w = rw[m][bj];
                    const f32x4 r0 = (f32x4){bflo(w.x), bfhi(w.x), bflo(w.y), bfhi(w.y)}, r1 = (f32x4){bflo(w.z), bfhi(w.z), bflo(w.w), bfhi(w.w)};
                    const f32x4 v0 = r0 + acc[ai][bj][m][0] * accs, v1 = r1 + acc[ai][bj][m][1] * accs;
                    ss += sq8(v0, v1);
                    *(u32x4*)(xh + off) = pack8(v0, v1);
                    *(u32x2*)(x8 + off) = (u32x2){pk4_fp8(clamp448(v0[0] * X8S), clamp448(v0[1] * X8S), clamp448(v0[2] * X8S), clamp448(v0[3] * X8S)), pk4_fp8(clamp448(v1[0] * X8S), clamp448(v1[1] * X8S), clamp448(v1[2] * X8S), clamp448(v1[3] * X8S))};
                }
                row_atomic(ssq + row, ss, fq);
            }
            asm volatile("" ::: "memory");
        }
    }
};
struct EpiQ {
    static constexpr bool MID = false; static constexpr bool PROBE2 = false; EPI_PROBE_COPY(EpiQ)
    const float* ssq2; bf16_t* q;
    __device__ __forceinline__ void mid(f32x4 (&)[2][2][4][2], const Unit&, int, int, int) const {}
    __device__ __forceinline__ void operator()(const f32x4 (&acc)[2][2][4][2], const Unit& u, int wr, int wc, int fr, int fq, LAS unsigned char*) const {
        const int col0 = u.pn * 256 + wc * 32 + 8 * fq;
        float sq[2][4];
        EPI_ROWS(ai, m) sq[ai][m] = ssq2[u.pm * 256 + ai * 128 + wr * 64 + m * 16 + fr];
        EPI_ROWS(ai, m) {
            const int row = u.pm * 256 + ai * 128 + wr * 64 + m * 16 + fr;
            const float sc = rsqrtf(sq[ai][m] * (1.0f / 1024.0f) + EPS) * (1.4426950408889634f / 16.0f) * (1.0f / (X8S * W8S));
#pragma unroll
            for (int bj = 0; bj < 2; ++bj) { const f32x4 a0 = acc[ai][bj][m][0] * (sc * Q8S), a1 = acc[ai][bj][m][1] * (sc * Q8S);
                *(u32x2*)((unsigned char*)q + ((size_t)(((row >> 12) * 4 + u.pn) * SEQ + (row & 4095))) * 256 + (col0 & 255) + bj * 128) = (u32x2){pk4_fp8(clamp448(a0[0]), clamp448(a0[1]), clamp448(a0[2]), clamp448(a0[3])), pk4_fp8(clamp448(a1[0]), clamp448(a1[1]), clamp448(a1[2]), clamp448(a1[3]))}; }
        }
    }
};
struct EpiAttn {
    static constexpr bool MID = false; static constexpr bool PROBE2 = false; EPI_PROBE_COPY(EpiAttn)
    bf16_t* pbuf; bf16_t* o; int c;
    __device__ __forceinline__ void mid(f32x4 (&)[2][2][4][2], const Unit&, int, int, int) const {}
    __device__ __forceinline__ void operator()(const f32x4 (&acc)[2][2][4][2], const Unit& u, int wr, int wc, int fr, int fq, LAS unsigned char* lds) const {
        LAS float* pmax = (LAS float*)(lds + XL_OFF + XL_PMAX);
        LAS float* psum = (LAS float*)(lds + XL_OFF + XL_PSUM) + u.e * 1024;
        if (u.job == 0) {
            EPI_ROWS(ai, m) {
                const int r = ai * 128 + wr * 64 + m * 16 + fr; float mx = -3.0e38f;
#pragma unroll
                for (int bj = 0; bj < 2; ++bj)
#pragma unroll
                    for (int n = 0; n < 2; ++n)
#pragma unroll
                        for (int i = 0; i < 4; ++i) mx = fmaxf(mx, acc[ai][bj][m][n][i]);
                mx = fmaxf(mx, __shfl_xor(mx, 16)); mx = fmaxf(mx, __shfl_xor(mx, 32));
                if (fq == 0) pmax[r * 4 + wc] = mx;
            }
            asm volatile("s_waitcnt lgkmcnt(0)" ::: "memory"); __builtin_amdgcn_s_barrier(); asm volatile("" ::: "memory");
            bf16_t* P = (bf16_t*)((unsigned char*)pbuf + (size_t)(c * 2 + u.e) * 256 * 256);
            EPI_ROWS(ai, m) {
                const int r = ai * 128 + wr * 64 + m * 16 + fr;
                const f32x4 pm4 = *(const LAS f32x4*)(pmax + r * 4);
                const float mx = fmaxf(fmaxf(pm4[0], pm4[1]), fmaxf(pm4[2], pm4[3])); float ss = 0.f;
#pragma unroll
                for (int bj = 0; bj < 2; ++bj) {
                    f32x4 p0, p1;
#pragma unroll
                    for (int i = 0; i < 4; ++i) { p0[i] = __builtin_amdgcn_exp2f((acc[ai][bj][m][0][i] - mx) * (1.0f / (Q8S * K8S))); p1[i] = __builtin_amdgcn_exp2f((acc[ai][bj][m][1][i] - mx) * (1.0f / (Q8S * K8S))); }
                    ss += (p0[0] + p0[1]) + (p0[2] + p0[3]) + (p1[0] + p1[1]) + (p1[2] + p1[3]);
                    *(u32x2*)((unsigned char*)P + (size_t)r * 256 + wc * 32 + 8 * fq + bj * 128) = (u32x2){pk4_fp8(p0[0] * P8S, p0[1] * P8S, p0[2] * P8S, p0[3] * P8S), pk4_fp8(p1[0] * P8S, p1[1] * P8S, p1[2] * P8S, p1[3] * P8S)};
                }
                ss += __shfl_xor(ss, 16); ss += __shfl_xor(ss, 32);
                if (fq == 0) psum[r * 4 + wc] = ss;
                asm volatile("" ::: "memory");
            }
            asm volatile("s_waitcnt vmcnt(0) lgkmcnt(0)" ::: "memory"); __builtin_amdgcn_s_barrier(); asm volatile("" ::: "memory");
        } else {
            const int b = u.pm >> 4, qb = u.pm & 15, h = u.pn;
            EPI_ROWS(ai, m) {
                const int r = ai * 128 + wr * 64 + m * 16 + fr;
                const f32x4 ps = *(const LAS f32x4*)(psum + r * 4);
                const float inv = (O8S / (P8S * K8S)) / ((ps[0] + ps[1]) + (ps[2] + ps[3]));
                unsigned char* dst = (unsigned char*)o + (size_t)(b * SEQ + qb * 256 + r) * 1024 + h * 256 + wc * 32 + 8 * fq;
#pragma unroll
                for (int bj = 0; bj < 2; ++bj) { const f32x4 a0 = acc[ai][bj][m][0] * inv, a1 = acc[ai][bj][m][1] * inv;
                    *(u32x2*)(dst + bj * 128) = (u32x2){pk4_fp8(clamp448(a0[0]), clamp448(a0[1]), clamp448(a0[2]), clamp448(a0[3])), pk4_fp8(clamp448(a1[0]), clamp448(a1[1]), clamp448(a1[2]), clamp448(a1[3]))}; }
            }
        }
    }
};
struct EpiMoe1 {
    static constexpr bool MID = false; static constexpr bool PROBE2 = (PROBE_EPI == 9); EPI_PROBE_COPY(EpiMoe1)
    const float* rstdl; const float* bgu; bf16_t* act;
    __device__ __forceinline__ void mid(f32x4 (&)[2][2][4][2], const Unit&, int, int, int) const {}
    __device__ __forceinline__ void operator()(const f32x4 (&acc)[2][2][4][2], const Unit& u, int wr, int wc, int fr, int fq, LAS unsigned char*) const {
        const int cj = u.pn * 128 + wc * 32 + 8 * fq;
        const float* bg = bgu + (size_t)u.e * 2048 + cj;
        float rs[2][4];
        EPI_ROWS(ai, m) { const int r = ai * 128 + wr * 64 + m * 16 + fr; rs[ai][m] = rstdl[(size_t)u.e * ECAP + u.aux + (r < u.valid ? r : 0)]; }
        const f32x4 bgv[2] = {*(const f32x4*)bg, *(const f32x4*)(bg + 4)}, blv[2] = {*(const f32x4*)(bg + 1024), *(const f32x4*)(bg + 1028)};
        EPI_ROWS(ai, m) {
            const int r = ai * 128 + wr * 64 + m * 16 + fr; const float sc = rs[ai][m] * (1.0f / (X8S * W8S));
            unsigned w[2];
#pragma unroll
            for (int n = 0; n < 2; ++n) { f32x2 o2[2];
#pragma unroll
                for (int h = 0; h < 2; ++h) {
                    const f32x2 ag = {acc[ai][0][m][n][2 * h], acc[ai][0][m][n][2 * h + 1]}, al = {acc[ai][1][m][n][2 * h], acc[ai][1][m][n][2 * h + 1]};
                    const f32x2 bg2 = {bgv[n][2 * h], bgv[n][2 * h + 1]}, bl2 = {blv[n][2 * h], blv[n][2 * h + 1]};
                    f32x2 g = ag * sc + bg2, l = al * sc + bl2;
                    g[0] = fminf(g[0], 7.0f); g[1] = fminf(g[1], 7.0f);
                    l[0] = __builtin_amdgcn_fmed3f(l[0], -7.0f, 7.0f); l[1] = __builtin_amdgcn_fmed3f(l[1], -7.0f, 7.0f);
                    f32x2 e = g * (-1.702f * 1.4426950408889634f);
                    e[0] = __builtin_amdgcn_exp2f(e[0]); e[1] = __builtin_amdgcn_exp2f(e[1]);
                    f32x2 d = e + 1.0f;
                    d[0] = __builtin_amdgcn_rcpf(d[0]); d[1] = __builtin_amdgcn_rcpf(d[1]);
                    o2[h] = (g * d) * (l * A8S + A8S);
                }
                w[n] = pk4_fp8(o2[0][0], o2[0][1], o2[1][0], o2[1][1]); }
            *(u32x2*)((unsigned char*)act + (size_t)(u.pm * 256 + r) * 1024 + cj) = (u32x2){w[0], w[1]};
        }
    }
};
struct EpiMoe2 {
    static constexpr bool MID = false; static constexpr bool PROBE2 = (PROBE_EPI == 10); EPI_PROBE_COPY(EpiMoe2)
    const int* tokl; const float* gatel; const float* bdn; bf16_t* slots;
    __device__ __forceinline__ void mid(f32x4 (&)[2][2][4][2], const Unit&, int, int, int) const {}
    __device__ __forceinline__ void operator()(const f32x4 (&acc)[2][2][4][2], const Unit& u, int wr, int wc, int fr, int fq, LAS unsigned char*) const {
        const int col0 = u.pn * 256 + wc * 32 + 8 * fq;
        const float* bp = bdn + (size_t)u.e * 1024 + col0;
        int sl[2][4]; float gt[2][4];
        EPI_ROWS(ai, m) { const int r = ai * 128 + wr * 64 + m * 16 + fr; const size_t idx = (size_t)u.e * ECAP + u.aux + (r < u.valid ? r : 0); sl[ai][m] = tokl[idx]; gt[ai][m] = gatel[idx]; }
        f32x4 bv[2][2];
#pragma unroll
        for (int bj = 0; bj < 2; ++bj) { bv[bj][0] = *(const f32x4*)(bp + bj * 128); bv[bj][1] = *(const f32x4*)(bp + bj * 128 + 4); }
        EPI_ROWS(ai, m) {
            const int r = ai * 128 + wr * 64 + m * 16 + fr;
            if (r < u.valid) {
                const int slot = sl[ai][m]; const float g = gt[ai][m];
#pragma unroll
                for (int bj = 0; bj < 2; ++bj) { const float gs = g * S8S; const f32x4 o0 = (acc[ai][bj][m][0] * (1.0f / (A8S * W8S)) + bv[bj][0]) * gs, o1 = (acc[ai][bj][m][1] * (1.0f / (A8S * W8S)) + bv[bj][1]) * gs;
                    *(u32x2*)((unsigned char*)slots + (size_t)slot * 1024 + col0 + bj * 128) = (u32x2){pk4_fp8(clamp448(o0[0]), clamp448(o0[1]), clamp448(o0[2]), clamp448(o0[3])), pk4_fp8(clamp448(o1[0]), clamp448(o1[1]), clamp448(o1[2]), clamp448(o1[3]))}; }
            }
        }
    }
};

#define XB_TMO      128
#define XB_XCNT(j)  (256  + 64 * (j))
#define XB_XSUB(j)  (1280 + 64 * (j))
#define XB_XGEN(j)  (2304 + 64 * (j))
#define XB_TOP      3328
#define XB_TOPGEN   3392
#define XCD_BAR_WORDS 3456
#define XB_SPIN_CAP (1u << 20)
__device__ __forceinline__ unsigned xb_ld(unsigned* p)              { return __hip_atomic_load(p, __ATOMIC_RELAXED, __HIP_MEMORY_SCOPE_AGENT); }
__device__ __forceinline__ unsigned xb_add(unsigned* p, unsigned v) { return __hip_atomic_fetch_add(p, v, __ATOMIC_RELAXED, __HIP_MEMORY_SCOPE_AGENT); }
__device__ __forceinline__ unsigned xb_xcc_id() { return (unsigned)__builtin_amdgcn_s_getreg((3 << 11) | 20) & 0xFu; }
#define XB_SPIN(cond, bar) do { unsigned _sp = 0; while (cond) { __builtin_amdgcn_s_sleep(1); \
    if ((++_sp & 255u) == 0u) { if (xb_ld(&(bar)[XB_TMO])) break; if (_sp > XB_SPIN_CAP) { atomicAdd(&(bar)[XB_TMO], 1u); break; } } } } while (0)
struct XcdBarrier { unsigned* bar; unsigned x; volatile LAS unsigned* st; };
__device__ __forceinline__ XcdBarrier xcd_barrier_post(unsigned* bar, volatile LAS unsigned* st) {
    XcdBarrier b; b.bar = bar; b.x = xb_xcc_id(); b.st = st;
    if (threadIdx.x == 0) (void)xb_add(&bar[XB_XCNT(b.x)], 1u);
    return b;
}
__device__ __forceinline__ void xcd_barrier_complete(unsigned* bar, unsigned x, unsigned& nloc, unsigned& nx) {
    const unsigned G = gridDim.x * gridDim.y * gridDim.z;
    unsigned sum, cnt, mine, sp = 0u;
    for (;;) {
        sum = 0u; cnt = 0u; mine = 0u;
#pragma unroll
        for (unsigned j = 0; j < 16; ++j) { const unsigned c = xb_ld(&bar[XB_XCNT(j)]); sum += c; cnt += (c > 0u) ? 1u : 0u; mine = (j == x) ? c : mine; }
        if (sum == G) break;
        __builtin_amdgcn_s_sleep(1);
        if ((++sp & 255u) == 0u) { if (xb_ld(&bar[XB_TMO])) break; if (sp > XB_SPIN_CAP) { atomicAdd(&bar[XB_TMO], 1u); break; } }
    }
    nloc = mine > 0u ? mine : 1u; nx = cnt > 0u ? cnt : 1u;
}
__device__ __forceinline__ void xcd_barrier(const XcdBarrier& b) {
    asm volatile("s_waitcnt vmcnt(0)" ::: "memory");
    __syncthreads();
    if (threadIdx.x == 0) {
        unsigned* bar = b.bar;
        __builtin_amdgcn_s_waitcnt(0);
        unsigned nloc = b.st[0], nx = b.st[1];
        if (nloc == 0u) { xcd_barrier_complete(bar, b.x, nloc, nx); b.st[0] = nloc; b.st[1] = nx; }
        const unsigned old = xb_add(&bar[XB_XSUB(b.x)], 1u);
        const unsigned gen = old / nloc;
        if (old + 1u == (gen + 1u) * nloc) {
            __builtin_amdgcn_fence(__ATOMIC_RELEASE, "agent");
            asm volatile("s_waitcnt vmcnt(0)" ::: "memory");
            const unsigned og = xb_add(&bar[XB_TOP], 1u);
            const unsigned tg = og / nx;
            if (og + 1u == (tg + 1u) * nx) xb_add(&bar[XB_TOPGEN], 1u);
            else XB_SPIN(xb_ld(&bar[XB_TOPGEN]) == tg, bar);
            __builtin_amdgcn_fence(__ATOMIC_ACQUIRE, "agent");
            xb_add(&bar[XB_XGEN(b.x)], 1u);
            asm volatile("s_waitcnt vmcnt(0)" ::: "memory");
        } else {
            XB_SPIN(xb_ld(&bar[XB_XGEN(b.x)]) == gen, bar);
            __builtin_amdgcn_fence(__ATOMIC_ACQUIRE, "agent");
            asm volatile("s_waitcnt vmcnt(0)" ::: "memory");
        }
    }
    __syncthreads();
}

struct Args { const float* in[30]; float* out; unsigned char* ws; int ph_lo, ph_hi; };
enum { I_X = 0, I_MEM, I_NMIX, I_WIN, I_CONVW, I_ARE, I_AIM, I_LOGDT, I_BRE, I_BIM, I_CRE, I_CIM, I_D, I_WGLU, I_NCO, I_NSO, I_WOUT, I_NX, I_NM, I_WQ, I_WKV, I_WO, I_NMOE, I_WR, I_BR, I_WGU, I_BGU, I_WDN, I_BDN, I_NF };

struct CvItem { const float* W; const float* scale; unsigned char* WT; int ldw, k0, n0, ldt, drow0, dk0, f8; };
__device__ __forceinline__ void cv_load(const CvItem& c, float (&v)[64], int lane) {
    const float* src = c.W + (size_t)c.k0 * c.ldw + c.n0 + lane;
#pragma unroll
    for (int i = 0; i < 64; ++i) v[i] = __builtin_nontemporal_load(src + (size_t)i * c.ldw);
}
__device__ __forceinline__ void cv_store(const CvItem& c, float (&v)[64], int lane, LAS unsigned char* scr) {
    if (c.scale) {
#pragma unroll
        for (int i = 0; i < 64; ++i) v[i] *= c.scale[c.k0 + i];
    }
    if (c.f8) {
#pragma unroll
        for (int q = 0; q < 4; ++q) { u32x4 o; o.x = pk4_fp8(v[16 * q] * W8S, v[16 * q + 1] * W8S, v[16 * q + 2] * W8S, v[16 * q + 3] * W8S); o.y = pk4_fp8(v[16 * q + 4] * W8S, v[16 * q + 5] * W8S, v[16 * q + 6] * W8S, v[16 * q + 7] * W8S);
            o.z = pk4_fp8(v[16 * q + 8] * W8S, v[16 * q + 9] * W8S, v[16 * q + 10] * W8S, v[16 * q + 11] * W8S); o.w = pk4_fp8(v[16 * q + 12] * W8S, v[16 * q + 13] * W8S, v[16 * q + 14] * W8S, v[16 * q + 15] * W8S);
            *(LAS u32x4*)(scr + lane * 80 + 16 * q) = o; }
        asm volatile("s_waitcnt lgkmcnt(0)" ::: "memory");
#pragma unroll
        for (int j = 0; j < 4; ++j) { const int row = 16 * j + (lane >> 2), ch = lane & 3; const u32x4 o = *(const LAS u32x4*)(scr + row * 80 + 16 * ch);
            *(u32x4*)(c.WT + (size_t)(c.drow0 + row) * c.ldt + c.dk0 + 16 * ch) = o; }
    } else {
#pragma unroll
        for (int q = 0; q < 8; ++q) { u32x4 o; o.x = pk2(v[8 * q], v[8 * q + 1]); o.y = pk2(v[8 * q + 2], v[8 * q + 3]); o.z = pk2(v[8 * q + 4], v[8 * q + 5]); o.w = pk2(v[8 * q + 6], v[8 * q + 7]);
            *(LAS u32x4*)(scr + lane * 144 + 16 * q) = o; }
        asm volatile("s_waitcnt lgkmcnt(0)" ::: "memory");
#pragma unroll
        for (int j = 0; j < 8; ++j) { const int row = 8 * j + (lane >> 3), ch = lane & 7; const u32x4 o = *(const LAS u32x4*)(scr + row * 144 + 16 * ch);
            *(u32x4*)(c.WT + (size_t)(c.drow0 + row) * c.ldt + c.dk0 + 16 * ch) = o; }
    }
    asm volatile("s_waitcnt lgkmcnt(0)" ::: "memory");
}

__global__ void __launch_bounds__(NTHREADS, 2) mk_fwd(Args args) {
    extern __shared__ __attribute__((aligned(16))) unsigned char lds_raw[];
    LAS unsigned char* lds = (LAS unsigned char*)lds_raw;
    cg::grid_group grid = cg::this_grid();
    const int wave = __builtin_amdgcn_readfirstlane(threadIdx.x >> 6);
#define PH_IDS const int lane = lane_id_volatile(), tid = wave * 64 + lane; (void)lane; (void)tid
    const int G = gridDim.x, bx = blockIdx.x;
#define vcu ((G % 8 == 0) ? (bx % 8) * (G / 8) + bx / 8 : bx)
    unsigned char* const ws = args.ws;
#define PH_WS __attribute__((address_space(1))) unsigned char* ws_ = (__attribute__((address_space(1))) unsigned char*)args.ws; asm volatile("" : "+s"(ws_)); unsigned char* const ws = (unsigned char*)ws_
    const int lo = MK_PER_PHASE ? args.ph_lo : 0, hi = MK_PER_PHASE ? args.ph_hi : 12;
#ifndef PH_MASK
#define PH_MASK 0xfff
#endif
#define IN(k) (((PH_MASK >> (k)) & 1) && lo <= (k) && (k) < hi)
#if MK_USE_CG
#define SEAM(k) do { if (IN(k) && IN((k) + 1)) grid.sync(); STAMP(k); } while (0)
#else
#define SEAM(k) do { if (IN(k) && IN((k) + 1)) { XcdBarrier xb_; xb_.bar = (unsigned*)(ws + WS_BAR); xb_.x = xb_xcc_id(); xb_.st = (volatile LAS unsigned*)(lds + XL_OFF + XL_MISC); xcd_barrier(xb_); } STAMP(k); } while (0)
#endif
#if PROBE_PHASE >= 0 || PROBE_A >= 0
    unsigned long long* stamps = (unsigned long long*)(ws + WS_STAMP);
#define STAMP(k) do { if (bx == 0 && threadIdx.x == 0) stamps[(k) + 1] = __builtin_amdgcn_s_memrealtime(); } while (0)
    if (bx == 0 && threadIdx.x == 0) stamps[0] = __builtin_amdgcn_s_memrealtime();
#define STAMPX(i) do { if (bx == 0 && threadIdx.x == 0) stamps[(i)] = __builtin_amdgcn_s_memrealtime(); } while (0)
#else
#define STAMP(k) do { } while (0)
#define STAMPX(i) do { } while (0)
#endif
    volatile LAS unsigned* misc = (volatile LAS unsigned*)(lds + XL_OFF + XL_MISC);
    if (threadIdx.x == 0) { misc[0] = 0u; misc[1] = 0u; }
    __syncthreads();
    if (!MK_PER_PHASE && !MK_USE_CG) (void)xcd_barrier_post((unsigned*)(ws + WS_BAR), misc);
#define gw (vcu * NWAVES + wave)
#define NGW (G * NWAVES)
#define counts ((int*)(ws + WS_CNT))
#define rstd1 ((float*)(ws + WS_RSTD1))
#define ssqs ((float*)(ws + WS_SSQS))
#define ssq2 ((float*)(ws + WS_SSQ2))
#define ssq3 ((float*)(ws + WS_SSQ3))
#define gates ((float*)(ws + WS_GATES))
#define gatel ((float*)(ws + WS_GATEL))
#define rstdl ((float*)(ws + WS_RSTDL))
#define wrs ((float*)(ws + WS_WR))
#define tokl ((int*)(ws + WS_TOKL))
#define xb ((bf16_t*)(ws + WS_XB))
#define proj ((bf16_t*)(ws + WS_PROJ))
#define ug ((bf16_t*)(ws + WS_UG))
#define ycat ((bf16_t*)(ws + WS_YCAT))
#define ygelu ((bf16_t*)(ws + WS_YGELU))
#define x8 ((unsigned char*)(ws + WS_X1))
#define xh ((bf16_t*)(ws + WS_XH))
#define qo ((bf16_t*)(ws + WS_QO))
#define pbuf ((bf16_t*)(ws + WS_PBUF))
#define ob ((bf16_t*)(ws + WS_O))
#define act ((bf16_t*)(ws + WS_ACT))
#define slots ((bf16_t*)(ws + WS_SLOTS))
#define memn ((bf16_t*)(ws + WS_MEMN))
#define kmat ((bf16_t*)(ws + WS_KMAT))
#define vt ((bf16_t*)(ws + WS_VT))

    if (IN(0)) {
        PH_WS;
        PH_IDS;
        for (int i = bx * NTHREADS + tid; i < 3 * NTOK; i += G * NTHREADS) ssqs[i] = 0.f;
        if (bx == 0 && tid < NEXP) counts[tid] = 0;
        for (int i = bx * NTHREADS + tid; i < DM * NEXP; i += G * NTHREADS) wrs[i] = args.in[I_WR][i] * args.in[I_NMOE][i >> 5];
        for (int item = bx; item < 256; item += G) {
            const int g = item >> 3, part = item & 7;
            LAS float* Wp = (LAS float*)lds;
            LAS float* Bb = Wp + 65 * 128;
            LAS float* Cc = Bb + 64 * 32;
            const float dt = __expf(args.in[I_LOGDT][g]);
            __syncthreads();
            for (int i = tid; i < 65 * 64; i += NTHREADS) { const int p = i >> 6, j = i & 63; const float ar = args.in[I_ARE][g * 64 + j], aim = args.in[I_AIM][g * 64 + j];
                const float mag = expf((float)p * dt * ar); float sn, cs; sincosf((float)p * dt * aim, &sn, &cs); Wp[i * 2] = mag * cs; Wp[i * 2 + 1] = mag * sn; }
            for (int i = tid; i < 64 * 16; i += NTHREADS) { const int j = i >> 4; const float ar = args.in[I_ARE][g * 64 + j], aim = args.in[I_AIM][g * 64 + j];
                float sn, cs; sincosf(dt * aim, &sn, &cs); const float em1 = expm1f(dt * ar); float sh, ch; sincosf(0.5f * dt * aim, &sh, &ch);
                const float pre = em1 * cs - 2.0f * sh * sh, pim = (em1 + 1.0f) * sn, den = ar * ar + aim * aim;
                const float qre = (pre * ar + pim * aim) / den, qim = (pim * ar - pre * aim) / den;
                const float br = args.in[I_BRE][(size_t)g * 1024 + i], bi = args.in[I_BIM][(size_t)g * 1024 + i];
                Bb[i * 2] = qre * br - qim * bi; Bb[i * 2 + 1] = qre * bi + qim * br; }
            for (int i = tid; i < 16 * 64; i += NTHREADS) { Cc[i * 2] = args.in[I_CRE][(size_t)g * 1024 + i]; Cc[i * 2 + 1] = args.in[I_CIM][(size_t)g * 1024 + i]; }
            __syncthreads();
            unsigned char* tab = ws + WS_SSM + (size_t)g * SSM_STRIDE;
            if (part == 0 && tid < 64) { ((float*)tab)[tid * 2] = Wp[(64 * 64 + tid) * 2]; ((float*)tab)[tid * 2 + 1] = Wp[(64 * 64 + tid) * 2 + 1]; }
            bf16_t* Kt = (bf16_t*)(tab + SSM_KT); bf16_t* Pt = (bf16_t*)(tab + SSM_PT); bf16_t* Qt = (bf16_t*)(tab + SSM_QT);
            {
                const int lag = 8 * part + (tid >> 6), c = (tid >> 2) & 15, cp0 = (tid & 3) * 4; float s0 = 0.f, s1 = 0.f, s2 = 0.f, s3 = 0.f;
#pragma unroll 4
                for (int j = 0; j < 64; ++j) { const f32x2 w = *(const LAS f32x2*)(Wp + (lag * 64 + j) * 2), cc = *(const LAS f32x2*)(Cc + (c * 64 + j) * 2);
                    const float xr = cc[0] * w[0] - cc[1] * w[1], xi = cc[0] * w[1] + cc[1] * w[0];
                    const f32x4 b0 = *(const LAS f32x4*)(Bb + (j * 16 + cp0) * 2), b1 = *(const LAS f32x4*)(Bb + (j * 16 + cp0 + 2) * 2);
                    s0 += xr * b0[0] - xi * b0[1]; s1 += xr * b0[2] - xi * b0[3]; s2 += xr * b1[0] - xi * b1[1]; s3 += xr * b1[2] - xi * b1[3]; }
                *(u32x2*)(Kt + (size_t)lag * 256 + c * 16 + cp0) = (u32x2){pk2(s0, s1), pk2(s2, s3)};
            }
            {
                const int k = 2 * tid, sidx = k >> 4, cp = k & 15;
#pragma unroll 4
                for (int r = 0; r < 16; ++r) { const int n = 16 * part + r, ri = n >> 6, j = n & 63;
                    const f32x2 w = *(const LAS f32x2*)(Wp + ((63 - sidx) * 64 + j) * 2); const f32x4 b = *(const LAS f32x4*)(Bb + (j * 16 + cp) * 2);
                    const float v0 = ri ? (w[0] * b[1] + w[1] * b[0]) : (w[0] * b[0] - w[1] * b[1]), v1 = ri ? (w[0] * b[3] + w[1] * b[2]) : (w[0] * b[2] - w[1] * b[3]);
                    *(unsigned*)(Pt + (size_t)n * 1024 + k) = pk2(v0, v1); }
            }
            {
                const int n = 2 * (tid & 63), ri = n >> 6, j = n & 63;
#pragma unroll 4
                for (int r = 0; r < 16; ++r) { const int tc = 128 * part + (tid >> 6) + 8 * r, t = tc >> 4, c = tc & 15;
                    const f32x4 w = *(const LAS f32x4*)(Wp + ((t + 1) * 64 + j) * 2), cc = *(const LAS f32x4*)(Cc + (c * 64 + j) * 2);
                    const float v0 = ri ? -(cc[0] * w[1] + cc[1] * w[0]) : (cc[0] * w[0] - cc[1] * w[1]), v1 = ri ? -(cc[2] * w[3] + cc[3] * w[2]) : (cc[2] * w[2] - cc[3] * w[3]);
                    *(unsigned*)(Qt + (size_t)tc * 128 + n) = pk2(v0, v1); }
            }
        }
        STAMPX(30);
        for (int m4 = gw * 4; m4 < NTOK + NMEM; m4 += NGW * 4) {
            const bool isx = m4 < NTOK; const int r0 = isx ? m4 : m4 - NTOK;
            const f32x4* xr = (const f32x4*)((isx ? args.in[I_X] : args.in[I_MEM]) + (size_t)r0 * DM) + lane;
            f32x4 v[4][4];
#pragma unroll
            for (int q = 0; q < 4; ++q)
#pragma unroll
                for (int j = 0; j < 4; ++j) v[q][j] = __builtin_nontemporal_load(xr + q * 256 + 64 * j);
#pragma unroll
            for (int q = 0; q < 4; ++q) {
                float ss = 0.f;
#pragma unroll
                for (int j = 0; j < 4; ++j) ss += (v[q][j][0] * v[q][j][0] + v[q][j][1] * v[q][j][1]) + (v[q][j][2] * v[q][j][2] + v[q][j][3] * v[q][j][3]);
                const float rs = rsqrtf(wave_sum(ss) * (1.f / DM) + EPS);
                u32x2* o8 = (u32x2*)((isx ? xb : memn) + (size_t)(r0 + q) * DM) + lane;
                if (isx) { if (lane == 0) rstd1[r0 + q] = rs;
#pragma unroll
                    for (int j = 0; j < 4; ++j) o8[64 * j] = (u32x2){pk2(v[q][j][0], v[q][j][1]), pk2(v[q][j][2], v[q][j][3])}; }
                else {
#pragma unroll
                    for (int j = 0; j < 4; ++j) { const f32x4 g = ((const f32x4*)args.in[I_NM])[lane + 64 * j]; o8[64 * j] = (u32x2){pk2(v[q][j][0] * rs * g[0], v[q][j][1] * rs * g[1]), pk2(v[q][j][2] * rs * g[2], v[q][j][3] * rs * g[3])}; } }
            }
        }
        STAMPX(31);
        {
            constexpr int I_IN = 16 * 32, I_GLU = 8 * 8, I_OUT = 16 * 16, I_Q = 16 * 16, I_KV = 16 * 32, I_O = 16 * 16, I_GU = 32 * 16 * 32, I_DN = 32 * 16 * 16;
            constexpr int NIT = I_IN + I_GLU + I_OUT + I_Q + I_KV + I_O + I_GU + I_DN;
#define CV_DECODE(c, it) do { int r = (it); \
                if (r < I_GU) { const int e = r / 512, q = r % 512, kb = q / 32, nb = q % 32, n0 = nb * 64, j = n0 & 1023, lin = n0 >> 10; \
                    c = CvItem{args.in[I_WGU] + (size_t)e * 1024 * 2048, args.in[I_NMOE], ws + WS_WGU + (size_t)e * 2048 * 1024, 2048, kb * 64, n0, 1024, 256 * (j >> 7) + 128 * lin + (j & 127), kb * 64, 1}; break; } r -= I_GU; \
                if (r < I_DN) { const int e = r / 256, q = r % 256, kb = q / 16, nb = q % 16; \
                    c = CvItem{args.in[I_WDN] + (size_t)e * 1024 * 1024, nullptr, ws + WS_WDN + (size_t)e * 1024 * 1024, 1024, kb * 64, nb * 64, 1024, nb * 64, kb * 64, 1}; break; } r -= I_DN; \
                if (r < I_IN) { const int kb = r / 32, nb = r % 32; c = CvItem{args.in[I_WIN], args.in[I_NMIX], ws + WS_WIN, 2048, kb * 64, nb * 64, 2048, nb * 64, kb * 128, 0}; break; } r -= I_IN; \
                if (r < I_GLU) { const int kb = r / 8, nb = r % 8; c = CvItem{args.in[I_WGLU], nullptr, ws + WS_WGLU, 512, kb * 64, nb * 64, 1024, nb * 64, kb * 128, 0}; break; } r -= I_GLU; \
                if (r < I_OUT) { const int kb = r / 16, nb = r % 16, k0 = kb * 64;        \
                    c = CvItem{args.in[I_WOUT], (k0 < 512) ? args.in[I_NCO] : args.in[I_NSO] - 512, ws + WS_WOUT, 1024, k0, nb * 64, 2048, nb * 64, ((k0 + 512) & 1023) * 2, 0}; break; } r -= I_OUT; \
                if (r < I_Q) { const int kb = r / 16, nb = r % 16; c = CvItem{args.in[I_WQ], args.in[I_NX], ws + WS_WQ, 1024, kb * 64, nb * 64, 1024, nb * 64, kb * 64, 1}; break; } r -= I_Q; \
                if (r < I_KV) { const int kb = r / 32, nb = r % 32, n0 = nb * 64; c = CvItem{args.in[I_WKV], nullptr, ws + (n0 < 1024 ? WS_WK : WS_WV), 2048, kb * 64, n0, 2048, n0 & 1023, kb * 128, 0}; break; } r -= I_KV; \
                { const int kb = r / 16, nb = r % 16; c = CvItem{args.in[I_WO], nullptr, ws + WS_WO, 1024, kb * 64, nb * 64, 1024, nb * 64, kb * 64, 1}; } } while (0)
            float va[64], vb[64]; CvItem ca, cb;
            __syncthreads();
            LAS unsigned char* cvscr = lds + wave * 10240;
            int it = gw;
            if (it < NIT) { CV_DECODE(ca, it); cv_load(ca, va, lane); }
            while (it < NIT) {
                int it2 = it + NGW;
                if (it2 < NIT) { CV_DECODE(cb, it2); cv_load(cb, vb, lane); }
                cv_store(ca, va, lane, cvscr);
                it = it2; if (it >= NIT) break;
                it2 = it + NGW;
                if (it2 < NIT) { CV_DECODE(ca, it2); cv_load(ca, va, lane); }
                cv_store(cb, vb, lane, cvscr);
                it = it2;
            }
#undef CV_DECODE
        }
    }
    SEAM(0);
    if (IN(1)) {
        PH_WS;
        SchedP1 S{(const char*)xb, (const char*)(ws + WS_WIN), (const char*)memn, (const char*)(ws + WS_WK), (const char*)(ws + WS_WV), 2048u, 2048u, 1024, G, bx};
        EpiP1 E{rstd1, proj, ug, kmat, vt};
        g8::gemm_phase(lds, S, E, wave);
    }
    SEAM(1);
    if (IN(2)) {
        PH_WS;
        PH_IDS;
        constexpr int L_KT = 0, L_SPV = 32768, L_UH = 49152, UROW = 1040, L_STG = 115712;
        const int l15 = lane & 15, lq = lane >> 4;
        for (int it_ = vcu; it_ < BATCH * 32; it_ += G) {
            const int g = (it_ >> 5) * 4 + (it_ & 3), b = (it_ >> 2) & 7, item = b * 32 + g;
            const bf16_t* ugp = ug + (size_t)item * SEQ * 16;
            const unsigned char* tab = ws + WS_SSM + (size_t)g * SSM_STRIDE;
            const float* A64 = (const float*)tab; const bf16_t* Kt = (const bf16_t*)(tab + SSM_KT); const bf16_t* Pt = (const bf16_t*)(tab + SSM_PT); const bf16_t* Qt = (const bf16_t*)(tab + SSM_QT);
#define STAGE_U(p) do { _Pragma("unroll") for (int _i = 0; _i < 8; ++_i) { const int _c = wave * 8 + _i; \
                const u32x4 _v = *(const u32x4*)(ugp + ((size_t)_c * 64 + 32 * (p)) * 16 + lane * 8); *(LAS u32x4*)(lds + L_UH + _c * UROW + lane * 16) = _v; } } while (0)
#define UFRAG(mb, kk) (*(const LAS bf16x8*)(lds + L_UH + (16 * (mb) + l15) * UROW + (32 * (kk) + 8 * lq) * 2))
            f32x4 sacc[4];
#pragma unroll
            for (int mb = 0; mb < 4; ++mb) sacc[mb] = (f32x4){0.f, 0.f, 0.f, 0.f};
#pragma unroll 1
            for (int p = 0; p < 2; ++p) {
                bf16x8 pf[16];
#pragma unroll
                for (int kk = 0; kk < 16; ++kk) pf[kk] = *(const bf16x8*)(Pt + (size_t)(16 * wave + l15) * 1024 + 32 * (16 * p + kk) + 8 * lq);
                __syncthreads(); STAGE_U(p); __syncthreads();
#pragma unroll
                for (int kk = 0; kk < 16; ++kk) {
#pragma unroll
                    for (int mb = 0; mb < 4; ++mb) sacc[mb] = __builtin_amdgcn_mfma_f32_16x16x32_bf16(UFRAG(mb, kk), pf[kk], sacc[mb], 0, 0, 0);
                }
            }
            STAMPX(20);
            { LAS float* Sl = (LAS float*)(lds + L_KT);
#pragma unroll
              for (int mb = 0; mb < 4; ++mb)
#pragma unroll
                for (int r = 0; r < 4; ++r) Sl[(16 * mb + 4 * lq + r) * 128 + 16 * wave + l15] = sacc[mb][r]; }
            __syncthreads();
            if (wave == 0) {
                const LAS float* Sl = (const LAS float*)(lds + L_KT); LAS bf16_t* Sp = (LAS bf16_t*)(lds + L_SPV);
                const float ar = A64[lane * 2], ai = A64[lane * 2 + 1]; float sr = 0.f, si = 0.f;
#pragma unroll 2
                for (int c = 0; c < 64; ++c) { Sp[c * 128 + lane] = (bf16_t)f2bf(sr); Sp[c * 128 + 64 + lane] = (bf16_t)f2bf(si);
                    const float lr = Sl[c * 128 + lane], li = Sl[c * 128 + 64 + lane]; const float nr = ar * sr - ai * si + lr, ni = ar * si + ai * sr + li; sr = nr; si = ni; }
            }
            __syncthreads();
            { const u32x4* src = (const u32x4*)Kt;
#pragma unroll
              for (int i = 0; i < 4; ++i) *(LAS u32x4*)(lds + L_KT + (tid + i * NTHREADS) * 16) = src[tid + i * NTHREADS]; }
            __syncthreads();
            STAMPX(21);
            const f32x4 dv4 = *(const f32x4*)(args.in[I_D] + g * 16 + (lane & 3) * 4);
#pragma unroll 1
            for (int ig = 1; ig >= 0; --ig) {
                f32x4 acc[4][4];
#pragma unroll
                for (int i = 0; i < 4; ++i)
#pragma unroll
                    for (int mb = 0; mb < 4; ++mb) acc[i][mb] = (f32x4){0.f, 0.f, 0.f, 0.f};
                const int tb0 = wave + 32 * ig, tmax = tb0 + 24;
                bf16x8 qf[4][4];
#pragma unroll
                for (int kq = 0; kq < 4; ++kq)
#pragma unroll
                    for (int i = 0; i < 4; ++i) qf[kq][i] = *(const bf16x8*)(Qt + (size_t)((tb0 + 8 * i) * 16 + l15) * 128 + 32 * kq + 8 * lq);
#pragma unroll 1
                for (int p = ig; p >= 0; --p) {
                    if (ig == 1 && p == 0) { __syncthreads(); STAGE_U(0); __syncthreads(); }
#pragma unroll 1
                    for (int kk = 0; kk < 16; ++kk) {
                        const int s0 = 32 * p + 2 * kk; if (s0 > tmax) break;
                        bf16x8 af[4];
#pragma unroll
                        for (int mb = 0; mb < 4; ++mb) af[mb] = UFRAG(mb, kk);
                        const int s = s0 + (lq >> 1);
#pragma unroll
                        for (int i = 0; i < 4; ++i) { const int t = tb0 + 8 * i;
                            if (t >= s0) { const int lag = t - s; bf16x8 bfr = *(const LAS bf16x8*)(lds + L_KT + (((lag < 0 ? 0 : lag) * 16 + l15) * 16 + 8 * (lq & 1)) * 2);
                                if (lag < 0) bfr = (bf16x8){0, 0, 0, 0, 0, 0, 0, 0};
#pragma unroll
                                for (int mb = 0; mb < 4; ++mb) acc[i][mb] = __builtin_amdgcn_mfma_f32_16x16x32_bf16(af[mb], bfr, acc[i][mb], 0, 0, 0); } }
                    }
                }
#pragma unroll
                for (int kq = 0; kq < 4; ++kq) {
                    bf16x8 af[4];
#pragma unroll
                    for (int mb = 0; mb < 4; ++mb) af[mb] = *(const LAS bf16x8*)(lds + L_SPV + ((16 * mb + l15) * 128 + 32 * kq + 8 * lq) * 2);
#pragma unroll
                    for (int i = 0; i < 4; ++i) {
#pragma unroll
                        for (int mb = 0; mb < 4; ++mb) acc[i][mb] = __builtin_amdgcn_mfma_f32_16x16x32_bf16(af[mb], qf[kq][i], acc[i][mb], 0, 0, 0); }
                }
                LAS float* stg = (LAS float*)(lds + L_STG + wave * 2048);
#pragma unroll
                for (int i = 0; i < 4; ++i) { const int t = tb0 + 8 * i;
                    u32x2 uq[2][2];
#pragma unroll
                    for (int hf = 0; hf < 2; ++hf)
#pragma unroll
                        for (int it = 0; it < 2; ++it) uq[hf][it] = *(const u32x2*)(ugp + (size_t)((32 * hf + ((it * 64 + lane) >> 2)) * 64 + t) * 16 + (lane & 3) * 4);
#pragma unroll
                    for (int hf = 0; hf < 2; ++hf) {
#pragma unroll
                        for (int ml = 0; ml < 2; ++ml)
#pragma unroll
                            for (int r = 0; r < 4; ++r) stg[(16 * ml + 4 * lq + r) * 16 + l15] = acc[i][2 * hf + ml][r];
                        asm volatile("s_waitcnt lgkmcnt(0)" ::: "memory");
#pragma unroll
                        for (int it = 0; it < 2; ++it) { const int idx = it * 64 + lane, tt = (32 * hf + (idx >> 2)) * 64 + t, c4 = (idx & 3) * 4;
                            const f32x4 yv = *(const LAS f32x4*)(stg + idx * 4); const u32x2 uu = uq[hf][it];
                            const f32x2 ya = gelu_tanh2((f32x2){yv[0], yv[1]} + (f32x2){dv4[0], dv4[1]} * (f32x2){bflo(uu.x), bfhi(uu.x)}), yb = gelu_tanh2((f32x2){yv[2], yv[3]} + (f32x2){dv4[2], dv4[3]} * (f32x2){bflo(uu.y), bfhi(uu.y)});
                            *(u32x2*)(ygelu + (size_t)(b * SEQ + tt) * 512 + g * 16 + c4) = (u32x2){cvt_pk_bf16(ya[0], ya[1]), cvt_pk_bf16(yb[0], yb[1])}; }
                        asm volatile("s_waitcnt lgkmcnt(0)" ::: "memory");
                    }
                }
            }
#undef STAGE_U
#undef UFRAG
        }
        STAMPX(22);
        {
            const int ch = lane * 8;
            float w0[8], w1[8], w2[8];
#pragma unroll
            for (int i = 0; i < 8; ++i) { w0[i] = args.in[I_CONVW][ch + i]; w1[i] = args.in[I_CONVW][512 + ch + i]; w2[i] = args.in[I_CONVW][1024 + ch + i]; }
            for (int run = gw; run < NTOK / 16; run += NGW) {
                const int r0 = run * 16, tin = r0 & (SEQ - 1);
                float vm2[8], vm1[8];
#pragma unroll
                for (int i = 0; i < 8; ++i) { vm2[i] = 0.f; vm1[i] = 0.f; }
                if (tin > 0) {
#pragma unroll
                    for (int d = 2; d >= 1; --d) { const bf16_t* pr = proj + (size_t)(r0 - d) * 1536;
                        const u32x4 c4 = *(const u32x4*)(pr + 512 + ch), x4 = *(const u32x4*)(pr + 1024 + ch);
                        float v[8]; v[0] = bflo(c4.x) * bflo(x4.x); v[1] = bfhi(c4.x) * bfhi(x4.x); v[2] = bflo(c4.y) * bflo(x4.y); v[3] = bfhi(c4.y) * bfhi(x4.y);
                        v[4] = bflo(c4.z) * bflo(x4.z); v[5] = bfhi(c4.z) * bfhi(x4.z); v[6] = bflo(c4.w) * bflo(x4.w); v[7] = bfhi(c4.w) * bfhi(x4.w);
#pragma unroll
                        for (int i = 0; i < 8; ++i) { if (d == 2) vm2[i] = v[i]; else vm1[i] = v[i]; } }
                }
#pragma unroll 1
                for (int tb = 0; tb < 16; tb += 8) {
                    u32x4 b4[8], c4[8], x4[8];
#pragma unroll
                    for (int q = 0; q < 8; ++q) { const bf16_t* pr = proj + (size_t)(r0 + tb + q) * 1536; b4[q] = *(const u32x4*)(pr + ch); c4[q] = *(const u32x4*)(pr + 512 + ch); x4[q] = *(const u32x4*)(pr + 1024 + ch); }
#pragma unroll
                    for (int q = 0; q < 8; ++q) {
                        float v[8], bgv[8], y[8]; v[0] = bflo(c4[q].x) * bflo(x4[q].x); v[1] = bfhi(c4[q].x) * bfhi(x4[q].x); v[2] = bflo(c4[q].y) * bflo(x4[q].y); v[3] = bfhi(c4[q].y) * bfhi(x4[q].y);
                        v[4] = bflo(c4[q].z) * bflo(x4[q].z); v[5] = bfhi(c4[q].z) * bfhi(x4[q].z); v[6] = bflo(c4[q].w) * bflo(x4[q].w); v[7] = bfhi(c4[q].w) * bfhi(x4[q].w);
                        bgv[0] = bflo(b4[q].x); bgv[1] = bfhi(b4[q].x); bgv[2] = bflo(b4[q].y); bgv[3] = bfhi(b4[q].y); bgv[4] = bflo(b4[q].z); bgv[5] = bfhi(b4[q].z); bgv[6] = bflo(b4[q].w); bgv[7] = bfhi(b4[q].w);
                        float ss = 0.f;
#pragma unroll
                        for (int i = 0; i < 8; ++i) { y[i] = bgv[i] * (w0[i] * vm2[i] + w1[i] * vm1[i] + w2[i] * v[i]); ss += y[i] * y[i]; vm2[i] = vm1[i]; vm1[i] = v[i]; }
                        const float rs = rsqrtf(wave_sum(ss) * (1.f / 512.f) + EPS);
                        u32x4 o; o.x = pk2(y[0] * rs, y[1] * rs); o.y = pk2(y[2] * rs, y[3] * rs); o.z = pk2(y[4] * rs, y[5] * rs); o.w = pk2(y[6] * rs, y[7] * rs);
                        *(u32x4*)(ycat + (size_t)(r0 + tb + q) * 1024 + 512 + ch) = o;
                    }
                }
            }
        }
    }
    SEAM(2);
    if (IN(3)) {
        PH_WS;
        SchedDense S{(const char*)ygelu, (const char*)(ws + WS_WGLU), 1024u, 1024u, 512, NTOK / 256, 2, G, bx};
        EpiGlu E{ygelu, ycat, ssqs};
        g8::gemm_phase(lds, S, E, wave);
    }
    SEAM(3);
    if (IN(4)) {
        PH_WS;
        SchedDense S{(const char*)ycat, (const char*)(ws + WS_WOUT), 2048u, 2048u, 1024, NTOK / 256, 4, G, bx};
        EpiRes E{xb, xh, x8, ssq2, ssqs, 6, 1.0f};
        g8::gemm_phase(lds, S, E, wave);
    }
    SEAM(4);
    if (IN(5)) {
        PH_WS;
        SchedQ S{(const char*)x8, (const char*)(ws + WS_WQ), 1024u, 1024u, 512, G, bx};
        EpiQ E{ssq2, qo};
        g8::gemm_phase(lds, S, E, wave);
    }
    STAMP(5);
    if (IN(6)) {
        PH_WS;
        SchedAttn S{(const char*)qo, (const char*)kmat, (const char*)vt, (const char*)pbuf, 256u, 256u, 128, G, bx, (BATCH * 4 * 16) / G};
        EpiAttn E{pbuf, ob, bx};
        g8::gemm_phase(lds, S, E, wave);
    }
    SEAM(6);
    if (IN(7)) {
        PH_WS;
        SchedDenseT<true> S{(const char*)ob, (const char*)(ws + WS_WO), 1024u, 1024u, 512, NTOK / 256, 4, G, bx};
        EpiRes E{xh, xh, x8, ssq3, ssqs, -1, 1.0f / (O8S * W8S)};
        g8::gemm_phase(lds, S, E, wave);
    }
    SEAM(7);
    if (IN(8)) {
        PH_WS;
        PH_IDS;
        LAS float* Xs = (LAS float*)lds;
        LAS float* Ws = (LAS float*)(lds + 34816);
        LAS float* Lg = (LAS float*)(lds + 69632);
        LAS int* hist = (LAS int*)(lds + 86528);
        LAS int* hbase = (LAS int*)(lds + 86656);
        const int te = tid & 7, tt = (tid >> 3) & 15, ks = tid >> 7;
        for (int blk = vcu; blk < NTOK / 128; blk += G) {
            const int r0 = blk * 128;
            float ac[8][4];
#pragma unroll
            for (int a = 0; a < 8; ++a)
#pragma unroll
                for (int e = 0; e < 4; ++e) ac[a][e] = 0.f;
            if (tid < 32) hist[tid] = 0;
            u32x2 xa[4], xb_[4]; f32x4 wa, wb;
#define P8_LOAD(xr, wv, kc) do { _Pragma("unroll") for (int j = 0; j < 4; ++j) xr[j] = *(const u32x2*)(xh + (size_t)(r0 + (tid >> 4) + 32 * j) * DM + (kc) * 64 + 4 * (tid & 15)); \
                wv = *(const f32x4*)(wrs + (size_t)((kc) * 64 + (tid >> 3)) * 32 + 4 * (tid & 7)); } while (0)
#define P8_STEP(xr, wv, kc) do { __syncthreads(); \
                _Pragma("unroll") for (int j = 0; j < 4; ++j) *(LAS f32x4*)(Xs + ((tid >> 4) + 32 * j) * 68 + 4 * (tid & 15)) = (f32x4){bflo(xr[j].x), bfhi(xr[j].x), bflo(xr[j].y), bfhi(xr[j].y)}; \
                *(LAS f32x4*)(Ws + (tid >> 3) * 32 + 4 * (tid & 7)) = wv; \
                __syncthreads(); \
                if ((kc) + 2 < 16) P8_LOAD(xr, wv, (kc) + 2); \
                _Pragma("unroll 2") \
                for (int q = 0; q < 4; ++q) { const int k4 = 4 * ks + q; \
                    f32x4 xv[8], w4[4]; \
                _Pragma("unroll") \
                    for (int i = 0; i < 8; ++i) xv[i] = *(const LAS f32x4*)(Xs + (tt + 16 * i) * 68 + 4 * k4); \
                _Pragma("unroll") \
                    for (int kk = 0; kk < 4; ++kk) w4[kk] = *(const LAS f32x4*)(Ws + (4 * k4 + kk) * 32 + 4 * te); \
                _Pragma("unroll") \
                    for (int i = 0; i < 8; ++i) \
                _Pragma("unroll") \
                        for (int kk = 0; kk < 4; ++kk) \
                _Pragma("unroll") \
                            for (int e = 0; e < 4; ++e) ac[i][e] += xv[i][kk] * w4[kk][e]; } \
                } while (0)
            P8_LOAD(xa, wa, 0); P8_LOAD(xb_, wb, 1);
            for (int kc = 0; kc < 16; kc += 2) { P8_STEP(xa, wa, kc); P8_STEP(xb_, wb, kc + 1); }
#undef P8_STEP
#undef P8_LOAD
            __syncthreads();
            { LAS float* Lp = (LAS float*)lds;
#pragma unroll
              for (int i = 0; i < 8; ++i)
#pragma unroll
                for (int e = 0; e < 4; ++e) Lp[(ks * 128 + tt + 16 * i) * 33 + 4 * te + e] = ac[i][e]; }
            __syncthreads();
            for (int o = tid; o < 128 * 32; o += NTHREADS) { const int t = o >> 5, e = o & 31; const LAS float* Lp = (const LAS float*)lds;
                const float sum = (Lp[t * 33 + e] + Lp[(128 + t) * 33 + e]) + (Lp[(256 + t) * 33 + e] + Lp[(384 + t) * 33 + e]);
                Lg[t * 33 + e] = sum * rsqrtf(ssq3[r0 + t] * (1.0f / 1024.0f) + EPS) + args.in[I_BR][e]; }
            __syncthreads();
            int ei[4], lp[4]; float gv[4];
            if (tid < 128) {
                unsigned taken = 0u; float tv[4];
#pragma unroll
                for (int k = 0; k < 4; ++k) { float best = -3.0e38f; int bi = 0;
                    for (int e = 0; e < 32; ++e) { const float v = Lg[tid * 33 + e]; if (!((taken >> e) & 1u) && v > best) { best = v; bi = e; } }
                    taken |= 1u << bi; ei[k] = bi; tv[k] = best; }
                float sum = 0.f;
#pragma unroll
                for (int k = 0; k < 4; ++k) { gv[k] = __expf(tv[k] - tv[0]); sum += gv[k]; }
                const float inv = 1.0f / sum;
#pragma unroll
                for (int k = 0; k < 4; ++k) { gv[k] *= inv; lp[k] = __hip_atomic_fetch_add((LAS int*)(hist + ei[k]), 1, __ATOMIC_RELAXED, __HIP_MEMORY_SCOPE_WORKGROUP); }
            }
            __syncthreads();
            if (tid < 32) hbase[tid] = atomicAdd(counts + tid, hist[tid]);
            __syncthreads();
            if (tid < 128) {
                const int tok = r0 + tid; const float rs = rsqrtf(ssq3[tok] * (1.0f / 1024.0f) + EPS);
#pragma unroll
                for (int k = 0; k < 4; ++k) { const size_t idx = (size_t)ei[k] * ECAP + hbase[ei[k]] + lp[k]; tokl[idx] = tok * 4 + k; gatel[idx] = gv[k]; rstdl[idx] = rs; }
            }
            __syncthreads();
        }
    }
    SEAM(8);
    if (IN(9) || IN(10)) {
        PH_WS;
        PH_IDS;
        LAS int* tb = (LAS int*)(lds + XL_OFF + XL_TB); LAS int* cn = (LAS int*)(lds + XL_OFF + XL_CNT);
        __syncthreads();
        if (tid == 0) { int a = 0; for (int e = 0; e < NEXP; ++e) { const int c = ald(counts + e); cn[e] = c; tb[e] = a; a += (c + 255) >> 8; } tb[NEXP] = a; }
        __syncthreads();
        if (IN(9)) {
        PH_WS;
            SchedMoeT<true> S; S.tb = tb; S.cnt = cn; S.tl = tokl; S.A = (const char*)x8; S.B = (const char*)(ws + WS_WGU); S.lda2 = 1024u; S.ldb2 = 1024u; S.K = 512; S.nN = 8; S.G = G; S.c = bx; S.bstride = (size_t)2048 * 1024; S.gather = true;
            EpiMoe1 E{rstdl, args.in[I_BGU], act};
            g8::gemm_phase(lds, S, E, wave);
        }
    }
    SEAM(9);
    if (IN(10)) {
        PH_WS;
        LAS int* tb = (LAS int*)(lds + XL_OFF + XL_TB); LAS int* cn = (LAS int*)(lds + XL_OFF + XL_CNT);
        SchedMoeT<false> S; S.tb = tb; S.cnt = cn; S.tl = tokl; S.A = (const char*)act; S.B = (const char*)(ws + WS_WDN); S.lda2 = 1024u; S.ldb2 = 1024u; S.K = 512; S.nN = 4; S.G = G; S.c = bx; S.bstride = (size_t)1024 * 1024; S.gather = false;
        EpiMoe2 E{tokl, gatel, args.in[I_BDN], slots};
        g8::gemm_phase(lds, S, E, wave);
    }
    SEAM(10);
    if (IN(11)) {
        PH_WS;
        PH_IDS;
        for (int m = gw; m < NTOK; m += NGW) {
            f32x4 v[4];
            { const u32x2* xr = (const u32x2*)(xh + (size_t)m * DM) + lane;
#pragma unroll
              for (int j = 0; j < 4; ++j) { const u32x2 w = xr[64 * j]; v[j] = (f32x4){bflo(w.x), bfhi(w.x), bflo(w.y), bfhi(w.y)}; } }
            if (DBG_OUT == 0) {
#pragma unroll
                for (int k = 0; k < 4; ++k) { const unsigned* sr = (const unsigned*)((const unsigned char*)slots + (size_t)(m * 4 + k) * DM) + lane;
#pragma unroll
                    for (int j = 0; j < 4; ++j) { const int w = (int)sr[64 * j]; const f32x2 lo = __builtin_amdgcn_cvt_pk_f32_fp8(w, false), hi = __builtin_amdgcn_cvt_pk_f32_fp8(w, true);
                        v[j][0] += lo[0] * (1.0f / S8S); v[j][1] += lo[1] * (1.0f / S8S); v[j][2] += hi[0] * (1.0f / S8S); v[j][3] += hi[1] * (1.0f / S8S); } }
            }
            float ss = 0.f;
#pragma unroll
            for (int j = 0; j < 4; ++j) ss += (v[j][0] * v[j][0] + v[j][1] * v[j][1]) + (v[j][2] * v[j][2] + v[j][3] * v[j][3]);
            const float rs = rsqrtf(wave_sum(ss) * (1.f / DM) + EPS);
            f32x4* o = (f32x4*)(args.out + (size_t)m * DM) + lane;
#pragma unroll
            for (int j = 0; j < 4; ++j) { const f32x4 g = ((const f32x4*)args.in[I_NF])[lane + 64 * j]; o[64 * j] = v[j] * rs * g; }
        }
    }
#if PROBE_PHASE >= 0 || PROBE_A >= 0
    STAMP(11);
    if (bx == 0 && threadIdx.x == 0) {
        const int ia = (PROBE_A >= 0) ? PROBE_A : PROBE_PHASE, ib = (PROBE_A >= 0) ? PROBE_B : PROBE_PHASE + 1;
        const unsigned long long d = (stamps[ib] - stamps[ia]) * (unsigned long long)PROBE_MULT, t0 = __builtin_amdgcn_s_memrealtime();
        while (__builtin_amdgcn_s_memrealtime() - t0 < d) __builtin_amdgcn_s_sleep(16);
    }
#endif
#undef IN
#undef SEAM
#undef vcu
#undef gw
#undef NGW
#undef counts
#undef rstd1
#undef ssqs
#undef ssq2
#undef ssq3
#undef gates
#undef gatel
#undef rstdl
#undef wrs
#undef tokl
#undef xb
#undef proj
#undef ug
#undef ycat
#undef ygelu
#undef x8
#undef xh
#undef qo
#undef pbuf
#undef ob
#undef act
#undef slots
#undef memn
#undef kmat
#undef vt
}

extern "C" void kernel_launch(void* const* d_in, const int* in_sizes, int n_in, void* d_out, int out_size, void* d_ws, size_t ws_size, hipStream_t stream) {
    static int grid = 0;
    if (grid == 0) {
        if (n_in != 30 || in_sizes[0] != NTOK * DM || out_size != NTOK * DM || ws_size < WS_END) { fprintf(stderr, "kernel_launch: unexpected shapes (n_in %d, in0 %d, out %d, ws %zu < %zu); nothing launched\n", n_in, n_in > 0 ? in_sizes[0] : -1, out_size, ws_size, (size_t)WS_END); grid = -1; return; }
        int dev = 0, cus = 0, per_cu = 0;
        if (hipGetDevice(&dev) != hipSuccess || hipDeviceGetAttribute(&cus, hipDeviceAttributeMultiprocessorCount, dev) != hipSuccess) { grid = -1; return; }
        if (hipFuncSetAttribute((const void*)mk_fwd, hipFuncAttributeMaxDynamicSharedMemorySize, LDS_BYTES) != hipSuccess) { fprintf(stderr, "kernel_launch: hipFuncSetAttribute failed\n"); grid = -1; return; }
        if (hipOccupancyMaxActiveBlocksPerMultiprocessor(&per_cu, (const void*)mk_fwd, NTHREADS, LDS_BYTES) != hipSuccess || per_cu < 1) { fprintf(stderr, "kernel_launch: occupancy query says %d blocks per CU\n", per_cu); per_cu = 1; }
        (void)hipGetLastError();
        grid = cus;
        if (grid != 256) fprintf(stderr, "kernel_launch: %d CUs; the attention phase assumes 256\n", grid);
    }
    if (grid < 0) return;
    if (hipMemsetAsync((char*)d_ws + WS_BAR, 0, BAR_ZERO_BYTES, stream) != hipSuccess) { fprintf(stderr, "kernel_launch: hipMemsetAsync failed\n"); return; }
    Args a{};
    for (int i = 0; i < 30; ++i) a.in[i] = (const float*)d_in[i];
    a.out = (float*)d_out; a.ws = (unsigned char*)d_ws;
#if MK_PER_PHASE
    for (int ph = 0; ph < 12; ++ph) { a.ph_lo = ph; a.ph_hi = ph + 1; hipLaunchKernelGGL(mk_fwd, dim3(grid), dim3(NTHREADS), LDS_BYTES, stream, a); }
#else
    a.ph_lo = 0; a.ph_hi = 12;
    void* kargs[] = {&a};
    hipError_t e = hipLaunchCooperativeKernel((const void*)mk_fwd, dim3(grid), dim3(NTHREADS), kargs, LDS_BYTES, stream);
    if (e != hipSuccess) fprintf(stderr, "kernel_launch: cooperative launch failed: %s (grid %d)\n", hipGetErrorString(e), grid);
#endif
}
```

```cpp
#include <hip/hip_runtime.h>
#include <hip/hip_cooperative_groups.h>
#include <cstdio>
#include <cstdint>
#include <cmath>
namespace cg = cooperative_groups;

#ifndef MK_PER_PHASE
#define MK_PER_PHASE 0
#endif
#ifndef MK_USE_CG
#define MK_USE_CG 0
#endif
#ifndef PROBE_PHASE
#define PROBE_PHASE -1
#endif
#ifndef PROBE_EPI
#define PROBE_EPI -1
#endif
#ifndef PROBE_A
#define PROBE_A -1
#define PROBE_B -1
#endif
#ifndef PROBE_MULT
#define PROBE_MULT 1
#endif
#ifndef DBG_OUT
#define DBG_OUT 0
#endif

#define LAS __attribute__((address_space(3)))
typedef unsigned short bf16_t;
typedef short bf16x8 __attribute__((ext_vector_type(8)));
typedef float f32x4 __attribute__((ext_vector_type(4)));
typedef float f32x2 __attribute__((ext_vector_type(2)));
typedef unsigned u32x4 __attribute__((ext_vector_type(4)));
typedef unsigned u32x2 __attribute__((ext_vector_type(2)));
typedef int i32x4 __attribute__((ext_vector_type(4)));
typedef int i32x8 __attribute__((ext_vector_type(8)));

constexpr int NTHREADS = 512, NWAVES = 8;
constexpr int DM = 1024, BATCH = 8, SEQ = 4096, NTOK = BATCH * SEQ, MEMLEN = 256, NMEM = BATCH * MEMLEN;
constexpr int NEXP = 32, TOPK = 4, ECAP = NTOK;
constexpr int MAXTILES = (NTOK * TOPK) / 256 + NEXP;
constexpr float EPS = 1e-5f;
constexpr float X8S = 16.0f, W8S = 256.0f, A8S = 4.0f, O8S = 64.0f, S8S = 32.0f, Q8S = 64.0f, K8S = 16.0f, P8S = 256.0f;

constexpr size_t MiB = 1u << 20;
constexpr size_t WS_CNT = 0;
constexpr size_t WS_BAR = 256 * 1024, BAR_ZERO_BYTES = 16 * 1024;
constexpr size_t WS_STAMP = 512 * 1024;
constexpr size_t WS_RSTD1 = 1 * MiB;
constexpr size_t WS_SSQS = WS_RSTD1 + 128 * 1024;
constexpr size_t WS_SSQ2 = WS_SSQS + 128 * 1024;
constexpr size_t WS_SSQ3 = WS_SSQ2 + 128 * 1024;
constexpr size_t WS_GATES = 2 * MiB;
constexpr size_t WS_WR = 3 * MiB;
constexpr size_t WS_TOKL = 4 * MiB;
constexpr size_t WS_SSM = 8 * MiB;
constexpr size_t SSM_STRIDE = 576 * 1024, SSM_KT = 1024, SSM_PT = 64 * 1024, SSM_QT = 320 * 1024;
constexpr size_t WS_WIN = 26 * MiB, WS_WGLU = 30 * MiB, WS_WOUT = 31 * MiB, WS_WQ = 33 * MiB, WS_WK = 35 * MiB, WS_WV = 37 * MiB, WS_WO = 39 * MiB;
constexpr size_t WS_MEMN = 41 * MiB, WS_KMAT = 45 * MiB, WS_VT = 49 * MiB;
constexpr size_t WS_WGU = 56 * MiB, WS_WDN = 184 * MiB;
constexpr size_t WS_YGELU = 248 * MiB;
constexpr size_t WS_X1 = 280 * MiB;
constexpr size_t WS_ACT = 408 * MiB;
constexpr size_t WS_XB = 408 * MiB, WS_PROJ = 472 * MiB, WS_UG = 568 * MiB, WS_YCAT = 600 * MiB;
constexpr size_t WS_SLOTS = 680 * MiB;
constexpr size_t WS_XH = 312 * MiB  , WS_QO = 744 * MiB, WS_PBUF = 808 * MiB, WS_O = 872 * MiB;
constexpr size_t WS_GATEL = 936 * MiB, WS_RSTDL = 940 * MiB;
constexpr size_t WS_END = 944 * MiB;

constexpr int LDS_BYTES = 147456;
constexpr int XL_OFF = 131072;
constexpr int XL_PMAX = 0, XL_PSUM = 4096, XL_TB = 12288, XL_CNT = 12544, XL_MISC = 13312;

__device__ __forceinline__ float wave_sum(float v) {
#pragma unroll
    for (int o = 1; o < 64; o <<= 1) v += __shfl_xor(v, o);
    return v;
}
__device__ __forceinline__ unsigned f2bf(float f) { unsigned u = __builtin_bit_cast(unsigned, f); return (u + 0x7fffu + ((u >> 16) & 1u)) >> 16; }
__device__ __forceinline__ unsigned pk2(float lo, float hi) { return f2bf(lo) | (f2bf(hi) << 16); }
__device__ __forceinline__ unsigned cvt_pk_bf16(float lo, float hi) { unsigned r; asm volatile("v_cvt_pk_bf16_f32 %0, %1, %2" : "=v"(r) : "v"(lo), "v"(hi)); return r; }
__device__ __forceinline__ unsigned pk4_fp8(float a, float b, float c, float d) { int w = __builtin_amdgcn_cvt_pk_fp8_f32(a, b, 0, false); w = __builtin_amdgcn_cvt_pk_fp8_f32(c, d, w, true); return (unsigned)w; }
__device__ __forceinline__ float clamp448(float v) { return __builtin_amdgcn_fmed3f(v, -448.0f, 448.0f); }
__device__ __forceinline__ float bflo(unsigned w) { return __builtin_bit_cast(float, w << 16); }
__device__ __forceinline__ float bfhi(unsigned w) { return __builtin_bit_cast(float, w & 0xffff0000u); }
__device__ __forceinline__ float bf2f(bf16_t b) { return __builtin_bit_cast(float, (unsigned)b << 16); }
__device__ __forceinline__ float sigmoidf_(float x) { return __builtin_amdgcn_rcpf(1.0f + __builtin_amdgcn_exp2f(-1.4426950408889634f * x)); }
__device__ __forceinline__ f32x2 sigmoid2(f32x2 x) { f32x2 e = x * -1.4426950408889634f; e[0] = __builtin_amdgcn_exp2f(e[0]); e[1] = __builtin_amdgcn_exp2f(e[1]); f32x2 d = e + 1.0f; d[0] = __builtin_amdgcn_rcpf(d[0]); d[1] = __builtin_amdgcn_rcpf(d[1]); return d; }
__device__ __forceinline__ f32x2 gelu_tanh2(f32x2 y) { const f32x2 t = (y * y * 0.044715f + 1.0f) * y * (2.0f * 0.7978845608028654f); return y * sigmoid2(t); }
__device__ __forceinline__ float gelu_tanh(float y) { const float t = 0.7978845608028654f * (y + 0.044715f * y * y * y); return y * sigmoidf_(2.0f * t); }
__device__ __forceinline__ int ald(const int* p) { return __hip_atomic_load(p, __ATOMIC_RELAXED, __HIP_MEMORY_SCOPE_AGENT); }

namespace g8 {
constexpr int BM = 256, BK = 64, HALF = 128, HTB = HALF * BK * 2, NXCD = 8, WGM = 8;
__device__ __forceinline__ int lds_byte(int r, int c) { const int st = (r >> 4) * 2 + (c >> 5), rr = r & 15, cc = c & 31, ob = rr * 64 + cc * 2; return st * 1024 + (ob ^ (((ob >> 9) & 1) << 5)); }
__device__ __forceinline__ void stage_rc(int b, int& R, int& C) { const int st = b / 1024, sb = b % 1024, swz = sb ^ (((sb >> 9) & 1) << 5); R = (st >> 1) * 16 + swz / 64; C = (st & 1) * 32 + (swz % 64) / 2; }
__device__ __forceinline__ int perm32(int rho) { const int n = rho >> 4, i = rho & 15; return 8 * (i >> 2) + 4 * n + (i & 3); }

struct Unit { const char* A; const char* B; int pm, pn, e, aux, valid, job; };

__device__ __forceinline__ bool tile_order(int i, int G, int c, int nM, int nN, int& pm, int& pn) {
    const int nwg = nM * nN; const long L = (long)i * G + c; if (L >= nwg) return false;
    int wgid = (int)L; { const int q = nwg / NXCD, r = nwg % NXCD, xcd = wgid % NXCD, off = wgid / NXCD; wgid = (xcd < r ? xcd * (q + 1) : r * (q + 1) + (xcd - r) * q) + off; }
    const int nig = WGM * nN, gid = wgid / nig, fm = gid * WGM, gsz = (nM - fm) < WGM ? (nM - fm) : WGM;
    pm = fm + ((wgid % nig) % gsz); pn = (wgid % nig) / gsz; return true;
}

__device__ __forceinline__ int lane_id_volatile() { int l; asm volatile("v_mbcnt_lo_u32_b32 %0, -1, 0\n\tv_mbcnt_hi_u32_b32 %0, -1, %0" : "=v"(l)); return l; }
template <class Epi, class Sched>
__device__ __forceinline__ void gemm_phase(LAS unsigned char* lds, const Sched& S, const Epi& E, const int wid) {
    const int lane = lane_id_volatile(), tid = wid * 64 + lane, wr = wid >> 2, wc = wid & 3, fr = lane & 15, fq = lane >> 4;
    const int K = S.K, nt = K / BK;
    const unsigned lda2 = S.lda2, ldb2 = S.ldb2;
    unsigned voffB0, cb0;
    { int R, C; stage_rc(tid * 16, R, C); cb0 = (unsigned)C * 2u; const int Rb = 64 * (R >> 5) + 16 * ((R >> 2) & 3) + 4 * ((R >> 4) & 1) + (R & 3); voffB0 = (unsigned)Rb * ldb2 + cb0; }
    const size_t pstepA = (size_t)64 * lda2, pstepB = (size_t)128 * ldb2, hstepA = (size_t)HALF * lda2;
    const size_t kstep = (size_t)(BK * 2);
    const size_t hstepB = (size_t)8 * ldb2;
    const unsigned ldsw = (unsigned)wid * 1024u;
    const int aoff = lds_byte(wr * 64 + fr, fq * 8), boff = lds_byte(wc * 32 + fr, fq * 8);
#define G8_SA(b, h) (((b) * 2 + (h)) * HTB)
#define G8_SB(b, h) ((4 + (b) * 2 + (h)) * HTB)
#define G8_STAGE_B(bufoff, gbase) do { _Pragma("unroll") for (int _i = 0; _i < 2; ++_i) \
        __builtin_amdgcn_global_load_lds((const unsigned*)((const char*)(gbase) + _i * pstepB + voffB0), (LAS unsigned*)(lds + (bufoff) + ldsw + _i * 8192), 16, 0, 0); } while (0)
#define G8_STAGE_A(bufoff, gbase, o0, o1) do { \
        __builtin_amdgcn_global_load_lds((const unsigned*)((const char*)(gbase) + (o0)), (LAS unsigned*)(lds + (bufoff) + ldsw), 16, 0, 0); \
        __builtin_amdgcn_global_load_lds((const unsigned*)((const char*)(gbase) + (o1)), (LAS unsigned*)(lds + (bufoff) + ldsw + 8192), 16, 0, 0); } while (0)
#define G8_LDA(dst, b, h) do { _Pragma("unroll") for (int m = 0; m < 4; ++m) _Pragma("unroll") for (int k = 0; k < 2; ++k) dst[m][k] = *(const LAS bf16x8*)(lds + G8_SA(b, h) + aoff + m * 2048 + k * 1024); } while (0)
#define G8_LDB(dst, b, h) do { _Pragma("unroll") for (int n = 0; n < 2; ++n) _Pragma("unroll") for (int k = 0; k < 2; ++k) dst[n][k] = *(const LAS bf16x8*)(lds + G8_SB(b, h) + boff + n * 2048 + k * 1024); } while (0)
#define G8_MMA(ai, bj, At, Bt) do { __builtin_amdgcn_s_setprio(1); _Pragma("unroll") for (int m = 0; m < 4; ++m) _Pragma("unroll") for (int n = 0; n < 2; ++n) _Pragma("unroll") for (int k = 0; k < 2; ++k) \
        acc[ai][bj][m][n] = __builtin_amdgcn_mfma_f32_16x16x32_bf16(Bt[n][k], At[m][k], acc[ai][bj][m][n], 0, 0, 0); __builtin_amdgcn_s_setprio(0); } while (0)
#define G8_RD16(off) __builtin_bit_cast(i32x4, *(const LAS bf16x8*)(lds + (off)))
#define G8_LDA8(dst, b, h) do { _Pragma("unroll") for (int m = 0; m < 4; ++m) dst[m] = __builtin_shufflevector(G8_RD16(G8_SA(b, h) + aoff + m * 2048), G8_RD16(G8_SA(b, h) + aoff + m * 2048 + 1024), 0, 1, 2, 3, 4, 5, 6, 7); } while (0)
#define G8_LDB8(dst, b, h) do { _Pragma("unroll") for (int n = 0; n < 2; ++n) dst[n] = __builtin_shufflevector(G8_RD16(G8_SB(b, h) + boff + n * 2048), G8_RD16(G8_SB(b, h) + boff + n * 2048 + 1024), 0, 1, 2, 3, 4, 5, 6, 7); } while (0)
#define G8_MMA8(ai, bj, At, Bt) do { __builtin_amdgcn_s_setprio(1); _Pragma("unroll") for (int m = 0; m < 4; ++m) _Pragma("unroll") for (int n = 0; n < 2; ++n) \
        asm volatile("s_nop 1\n\tv_mfma_scale_f32_16x16x128_f8f6f4 %0, %1, %2, %0, %3, %3 op_sel_hi:[0,0,0]" : "+v"(acc[ai][bj][m][n]) : "v"(Bt[n]), "v"(At[m]), "v"(scl8)); __builtin_amdgcn_s_setprio(0); } while (0)
#define G8_MM(ai, bj, X) do { if constexpr (Sched::FP8) G8_MMA8(ai, bj, At8, X##8); else G8_MMA(ai, bj, At, X); } while (0)
#define G8_LA(b, h) do { if constexpr (Sched::FP8) G8_LDA8(At8, b, h); else G8_LDA(At, b, h); } while (0)
#define G8_LB(X, b, h) do { if constexpr (Sched::FP8) G8_LDB8(X##8, b, h); else G8_LDB(X, b, h); } while (0)
#define G8_WAIT_V(n) asm volatile("s_waitcnt vmcnt(" #n ")" ::: "memory")
#define G8_WAIT_L(n) asm volatile("s_waitcnt lgkmcnt(" #n ")" ::: "memory")
#define G8_BAR __builtin_amdgcn_s_barrier()
#define G8_SCHED __builtin_amdgcn_sched_barrier(0)
#define G8_SETOFF(o, u) do { const int _t = wid * 64 + lane_id_volatile(); _Pragma("unroll") for (int _i = 0; _i < 2; ++_i) { int _R, _C; stage_rc(_t * 16 + _i * 8192, _R, _C); \
        _Pragma("unroll") for (int _h = 0; _h < 2; ++_h) { if (Sched::GATHER) { const unsigned _tk = S.arow_tok(u, _h * HALF + _R); if (_i == 0) o[_h][0] = _tk; else o[_h][0] |= _tk << 16; } \
            else if (_h == 0 && _i == 0) o[0][0] = (unsigned)_R * lda2 + (unsigned)_C * 2u; } } } while (0)
#define G8_GOFF0(pk) (((pk) & 0xffffu) * lda2 + cb0)
#define G8_GOFF1(pk) (((pk) >> 16) * lda2 + cb0)
#define G8_STAGE_AH(bufoff, gbase, h, pk) do { if (Sched::GATHER) { G8_STAGE_A(bufoff, gbase, G8_GOFF0(pk), G8_GOFF1(pk)); } \
        else { G8_STAGE_A(bufoff, (const char*)(gbase) + (h) * hstepA, oa[0][0], pstepA + oa[0][0]); } } while (0)
    Unit cur, nxt; int ui = 0;
    if (!S.next(0, cur)) return;
    f32x4 acc[2][2][4][2];
#pragma unroll
    for (int a = 0; a < 2; ++a)
#pragma unroll
        for (int b = 0; b < 2; ++b)
#pragma unroll
            for (int m = 0; m < 4; ++m)
#pragma unroll
                for (int n = 0; n < 2; ++n) acc[a][b][m][n] = (f32x4){0.f, 0.f, 0.f, 0.f};
    bf16x8 At[4][2], B0[2][2], B1[2][2];
    i32x8 At8[4], B08[2], B18[2]; const int scl8 = 0x7F7F7F7F;
    unsigned oa[2][2], on[2][2];
    G8_SETOFF(oa, cur);
    const char* cA = cur.A; const char* cB = cur.B;
    G8_STAGE_B(G8_SB(0, 0), cB); G8_STAGE_B(G8_SB(0, 1), cB + hstepB); G8_STAGE_AH(G8_SA(0, 0), cA, 0, oa[0][0]); G8_STAGE_AH(G8_SA(0, 1), cA, 1, oa[1][0]);
    if (wr == 1) G8_BAR;
    G8_WAIT_V(2); G8_BAR;
    G8_STAGE_B(G8_SB(1, 0), cB + kstep); G8_STAGE_AH(G8_SA(1, 0), cA + kstep, 0, oa[0][0]); G8_STAGE_B(G8_SB(1, 1), cB + hstepB + kstep);
    G8_WAIT_V(6); G8_BAR;
    bool has_next = S.next(1, nxt);
    if (Sched::GATHER) { if (has_next) { G8_SETOFF(on, nxt); } else {
#pragma unroll
        for (int h = 0; h < 2; ++h) on[h][0] = oa[h][0]; } }
    for (;;) {
        const char* nA = has_next ? nxt.A : cA; const char* nB = has_next ? nxt.B : cB;
#pragma unroll 1
        for (int t = 0; t < nt; t += 2) {
            const bool last = (t == nt - 2);
            const char* a1 = cA + (size_t)(t + 1) * kstep;
            const char* a2 = last ? nA : cA + (size_t)(t + 2) * kstep; const char* b2 = last ? nB : cB + (size_t)(t + 2) * kstep;
            const char* a3 = a2 + kstep; const char* b3 = b2 + kstep;
            unsigned p0 = 0, p1 = 0;
            if (Sched::GATHER) { p0 = last ? on[0][0] : oa[0][0]; p1 = last ? on[1][0] : oa[1][0]; }
            G8_LB(B0, 0, 0); G8_LB(B1, 0, 1); G8_SCHED; G8_LA(0, 0); G8_STAGE_AH(G8_SA(1, 1), a1, 1, oa[1][0]);
            G8_WAIT_V(8); G8_WAIT_L(0); G8_BAR; G8_MM(0, 0, B0); G8_MM(0, 1, B1); G8_BAR; G8_SCHED;
            G8_LA(0, 1); G8_STAGE_B(G8_SB(0, 0), b2); G8_STAGE_B(G8_SB(0, 1), b2 + hstepB); G8_STAGE_AH(G8_SA(0, 0), a2, 0, p0);
            G8_WAIT_V(8); G8_WAIT_L(0); G8_BAR; G8_MM(1, 0, B0); G8_MM(1, 1, B1); G8_BAR; G8_SCHED;
            G8_LB(B0, 1, 0); G8_LB(B1, 1, 1); G8_SCHED; G8_LA(1, 0); G8_STAGE_AH(G8_SA(0, 1), a2, 1, p1);
            G8_WAIT_V(8); G8_WAIT_L(0); G8_BAR; G8_MM(0, 0, B0); G8_MM(0, 1, B1); G8_BAR; G8_SCHED;
            G8_LA(1, 1); G8_STAGE_B(G8_SB(1, 0), b3); G8_STAGE_B(G8_SB(1, 1), b3 + hstepB); G8_STAGE_AH(G8_SA(1, 0), a3, 0, p0);
            G8_WAIT_V(8); G8_WAIT_L(0); G8_BAR; G8_MM(1, 0, B0); G8_MM(1, 1, B1); G8_BAR; G8_SCHED;
            if (Epi::MID) { const int fr_e = lane_id_volatile() & 15; E.mid(acc, cur, t, wr, fr_e); }
        }
        if (wr == 0) G8_BAR;
        if constexpr (Sched::FP8) asm volatile("s_nop 15\n\ts_nop 15" ::: "memory");
        Unit n2; bool has2 = false; unsigned tk[2][2] = {{0u, 0u}, {0u, 0u}};
        if (has_next) { has2 = S.next(ui + 2, n2);
            if (Sched::GATHER && has2) { const int _t = wid * 64 + lane_id_volatile();
#pragma unroll
                for (int _i = 0; _i < 2; ++_i) { int _R, _C; stage_rc(_t * 16 + _i * 8192, _R, _C);
#pragma unroll
                    for (int _h = 0; _h < 2; ++_h) tk[_h][_i] = S.arow_tok(n2, _h * HALF + _R); } } }
        { const int l_e = lane_id_volatile(), fr_e = l_e & 15, fq_e = l_e >> 4;
          E(acc, cur, wr, wc, fr_e, fq_e, lds); if constexpr (Epi::PROBE2) { asm volatile("" ::: "memory"); const Epi E2 = E.probe_copy(); E2(acc, cur, wr, wc, fr_e, fq_e, lds); } }
        if (!has_next) break;
#pragma unroll
        for (int a = 0; a < 2; ++a)
#pragma unroll
            for (int b = 0; b < 2; ++b)
#pragma unroll
                for (int m = 0; m < 4; ++m)
#pragma unroll
                    for (int n = 0; n < 2; ++n) acc[a][b][m][n] = (f32x4){0.f, 0.f, 0.f, 0.f};
        cur = nxt; cA = nA; cB = nB; ++ui;
        if (Sched::GATHER) {
#pragma unroll
            for (int h = 0; h < 2; ++h) { oa[h][0] = on[h][0]; if (has2) on[h][0] = tk[h][0] | (tk[h][1] << 16); } }
        nxt = n2; has_next = has2;
        if (wr == 1) G8_BAR;
    }
    G8_WAIT_V(0);
    G8_BAR;
#undef G8_SA
#undef G8_SB
#undef G8_STAGE_A
#undef G8_STAGE_B
#undef G8_LDA
#undef G8_LDB
#undef G8_MMA
#undef G8_MMA8
#undef G8_MM
#undef G8_LA
#undef G8_LB
#undef G8_LDA8
#undef G8_LDB8
#undef G8_RD16
#undef G8_WAIT_V
#undef G8_WAIT_L
#undef G8_BAR
#undef G8_SCHED
#undef G8_SETOFF
#undef G8_GOFF0
#undef G8_GOFF1
#undef G8_STAGE_AH
}
}
using g8::Unit;
using g8::lane_id_volatile;

#define EPI_PROBE_COPY(T) __device__ __forceinline__ T probe_copy() const { return *this; }
#define EPI_ROWS(ai, m) _Pragma("unroll") for (int ai = 0; ai < 2; ++ai) _Pragma("unroll") for (int m = 0; m < 4; ++m)
__device__ __forceinline__ u32x4 pack8(const f32x4 a, const f32x4 b) { u32x4 w; w.x = cvt_pk_bf16(a[0], a[1]); w.y = cvt_pk_bf16(a[2], a[3]); w.z = cvt_pk_bf16(b[0], b[1]); w.w = cvt_pk_bf16(b[2], b[3]); return w; }
__device__ __forceinline__ float sq8(const f32x4 a, const f32x4 b) { return (a[0] * a[0] + a[1] * a[1]) + (a[2] * a[2] + a[3] * a[3]) + (b[0] * b[0] + b[1] * b[1]) + (b[2] * b[2] + b[3] * b[3]); }
__device__ __forceinline__ void row_atomic(float* p, float s, int fq) { s += __shfl_xor(s, 16); s += __shfl_xor(s, 32); if (fq == 0) atomicAdd(p, s); }

template <bool F8> struct SchedDenseT {
    static constexpr bool GATHER = false, FP8 = F8;
    const char* A; const char* B; unsigned lda2, ldb2; int K, nM, nN, G, c;
    __device__ __forceinline__ bool next(int i, Unit& u) const {
        int pm, pn; if (!g8::tile_order(i, G, c, nM, nN, pm, pn)) return false;
        u.pm = pm; u.pn = pn; u.A = A + (size_t)pm * 256 * lda2; u.B = B + (size_t)pn * 256 * ldb2; u.e = 0; u.aux = 0; u.valid = 256; u.job = 0; return true;
    }
    __device__ __forceinline__ unsigned arow_tok(const Unit&, int) const { return 0u; }
};
typedef SchedDenseT<false> SchedDense;
struct SchedP1 {
    static constexpr bool GATHER = false, FP8 = false;
    const char *xb, *win, *memn, *wk, *wv; unsigned lda2, ldb2; int K, G, c;
    __device__ __forceinline__ bool next(int i, Unit& u) const {
        const int L = i * G + c;
        u.e = 0; u.aux = 0; u.valid = 256;
        if (L < 1024) { int pm, pn; g8::tile_order(i, G, c, 128, 8, pm, pn); u.pm = pm; u.pn = pn; u.job = 0; u.A = xb + (size_t)pm * 256 * 2048; u.B = win + (size_t)pn * 256 * 2048; return true; }
        const int r = L - 1024;
        if (r < 32) { u.pm = r >> 2; u.pn = r & 3; u.job = 1; u.A = memn + (size_t)u.pm * 256 * 2048; u.B = wk + (size_t)u.pn * 256 * 2048; return true; }
        if (r < 64) { const int q = r - 32; u.pm = q >> 3; u.pn = q & 7; u.job = 2; u.A = wv + (size_t)u.pm * 256 * 2048; u.B = memn + (size_t)u.pn * 256 * 2048; return true; }
        return false;
    }
    __device__ __forceinline__ unsigned arow_tok(const Unit&, int) const { return 0u; }
};
struct SchedQ {
    static constexpr bool GATHER = false, FP8 = true;
    const char *A, *B; unsigned lda2, ldb2; int K, G, c;
    __device__ __forceinline__ bool next(int i, Unit& u) const {
        const int p = c + i * G; if (p >= BATCH * 4 * 16) return false;
        const int b = p >> 6, h = (p >> 4) & 3, qb = p & 15;
        u.pm = b * 16 + qb; u.pn = h; u.e = 0; u.aux = 0; u.valid = 256; u.job = 0; u.A = A + (size_t)u.pm * 256 * lda2; u.B = B + (size_t)h * 256 * ldb2; return true;
    }
    __device__ __forceinline__ unsigned arow_tok(const Unit&, int) const { return 0u; }
};
struct SchedAttn {
    static constexpr bool GATHER = false, FP8 = true;
    const char *q, *kmat, *vt, *pbuf; unsigned lda2, ldb2; int K, G, c, npair;
    __device__ __forceinline__ void pair_unit(int j, bool isO, Unit& u) const {
        const int p = c + j * G; const int b = p >> 6, h = (p >> 4) & 3, qb = p & 15;
        u.pm = b * 16 + qb; u.pn = h; u.e = j & 1; u.aux = 0; u.valid = 256; u.job = isO ? 1 : 0;
        if (!isO) { u.A = q + ((size_t)((b * 4 + h) * SEQ + qb * 256)) * 256; u.B = kmat + ((size_t)((b * 4 + h) * 256)) * 256; }
        else      { u.A = pbuf + ((size_t)(c * 2 + (j & 1))) * 256 * 256; u.B = vt + ((size_t)((b * 4 + h) * 256)) * 256; }
    }
    __device__ __forceinline__ bool next(int i, Unit& u) const {
        const int n = npair; if (i >= 2 * n) return false;
        if (i == 0) { pair_unit(0, false, u); return true; }
        const int k = (i - 1) >> 1;
        if (i & 1) { if (k + 1 < n) pair_unit(k + 1, false, u); else pair_unit(n - 1, true, u); }
        else pair_unit(k, true, u);
        return true;
    }
    __device__ __forceinline__ unsigned arow_tok(const Unit&, int) const { return 0u; }
};
struct SchedMoe {
    static constexpr bool GATHER_ = true;
    const LAS int* tb; const LAS int* cnt; const int* tl; const char* A; const char* B; unsigned lda2, ldb2; int K, nN, G, c; size_t bstride; bool gather;
};
template <bool GATH> struct SchedMoeT : SchedMoe {
    static constexpr bool GATHER = GATH, FP8 = true;
    __device__ __forceinline__ bool next(int i, Unit& u) const {
        const int nM = __builtin_amdgcn_readfirstlane(tb[NEXP]); int pm, pn; if (!g8::tile_order(i, G, c, nM, nN, pm, pn)) return false;
        int e = 0;
#pragma unroll
        for (int s = 16; s >= 1; s >>= 1) if (__builtin_amdgcn_readfirstlane(tb[e + s]) <= pm) e += s;
        u.pm = pm; u.pn = pn; u.e = e; u.aux = (pm - __builtin_amdgcn_readfirstlane(tb[e])) * 256; const int v = __builtin_amdgcn_readfirstlane(cnt[e]) - u.aux; u.valid = v < 256 ? v : 256; u.job = 0;
        u.A = GATH ? A : A + (size_t)pm * 256 * lda2; u.B = B + (size_t)e * bstride + (size_t)pn * 256 * ldb2; return true;
    }
    __device__ __forceinline__ unsigned arow_tok(const Unit& u, int r) const {
        return (unsigned)((r < u.valid) ? (tl[(size_t)u.e * ECAP + u.aux + r] >> 2) : 0);
    }
};

struct EpiP1 {
    static constexpr bool MID = false; static constexpr bool PROBE2 = false; EPI_PROBE_COPY(EpiP1)
    const float* rstd1; bf16_t *proj, *ug, *kmat, *vt;
    __device__ __forceinline__ void mid(f32x4 (&)[2][2][4][2], const Unit&, int, int, int) const {}
    __device__ __forceinline__ void operator()(const f32x4 (&acc)[2][2][4][2], const Unit& u, int wr, int wc, int fr, int fq, LAS unsigned char*) const {
        const int col0 = u.pn * 256 + wc * 64 + 16 * fq;
        float rs[2][4];
        EPI_ROWS(ai, m) rs[ai][m] = (u.job == 0) ? rstd1[u.pm * 256 + ai * 128 + wr * 64 + m * 16 + fr] : 1.0f;
        EPI_ROWS(ai, m) {
            const int row = u.pm * 256 + ai * 128 + wr * 64 + m * 16 + fr;
            const float sc = rs[ai][m];
#pragma unroll
            for (int bj = 0; bj < 2; ++bj) {
                const int col = col0 + bj * 8;
                if (u.job == 0) { const u32x4 w = pack8(acc[ai][bj][m][0] * sc, acc[ai][bj][m][1] * sc); bf16_t* dst;
                    if (u.pn < 6) dst = proj + (size_t)row * 1536 + col; else { const int cc = col - 1536; dst = ug + ((size_t)((row >> 12) * 32 + (cc >> 4)) * SEQ + (row & 4095)) * 16 + (cc & 15); }
                    *(u32x4*)dst = w; }
                else { const f32x4 a0 = acc[ai][bj][m][0] * K8S, a1 = acc[ai][bj][m][1] * K8S;
                    unsigned char* dst = (u.job == 1) ? (unsigned char*)kmat + ((size_t)((u.pm * 4 + u.pn) * 256 + (row & 255))) * 256 + (col & 255)
                                                      : (unsigned char*)vt + ((size_t)((u.pn * 4 + u.pm) * 256 + (row & 255))) * 256 + (col & 255);
                    *(u32x2*)dst = (u32x2){pk4_fp8(clamp448(a0[0]), clamp448(a0[1]), clamp448(a0[2]), clamp448(a0[3])), pk4_fp8(clamp448(a1[0]), clamp448(a1[1]), clamp448(a1[2]), clamp448(a1[3]))}; }
            }
        }
    }
};
struct EpiGlu {
    static constexpr bool MID = false; static constexpr bool PROBE2 = false; EPI_PROBE_COPY(EpiGlu)
    const bf16_t* ygelu; bf16_t* ycat; float* ssqs;
    __device__ __forceinline__ void mid(f32x4 (&)[2][2][4][2], const Unit&, int, int, int) const {}
    __device__ __forceinline__ void operator()(const f32x4 (&acc)[2][2][4][2], const Unit& u, int wr, int wc, int fr, int fq, LAS unsigned char*) const {
        const int col0 = u.pn * 256 + wc * 64 + 16 * fq;
#pragma unroll
        for (int ai = 0; ai < 2; ++ai) {
            u32x4 aw[4][2];
#pragma unroll
            for (int m = 0; m < 4; ++m)
#pragma unroll
                for (int bj = 0; bj < 2; ++bj) aw[m][bj] = *(const u32x4*)(ygelu + (size_t)(u.pm * 256 + ai * 128 + wr * 64 + m * 16 + fr) * 512 + col0 + bj * 8);
#pragma unroll
            for (int m = 0; m < 4; ++m) {
                const int row = u.pm * 256 + ai * 128 + wr * 64 + m * 16 + fr; float ss = 0.f;
#pragma unroll
                for (int bj = 0; bj < 2; ++bj) {
                    const u32x4 a = aw[m][bj];
                    f32x4 z0, z1; const f32x4 g0 = acc[ai][bj][m][0], g1 = acc[ai][bj][m][1];
                    { const f32x2 s0 = sigmoid2((f32x2){g0[0], g0[1]}) * (f32x2){bflo(a.x), bfhi(a.x)}, s1 = sigmoid2((f32x2){g0[2], g0[3]}) * (f32x2){bflo(a.y), bfhi(a.y)};
                      const f32x2 s2 = sigmoid2((f32x2){g1[0], g1[1]}) * (f32x2){bflo(a.z), bfhi(a.z)}, s3 = sigmoid2((f32x2){g1[2], g1[3]}) * (f32x2){bflo(a.w), bfhi(a.w)};
                      z0 = (f32x4){s0[0], s0[1], s1[0], s1[1]}; z1 = (f32x4){s2[0], s2[1], s3[0], s3[1]}; }
                    ss += sq8(z0, z1);
                    *(u32x4*)(ycat + (size_t)row * 1024 + col0 + bj * 8) = pack8(z0, z1);
                }
                row_atomic(ssqs + row, ss, fq);
            }
            asm volatile("" ::: "memory");
        }
    }
};
struct EpiRes {
    static constexpr bool MID = true; static constexpr bool PROBE2 = (PROBE_EPI == 4); __device__ __forceinline__ EpiRes probe_copy() const { EpiRes e = *this; e.ssq = ssq + 3 * NTOK; e.skip = (midt < 0); return e; }
    const bf16_t* xsrc; bf16_t* xh; unsigned char* x8; float* ssq; const float* ssqs; int midt; float accs; bool skip = false;
    __device__ __forceinline__ void mid(f32x4 (&acc)[2][2][4][2], const Unit& u, int t, int wr, int fr) const {
        if (t != midt) return;
        EPI_ROWS(ai, m) {
            const int row = u.pm * 256 + ai * 128 + wr * 64 + m * 16 + fr;
            const float sc = rsqrtf(ssqs[row] * (1.0f / 512.0f) + EPS);
#pragma unroll
            for (int bj = 0; bj < 2; ++bj)
#pragma unroll
                for (int n = 0; n < 2; ++n) acc[ai][bj][m][n] *= sc;
        }
    }
    __device__ __forceinline__ void operator()(const f32x4 (&acc)[2][2][4][2], const Unit& u, int wr, int wc, int fr, int fq, LAS unsigned char*) const {
        if (skip) return;
        const int col0 = u.pn * 256 + wc * 64 + 16 * fq;
#pragma unroll
        for (int ai = 0; ai < 2; ++ai) {
            u32x4 rw[4][2];
#pragma unroll
            for (int m = 0; m < 4; ++m)
#pragma unroll
                for (int bj = 0; bj < 2; ++bj) rw[m][bj] = *(const u32x4*)(xsrc + (size_t)(u.pm * 256 + ai * 128 + wr * 64 + m * 16 + fr) * 1024 + col0 + bj * 8);
#pragma unroll
            for (int m = 0; m < 4; ++m) {
                const int row = u.pm * 256 + ai * 128 + wr * 64 + m * 16 + fr; float ss = 0.f;
#pragma unroll
                for (int bj = 0; bj < 2; ++bj) {
                    const size_t off = (size_t)row * 1024 + col0 + bj * 8; const u32x4 w = rw[m][bj];
                    const f32x4 r0 = (f32x4){bflo(w.x), bfhi(w.x), bflo(w.y), bfhi(w.y)}, r1 = (f32x4){bflo(w.z), bfhi(w.z), bflo(w.w), bfhi(w.w)};
                    const f32x4 v0 = r0 + acc[ai][bj][m][0] * accs, v1 = r1 + acc[ai][bj][m][1] * accs;
                    ss += sq8(v0, v1);
                    *(u32x4*)(xh + off) = pack8(v0, v1);
                    *(u32x2*)(x8 + off) = (u32x2){pk4_fp8(clamp448(v0[0] * X8S), clamp448(v0[1] * X8S), clamp448(v0[2] * X8S), clamp448(v0[3] * X8S)), pk4_fp8(clamp448(v1[0] * X8S), clamp448(v1[1] * X8S), clamp448(v1[2] * X8S), clamp448(v1[3] * X8S))};
                }
                row_atomic(ssq + row, ss, fq);
            }
            asm volatile("" ::: "memory");
        }
    }
};
struct EpiQ {
    static constexpr bool MID = false; static constexpr bool PROBE2 = false; EPI_PROBE_COPY(EpiQ)
    const float* ssq2; bf16_t* q;
    __device__ __forceinline__ void mid(f32x4 (&)[2][2][4][2], const Unit&, int, int, int) const {}
    __device__ __forceinline__ void operator()(const f32x4 (&acc)[2][2][4][2], const Unit& u, int wr, int wc, int fr, int fq, LAS unsigned char*) const {
        const int col0 = u.pn * 256 + wc * 64 + 16 * fq;
        float sq[2][4];
        EPI_ROWS(ai, m) sq[ai][m] = ssq2[u.pm * 256 + ai * 128 + wr * 64 + m * 16 + fr];
        EPI_ROWS(ai, m) {
            const int row = u.pm * 256 + ai * 128 + wr * 64 + m * 16 + fr;
            const float sc = rsqrtf(sq[ai][m] * (1.0f / 1024.0f) + EPS) * (1.4426950408889634f / 16.0f) * (1.0f / (X8S * W8S));
#pragma unroll
            for (int bj = 0; bj < 2; ++bj) { const f32x4 a0 = acc[ai][bj][m][0] * (sc * Q8S), a1 = acc[ai][bj][m][1] * (sc * Q8S);
                *(u32x2*)((unsigned char*)q + ((size_t)(((row >> 12) * 4 + u.pn) * SEQ + (row & 4095))) * 256 + (col0 & 255) + bj * 8) = (u32x2){pk4_fp8(clamp448(a0[0]), clamp448(a0[1]), clamp448(a0[2]), clamp448(a0[3])), pk4_fp8(clamp448(a1[0]), clamp448(a1[1]), clamp448(a1[2]), clamp448(a1[3]))}; }
        }
    }
};
struct EpiAttn {
    static constexpr bool MID = false; static constexpr bool PROBE2 = false; EPI_PROBE_COPY(EpiAttn)
    bf16_t* pbuf; bf16_t* o; int c;
    __device__ __forceinline__ void mid(f32x4 (&)[2][2][4][2], const Unit&, int, int, int) const {}
    __device__ __forceinline__ void operator()(const f32x4 (&acc)[2][2][4][2], const Unit& u, int wr, int wc, int fr, int fq, LAS unsigned char* lds) const {
        LAS float* pmax = (LAS float*)(lds + XL_OFF + XL_PMAX);
        LAS float* psum = (LAS float*)(lds + XL_OFF + XL_PSUM) + u.e * 1024;
        if (u.job == 0) {
            EPI_ROWS(ai, m) {
                const int r = ai * 128 + wr * 64 + m * 16 + fr; float mx = -3.0e38f;
#pragma unroll
                for (int bj = 0; bj < 2; ++bj)
#pragma unroll
                    for (int n = 0; n < 2; ++n)
#pragma unroll
                        for (int i = 0; i < 4; ++i) mx = fmaxf(mx, acc[ai][bj][m][n][i]);
                mx = fmaxf(mx, __shfl_xor(mx, 16)); mx = fmaxf(mx, __shfl_xor(mx, 32));
                if (fq == 0) pmax[r * 4 + wc] = mx;
            }
            asm volatile("s_waitcnt lgkmcnt(0)" ::: "memory"); __builtin_amdgcn_s_barrier(); asm volatile("" ::: "memory");
            bf16_t* P = (bf16_t*)((unsigned char*)pbuf + (size_t)(c * 2 + u.e) * 256 * 256);
            EPI_ROWS(ai, m) {
                const int r = ai * 128 + wr * 64 + m * 16 + fr;
                const f32x4 pm4 = *(const LAS f32x4*)(pmax + r * 4);
                const float mx = fmaxf(fmaxf(pm4[0], pm4[1]), fmaxf(pm4[2], pm4[3])); float ss = 0.f;
#pragma unroll
                for (int bj = 0; bj < 2; ++bj) {
                    f32x4 p0, p1;
#pragma unroll
                    for (int i = 0; i < 4; ++i) { p0[i] = __builtin_amdgcn_exp2f((acc[ai][bj][m][0][i] - mx) * (1.0f / (Q8S * K8S))); p1[i] = __builtin_amdgcn_exp2f((acc[ai][bj][m][1][i] - mx) * (1.0f / (Q8S * K8S))); }
                    ss += (p0[0] + p0[1]) + (p0[2] + p0[3]) + (p1[0] + p1[1]) + (p1[2] + p1[3]);
                    *(u32x2*)((unsigned char*)P + (size_t)r * 256 + wc * 64 + 16 * fq + bj * 8) = (u32x2){pk4_fp8(p0[0] * P8S, p0[1] * P8S, p0[2] * P8S, p0[3] * P8S), pk4_fp8(p1[0] * P8S, p1[1] * P8S, p1[2] * P8S, p1[3] * P8S)};
                }
                ss += __shfl_xor(ss, 16); ss += __shfl_xor(ss, 32);
                if (fq == 0) psum[r * 4 + wc] = ss;
                asm volatile("" ::: "memory");
            }
            asm volatile("s_waitcnt vmcnt(0) lgkmcnt(0)" ::: "memory"); __builtin_amdgcn_s_barrier(); asm volatile("" ::: "memory");
        } else {
            const int b = u.pm >> 4, qb = u.pm & 15, h = u.pn;
            EPI_ROWS(ai, m) {
                const int r = ai * 128 + wr * 64 + m * 16 + fr;
                const f32x4 ps = *(const LAS f32x4*)(psum + r * 4);
                const float inv = (O8S / (P8S * K8S)) / ((ps[0] + ps[1]) + (ps[2] + ps[3]));
                unsigned char* dst = (unsigned char*)o + (size_t)(b * SEQ + qb * 256 + r) * 1024 + h * 256 + wc * 64 + 16 * fq;
#pragma unroll
                for (int bj = 0; bj < 2; ++bj) { const f32x4 a0 = acc[ai][bj][m][0] * inv, a1 = acc[ai][bj][m][1] * inv;
                    *(u32x2*)(dst + bj * 8) = (u32x2){pk4_fp8(clamp448(a0[0]), clamp448(a0[1]), clamp448(a0[2]), clamp448(a0[3])), pk4_fp8(clamp448(a1[0]), clamp448(a1[1]), clamp448(a1[2]), clamp448(a1[3]))}; }
            }
        }
    }
};
struct EpiMoe1 {
    static constexpr bool MID = false; static constexpr bool PROBE2 = (PROBE_EPI == 9); EPI_PROBE_COPY(EpiMoe1)
    const float* rstdl; const float* bgu; bf16_t* act;
    __device__ __forceinline__ void mid(f32x4 (&)[2][2][4][2], const Unit&, int, int, int) const {}
    __device__ __forceinline__ void operator()(const f32x4 (&acc)[2][2][4][2], const Unit& u, int wr, int wc, int fr, int fq, LAS unsigned char*) const {
        const int cj = u.pn * 128 + wc * 32 + 8 * fq;
        const float* bg = bgu + (size_t)u.e * 2048 + cj;
        float rs[2][4];
        EPI_ROWS(ai, m) { const int r = ai * 128 + wr * 64 + m * 16 + fr; rs[ai][m] = rstdl[(size_t)u.e * ECAP + u.aux + (r < u.valid ? r : 0)]; }
        const f32x4 bgv[2] = {*(const f32x4*)bg, *(const f32x4*)(bg + 4)}, blv[2] = {*(const f32x4*)(bg + 1024), *(const f32x4*)(bg + 1028)};
        EPI_ROWS(ai, m) {
            const int r = ai * 128 + wr * 64 + m * 16 + fr; const float sc = rs[ai][m] * (1.0f / (X8S * W8S));
            unsigned w[2];
#pragma unroll
            for (int n = 0; n < 2; ++n) { f32x2 o2[2];
#pragma unroll
                for (int h = 0; h < 2; ++h) {
                    const f32x2 ag = {acc[ai][0][m][n][2 * h], acc[ai][0][m][n][2 * h + 1]}, al = {acc[ai][1][m][n][2 * h], acc[ai][1][m][n][2 * h + 1]};
                    const f32x2 bg2 = {bgv[n][2 * h], bgv[n][2 * h + 1]}, bl2 = {blv[n][2 * h], blv[n][2 * h + 1]};
                    f32x2 g = ag * sc + bg2, l = al * sc + bl2;
                    g[0] = fminf(g[0], 7.0f); g[1] = fminf(g[1], 7.0f);
                    l[0] = __builtin_amdgcn_fmed3f(l[0], -7.0f, 7.0f); l[1] = __builtin_amdgcn_fmed3f(l[1], -7.0f, 7.0f);
                    f32x2 e = g * (-1.702f * 1.4426950408889634f);
                    e[0] = __builtin_amdgcn_exp2f(e[0]); e[1] = __builtin_amdgcn_exp2f(e[1]);
                    f32x2 d = e + 1.0f;
                    d[0] = __builtin_amdgcn_rcpf(d[0]); d[1] = __builtin_amdgcn_rcpf(d[1]);
                    o2[h] = (g * d) * (l * A8S + A8S);
                }
                w[n] = pk4_fp8(o2[0][0], o2[0][1], o2[1][0], o2[1][1]); }
            *(u32x2*)((unsigned char*)act + (size_t)(u.pm * 256 + r) * 1024 + cj) = (u32x2){w[0], w[1]};
        }
    }
};
struct EpiMoe2 {
    static constexpr bool MID = false; static constexpr bool PROBE2 = (PROBE_EPI == 10); EPI_PROBE_COPY(EpiMoe2)
    const int* tokl; const float* gatel; const float* bdn; bf16_t* slots;
    __device__ __forceinline__ void mid(f32x4 (&)[2][2][4][2], const Unit&, int, int, int) const {}
    __device__ __forceinline__ void operator()(const f32x4 (&acc)[2][2][4][2], const Unit& u, int wr, int wc, int fr, int fq, LAS unsigned char*) const {
        const int col0 = u.pn * 256 + wc * 64 + 16 * fq;
        const float* bp = bdn + (size_t)u.e * 1024 + col0;
        int sl[2][4]; float gt[2][4];
        EPI_ROWS(ai, m) { const int r = ai * 128 + wr * 64 + m * 16 + fr; const size_t idx = (size_t)u.e * ECAP + u.aux + (r < u.valid ? r : 0); sl[ai][m] = tokl[idx]; gt[ai][m] = gatel[idx]; }
        f32x4 bv[2][2];
#pragma unroll
        for (int bj = 0; bj < 2; ++bj) { bv[bj][0] = *(const f32x4*)(bp + bj * 8); bv[bj][1] = *(const f32x4*)(bp + bj * 8 + 4); }
        EPI_ROWS(ai, m) {
            const int r = ai * 128 + wr * 64 + m * 16 + fr;
            if (r < u.valid) {
                const int slot = sl[ai][m]; const float g = gt[ai][m];
#pragma unroll
                for (int bj = 0; bj < 2; ++bj) { const float gs = g * S8S; const f32x4 o0 = (acc[ai][bj][m][0] * (1.0f / (A8S * W8S)) + bv[bj][0]) * gs, o1 = (acc[ai][bj][m][1] * (1.0f / (A8S * W8S)) + bv[bj][1]) * gs;
                    *(u32x2*)((unsigned char*)slots + (size_t)slot * 1024 + col0 + bj * 8) = (u32x2){pk4_fp8(clamp448(o0[0]), clamp448(o0[1]), clamp448(o0[2]), clamp448(o0[3])), pk4_fp8(clamp448(o1[0]), clamp448(o1[1]), clamp448(o1[2]), clamp448(o1[3]))}; }
            }
        }
    }
};

#define XB_TMO      128
#define XB_XCNT(j)  (256  + 64 * (j))
#define XB_XSUB(j)  (1280 + 64 * (j))
#define XB_XGEN(j)  (2304 + 64 * (j))
#define XB_TOP      3328
#define XB_TOPGEN   3392
#define XCD_BAR_WORDS 3456
#define XB_SPIN_CAP (1u << 20)
__device__ __forceinline__ unsigned xb_ld(unsigned* p)              { return __hip_atomic_load(p, __ATOMIC_RELAXED, __HIP_MEMORY_SCOPE_AGENT); }
__device__ __forceinline__ unsigned xb_add(unsigned* p, unsigned v) { return __hip_atomic_fetch_add(p, v, __ATOMIC_RELAXED, __HIP_MEMORY_SCOPE_AGENT); }
__device__ __forceinline__ unsigned xb_xcc_id() { return (unsigned)__builtin_amdgcn_s_getreg((3 << 11) | 20) & 0xFu; }
#define XB_SPIN(cond, bar) do { unsigned _sp = 0; while (cond) { __builtin_amdgcn_s_sleep(1); \
    if ((++_sp & 255u) == 0u) { if (xb_ld(&(bar)[XB_TMO])) break; if (_sp > XB_SPIN_CAP) { atomicAdd(&(bar)[XB_TMO], 1u); break; } } } } while (0)
struct XcdBarrier { unsigned* bar; unsigned x; volatile LAS unsigned* st; };
__device__ __forceinline__ XcdBarrier xcd_barrier_post(unsigned* bar, volatile LAS unsigned* st) {
    XcdBarrier b; b.bar = bar; b.x = xb_xcc_id(); b.st = st;
    if (threadIdx.x == 0) (void)xb_add(&bar[XB_XCNT(b.x)], 1u);
    return b;
}
__device__ __forceinline__ void xcd_barrier_complete(unsigned* bar, unsigned x, unsigned& nloc, unsigned& nx) {
    const unsigned G = gridDim.x * gridDim.y * gridDim.z;
    unsigned sum, cnt, mine, sp = 0u;
    for (;;) {
        sum = 0u; cnt = 0u; mine = 0u;
#pragma unroll
        for (unsigned j = 0; j < 16; ++j) { const unsigned c = xb_ld(&bar[XB_XCNT(j)]); sum += c; cnt += (c > 0u) ? 1u : 0u; mine = (j == x) ? c : mine; }
        if (sum == G) break;
        __builtin_amdgcn_s_sleep(1);
        if ((++sp & 255u) == 0u) { if (xb_ld(&bar[XB_TMO])) break; if (sp > XB_SPIN_CAP) { atomicAdd(&bar[XB_TMO], 1u); break; } }
    }
    nloc = mine > 0u ? mine : 1u; nx = cnt > 0u ? cnt : 1u;
}
__device__ __forceinline__ void xcd_barrier(const XcdBarrier& b) {
    asm volatile("s_waitcnt vmcnt(0)" ::: "memory");
    __syncthreads();
    if (threadIdx.x == 0) {
        unsigned* bar = b.bar;
        __builtin_amdgcn_s_waitcnt(0);
        unsigned nloc = b.st[0], nx = b.st[1];
        if (nloc == 0u) { xcd_barrier_complete(bar, b.x, nloc, nx); b.st[0] = nloc; b.st[1] = nx; }
        const unsigned old = xb_add(&bar[XB_XSUB(b.x)], 1u);
        const unsigned gen = old / nloc;
        if (old + 1u == (gen + 1u) * nloc) {
            __builtin_amdgcn_fence(__ATOMIC_RELEASE, "agent");
            asm volatile("s_waitcnt vmcnt(0)" ::: "memory");
            const unsigned og = xb_add(&bar[XB_TOP], 1u);
            const unsigned tg = og / nx;
            if (og + 1u == (tg + 1u) * nx) xb_add(&bar[XB_TOPGEN], 1u);
            else XB_SPIN(xb_ld(&bar[XB_TOPGEN]) == tg, bar);
            __builtin_amdgcn_fence(__ATOMIC_ACQUIRE, "agent");
            xb_add(&bar[XB_XGEN(b.x)], 1u);
            asm volatile("s_waitcnt vmcnt(0)" ::: "memory");
        } else {
            XB_SPIN(xb_ld(&bar[XB_XGEN(b.x)]) == gen, bar);
            __builtin_amdgcn_fence(__ATOMIC_ACQUIRE, "agent");
            asm volatile("s_waitcnt vmcnt(0)" ::: "memory");
        }
    }
    __syncthreads();
}

struct Args { const float* in[30]; float* out; unsigned char* ws; int ph_lo, ph_hi; };
enum { I_X = 0, I_MEM, I_NMIX, I_WIN, I_CONVW, I_ARE, I_AIM, I_LOGDT, I_BRE, I_BIM, I_CRE, I_CIM, I_D, I_WGLU, I_NCO, I_NSO, I_WOUT, I_NX, I_NM, I_WQ, I_WKV, I_WO, I_NMOE, I_WR, I_BR, I_WGU, I_BGU, I_WDN, I_BDN, I_NF };

struct CvItem { const float* W; const float* scale; unsigned char* WT; int ldw, k0, n0, ldt, drow0, dk0, f8, rmap; };
__device__ __forceinline__ void cv_load(const CvItem& c, float (&v)[64], int lane) {
    const float* src = c.W + (size_t)c.k0 * c.ldw + c.n0 + lane;
#pragma unroll
    for (int i = 0; i < 64; ++i) v[i] = __builtin_nontemporal_load(src + (size_t)i * c.ldw);
}
__device__ __forceinline__ void cv_store(const CvItem& c, float (&v)[64], int lane, LAS unsigned char* scr) {
    if (c.scale) {
#pragma unroll
        for (int i = 0; i < 64; ++i) v[i] *= c.scale[c.k0 + i];
    }
    if (c.f8) {
#pragma unroll
        for (int q = 0; q < 4; ++q) { u32x4 o; o.x = pk4_fp8(v[16 * q] * W8S, v[16 * q + 1] * W8S, v[16 * q + 2] * W8S, v[16 * q + 3] * W8S); o.y = pk4_fp8(v[16 * q + 4] * W8S, v[16 * q + 5] * W8S, v[16 * q + 6] * W8S, v[16 * q + 7] * W8S);
            o.z = pk4_fp8(v[16 * q + 8] * W8S, v[16 * q + 9] * W8S, v[16 * q + 10] * W8S, v[16 * q + 11] * W8S); o.w = pk4_fp8(v[16 * q + 12] * W8S, v[16 * q + 13] * W8S, v[16 * q + 14] * W8S, v[16 * q + 15] * W8S);
            *(LAS u32x4*)(scr + lane * 80 + 16 * q) = o; }
        asm volatile("s_waitcnt lgkmcnt(0)" ::: "memory");
#pragma unroll
        for (int j = 0; j < 4; ++j) { const int row = 16 * j + (lane >> 2), ch = lane & 3; const u32x4 o = *(const LAS u32x4*)(scr + row * 80 + 16 * ch);
            const int drow = c.drow0 + (c.rmap ? 16 * (row >> 3) + (row & 7) : row);
            *(u32x4*)(c.WT + (size_t)drow * c.ldt + c.dk0 + 16 * ch) = o; }
    } else {
#pragma unroll
        for (int q = 0; q < 8; ++q) { u32x4 o; o.x = pk2(v[8 * q], v[8 * q + 1]); o.y = pk2(v[8 * q + 2], v[8 * q + 3]); o.z = pk2(v[8 * q + 4], v[8 * q + 5]); o.w = pk2(v[8 * q + 6], v[8 * q + 7]);
            *(LAS u32x4*)(scr + lane * 144 + 16 * q) = o; }
        asm volatile("s_waitcnt lgkmcnt(0)" ::: "memory");
#pragma unroll
        for (int j = 0; j < 8; ++j) { const int row = 8 * j + (lane >> 3), ch = lane & 7; const u32x4 o = *(const LAS u32x4*)(scr + row * 144 + 16 * ch);
            *(u32x4*)(c.WT + (size_t)(c.drow0 + row) * c.ldt + c.dk0 + 16 * ch) = o; }
    }
    asm volatile("s_waitcnt lgkmcnt(0)" ::: "memory");
}

__global__ void __launch_bounds__(NTHREADS, 2) mk_fwd(Args args) {
    extern __shared__ __attribute__((aligned(16))) unsigned char lds_raw[];
    LAS unsigned char* lds = (LAS unsigned char*)lds_raw;
    cg::grid_group grid = cg::this_grid();
    const int wave = __builtin_amdgcn_readfirstlane(threadIdx.x >> 6);
#define PH_IDS const int lane = lane_id_volatile(), tid = wave * 64 + lane; (void)lane; (void)tid
    const int G = gridDim.x, bx = blockIdx.x;
#define vcu ((G % 8 == 0) ? (bx % 8) * (G / 8) + bx / 8 : bx)
    unsigned char* const ws = args.ws;
#define PH_WS __attribute__((address_space(1))) unsigned char* ws_ = (__attribute__((address_space(1))) unsigned char*)args.ws; asm volatile("" : "+s"(ws_)); unsigned char* const ws = (unsigned char*)ws_
    const int lo = MK_PER_PHASE ? args.ph_lo : 0, hi = MK_PER_PHASE ? args.ph_hi : 12;
#ifndef PH_MASK
#define PH_MASK 0xfff
#endif
#define IN(k) (((PH_MASK >> (k)) & 1) && lo <= (k) && (k) < hi)
#if MK_USE_CG
#define SEAM(k) do { if (IN(k) && IN((k) + 1)) grid.sync(); STAMP(k); } while (0)
#else
#define SEAM(k) do { if (IN(k) && IN((k) + 1)) { XcdBarrier xb_; xb_.bar = (unsigned*)(ws + WS_BAR); xb_.x = xb_xcc_id(); xb_.st = (volatile LAS unsigned*)(lds + XL_OFF + XL_MISC); xcd_barrier(xb_); } STAMP(k); } while (0)
#endif
#if PROBE_PHASE >= 0 || PROBE_A >= 0
    unsigned long long* stamps = (unsigned long long*)(ws + WS_STAMP);
#define STAMP(k) do { if (bx == 0 && threadIdx.x == 0) stamps[(k) + 1] = __builtin_amdgcn_s_memrealtime(); } while (0)
    if (bx == 0 && threadIdx.x == 0) stamps[0] = __builtin_amdgcn_s_memrealtime();
#define STAMPX(i) do { if (bx == 0 && threadIdx.x == 0) stamps[(i)] = __builtin_amdgcn_s_memrealtime(); } while (0)
#else
#define STAMP(k) do { } while (0)
#define STAMPX(i) do { } while (0)
#endif
    volatile LAS unsigned* misc = (volatile LAS unsigned*)(lds + XL_OFF + XL_MISC);
    if (threadIdx.x == 0) { misc[0] = 0u; misc[1] = 0u; }
    __syncthreads();
    if (!MK_PER_PHASE && !MK_USE_CG) (void)xcd_barrier_post((unsigned*)(ws + WS_BAR), misc);
#define gw (vcu * NWAVES + wave)
#define NGW (G * NWAVES)
#define counts ((int*)(ws + WS_CNT))
#define rstd1 ((float*)(ws + WS_RSTD1))
#define ssqs ((float*)(ws + WS_SSQS))
#define ssq2 ((float*)(ws + WS_SSQ2))
#define ssq3 ((float*)(ws + WS_SSQ3))
#define gates ((float*)(ws + WS_GATES))
#define gatel ((float*)(ws + WS_GATEL))
#define rstdl ((float*)(ws + WS_RSTDL))
#define wrs ((float*)(ws + WS_WR))
#define tokl ((int*)(ws + WS_TOKL))
#define xb ((bf16_t*)(ws + WS_XB))
#define proj ((bf16_t*)(ws + WS_PROJ))
#define ug ((bf16_t*)(ws + WS_UG))
#define ycat ((bf16_t*)(ws + WS_YCAT))
#define ygelu ((bf16_t*)(ws + WS_YGELU))
#define x8 ((unsigned char*)(ws + WS_X1))
#define xh ((bf16_t*)(ws + WS_XH))
#define qo ((bf16_t*)(ws + WS_QO))
#define pbuf ((bf16_t*)(ws + WS_PBUF))
#define ob ((bf16_t*)(ws + WS_O))
#define act ((bf16_t*)(ws + WS_ACT))
#define slots ((bf16_t*)(ws + WS_SLOTS))
#define memn ((bf16_t*)(ws + WS_MEMN))
#define kmat ((bf16_t*)(ws + WS_KMAT))
#define vt ((bf16_t*)(ws + WS_VT))

    if (IN(0)) {
        PH_WS;
        PH_IDS;
        for (int i = bx * NTHREADS + tid; i < 3 * NTOK; i += G * NTHREADS) ssqs[i] = 0.f;
        if (bx == 0 && tid < NEXP) counts[tid] = 0;
        for (int i = bx * NTHREADS + tid; i < DM * NEXP; i += G * NTHREADS) wrs[i] = args.in[I_WR][i] * args.in[I_NMOE][i >> 5];
        for (int item = bx; item < 256; item += G) {
            const int g = item >> 3, part = item & 7;
            LAS float* Wp = (LAS float*)lds;
            LAS float* Bb = Wp + 65 * 128;
            LAS float* Cc = Bb + 64 * 32;
            const float dt = __expf(args.in[I_LOGDT][g]);
            __syncthreads();
            for (int i = tid; i < 65 * 64; i += NTHREADS) { const int p = i >> 6, j = i & 63; const float ar = args.in[I_ARE][g * 64 + j], aim = args.in[I_AIM][g * 64 + j];
                const float mag = expf((float)p * dt * ar); float sn, cs; sincosf((float)p * dt * aim, &sn, &cs); Wp[i * 2] = mag * cs; Wp[i * 2 + 1] = mag * sn; }
            for (int i = tid; i < 64 * 16; i += NTHREADS) { const int j = i >> 4; const float ar = args.in[I_ARE][g * 64 + j], aim = args.in[I_AIM][g * 64 + j];
                float sn, cs; sincosf(dt * aim, &sn, &cs); const float em1 = expm1f(dt * ar); float sh, ch; sincosf(0.5f * dt * aim, &sh, &ch);
                const float pre = em1 * cs - 2.0f * sh * sh, pim = (em1 + 1.0f) * sn, den = ar * ar + aim * aim;
                const float qre = (pre * ar + pim * aim) / den, qim = (pim * ar - pre * aim) / den;
                const float br = args.in[I_BRE][(size_t)g * 1024 + i], bi = args.in[I_BIM][(size_t)g * 1024 + i];
                Bb[i * 2] = qre * br - qim * bi; Bb[i * 2 + 1] = qre * bi + qim * br; }
            for (int i = tid; i < 16 * 64; i += NTHREADS) { Cc[i * 2] = args.in[I_CRE][(size_t)g * 1024 + i]; Cc[i * 2 + 1] = args.in[I_CIM][(size_t)g * 1024 + i]; }
            __syncthreads();
            unsigned char* tab = ws + WS_SSM + (size_t)g * SSM_STRIDE;
            if (part == 0 && tid < 64) { ((float*)tab)[tid * 2] = Wp[(64 * 64 + tid) * 2]; ((float*)tab)[tid * 2 + 1] = Wp[(64 * 64 + tid) * 2 + 1]; }
            bf16_t* Kt = (bf16_t*)(tab + SSM_KT); bf16_t* Pt = (bf16_t*)(tab + SSM_PT); bf16_t* Qt = (bf16_t*)(tab + SSM_QT);
            {
                const int lag = 8 * part + (tid >> 6), c = (tid >> 2) & 15, cp0 = (tid & 3) * 4; float s0 = 0.f, s1 = 0.f, s2 = 0.f, s3 = 0.f;
#pragma unroll 4
                for (int j = 0; j < 64; ++j) { const f32x2 w = *(const LAS f32x2*)(Wp + (lag * 64 + j) * 2), cc = *(const LAS f32x2*)(Cc + (c * 64 + j) * 2);
                    const float xr = cc[0] * w[0] - cc[1] * w[1], xi = cc[0] * w[1] + cc[1] * w[0];
                    const f32x4 b0 = *(const LAS f32x4*)(Bb + (j * 16 + cp0) * 2), b1 = *(const LAS f32x4*)(Bb + (j * 16 + cp0 + 2) * 2);
                    s0 += xr * b0[0] - xi * b0[1]; s1 += xr * b0[2] - xi * b0[3]; s2 += xr * b1[0] - xi * b1[1]; s3 += xr * b1[2] - xi * b1[3]; }
                *(u32x2*)(Kt + (size_t)lag * 256 + c * 16 + cp0) = (u32x2){pk2(s0, s1), pk2(s2, s3)};
            }
            {
                const int k = 2 * tid, sidx = k >> 4, cp = k & 15;
#pragma unroll 4
                for (int r = 0; r < 16; ++r) { const int n = 16 * part + r, ri = n >> 6, j = n & 63;
                    const f32x2 w = *(const LAS f32x2*)(Wp + ((63 - sidx) * 64 + j) * 2); const f32x4 b = *(const LAS f32x4*)(Bb + (j * 16 + cp) * 2);
                    const float v0 = ri ? (w[0] * b[1] + w[1] * b[0]) : (w[0] * b[0] - w[1] * b[1]), v1 = ri ? (w[0] * b[3] + w[1] * b[2]) : (w[0] * b[2] - w[1] * b[3]);
                    *(unsigned*)(Pt + (size_t)n * 1024 + k) = pk2(v0, v1); }
            }
            {
                const int n = 2 * (tid & 63), ri = n >> 6, j = n & 63;
#pragma unroll 4
                for (int r = 0; r < 16; ++r) { const int tc = 128 * part + (tid >> 6) + 8 * r, t = tc >> 4, c = tc & 15;
                    const f32x4 w = *(const LAS f32x4*)(Wp + ((t + 1) * 64 + j) * 2), cc = *(const LAS f32x4*)(Cc + (c * 64 + j) * 2);
                    const float v0 = ri ? -(cc[0] * w[1] + cc[1] * w[0]) : (cc[0] * w[0] - cc[1] * w[1]), v1 = ri ? -(cc[2] * w[3] + cc[3] * w[2]) : (cc[2] * w[2] - cc[3] * w[3]);
                    *(unsigned*)(Qt + (size_t)tc * 128 + n) = pk2(v0, v1); }
            }
        }
        STAMPX(30);
        for (int m4 = gw * 4; m4 < NTOK + NMEM; m4 += NGW * 4) {
            const bool isx = m4 < NTOK; const int r0 = isx ? m4 : m4 - NTOK;
            const f32x4* xr = (const f32x4*)((isx ? args.in[I_X] : args.in[I_MEM]) + (size_t)r0 * DM) + lane;
            f32x4 v[4][4];
#pragma unroll
            for (int q = 0; q < 4; ++q)
#pragma unroll
                for (int j = 0; j < 4; ++j) v[q][j] = __builtin_nontemporal_load(xr + q * 256 + 64 * j);
#pragma unroll
            for (int q = 0; q < 4; ++q) {
                float ss = 0.f;
#pragma unroll
                for (int j = 0; j < 4; ++j) ss += (v[q][j][0] * v[q][j][0] + v[q][j][1] * v[q][j][1]) + (v[q][j][2] * v[q][j][2] + v[q][j][3] * v[q][j][3]);
                const float rs = rsqrtf(wave_sum(ss) * (1.f / DM) + EPS);
                u32x2* o8 = (u32x2*)((isx ? xb : memn) + (size_t)(r0 + q) * DM) + lane;
                if (isx) { if (lane == 0) rstd1[r0 + q] = rs;
#pragma unroll
                    for (int j = 0; j < 4; ++j) o8[64 * j] = (u32x2){pk2(v[q][j][0], v[q][j][1]), pk2(v[q][j][2], v[q][j][3])}; }
                else {
#pragma unroll
                    for (int j = 0; j < 4; ++j) { const f32x4 g = ((const f32x4*)args.in[I_NM])[lane + 64 * j]; o8[64 * j] = (u32x2){pk2(v[q][j][0] * rs * g[0], v[q][j][1] * rs * g[1]), pk2(v[q][j][2] * rs * g[2], v[q][j][3] * rs * g[3])}; } }
            }
        }
        STAMPX(31);
        {
            constexpr int I_IN = 16 * 32, I_GLU = 8 * 8, I_OUT = 16 * 16, I_Q = 16 * 16, I_KV = 16 * 32, I_O = 16 * 16, I_GU = 32 * 16 * 32, I_DN = 32 * 16 * 16;
            constexpr int NIT = I_IN + I_GLU + I_OUT + I_Q + I_KV + I_O + I_GU + I_DN;
#define CV_DECODE(c, it) do { int r = (it); \
                if (r < I_GU) { const int e = r / 512, q = r % 512, kb = q / 32, nb = q % 32, n0 = nb * 64, j = n0 & 1023, lin = n0 >> 10; \
                    c = CvItem{args.in[I_WGU] + (size_t)e * 1024 * 2048, args.in[I_NMOE], ws + WS_WGU + (size_t)e * 2048 * 1024, 2048, kb * 64, n0, 1024, 256 * (j >> 7) + 8 * lin + 2 * (j & 127), kb * 64, 1, 1}; break; } r -= I_GU; \
                if (r < I_DN) { const int e = r / 256, q = r % 256, kb = q / 16, nb = q % 16; \
                    c = CvItem{args.in[I_WDN] + (size_t)e * 1024 * 1024, nullptr, ws + WS_WDN + (size_t)e * 1024 * 1024, 1024, kb * 64, nb * 64, 1024, nb * 64, kb * 64, 1, 0}; break; } r -= I_DN; \
                if (r < I_IN) { const int kb = r / 32, nb = r % 32; c = CvItem{args.in[I_WIN], args.in[I_NMIX], ws + WS_WIN, 2048, kb * 64, nb * 64, 2048, nb * 64, kb * 128, 0, 0}; break; } r -= I_IN; \
                if (r < I_GLU) { const int kb = r / 8, nb = r % 8; c = CvItem{args.in[I_WGLU], nullptr, ws + WS_WGLU, 512, kb * 64, nb * 64, 1024, nb * 64, kb * 128, 0, 0}; break; } r -= I_GLU; \
                if (r < I_OUT) { const int kb = r / 16, nb = r % 16, k0 = kb * 64;        \
                    c = CvItem{args.in[I_WOUT], (k0 < 512) ? args.in[I_NCO] : args.in[I_NSO] - 512, ws + WS_WOUT, 1024, k0, nb * 64, 2048, nb * 64, ((k0 + 512) & 1023) * 2, 0, 0}; break; } r -= I_OUT; \
                if (r < I_Q) { const int kb = r / 16, nb = r % 16; c = CvItem{args.in[I_WQ], args.in[I_NX], ws + WS_WQ, 1024, kb * 64, nb * 64, 1024, nb * 64, kb * 64, 1, 0}; break; } r -= I_Q; \
                if (r < I_KV) { const int kb = r / 32, nb = r % 32, n0 = nb * 64; c = CvItem{args.in[I_WKV], nullptr, ws + (n0 < 1024 ? WS_WK : WS_WV), 2048, kb * 64, n0, 2048, n0 & 1023, kb * 128, 0, 0}; break; } r -= I_KV; \
                { const int kb = r / 16, nb = r % 16; c = CvItem{args.in[I_WO], nullptr, ws + WS_WO, 1024, kb * 64, nb * 64, 1024, nb * 64, kb * 64, 1, 0}; } } while (0)
            float va[64], vb[64]; CvItem ca, cb;
            __syncthreads();
            LAS unsigned char* cvscr = lds + wave * 10240;
            int it = gw;
            if (it < NIT) { CV_DECODE(ca, it); cv_load(ca, va, lane); }
            while (it < NIT) {
                int it2 = it + NGW;
                if (it2 < NIT) { CV_DECODE(cb, it2); cv_load(cb, vb, lane); }
                cv_store(ca, va, lane, cvscr);
                it = it2; if (it >= NIT) break;
                it2 = it + NGW;
                if (it2 < NIT) { CV_DECODE(ca, it2); cv_load(ca, va, lane); }
                cv_store(cb, vb, lane, cvscr);
                it = it2;
            }
#undef CV_DECODE
        }
    }
    SEAM(0);
    if (IN(1)) {
        PH_WS;
        SchedP1 S{(const char*)xb, (const char*)(ws + WS_WIN), (const char*)memn, (const char*)(ws + WS_WK), (const char*)(ws + WS_WV), 2048u, 2048u, 1024, G, bx};
        EpiP1 E{rstd1, proj, ug, kmat, vt};
        g8::gemm_phase(lds, S, E, wave);
    }
    SEAM(1);
    if (IN(2)) {
        PH_WS;
        PH_IDS;
        constexpr int L_KT = 0, L_SPV = 32768, L_UH = 49152, UROW = 1040, L_STG = 115712;
        const int l15 = lane & 15, lq = lane >> 4;
        for (int it_ = vcu; it_ < BATCH * 32; it_ += G) {
            const int g = (it_ >> 5) * 4 + (it_ & 3), b = (it_ >> 2) & 7, item = b * 32 + g;
            const bf16_t* ugp = ug + (size_t)item * SEQ * 16;
            const unsigned char* tab = ws + WS_SSM + (size_t)g * SSM_STRIDE;
            const float* A64 = (const float*)tab; const bf16_t* Kt = (const bf16_t*)(tab + SSM_KT); const bf16_t* Pt = (const bf16_t*)(tab + SSM_PT); const bf16_t* Qt = (const bf16_t*)(tab + SSM_QT);
#define STAGE_U(p) do { _Pragma("unroll") for (int _i = 0; _i < 8; ++_i) { const int _c = wave * 8 + _i; \
                const u32x4 _v = *(const u32x4*)(ugp + ((size_t)_c * 64 + 32 * (p)) * 16 + lane * 8); *(LAS u32x4*)(lds + L_UH + _c * UROW + lane * 16) = _v; } } while (0)
#define UFRAG(mb, kk) (*(const LAS bf16x8*)(lds + L_UH + (16 * (mb) + l15) * UROW + (32 * (kk) + 8 * lq) * 2))
            f32x4 sacc[4];
#pragma unroll
            for (int mb = 0; mb < 4; ++mb) sacc[mb] = (f32x4){0.f, 0.f, 0.f, 0.f};
#pragma unroll 1
            for (int p = 0; p < 2; ++p) {
                bf16x8 pf[16];
#pragma unroll
                for (int kk = 0; kk < 16; ++kk) pf[kk] = *(const bf16x8*)(Pt + (size_t)(16 * wave + l15) * 1024 + 32 * (16 * p + kk) + 8 * lq);
                __syncthreads(); STAGE_U(p); __syncthreads();
#pragma unroll
                for (int kk = 0; kk < 16; ++kk) {
#pragma unroll
                    for (int mb = 0; mb < 4; ++mb) sacc[mb] = __builtin_amdgcn_mfma_f32_16x16x32_bf16(UFRAG(mb, kk), pf[kk], sacc[mb], 0, 0, 0);
                }
            }
            STAMPX(20);
            { LAS float* Sl = (LAS float*)(lds + L_KT);
#pragma unroll
              for (int mb = 0; mb < 4; ++mb)
#pragma unroll
                for (int r = 0; r < 4; ++r) Sl[(16 * mb + 4 * lq + r) * 128 + 16 * wave + l15] = sacc[mb][r]; }
            __syncthreads();
            if (wave == 0) {
                const LAS float* Sl = (const LAS float*)(lds + L_KT); LAS bf16_t* Sp = (LAS bf16_t*)(lds + L_SPV);
                const float ar = A64[lane * 2], ai = A64[lane * 2 + 1]; float sr = 0.f, si = 0.f;
#pragma unroll 2
                for (int c = 0; c < 64; ++c) { Sp[c * 128 + lane] = (bf16_t)f2bf(sr); Sp[c * 128 + 64 + lane] = (bf16_t)f2bf(si);
                    const float lr = Sl[c * 128 + lane], li = Sl[c * 128 + 64 + lane]; const float nr = ar * sr - ai * si + lr, ni = ar * si + ai * sr + li; sr = nr; si = ni; }
            }
            __syncthreads();
            { const u32x4* src = (const u32x4*)Kt;
#pragma unroll
              for (int i = 0; i < 4; ++i) *(LAS u32x4*)(lds + L_KT + (tid + i * NTHREADS) * 16) = src[tid + i * NTHREADS]; }
            __syncthreads();
            STAMPX(21);
            const f32x4 dv4 = *(const f32x4*)(args.in[I_D] + g * 16 + (lane & 3) * 4);
#pragma unroll 1
            for (int ig = 1; ig >= 0; --ig) {
                f32x4 acc[4][4];
#pragma unroll
                for (int i = 0; i < 4; ++i)
#pragma unroll
                    for (int mb = 0; mb < 4; ++mb) acc[i][mb] = (f32x4){0.f, 0.f, 0.f, 0.f};
                const int tb0 = wave + 32 * ig, tmax = tb0 + 24;
                bf16x8 qf[4][4];
#pragma unroll
                for (int kq = 0; kq < 4; ++kq)
#pragma unroll
                    for (int i = 0; i < 4; ++i) qf[kq][i] = *(const bf16x8*)(Qt + (size_t)((tb0 + 8 * i) * 16 + l15) * 128 + 32 * kq + 8 * lq);
#pragma unroll 1
                for (int p = ig; p >= 0; --p) {
                    if (ig == 1 && p == 0) { __syncthreads(); STAGE_U(0); __syncthreads(); }
#pragma unroll 1
                    for (int kk = 0; kk < 16; ++kk) {
                        const int s0 = 32 * p + 2 * kk; if (s0 > tmax) break;
                        bf16x8 af[4];
#pragma unroll
                        for (int mb = 0; mb < 4; ++mb) af[mb] = UFRAG(mb, kk);
                        const int s = s0 + (lq >> 1);
#pragma unroll
                        for (int i = 0; i < 4; ++i) { const int t = tb0 + 8 * i;
                            if (t >= s0) { const int lag = t - s; bf16x8 bfr = *(const LAS bf16x8*)(lds + L_KT + (((lag < 0 ? 0 : lag) * 16 + l15) * 16 + 8 * (lq & 1)) * 2);
                                if (lag < 0) bfr = (bf16x8){0, 0, 0, 0, 0, 0, 0, 0};
#pragma unroll
                                for (int mb = 0; mb < 4; ++mb) acc[i][mb] = __builtin_amdgcn_mfma_f32_16x16x32_bf16(af[mb], bfr, acc[i][mb], 0, 0, 0); } }
                    }
                }
#pragma unroll
                for (int kq = 0; kq < 4; ++kq) {
                    bf16x8 af[4];
#pragma unroll
                    for (int mb = 0; mb < 4; ++mb) af[mb] = *(const LAS bf16x8*)(lds + L_SPV + ((16 * mb + l15) * 128 + 32 * kq + 8 * lq) * 2);
#pragma unroll
                    for (int i = 0; i < 4; ++i) {
#pragma unroll
                        for (int mb = 0; mb < 4; ++mb) acc[i][mb] = __builtin_amdgcn_mfma_f32_16x16x32_bf16(af[mb], qf[kq][i], acc[i][mb], 0, 0, 0); }
                }
                LAS float* stg = (LAS float*)(lds + L_STG + wave * 2048);
#pragma unroll
                for (int i = 0; i < 4; ++i) { const int t = tb0 + 8 * i;
                    u32x2 uq[2][2];
#pragma unroll
                    for (int hf = 0; hf < 2; ++hf)
#pragma unroll
                        for (int it = 0; it < 2; ++it) uq[hf][it] = *(const u32x2*)(ugp + (size_t)((32 * hf + ((it * 64 + lane) >> 2)) * 64 + t) * 16 + (lane & 3) * 4);
#pragma unroll
                    for (int hf = 0; hf < 2; ++hf) {
#pragma unroll
                        for (int ml = 0; ml < 2; ++ml)
#pragma unroll
                            for (int r = 0; r < 4; ++r) stg[(16 * ml + 4 * lq + r) * 16 + l15] = acc[i][2 * hf + ml][r];
                        asm volatile("s_waitcnt lgkmcnt(0)" ::: "memory");
#pragma unroll
                        for (int it = 0; it < 2; ++it) { const int idx = it * 64 + lane, tt = (32 * hf + (idx >> 2)) * 64 + t, c4 = (idx & 3) * 4;
                            const f32x4 yv = *(const LAS f32x4*)(stg + idx * 4); const u32x2 uu = uq[hf][it];
                            const f32x2 ya = gelu_tanh2((f32x2){yv[0], yv[1]} + (f32x2){dv4[0], dv4[1]} * (f32x2){bflo(uu.x), bfhi(uu.x)}), yb = gelu_tanh2((f32x2){yv[2], yv[3]} + (f32x2){dv4[2], dv4[3]} * (f32x2){bflo(uu.y), bfhi(uu.y)});
                            *(u32x2*)(ygelu + (size_t)(b * SEQ + tt) * 512 + g * 16 + c4) = (u32x2){cvt_pk_bf16(ya[0], ya[1]), cvt_pk_bf16(yb[0], yb[1])}; }
                        asm volatile("s_waitcnt lgkmcnt(0)" ::: "memory");
                    }
                }
            }
#undef STAGE_U
#undef UFRAG
        }
        STAMPX(22);
        {
            const int ch = lane * 8;
            float w0[8], w1[8], w2[8];
#pragma unroll
            for (int i = 0; i < 8; ++i) { w0[i] = args.in[I_CONVW][ch + i]; w1[i] = args.in[I_CONVW][512 + ch + i]; w2[i] = args.in[I_CONVW][1024 + ch + i]; }
            for (int run = gw; run < NTOK / 16; run += NGW) {
                const int r0 = run * 16, tin = r0 & (SEQ - 1);
                float vm2[8], vm1[8];
#pragma unroll
                for (int i = 0; i < 8; ++i) { vm2[i] = 0.f; vm1[i] = 0.f; }
                if (tin > 0) {
#pragma unroll
                    for (int d = 2; d >= 1; --d) { const bf16_t* pr = proj + (size_t)(r0 - d) * 1536;
                        const u32x4 c4 = *(const u32x4*)(pr + 512 + ch), x4 = *(const u32x4*)(pr + 1024 + ch);
                        float v[8]; v[0] = bflo(c4.x) * bflo(x4.x); v[1] = bfhi(c4.x) * bfhi(x4.x); v[2] = bflo(c4.y) * bflo(x4.y); v[3] = bfhi(c4.y) * bfhi(x4.y);
                        v[4] = bflo(c4.z) * bflo(x4.z); v[5] = bfhi(c4.z) * bfhi(x4.z); v[6] = bflo(c4.w) * bflo(x4.w); v[7] = bfhi(c4.w) * bfhi(x4.w);
#pragma unroll
                        for (int i = 0; i < 8; ++i) { if (d == 2) vm2[i] = v[i]; else vm1[i] = v[i]; } }
                }
#pragma unroll 1
                for (int tb = 0; tb < 16; tb += 8) {
                    u32x4 b4[8], c4[8], x4[8];
#pragma unroll
                    for (int q = 0; q < 8; ++q) { const bf16_t* pr = proj + (size_t)(r0 + tb + q) * 1536; b4[q] = *(const u32x4*)(pr + ch); c4[q] = *(const u32x4*)(pr + 512 + ch); x4[q] = *(const u32x4*)(pr + 1024 + ch); }
#pragma unroll
                    for (int q = 0; q < 8; ++q) {
                        float v[8], bgv[8], y[8]; v[0] = bflo(c4[q].x) * bflo(x4[q].x); v[1] = bfhi(c4[q].x) * bfhi(x4[q].x); v[2] = bflo(c4[q].y) * bflo(x4[q].y); v[3] = bfhi(c4[q].y) * bfhi(x4[q].y);
                        v[4] = bflo(c4[q].z) * bflo(x4[q].z); v[5] = bfhi(c4[q].z) * bfhi(x4[q].z); v[6] = bflo(c4[q].w) * bflo(x4[q].w); v[7] = bfhi(c4[q].w) * bfhi(x4[q].w);
                        bgv[0] = bflo(b4[q].x); bgv[1] = bfhi(b4[q].x); bgv[2] = bflo(b4[q].y); bgv[3] = bfhi(b4[q].y); bgv[4] = bflo(b4[q].z); bgv[5] = bfhi(b4[q].z); bgv[6] = bflo(b4[q].w); bgv[7] = bfhi(b4[q].w);
                        float ss = 0.f;
#pragma unroll
                        for (int i = 0; i < 8; ++i) { y[i] = bgv[i] * (w0[i] * vm2[i] + w1[i] * vm1[i] + w2[i] * v[i]); ss += y[i] * y[i]; vm2[i] = vm1[i]; vm1[i] = v[i]; }
                        const float rs = rsqrtf(wave_sum(ss) * (1.f / 512.f) + EPS);
                        u32x4 o; o.x = pk2(y[0] * rs, y[1] * rs); o.y = pk2(y[2] * rs, y[3] * rs); o.z = pk2(y[4] * rs, y[5] * rs); o.w = pk2(y[6] * rs, y[7] * rs);
                        *(u32x4*)(ycat + (size_t)(r0 + tb + q) * 1024 + 512 + ch) = o;
                    }
                }
            }
        }
    }
    SEAM(2);
    if (IN(3)) {
        PH_WS;
        SchedDense S{(const char*)ygelu, (const char*)(ws + WS_WGLU), 1024u, 1024u, 512, NTOK / 256, 2, G, bx};
        EpiGlu E{ygelu, ycat, ssqs};
        g8::gemm_phase(lds, S, E, wave);
    }
    SEAM(3);
    if (IN(4)) {
        PH_WS;
        SchedDense S{(const char*)ycat, (const char*)(ws + WS_WOUT), 2048u, 2048u, 1024, NTOK / 256, 4, G, bx};
        EpiRes E{xb, xh, x8, ssq2, ssqs, 6, 1.0f};
        g8::gemm_phase(lds, S, E, wave);
    }
    SEAM(4);
    if (IN(5)) {
        PH_WS;
        SchedQ S{(const char*)x8, (const char*)(ws + WS_WQ), 1024u, 1024u, 512, G, bx};
        EpiQ E{ssq2, qo};
        g8::gemm_phase(lds, S, E, wave);
    }
    STAMP(5);
    if (IN(6)) {
        PH_WS;
        SchedAttn S{(const char*)qo, (const char*)kmat, (const char*)vt, (const char*)pbuf, 256u, 256u, 128, G, bx, (BATCH * 4 * 16) / G};
        EpiAttn E{pbuf, ob, bx};
        g8::gemm_phase(lds, S, E, wave);
    }
    SEAM(6);
    if (IN(7)) {
        PH_WS;
        SchedDenseT<true> S{(const char*)ob, (const char*)(ws + WS_WO), 1024u, 1024u, 512, NTOK / 256, 4, G, bx};
        EpiRes E{xh, xh, x8, ssq3, ssqs, -1, 1.0f / (O8S * W8S)};
        g8::gemm_phase(lds, S, E, wave);
    }
    SEAM(7);
    if (IN(8)) {
        PH_WS;
        PH_IDS;
        LAS float* Xs = (LAS float*)lds;
        LAS float* Ws = (LAS float*)(lds + 34816);
        LAS float* Lg = (LAS float*)(lds + 69632);
        LAS int* hist = (LAS int*)(lds + 86528);
        LAS int* hbase = (LAS int*)(lds + 86656);
        const int te = tid & 7, tt = (tid >> 3) & 15, ks = tid >> 7;
        for (int blk = vcu; blk < NTOK / 128; blk += G) {
            const int r0 = blk * 128;
            float ac[8][4];
#pragma unroll
            for (int a = 0; a < 8; ++a)
#pragma unroll
                for (int e = 0; e < 4; ++e) ac[a][e] = 0.f;
            if (tid < 32) hist[tid] = 0;
            u32x2 xa[4], xb_[4]; f32x4 wa, wb;
#define P8_LOAD(xr, wv, kc) do { _Pragma("unroll") for (int j = 0; j < 4; ++j) xr[j] = *(const u32x2*)(xh + (size_t)(r0 + (tid >> 4) + 32 * j) * DM + (kc) * 64 + 4 * (tid & 15)); \
                wv = *(const f32x4*)(wrs + (size_t)((kc) * 64 + (tid >> 3)) * 32 + 4 * (tid & 7)); } while (0)
#define P8_STEP(xr, wv, kc) do { __syncthreads(); \
                _Pragma("unroll") for (int j = 0; j < 4; ++j) *(LAS f32x4*)(Xs + ((tid >> 4) + 32 * j) * 68 + 4 * (tid & 15)) = (f32x4){bflo(xr[j].x), bfhi(xr[j].x), bflo(xr[j].y), bfhi(xr[j].y)}; \
                *(LAS f32x4*)(Ws + (tid >> 3) * 32 + 4 * (tid & 7)) = wv; \
                __syncthreads(); \
                if ((kc) + 2 < 16) P8_LOAD(xr, wv, (kc) + 2); \
                _Pragma("unroll 2") \
                for (int q = 0; q < 4; ++q) { const int k4 = 4 * ks + q; \
                    f32x4 xv[8], w4[4]; \
                _Pragma("unroll") \
                    for (int i = 0; i < 8; ++i) xv[i] = *(const LAS f32x4*)(Xs + (tt + 16 * i) * 68 + 4 * k4); \
                _Pragma("unroll") \
                    for (int kk = 0; kk < 4; ++kk) w4[kk] = *(const LAS f32x4*)(Ws + (4 * k4 + kk) * 32 + 4 * te); \
                _Pragma("unroll") \
                    for (int i = 0; i < 8; ++i) \
                _Pragma("unroll") \
                        for (int kk = 0; kk < 4; ++kk) \
                _Pragma("unroll") \
                            for (int e = 0; e < 4; ++e) ac[i][e] += xv[i][kk] * w4[kk][e]; } \
                } while (0)
            P8_LOAD(xa, wa, 0); P8_LOAD(xb_, wb, 1);
            for (int kc = 0; kc < 16; kc += 2) { P8_STEP(xa, wa, kc); P8_STEP(xb_, wb, kc + 1); }
#undef P8_STEP
#undef P8_LOAD
            __syncthreads();
            { LAS float* Lp = (LAS float*)lds;
#pragma unroll
              for (int i = 0; i < 8; ++i)
#pragma unroll
                for (int e = 0; e < 4; ++e) Lp[(ks * 128 + tt + 16 * i) * 33 + 4 * te + e] = ac[i][e]; }
            __syncthreads();
            for (int o = tid; o < 128 * 32; o += NTHREADS) { const int t = o >> 5, e = o & 31; const LAS float* Lp = (const LAS float*)lds;
                const float sum = (Lp[t * 33 + e] + Lp[(128 + t) * 33 + e]) + (Lp[(256 + t) * 33 + e] + Lp[(384 + t) * 33 + e]);
                Lg[t * 33 + e] = sum * rsqrtf(ssq3[r0 + t] * (1.0f / 1024.0f) + EPS) + args.in[I_BR][e]; }
            __syncthreads();
            int ei[4], lp[4]; float gv[4];
            if (tid < 128) {
                unsigned taken = 0u; float tv[4];
#pragma unroll
                for (int k = 0; k < 4; ++k) { float best = -3.0e38f; int bi = 0;
                    for (int e = 0; e < 32; ++e) { const float v = Lg[tid * 33 + e]; if (!((taken >> e) & 1u) && v > best) { best = v; bi = e; } }
                    taken |= 1u << bi; ei[k] = bi; tv[k] = best; }
                float sum = 0.f;
#pragma unroll
                for (int k = 0; k < 4; ++k) { gv[k] = __expf(tv[k] - tv[0]); sum += gv[k]; }
                const float inv = 1.0f / sum;
#pragma unroll
                for (int k = 0; k < 4; ++k) { gv[k] *= inv; lp[k] = __hip_atomic_fetch_add((LAS int*)(hist + ei[k]), 1, __ATOMIC_RELAXED, __HIP_MEMORY_SCOPE_WORKGROUP); }
            }
            __syncthreads();
            if (tid < 32) hbase[tid] = atomicAdd(counts + tid, hist[tid]);
            __syncthreads();
            if (tid < 128) {
                const int tok = r0 + tid; const float rs = rsqrtf(ssq3[tok] * (1.0f / 1024.0f) + EPS);
#pragma unroll
                for (int k = 0; k < 4; ++k) { const size_t idx = (size_t)ei[k] * ECAP + hbase[ei[k]] + lp[k]; tokl[idx] = tok * 4 + k; gatel[idx] = gv[k]; rstdl[idx] = rs; }
            }
            __syncthreads();
        }
    }
    SEAM(8);
    if (IN(9) || IN(10)) {
        PH_WS;
        PH_IDS;
        LAS int* tb = (LAS int*)(lds + XL_OFF + XL_TB); LAS int* cn = (LAS int*)(lds + XL_OFF + XL_CNT);
        __syncthreads();
        if (tid == 0) { int a = 0; for (int e = 0; e < NEXP; ++e) { const int c = ald(counts + e); cn[e] = c; tb[e] = a; a += (c + 255) >> 8; } tb[NEXP] = a; }
        __syncthreads();
        if (IN(9)) {
        PH_WS;
            SchedMoeT<true> S; S.tb = tb; S.cnt = cn; S.tl = tokl; S.A = (const char*)x8; S.B = (const char*)(ws + WS_WGU); S.lda2 = 1024u; S.ldb2 = 1024u; S.K = 512; S.nN = 8; S.G = G; S.c = bx; S.bstride = (size_t)2048 * 1024; S.gather = true;
            EpiMoe1 E{rstdl, args.in[I_BGU], act};
            g8::gemm_phase(lds, S, E, wave);
        }
    }
    SEAM(9);
    if (IN(10)) {
        PH_WS;
        LAS int* tb = (LAS int*)(lds + XL_OFF + XL_TB); LAS int* cn = (LAS int*)(lds + XL_OFF + XL_CNT);
        SchedMoeT<false> S; S.tb = tb; S.cnt = cn; S.tl = tokl; S.A = (const char*)act; S.B = (const char*)(ws + WS_WDN); S.lda2 = 1024u; S.ldb2 = 1024u; S.K = 512; S.nN = 4; S.G = G; S.c = bx; S.bstride = (size_t)1024 * 1024; S.gather = false;
        EpiMoe2 E{tokl, gatel, args.in[I_BDN], slots};
        g8::gemm_phase(lds, S, E, wave);
    }
    SEAM(10);
    if (IN(11)) {
        PH_WS;
        PH_IDS;
        for (int m = gw; m < NTOK; m += NGW) {
            f32x4 v[4];
            { const u32x2* xr = (const u32x2*)(xh + (size_t)m * DM) + lane;
#pragma unroll
              for (int j = 0; j < 4; ++j) { const u32x2 w = xr[64 * j]; v[j] = (f32x4){bflo(w.x), bfhi(w.x), bflo(w.y), bfhi(w.y)}; } }
            if (DBG_OUT == 0) {
#pragma unroll
                for (int k = 0; k < 4; ++k) { const unsigned* sr = (const unsigned*)((const unsigned char*)slots + (size_t)(m * 4 + k) * DM) + lane;
#pragma unroll
                    for (int j = 0; j < 4; ++j) { const int w = (int)sr[64 * j]; const f32x2 lo = __builtin_amdgcn_cvt_pk_f32_fp8(w, false), hi = __builtin_amdgcn_cvt_pk_f32_fp8(w, true);
                        v[j][0] += lo[0] * (1.0f / S8S); v[j][1] += lo[1] * (1.0f / S8S); v[j][2] += hi[0] * (1.0f / S8S); v[j][3] += hi[1] * (1.0f / S8S); } }
            }
            float ss = 0.f;
#pragma unroll
            for (int j = 0; j < 4; ++j) ss += (v[j][0] * v[j][0] + v[j][1] * v[j][1]) + (v[j][2] * v[j][2] + v[j][3] * v[j][3]);
            const float rs = rsqrtf(wave_sum(ss) * (1.f / DM) + EPS);
            f32x4* o = (f32x4*)(args.out + (size_t)m * DM) + lane;
#pragma unroll
            for (int j = 0; j < 4; ++j) { const f32x4 g = ((const f32x4*)args.in[I_NF])[lane + 64 * j]; o[64 * j] = v[j] * rs * g; }
        }
    }
#if PROBE_PHASE >= 0 || PROBE_A >= 0
    STAMP(11);
    if (bx == 0 && threadIdx.x == 0) {
        const int ia = (PROBE_A >= 0) ? PROBE_A : PROBE_PHASE, ib = (PROBE_A >= 0) ? PROBE_B : PROBE_PHASE + 1;
        const unsigned long long d = (stamps[ib] - stamps[ia]) * (unsigned long long)PROBE_MULT, t0 = __builtin_amdgcn_s_memrealtime();
        while (__builtin_amdgcn_s_memrealtime() - t0 < d) __builtin_amdgcn_s_sleep(16);
    }
#endif
#undef IN
#undef SEAM
#undef vcu
#undef gw
#undef NGW
#undef counts
#undef rstd1
#undef ssqs
#undef ssq2
#undef ssq3
#undef gates
#undef gatel
#undef rstdl
#undef wrs
#undef tokl
#undef xb
#undef proj
#undef ug
#undef ycat
#undef ygelu
#undef x8
#undef xh
#undef qo
#undef pbuf
#undef ob
#undef act
#undef slots
#undef memn
#undef kmat
#undef vt
}

extern "C" void kernel_launch(void* const* d_in, const int* in_sizes, int n_in, void* d_out, int out_size, void* d_ws, size_t ws_size, hipStream_t stream) {
    static int grid = 0;
    if (grid == 0) {
        if (n_in != 30 || in_sizes[0] != NTOK * DM || out_size != NTOK * DM || ws_size < WS_END) { fprintf(stderr, "kernel_launch: unexpected shapes (n_in %d, in0 %d, out %d, ws %zu < %zu); nothing launched\n", n_in, n_in > 0 ? in_sizes[0] : -1, out_size, ws_size, (size_t)WS_END); grid = -1; return; }
        int dev = 0, cus = 0, per_cu = 0;
        if (hipGetDevice(&dev) != hipSuccess || hipDeviceGetAttribute(&cus, hipDeviceAttributeMultiprocessorCount, dev) != hipSuccess) { grid = -1; return; }
        if (hipFuncSetAttribute((const void*)mk_fwd, hipFuncAttributeMaxDynamicSharedMemorySize, LDS_BYTES) != hipSuccess) { fprintf(stderr, "kernel_launch: hipFuncSetAttribute failed\n"); grid = -1; return; }
        if (hipOccupancyMaxActiveBlocksPerMultiprocessor(&per_cu, (const void*)mk_fwd, NTHREADS, LDS_BYTES) != hipSuccess || per_cu < 1) { fprintf(stderr, "kernel_launch: occupancy query says %d blocks per CU\n", per_cu); per_cu = 1; }
        (void)hipGetLastError();
        grid = cus;
        if (grid != 256) fprintf(stderr, "kernel_launch: %d CUs; the attention phase assumes 256\n", grid);
    }
    if (grid < 0) return;
    if (hipMemsetAsync((char*)d_ws + WS_BAR, 0, BAR_ZERO_BYTES, stream) != hipSuccess) { fprintf(stderr, "kernel_launch: hipMemsetAsync failed\n"); return; }
    Args a{};
    for (int i = 0; i < 30; ++i) a.in[i] = (const float*)d_in[i];
    a.out = (float*)d_out; a.ws = (unsigned char*)d_ws;
#if MK_PER_PHASE
    for (int ph = 0; ph < 12; ++ph) { a.ph_lo = ph; a.ph_hi = ph + 1; hipLaunchKernelGGL(mk_fwd, dim3(grid), dim3(NTHREADS), LDS_BYTES, stream, a); }
#else
    a.ph_lo = 0; a.ph_hi = 12;
    void* kargs[] = {&a};
    hipError_t e = hipLaunchCooperativeKernel((const void*)mk_fwd, dim3(grid), dim3(NTHREADS), kargs, LDS_BYTES, stream);
    if (e != hipSuccess) fprintf(stderr, "kernel_launch: cooperative launch failed: %s (grid %d)\n", hipGetErrorString(e), grid);
#endif
}
```

```cpp
#include <hip/hip_runtime.h>
#include <hip/hip_cooperative_groups.h>
#include <cstdio>
#include <cstdint>
#include <cmath>
namespace cg = cooperative_groups;

#ifndef MK_PER_PHASE
#define MK_PER_PHASE 0
#endif
#ifndef MK_USE_CG
#define MK_USE_CG 0
#endif
#ifndef PROBE_PHASE
#define PROBE_PHASE -1
#endif
#ifndef PROBE_EPI
#define PROBE_EPI -1
#endif
#ifndef PROBE_A
#define PROBE_A -1
#define PROBE_B -1
#endif
#ifndef PROBE_MULT
#define PROBE_MULT 1
#endif
#ifndef DBG_OUT
#define DBG_OUT 0
#endif

#define LAS __attribute__((address_space(3)))
typedef unsigned short bf16_t;
typedef short bf16x8 __attribute__((ext_vector_type(8)));
typedef float f32x4 __attribute__((ext_vector_type(4)));
typedef float f32x2 __attribute__((ext_vector_type(2)));
typedef unsigned u32x4 __attribute__((ext_vector_type(4)));
typedef unsigned u32x2 __attribute__((ext_vector_type(2)));
typedef int i32x4 __attribute__((ext_vector_type(4)));
typedef int i32x8 __attribute__((ext_vector_type(8)));

constexpr int NTHREADS = 512, NWAVES = 8;
constexpr int DM = 1024, BATCH = 8, SEQ = 4096, NTOK = BATCH * SEQ, MEMLEN = 256, NMEM = BATCH * MEMLEN;
constexpr int NEXP = 32, TOPK = 4, ECAP = NTOK;
constexpr int MAXTILES = (NTOK * TOPK) / 256 + NEXP;
constexpr float EPS = 1e-5f;
constexpr float X8S = 16.0f, W8S = 256.0f, A8S = 4.0f, O8S = 64.0f, S8S = 32.0f, Q8S = 64.0f, K8S = 16.0f, P8S = 256.0f;

constexpr size_t MiB = 1u << 20;
constexpr size_t WS_CNT = 0;
constexpr size_t WS_BAR = 256 * 1024, BAR_ZERO_BYTES = 16 * 1024;
constexpr size_t WS_STAMP = 512 * 1024;
constexpr size_t WS_RSTD1 = 1 * MiB;
constexpr size_t WS_SSQS = WS_RSTD1 + 128 * 1024;
constexpr size_t WS_SSQ2 = WS_SSQS + 128 * 1024;
constexpr size_t WS_SSQ3 = WS_SSQ2 + 128 * 1024;
constexpr size_t WS_GATES = 2 * MiB;
constexpr size_t WS_WR = 3 * MiB;
constexpr size_t WS_TOKL = 4 * MiB;
constexpr size_t WS_SSM = 8 * MiB;
constexpr size_t SSM_STRIDE = 576 * 1024, SSM_KT = 1024, SSM_PT = 64 * 1024, SSM_QT = 320 * 1024;
constexpr size_t WS_WIN = 26 * MiB, WS_WGLU = 30 * MiB, WS_WOUT = 31 * MiB, WS_WQ = 33 * MiB, WS_WK = 35 * MiB, WS_WV = 37 * MiB, WS_WO = 39 * MiB;
constexpr size_t WS_MEMN = 41 * MiB, WS_KMAT = 45 * MiB, WS_VT = 49 * MiB;
constexpr size_t WS_WGU = 56 * MiB, WS_WDN = 184 * MiB;
constexpr size_t WS_YGELU = 248 * MiB;
constexpr size_t WS_X1 = 280 * MiB;
constexpr size_t WS_ACT = 408 * MiB;
constexpr size_t WS_XB = 408 * MiB, WS_PROJ = 472 * MiB, WS_UG = 568 * MiB, WS_YCAT = 600 * MiB;
constexpr size_t WS_SLOTS = 680 * MiB;
constexpr size_t WS_XH = 312 * MiB  , WS_QO = 744 * MiB, WS_PBUF = 808 * MiB, WS_O = 872 * MiB;
constexpr size_t WS_GATEL = 936 * MiB, WS_RSTDL = 940 * MiB;
constexpr size_t WS_END = 944 * MiB;

constexpr int LDS_BYTES = 147456;
constexpr int XL_OFF = 131072;
constexpr int XL_PMAX = 0, XL_PSUM = 4096, XL_TB = 12288, XL_CNT = 12544, XL_MISC = 13312;

__device__ __forceinline__ float wave_sum(float v) {
#pragma unroll
    for (int o = 1; o < 64; o <<= 1) v += __shfl_xor(v, o);
    return v;
}
__device__ __forceinline__ unsigned f2bf(float f) { unsigned u = __builtin_bit_cast(unsigned, f); return (u + 0x7fffu + ((u >> 16) & 1u)) >> 16; }
__device__ __forceinline__ unsigned pk2(float lo, float hi) { return f2bf(lo) | (f2bf(hi) << 16); }
__device__ __forceinline__ unsigned cvt_pk_bf16(float lo, float hi) { unsigned r; asm volatile("v_cvt_pk_bf16_f32 %0, %1, %2" : "=v"(r) : "v"(lo), "v"(hi)); return r; }
__device__ __forceinline__ unsigned pk4_fp8(float a, float b, float c, float d) { int w = __builtin_amdgcn_cvt_pk_fp8_f32(a, b, 0, false); w = __builtin_amdgcn_cvt_pk_fp8_f32(c, d, w, true); return (unsigned)w; }
__device__ __forceinline__ float clamp448(float v) { return __builtin_amdgcn_fmed3f(v, -448.0f, 448.0f); }
__device__ __forceinline__ float bflo(unsigned w) { return __builtin_bit_cast(float, w << 16); }
__device__ __forceinline__ float bfhi(unsigned w) { return __builtin_bit_cast(float, w & 0xffff0000u); }
__device__ __forceinline__ float bf2f(bf16_t b) { return __builtin_bit_cast(float, (unsigned)b << 16); }
__device__ __forceinline__ float sigmoidf_(float x) { return __builtin_amdgcn_rcpf(1.0f + __builtin_amdgcn_exp2f(-1.4426950408889634f * x)); }
__device__ __forceinline__ f32x2 sigmoid2(f32x2 x) { f32x2 e = x * -1.4426950408889634f; e[0] = __builtin_amdgcn_exp2f(e[0]); e[1] = __builtin_amdgcn_exp2f(e[1]); f32x2 d = e + 1.0f; d[0] = __builtin_amdgcn_rcpf(d[0]); d[1] = __builtin_amdgcn_rcpf(d[1]); return d; }
__device__ __forceinline__ f32x2 gelu_tanh2(f32x2 y) { const f32x2 t = (y * y * 0.044715f + 1.0f) * y * (2.0f * 0.7978845608028654f); return y * sigmoid2(t); }
__device__ __forceinline__ float gelu_tanh(float y) { const float t = 0.7978845608028654f * (y + 0.044715f * y * y * y); return y * sigmoidf_(2.0f * t); }
__device__ __forceinline__ int ald(const int* p) { return __hip_atomic_load(p, __ATOMIC_RELAXED, __HIP_MEMORY_SCOPE_AGENT); }

namespace g8 {
constexpr int BM = 256, BK = 64, HALF = 128, HTB = HALF * BK * 2, NXCD = 8, WGM = 8;
__device__ __forceinline__ int lds_byte(int r, int c) { const int st = (r >> 4) * 2 + (c >> 5), rr = r & 15, cc = c & 31, ob = rr * 64 + cc * 2; return st * 1024 + (ob ^ (((ob >> 9) & 1) << 5)); }
__device__ __forceinline__ void stage_rc(int b, int& R, int& C) { const int st = b / 1024, sb = b % 1024, swz = sb ^ (((sb >> 9) & 1) << 5); R = (st >> 1) * 16 + swz / 64; C = (st & 1) * 32 + (swz % 64) / 2; }
__device__ __forceinline__ int perm32(int rho) { const int n = rho >> 4, i = rho & 15; return 8 * (i >> 2) + 4 * n + (i & 3); }

struct Unit { const char* A; const char* B; int pm, pn, e, aux, valid, job; };

__device__ __forceinline__ bool tile_order(int i, int G, int c, int nM, int nN, int& pm, int& pn) {
    const int nwg = nM * nN; const long L = (long)i * G + c; if (L >= nwg) return false;
    int wgid = (int)L; { const int q = nwg / NXCD, r = nwg % NXCD, xcd = wgid % NXCD, off = wgid / NXCD; wgid = (xcd < r ? xcd * (q + 1) : r * (q + 1) + (xcd - r) * q) + off; }
    const int nig = WGM * nN, gid = wgid / nig, fm = gid * WGM, gsz = (nM - fm) < WGM ? (nM - fm) : WGM;
    pm = fm + ((wgid % nig) % gsz); pn = (wgid % nig) / gsz; return true;
}

__device__ __forceinline__ int lane_id_volatile() { int l; asm volatile("v_mbcnt_lo_u32_b32 %0, -1, 0\n\tv_mbcnt_hi_u32_b32 %0, -1, %0" : "=v"(l)); return l; }
template <class Epi, class Sched>
__device__ __forceinline__ void gemm_phase(LAS unsigned char* lds, const Sched& S, const Epi& E, const int wid) {
    const int lane = lane_id_volatile(), tid = wid * 64 + lane, wr = wid >> 2, wc = wid & 3, fr = lane & 15, fq = lane >> 4;
    const int K = S.K, nt = K / BK;
    const unsigned lda2 = S.lda2, ldb2 = S.ldb2;
    unsigned voffB0, cb0;
    { int R, C; stage_rc(tid * 16, R, C); cb0 = (unsigned)C * 2u; const int Rb = 64 * (R >> 5) + 16 * ((R >> 2) & 3) + 4 * ((R >> 4) & 1) + (R & 3); voffB0 = (unsigned)Rb * ldb2 + cb0; }
    const size_t pstepA = (size_t)64 * lda2, pstepB = (size_t)128 * ldb2, hstepA = (size_t)HALF * lda2;
    const size_t kstep = (size_t)(BK * 2);
    const size_t hstepB = (size_t)8 * ldb2;
    const unsigned ldsw = (unsigned)wid * 1024u;
    const int aoff = lds_byte(wr * 64 + fr, fq * 8), boff = lds_byte(wc * 32 + fr, fq * 8);
#define G8_SA(b, h) (((b) * 2 + (h)) * HTB)
#define G8_SB(b, h) ((4 + (b) * 2 + (h)) * HTB)
#define G8_STAGE_B(bufoff, gbase) do { _Pragma("unroll") for (int _i = 0; _i < 2; ++_i) \
        __builtin_amdgcn_global_load_lds((const unsigned*)((const char*)(gbase) + _i * pstepB + voffB0), (LAS unsigned*)(lds + (bufoff) + ldsw + _i * 8192), 16, 0, 0); } while (0)
#define G8_STAGE_A(bufoff, gbase, o0, o1) do { \
        __builtin_amdgcn_global_load_lds((const unsigned*)((const char*)(gbase) + (o0)), (LAS unsigned*)(lds + (bufoff) + ldsw), 16, 0, 0); \
        __builtin_amdgcn_global_load_lds((const unsigned*)((const char*)(gbase) + (o1)), (LAS unsigned*)(lds + (bufoff) + ldsw + 8192), 16, 0, 0); } while (0)
#define G8_LDA(dst, b, h) do { _Pragma("unroll") for (int m = 0; m < 4; ++m) _Pragma("unroll") for (int k = 0; k < 2; ++k) dst[m][k] = *(const LAS bf16x8*)(lds + G8_SA(b, h) + aoff + m * 2048 + k * 1024); } while (0)
#define G8_LDB(dst, b, h) do { _Pragma("unroll") for (int n = 0; n < 2; ++n) _Pragma("unroll") for (int k = 0; k < 2; ++k) dst[n][k] = *(const LAS bf16x8*)(lds + G8_SB(b, h) + boff + n * 2048 + k * 1024); } while (0)
#define G8_MMA(ai, bj, At, Bt) do { __builtin_amdgcn_s_setprio(1); _Pragma("unroll") for (int m = 0; m < 4; ++m) _Pragma("unroll") for (int n = 0; n < 2; ++n) _Pragma("unroll") for (int k = 0; k < 2; ++k) \
        acc[ai][bj][m][n] = __builtin_amdgcn_mfma_f32_16x16x32_bf16(Bt[n][k], At[m][k], acc[ai][bj][m][n], 0, 0, 0); __builtin_amdgcn_s_setprio(0); } while (0)
#define G8_RD16(off) __builtin_bit_cast(i32x4, *(const LAS bf16x8*)(lds + (off)))
#define G8_LDA8(dst, b, h) do { _Pragma("unroll") for (int m = 0; m < 4; ++m) dst[m] = __builtin_shufflevector(G8_RD16(G8_SA(b, h) + aoff + m * 2048), G8_RD16(G8_SA(b, h) + aoff + m * 2048 + 1024), 0, 1, 2, 3, 4, 5, 6, 7); } while (0)
#define G8_LDB8(dst, b, h) do { _Pragma("unroll") for (int n = 0; n < 2; ++n) dst[n] = __builtin_shufflevector(G8_RD16(G8_SB(b, h) + boff + n * 2048), G8_RD16(G8_SB(b, h) + boff + n * 2048 + 1024), 0, 1, 2, 3, 4, 5, 6, 7); } while (0)
#define G8_MMA8(ai, bj, At, Bt) do { __builtin_amdgcn_s_setprio(1); _Pragma("unroll") for (int m = 0; m < 4; ++m) _Pragma("unroll") for (int n = 0; n < 2; ++n) \
        asm volatile("s_nop 1\n\tv_mfma_scale_f32_16x16x128_f8f6f4 %0, %1, %2, %0, %3, %3 op_sel_hi:[0,0,0]" : "+v"(acc[ai][bj][m][n]) : "v"(Bt[n]), "v"(At[m]), "v"(scl8)); __builtin_amdgcn_s_setprio(0); } while (0)
#define G8_MM(ai, bj, X) do { if constexpr (Sched::FP8) G8_MMA8(ai, bj, At8, X##8); else G8_MMA(ai, bj, At, X); } while (0)
#define G8_LA(b, h) do { if constexpr (Sched::FP8) G8_LDA8(At8, b, h); else G8_LDA(At, b, h); } while (0)
#define G8_LB(X, b, h) do { if constexpr (Sched::FP8) G8_LDB8(X##8, b, h); else G8_LDB(X, b, h); } while (0)
#define G8_WAIT_V(n) asm volatile("s_waitcnt vmcnt(" #n ")" ::: "memory")
#define G8_WAIT_L(n) asm volatile("s_waitcnt lgkmcnt(" #n ")" ::: "memory")
#define G8_BAR __builtin_amdgcn_s_barrier()
#define G8_SCHED __builtin_amdgcn_sched_barrier(0)
#define G8_SETOFF(o, u) do { const int _t = wid * 64 + lane_id_volatile(); _Pragma("unroll") for (int _i = 0; _i < 2; ++_i) { int _R, _C; stage_rc(_t * 16 + _i * 8192, _R, _C); \
        _Pragma("unroll") for (int _h = 0; _h < 2; ++_h) { if (Sched::GATHER) { const unsigned _tk = S.arow_tok(u, _h * HALF + _R); if (_i == 0) o[_h][0] = _tk; else o[_h][0] |= _tk << 16; } \
            else if (_h == 0 && _i == 0) o[0][0] = (unsigned)_R * lda2 + (unsigned)_C * 2u; } } } while (0)
#define G8_GOFF0(pk) (((pk) & 0xffffu) * lda2 + cb0)
#define G8_GOFF1(pk) (((pk) >> 16) * lda2 + cb0)
#define G8_STAGE_AH(bufoff, gbase, h, pk) do { if (Sched::GATHER) { G8_STAGE_A(bufoff, gbase, G8_GOFF0(pk), G8_GOFF1(pk)); } \
        else { G8_STAGE_A(bufoff, (const char*)(gbase) + (h) * hstepA, oa[0][0], pstepA + oa[0][0]); } } while (0)
    Unit cur, nxt; int ui = 0;
    if (!S.next(0, cur)) return;
    f32x4 acc[2][2][4][2];
#pragma unroll
    for (int a = 0; a < 2; ++a)
#pragma unroll
        for (int b = 0; b < 2; ++b)
#pragma unroll
            for (int m = 0; m < 4; ++m)
#pragma unroll
                for (int n = 0; n < 2; ++n) acc[a][b][m][n] = (f32x4){0.f, 0.f, 0.f, 0.f};
    bf16x8 At[4][2], B0[2][2], B1[2][2];
    i32x8 At8[4], B08[2], B18[2]; const int scl8 = 0x7F7F7F7F;
    unsigned oa[2][2], on[2][2];
    G8_SETOFF(oa, cur);
    const char* cA = cur.A; const char* cB = cur.B;
    G8_STAGE_B(G8_SB(0, 0), cB); G8_STAGE_B(G8_SB(0, 1), cB + hstepB); G8_STAGE_AH(G8_SA(0, 0), cA, 0, oa[0][0]); G8_STAGE_AH(G8_SA(0, 1), cA, 1, oa[1][0]);
    if (wr == 1) G8_BAR;
    G8_WAIT_V(2); G8_BAR;
    G8_STAGE_B(G8_SB(1, 0), cB + kstep); G8_STAGE_AH(G8_SA(1, 0), cA + kstep, 0, oa[0][0]); G8_STAGE_B(G8_SB(1, 1), cB + hstepB + kstep);
    G8_WAIT_V(6); G8_BAR;
    bool has_next = S.next(1, nxt);
    if (Sched::GATHER) { if (has_next) { G8_SETOFF(on, nxt); } else {
#pragma unroll
        for (int h = 0; h < 2; ++h) on[h][0] = oa[h][0]; } }
    for (;;) {
        const char* nA = has_next ? nxt.A : cA; const char* nB = has_next ? nxt.B : cB;
#pragma unroll 1
        for (int t = 0; t < nt; t += 2) {
            const bool last = (t == nt - 2);
            const char* a1 = cA + (size_t)(t + 1) * kstep;
            const char* a2 = last ? nA : cA + (size_t)(t + 2) * kstep; const char* b2 = last ? nB : cB + (size_t)(t + 2) * kstep;
            const char* a3 = a2 + kstep; const char* b3 = b2 + kstep;
            unsigned p0 = 0, p1 = 0;
            if (Sched::GATHER) { p0 = last ? on[0][0] : oa[0][0]; p1 = last ? on[1][0] : oa[1][0]; }
            G8_LB(B0, 0, 0); G8_LB(B1, 0, 1); G8_SCHED; G8_LA(0, 0); G8_STAGE_AH(G8_SA(1, 1), a1, 1, oa[1][0]);
            G8_WAIT_V(8); G8_WAIT_L(0); G8_BAR; G8_MM(0, 0, B0); G8_MM(0, 1, B1); G8_BAR; G8_SCHED;
            G8_LA(0, 1); G8_STAGE_B(G8_SB(0, 0), b2); G8_STAGE_B(G8_SB(0, 1), b2 + hstepB); G8_STAGE_AH(G8_SA(0, 0), a2, 0, p0);
            G8_WAIT_V(8); G8_WAIT_L(0); G8_BAR; G8_MM(1, 0, B0); G8_MM(1, 1, B1); G8_BAR; G8_SCHED;
            G8_LB(B0, 1, 0); G8_LB(B1, 1, 1); G8_SCHED; G8_LA(1, 0); G8_STAGE_AH(G8_SA(0, 1), a2, 1, p1);
            G8_WAIT_V(8); G8_WAIT_L(0); G8_BAR; G8_MM(0, 0, B0); G8_MM(0, 1, B1); G8_BAR; G8_SCHED;
            G8_LA(1, 1); G8_STAGE_B(G8_SB(1, 0), b3); G8_STAGE_B(G8_SB(1, 1), b3 + hstepB); G8_STAGE_AH(G8_SA(1, 0), a3, 0, p0);
            G8_WAIT_V(8); G8_WAIT_L(0); G8_BAR; G8_MM(1, 0, B0); G8_MM(1, 1, B1); G8_BAR; G8_SCHED;
            if (Epi::MID) { const int fr_e = lane_id_volatile() & 15; E.mid(acc, cur, t, wr, fr_e); }
        }
        if (wr == 0) G8_BAR;
        if constexpr (Sched::FP8) asm volatile("s_nop 15\n\ts_nop 15" ::: "memory");
        Unit n2; bool has2 = false; unsigned tk[2][2] = {{0u, 0u}, {0u, 0u}};
        if (has_next) { has2 = S.next(ui + 2, n2);
            if (Sched::GATHER && has2) { const int _t = wid * 64 + lane_id_volatile();
#pragma unroll
                for (int _i = 0; _i < 2; ++_i) { int _R, _C; stage_rc(_t * 16 + _i * 8192, _R, _C);
#pragma unroll
                    for (int _h = 0; _h < 2; ++_h) tk[_h][_i] = S.arow_tok(n2, _h * HALF + _R); } } }
        { const int l_e = lane_id_volatile(), fr_e = l_e & 15, fq_e = l_e >> 4;
          E(acc, cur, wr, wc, fr_e, fq_e, lds); if constexpr (Epi::PROBE2) { asm volatile("" ::: "memory"); const Epi E2 = E.probe_copy(); E2(acc, cur, wr, wc, fr_e, fq_e, lds); } }
        if (!has_next) break;
#pragma unroll
        for (int a = 0; a < 2; ++a)
#pragma unroll
            for (int b = 0; b < 2; ++b)
#pragma unroll
                for (int m = 0; m < 4; ++m)
#pragma unroll
                    for (int n = 0; n < 2; ++n) acc[a][b][m][n] = (f32x4){0.f, 0.f, 0.f, 0.f};
        cur = nxt; cA = nA; cB = nB; ++ui;
        if (Sched::GATHER) {
#pragma unroll
            for (int h = 0; h < 2; ++h) { oa[h][0] = on[h][0]; if (has2) on[h][0] = tk[h][0] | (tk[h][1] << 16); } }
        nxt = n2; has_next = has2;
        if (wr == 1) G8_BAR;
    }
    G8_WAIT_V(0);
    G8_BAR;
#undef G8_SA
#undef G8_SB
#undef G8_STAGE_A
#undef G8_STAGE_B
#undef G8_LDA
#undef G8_LDB
#undef G8_MMA
#undef G8_MMA8
#undef G8_MM
#undef G8_LA
#undef G8_LB
#undef G8_LDA8
#undef G8_LDB8
#undef G8_RD16
#undef G8_WAIT_V
#undef G8_WAIT_L
#undef G8_BAR
#undef G8_SCHED
#undef G8_SETOFF
#undef G8_GOFF0
#undef G8_GOFF1
#undef G8_STAGE_AH
}
}
using g8::Unit;
using g8::lane_id_volatile;

#define EPI_PROBE_COPY(T) __device__ __forceinline__ T probe_copy() const { return *this; }
#define EPI_ROWS(ai, m) _Pragma("unroll") for (int ai = 0; ai < 2; ++ai) _Pragma("unroll") for (int m = 0; m < 4; ++m)
__device__ __forceinline__ u32x4 pack8(const f32x4 a, const f32x4 b) { u32x4 w; w.x = cvt_pk_bf16(a[0], a[1]); w.y = cvt_pk_bf16(a[2], a[3]); w.z = cvt_pk_bf16(b[0], b[1]); w.w = cvt_pk_bf16(b[2], b[3]); return w; }
__device__ __forceinline__ float sq8(const f32x4 a, const f32x4 b) { return (a[0] * a[0] + a[1] * a[1]) + (a[2] * a[2] + a[3] * a[3]) + (b[0] * b[0] + b[1] * b[1]) + (b[2] * b[2] + b[3] * b[3]); }
__device__ __forceinline__ void row_atomic(float* p, float s, int fq) { s += __shfl_xor(s, 16); s += __shfl_xor(s, 32); if (fq == 0) atomicAdd(p, s); }

template <bool F8> struct SchedDenseT {
    static constexpr bool GATHER = false, FP8 = F8;
    const char* A; const char* B; unsigned lda2, ldb2; int K, nM, nN, G, c;
    __device__ __forceinline__ bool next(int i, Unit& u) const {
        int pm, pn; if (!g8::tile_order(i, G, c, nM, nN, pm, pn)) return false;
        u.pm = pm; u.pn = pn; u.A = A + (size_t)pm * 256 * lda2; u.B = B + (size_t)pn * 256 * ldb2; u.e = 0; u.aux = 0; u.valid = 256; u.job = 0; return true;
    }
    __device__ __forceinline__ unsigned arow_tok(const Unit&, int) const { return 0u; }
};
typedef SchedDenseT<false> SchedDense;
struct SchedP1 {
    static constexpr bool GATHER = false, FP8 = false;
    const char *xb, *win, *memn, *wk, *wv; unsigned lda2, ldb2; int K, G, c;
    __device__ __forceinline__ bool next(int i, Unit& u) const {
        const int L = i * G + c;
        u.e = 0; u.aux = 0; u.valid = 256;
        if (L < 1024) { int pm, pn; g8::tile_order(i, G, c, 128, 8, pm, pn); u.pm = pm; u.pn = pn; u.job = 0; u.A = xb + (size_t)pm * 256 * 2048; u.B = win + (size_t)pn * 256 * 2048; return true; }
        const int r = L - 1024;
        if (r < 32) { u.pm = r >> 2; u.pn = r & 3; u.job = 1; u.A = memn + (size_t)u.pm * 256 * 2048; u.B = wk + (size_t)u.pn * 256 * 2048; return true; }
        if (r < 64) { const int q = r - 32; u.pm = q >> 3; u.pn = q & 7; u.job = 2; u.A = wv + (size_t)u.pm * 256 * 2048; u.B = memn + (size_t)u.pn * 256 * 2048; return true; }
        return false;
    }
    __device__ __forceinline__ unsigned arow_tok(const Unit&, int) const { return 0u; }
};
struct SchedQ {
    static constexpr bool GATHER = false, FP8 = true;
    const char *A, *B; unsigned lda2, ldb2; int K, G, c;
    __device__ __forceinline__ bool next(int i, Unit& u) const {
        const int p = c + i * G; if (p >= BATCH * 4 * 16) return false;
        const int b = p >> 6, h = (p >> 4) & 3, qb = p & 15;
        u.pm = b * 16 + qb; u.pn = h; u.e = 0; u.aux = 0; u.valid = 256; u.job = 0; u.A = A + (size_t)u.pm * 256 * lda2; u.B = B + (size_t)h * 256 * ldb2; return true;
    }
    __device__ __forceinline__ unsigned arow_tok(const Unit&, int) const { return 0u; }
};
struct SchedAttn {
    static constexpr bool GATHER = false, FP8 = true;
    const char *q, *kmat, *vt, *pbuf; unsigned lda2, ldb2; int K, G, c, npair;
    __device__ __forceinline__ void pair_unit(int j, bool isO, Unit& u) const {
        const int p = c + j * G; const int b = p >> 6, h = (p >> 4) & 3, qb = p & 15;
        u.pm = b * 16 + qb; u.pn = h; u.e = j & 1; u.aux = 0; u.valid = 256; u.job = isO ? 1 : 0;
        if (!isO) { u.A = q + ((size_t)((b * 4 + h) * SEQ + qb * 256)) * 256; u.B = kmat + ((size_t)((b * 4 + h) * 256)) * 256; }
        else      { u.A = pbuf + ((size_t)(c * 2 + (j & 1))) * 256 * 256; u.B = vt + ((size_t)((b * 4 + h) * 256)) * 256; }
    }
    __device__ __forceinline__ bool next(int i, Unit& u) const {
        const int n = npair; if (i >= 2 * n) return false;
        if (i == 0) { pair_unit(0, false, u); return true; }
        const int k = (i - 1) >> 1;
        if (i & 1) { if (k + 1 < n) pair_unit(k + 1, false, u); else pair_unit(n - 1, true, u); }
        else pair_unit(k, true, u);
        return true;
    }
    __device__ __forceinline__ unsigned arow_tok(const Unit&, int) const { return 0u; }
};
struct SchedMoe {
    static constexpr bool GATHER_ = true;
    const LAS int* tb; const LAS int* cnt; const int* tl; const char* A; const char* B; unsigned lda2, ldb2; int K, nN, G, c; size_t bstride; bool gather;
};
template <bool GATH> struct SchedMoeT : SchedMoe {
    static constexpr bool GATHER = GATH, FP8 = true;
    __device__ __forceinline__ bool next(int i, Unit& u) const {
        const int nM = __builtin_amdgcn_readfirstlane(tb[NEXP]); int pm, pn; if (!g8::tile_order(i, G, c, nM, nN, pm, pn)) return false;
        int e = 0;
#pragma unroll
        for (int s = 16; s >= 1; s >>= 1) if (__builtin_amdgcn_readfirstlane(tb[e + s]) <= pm) e += s;
        u.pm = pm; u.pn = pn; u.e = e; u.aux = (pm - __builtin_amdgcn_readfirstlane(tb[e])) * 256; const int v = __builtin_amdgcn_readfirstlane(cnt[e]) - u.aux; u.valid = v < 256 ? v : 256; u.job = 0;
        u.A = GATH ? A : A + (size_t)pm * 256 * lda2; u.B = B + (size_t)e * bstride + (size_t)pn * 256 * ldb2; return true;
    }
    __device__ __forceinline__ unsigned arow_tok(const Unit& u, int r) const {
        return (unsigned)((r < u.valid) ? (tl[(size_t)u.e * ECAP + u.aux + r] >> 2) : 0);
    }
};

struct EpiP1 {
    static constexpr bool MID = false; static constexpr bool PROBE2 = false; EPI_PROBE_COPY(EpiP1)
    const float* rstd1; bf16_t *proj, *ug, *kmat, *vt;
    __device__ __forceinline__ void mid(f32x4 (&)[2][2][4][2], const Unit&, int, int, int) const {}
    __device__ __forceinline__ void operator()(const f32x4 (&acc)[2][2][4][2], const Unit& u, int wr, int wc, int fr, int fq, LAS unsigned char*) const {
        const int col0 = u.pn * 256 + wc * 64 + 16 * fq;
        float rs[2][4];
        EPI_ROWS(ai, m) rs[ai][m] = (u.job == 0) ? rstd1[u.pm * 256 + ai * 128 + wr * 64 + m * 16 + fr] : 1.0f;
        EPI_ROWS(ai, m) {
            const int row = u.pm * 256 + ai * 128 + wr * 64 + m * 16 + fr;
            const float sc = rs[ai][m];
#pragma unroll
            for (int bj = 0; bj < 2; ++bj) {
                const int col = col0 + bj * 8;
                if (u.job == 0) { const u32x4 w = pack8(acc[ai][bj][m][0] * sc, acc[ai][bj][m][1] * sc); bf16_t* dst;
                    if (u.pn < 6) dst = proj + (size_t)row * 1536 + col; else { const int cc = col - 1536; dst = ug + ((size_t)((row >> 12) * 32 + (cc >> 4)) * SEQ + (row & 4095)) * 16 + (cc & 15); }
                    *(u32x4*)dst = w; }
                else { const f32x4 a0 = acc[ai][bj][m][0] * K8S, a1 = acc[ai][bj][m][1] * K8S;
                    unsigned char* dst = (u.job == 1) ? (unsigned char*)kmat + ((size_t)((u.pm * 4 + u.pn) * 256 + (row & 255))) * 256 + (col & 255)
                                                      : (unsigned char*)vt + ((size_t)((u.pn * 4 + u.pm) * 256 + (row & 255))) * 256 + (col & 255);
                    *(u32x2*)dst = (u32x2){pk4_fp8(clamp448(a0[0]), clamp448(a0[1]), clamp448(a0[2]), clamp448(a0[3])), pk4_fp8(clamp448(a1[0]), clamp448(a1[1]), clamp448(a1[2]), clamp448(a1[3]))}; }
            }
        }
    }
};
struct EpiGlu {
    static constexpr bool MID = false; static constexpr bool PROBE2 = false; EPI_PROBE_COPY(EpiGlu)
    const bf16_t* ygelu; bf16_t* ycat; float* ssqs;
    __device__ __forceinline__ void mid(f32x4 (&)[2][2][4][2], const Unit&, int, int, int) const {}
    __device__ __forceinline__ void operator()(const f32x4 (&acc)[2][2][4][2], const Unit& u, int wr, int wc, int fr, int fq, LAS unsigned char*) const {
        const int col0 = u.pn * 256 + wc * 64 + 16 * fq;
#pragma unroll
        for (int ai = 0; ai < 2; ++ai) {
            u32x4 aw[4][2];
#pragma unroll
            for (int m = 0; m < 4; ++m)
#pragma unroll
                for (int bj = 0; bj < 2; ++bj) aw[m][bj] = *(const u32x4*)(ygelu + (size_t)(u.pm * 256 + ai * 128 + wr * 64 + m * 16 + fr) * 512 + col0 + bj * 8);
#pragma unroll
            for (int m = 0; m < 4; ++m) {
                const int row = u.pm * 256 + ai * 128 + wr * 64 + m * 16 + fr; float ss = 0.f;
#pragma unroll
                for (int bj = 0; bj < 2; ++bj) {
                    const u32x4 a = aw[m][bj];
                    f32x4 z0, z1; const f32x4 g0 = acc[ai][bj][m][0], g1 = acc[ai][bj][m][1];
                    { const f32x2 s0 = sigmoid2((f32x2){g0[0], g0[1]}) * (f32x2){bflo(a.x), bfhi(a.x)}, s1 = sigmoid2((f32x2){g0[2], g0[3]}) * (f32x2){bflo(a.y), bfhi(a.y)};
                      const f32x2 s2 = sigmoid2((f32x2){g1[0], g1[1]}) * (f32x2){bflo(a.z), bfhi(a.z)}, s3 = sigmoid2((f32x2){g1[2], g1[3]}) * (f32x2){bflo(a.w), bfhi(a.w)};
                      z0 = (f32x4){s0[0], s0[1], s1[0], s1[1]}; z1 = (f32x4){s2[0], s2[1], s3[0], s3[1]}; }
                    ss += sq8(z0, z1);
                    *(u32x4*)(ycat + (size_t)row * 1024 + col0 + bj * 8) = pack8(z0, z1);
                }
                row_atomic(ssqs + row, ss, fq);
            }
            asm volatile("" ::: "memory");
        }
    }
};
struct EpiRes {
    static constexpr bool MID = true; static constexpr bool PROBE2 = (PROBE_EPI == 4); __device__ __forceinline__ EpiRes probe_copy() const { EpiRes e = *this; e.ssq = ssq + 3 * NTOK; e.skip = (midt < 0); return e; }
    const bf16_t* xsrc; bf16_t* xh; unsigned char* x8; float* ssq; const float* ssqs; int midt; float accs; bool skip = false;
    __device__ __forceinline__ void mid(f32x4 (&acc)[2][2][4][2], const Unit& u, int t, int wr, int fr) const {
        if (t != midt) return;
        EPI_ROWS(ai, m) {
            const int row = u.pm * 256 + ai * 128 + wr * 64 + m * 16 + fr;
            const float sc = rsqrtf(ssqs[row] * (1.0f / 512.0f) + EPS);
#pragma unroll
            for (int bj = 0; bj < 2; ++bj)
#pragma unroll
                for (int n = 0; n < 2; ++n) acc[ai][bj][m][n] *= sc;
        }
    }
    __device__ __forceinline__ void operator()(const f32x4 (&acc)[2][2][4][2], const Unit& u, int wr, int wc, int fr, int fq, LAS unsigned char*) const {
        if (skip) return;
        const int col0 = u.pn * 256 + wc * 64 + 16 * fq;
#pragma unroll
        for (int ai = 0; ai < 2; ++ai) {
            u32x4 rw[4][2];
#pragma unroll
            for (int m = 0; m < 4; ++m)
#pragma unroll
                for (int bj = 0; bj < 2; ++bj) rw[m][bj] = *(const u32x4*)(xsrc + (size_t)(u.pm * 256 + ai * 128 + wr * 64 + m * 16 + fr) * 1024 + col0 + bj * 8);
#pragma unroll
            for (int m = 0; m < 4; ++m) {
                const int row = u.pm * 256 + ai * 128 + wr * 64 + m * 16 + fr; float ss = 0.f;
#pragma unroll
                for (int bj = 0; bj < 2; ++bj) {
                    const size_t off = (size_t)row * 1024 + col0 + bj * 8; const u32x4 w = rw[m][bj];
                    const f32x4 r0 = (f32x4){bflo(w.x), bfhi(w.x), bflo(w.y), bfhi(w.y)}, r1 = (f32x4){bflo(w.z), bfhi(w.z), bflo(w.w), bfhi(w.w)};
                    const f32x4 v0 = r0 + acc[ai][bj][m][0] * accs, v1 = r1 + acc[ai][bj][m][1] * accs;
                    ss += sq8(v0, v1);
                    *(u32x4*)(xh + off) = pack8(v0, v1);
                    *(u32x2*)(x8 + off) = (u32x2){pk4_fp8(clamp448(v0[0] * X8S), clamp448(v0[1] * X8S), clamp448(v0[2] * X8S), clamp448(v0[3] * X8S)), pk4_fp8(clamp448(v1[0] * X8S), clamp448(v1[1] * X8S), clamp448(v1[2] * X8S), clamp448(v1[3] * X8S))};
                }
                row_atomic(ssq + row, ss, fq);
            }
            asm volatile("" ::: "memory");
        }
    }
};
struct EpiQ {
    static constexpr bool MID = false; static constexpr bool PROBE2 = false; EPI_PROBE_COPY(EpiQ)
    const float* ssq2; bf16_t* q;
    __device__ __forceinline__ void mid(f32x4 (&)[2][2][4][2], const Unit&, int, int, int) const {}
    __device__ __forceinline__ void operator()(const f32x4 (&acc)[2][2][4][2], const Unit& u, int wr, int wc, int fr, int fq, LAS unsigned char*) const {
        const int col0 = u.pn * 256 + wc * 64 + 16 * fq;
        float sq[2][4];
        EPI_ROWS(ai, m) sq[ai][m] = ssq2[u.pm * 256 + ai * 128 + wr * 64 + m * 16 + fr];
        EPI_ROWS(ai, m) {
            const int row = u.pm * 256 + ai * 128 + wr * 64 + m * 16 + fr;
            const float sc = rsqrtf(sq[ai][m] * (1.0f / 1024.0f) + EPS) * (1.4426950408889634f / 16.0f) * (1.0f / (X8S * W8S));
#pragma unroll
            for (int bj = 0; bj < 2; ++bj) { const f32x4 a0 = acc[ai][bj][m][0] * (sc * Q8S), a1 = acc[ai][bj][m][1] * (sc * Q8S);
                *(u32x2*)((unsigned char*)q + ((size_t)(((row >> 12) * 4 + u.pn) * SEQ + (row & 4095))) * 256 + (col0 & 255) + bj * 8) = (u32x2){pk4_fp8(clamp448(a0[0]), clamp448(a0[1]), clamp448(a0[2]), clamp448(a0[3])), pk4_fp8(clamp448(a1[0]), clamp448(a1[1]), clamp448(a1[2]), clamp448(a1[3]))}; }
        }
    }
};
struct EpiAttn {
    static constexpr bool MID = false; static constexpr bool PROBE2 = false; EPI_PROBE_COPY(EpiAttn)
    bf16_t* pbuf; bf16_t* o; int c;
    __device__ __forceinline__ void mid(f32x4 (&)[2][2][4][2], const Unit&, int, int, int) const {}
    __device__ __forceinline__ void operator()(const f32x4 (&acc)[2][2][4][2], const Unit& u, int wr, int wc, int fr, int fq, LAS unsigned char* lds) const {
        LAS float* pmax = (LAS float*)(lds + XL_OFF + XL_PMAX);
        LAS float* psum = (LAS float*)(lds + XL_OFF + XL_PSUM) + u.e * 1024;
        if (u.job == 0) {
            EPI_ROWS(ai, m) {
                const int r = ai * 128 + wr * 64 + m * 16 + fr; float mx = -3.0e38f;
#pragma unroll
                for (int bj = 0; bj < 2; ++bj)
#pragma unroll
                    for (int n = 0; n < 2; ++n)
#pragma unroll
                        for (int i = 0; i < 4; ++i) mx = fmaxf(mx, acc[ai][bj][m][n][i]);
                mx = fmaxf(mx, __shfl_xor(mx, 16)); mx = fmaxf(mx, __shfl_xor(mx, 32));
                if (fq == 0) pmax[r * 4 + wc] = mx;
            }
            asm volatile("s_waitcnt lgkmcnt(0)" ::: "memory"); __builtin_amdgcn_s_barrier(); asm volatile("" ::: "memory");
            bf16_t* P = (bf16_t*)((unsigned char*)pbuf + (size_t)(c * 2 + u.e) * 256 * 256);
            EPI_ROWS(ai, m) {
                const int r = ai * 128 + wr * 64 + m * 16 + fr;
                const f32x4 pm4 = *(const LAS f32x4*)(pmax + r * 4);
                const float mx = fmaxf(fmaxf(pm4[0], pm4[1]), fmaxf(pm4[2], pm4[3])); float ss = 0.f;
#pragma unroll
                for (int bj = 0; bj < 2; ++bj) {
                    f32x4 p0, p1;
#pragma unroll
                    for (int i = 0; i < 4; ++i) { p0[i] = __builtin_amdgcn_exp2f((acc[ai][bj][m][0][i] - mx) * (1.0f / (Q8S * K8S))); p1[i] = __builtin_amdgcn_exp2f((acc[ai][bj][m][1][i] - mx) * (1.0f / (Q8S * K8S))); }
                    ss += (p0[0] + p0[1]) + (p0[2] + p0[3]) + (p1[0] + p1[1]) + (p1[2] + p1[3]);
                    *(u32x2*)((unsigned char*)P + (size_t)r * 256 + wc * 64 + 16 * fq + bj * 8) = (u32x2){pk4_fp8(p0[0] * P8S, p0[1] * P8S, p0[2] * P8S, p0[3] * P8S), pk4_fp8(p1[0] * P8S, p1[1] * P8S, p1[2] * P8S, p1[3] * P8S)};
                }
                ss += __shfl_xor(ss, 16); ss += __shfl_xor(ss, 32);
                if (fq == 0) psum[r * 4 + wc] = ss;
                asm volatile("" ::: "memory");
            }
            asm volatile("s_waitcnt vmcnt(0) lgkmcnt(0)" ::: "memory"); __builtin_amdgcn_s_barrier(); asm volatile("" ::: "memory");
        } else {
            const int b = u.pm >> 4, qb = u.pm & 15, h = u.pn;
            EPI_ROWS(ai, m) {
                const int r = ai * 128 + wr * 64 + m * 16 + fr;
                const f32x4 ps = *(const LAS f32x4*)(psum + r * 4);
                const float inv = (O8S / (P8S * K8S)) / ((ps[0] + ps[1]) + (ps[2] + ps[3]));
                unsigned char* dst = (unsigned char*)o + (size_t)(b * SEQ + qb * 256 + r) * 1024 + h * 256 + wc * 64 + 16 * fq;
#pragma unroll
                for (int bj = 0; bj < 2; ++bj) { const f32x4 a0 = acc[ai][bj][m][0] * inv, a1 = acc[ai][bj][m][1] * inv;
                    *(u32x2*)(dst + bj * 8) = (u32x2){pk4_fp8(clamp448(a0[0]), clamp448(a0[1]), clamp448(a0[2]), clamp448(a0[3])), pk4_fp8(clamp448(a1[0]), clamp448(a1[1]), clamp448(a1[2]), clamp448(a1[3]))}; }
            }
        }
    }
};
struct EpiMoe1 {
    static constexpr bool MID = false; static constexpr bool PROBE2 = (PROBE_EPI == 9); EPI_PROBE_COPY(EpiMoe1)
    const float* rstdl; const float* bgu; bf16_t* act;
    __device__ __forceinline__ void mid(f32x4 (&)[2][2][4][2], const Unit&, int, int, int) const {}
    __device__ __forceinline__ void operator()(const f32x4 (&acc)[2][2][4][2], const Unit& u, int wr, int wc, int fr, int fq, LAS unsigned char*) const {
        const int cj = u.pn * 128 + wc * 32 + 8 * fq;
        const float* bg = bgu + (size_t)u.e * 2048 + cj;
        float rs[2][4];
        EPI_ROWS(ai, m) { const int r = ai * 128 + wr * 64 + m * 16 + fr; rs[ai][m] = rstdl[(size_t)u.e * ECAP + u.aux + (r < u.valid ? r : 0)]; }
        const f32x4 bgv[2] = {*(const f32x4*)bg, *(const f32x4*)(bg + 4)}, blv[2] = {*(const f32x4*)(bg + 1024), *(const f32x4*)(bg + 1028)};
        EPI_ROWS(ai, m) {
            const int r = ai * 128 + wr * 64 + m * 16 + fr; const float sc = rs[ai][m] * (1.0f / (X8S * W8S));
            unsigned w[2];
#pragma unroll
            for (int n = 0; n < 2; ++n) { f32x2 o2[2];
#pragma unroll
                for (int h = 0; h < 2; ++h) {
                    const f32x2 ag = {acc[ai][0][m][n][2 * h], acc[ai][0][m][n][2 * h + 1]}, al = {acc[ai][1][m][n][2 * h], acc[ai][1][m][n][2 * h + 1]};
                    const f32x2 bg2 = {bgv[n][2 * h], bgv[n][2 * h + 1]}, bl2 = {blv[n][2 * h], blv[n][2 * h + 1]};
                    f32x2 g = ag * sc + bg2, l = al * sc + bl2;
                    g[0] = fminf(g[0], 7.0f); g[1] = fminf(g[1], 7.0f);
                    l[0] = __builtin_amdgcn_fmed3f(l[0], -7.0f, 7.0f); l[1] = __builtin_amdgcn_fmed3f(l[1], -7.0f, 7.0f);
                    f32x2 e = g * (-1.702f * 1.4426950408889634f);
                    e[0] = __builtin_amdgcn_exp2f(e[0]); e[1] = __builtin_amdgcn_exp2f(e[1]);
                    f32x2 d = e + 1.0f;
                    d[0] = __builtin_amdgcn_rcpf(d[0]); d[1] = __builtin_amdgcn_rcpf(d[1]);
                    o2[h] = (g * d) * (l * A8S + A8S);
                }
                w[n] = pk4_fp8(o2[0][0], o2[0][1], o2[1][0], o2[1][1]); }
            *(u32x2*)((unsigned char*)act + (size_t)(u.pm * 256 + r) * 1024 + cj) = (u32x2){w[0], w[1]};
        }
    }
};
struct EpiMoe2 {
    static constexpr bool MID = false; static constexpr bool PROBE2 = (PROBE_EPI == 10); EPI_PROBE_COPY(EpiMoe2)
    const int* tokl; const float* gatel; const float* bdn; bf16_t* slots;
    __device__ __forceinline__ void mid(f32x4 (&)[2][2][4][2], const Unit&, int, int, int) const {}
    __device__ __forceinline__ void operator()(const f32x4 (&acc)[2][2][4][2], const Unit& u, int wr, int wc, int fr, int fq, LAS unsigned char*) const {
        const int col0 = u.pn * 256 + wc * 64 + 16 * fq;
        const float* bp = bdn + (size_t)u.e * 1024 + col0;
        int sl[2][4]; float gt[2][4];
        EPI_ROWS(ai, m) { const int r = ai * 128 + wr * 64 + m * 16 + fr; const size_t idx = (size_t)u.e * ECAP + u.aux + (r < u.valid ? r : 0); sl[ai][m] = tokl[idx]; gt[ai][m] = gatel[idx]; }
        f32x4 bv[2][2];
#pragma unroll
        for (int bj = 0; bj < 2; ++bj) { bv[bj][0] = *(const f32x4*)(bp + bj * 8); bv[bj][1] = *(const f32x4*)(bp + bj * 8 + 4); }
        EPI_ROWS(ai, m) {
            const int r = ai * 128 + wr * 64 + m * 16 + fr;
            if (r < u.valid) {
                const int slot = sl[ai][m]; const float g = gt[ai][m];
#pragma unroll
                for (int bj = 0; bj < 2; ++bj) { const float gs = g * S8S; const f32x4 o0 = (acc[ai][bj][m][0] * (1.0f / (A8S * W8S)) + bv[bj][0]) * gs, o1 = (acc[ai][bj][m][1] * (1.0f / (A8S * W8S)) + bv[bj][1]) * gs;
                    *(u32x2*)((unsigned char*)slots + (size_t)slot * 1024 + col0 + bj * 8) = (u32x2){pk4_fp8(clamp448(o0[0]), clamp448(o0[1]), clamp448(o0[2]), clamp448(o0[3])), pk4_fp8(clamp448(o1[0]), clamp448(o1[1]), clamp448(o1[2]), clamp448(o1[3]))}; }
            }
        }
    }
};

#define XB_TMO      128
#define XB_XCNT(j)  (256  + 64 * (j))
#define XB_XSUB(j)  (1280 + 64 * (j))
#define XB_XGEN(j)  (2304 + 64 * (j))
#define XB_TOP      3328
#define XB_TOPGEN   3392
#define XCD_BAR_WORDS 3456
#define XB_SPIN_CAP (1u << 20)
__device__ __forceinline__ unsigned xb_ld(unsigned* p)              { return __hip_atomic_load(p, __ATOMIC_RELAXED, __HIP_MEMORY_SCOPE_AGENT); }
__device__ __forceinline__ unsigned xb_add(unsigned* p, unsigned v) { return __hip_atomic_fetch_add(p, v, __ATOMIC_RELAXED, __HIP_MEMORY_SCOPE_AGENT); }
__device__ __forceinline__ unsigned xb_xcc_id() { return (unsigned)__builtin_amdgcn_s_getreg((3 << 11) | 20) & 0xFu; }
#define XB_SPIN(cond, bar) do { unsigned _sp = 0; while (cond) { __builtin_amdgcn_s_sleep(1); \
    if ((++_sp & 255u) == 0u) { if (xb_ld(&(bar)[XB_TMO])) break; if (_sp > XB_SPIN_CAP) { atomicAdd(&(bar)[XB_TMO], 1u); break; } } } } while (0)
struct XcdBarrier { unsigned* bar; unsigned x; volatile LAS unsigned* st; };
__device__ __forceinline__ XcdBarrier xcd_barrier_post(unsigned* bar, volatile LAS unsigned* st) {
    XcdBarrier b; b.bar = bar; b.x = xb_xcc_id(); b.st = st;
    if (threadIdx.x == 0) (void)xb_add(&bar[XB_XCNT(b.x)], 1u);
    return b;
}
__device__ __forceinline__ void xcd_barrier_complete(unsigned* bar, unsigned x, unsigned& nloc, unsigned& nx) {
    const unsigned G = gridDim.x * gridDim.y * gridDim.z;
    unsigned sum, cnt, mine, sp = 0u;
    for (;;) {
        sum = 0u; cnt = 0u; mine = 0u;
#pragma unroll
        for (unsigned j = 0; j < 16; ++j) { const unsigned c = xb_ld(&bar[XB_XCNT(j)]); sum += c; cnt += (c > 0u) ? 1u : 0u; mine = (j == x) ? c : mine; }
        if (sum == G) break;
        __builtin_amdgcn_s_sleep(1);
        if ((++sp & 255u) == 0u) { if (xb_ld(&bar[XB_TMO])) break; if (sp > XB_SPIN_CAP) { atomicAdd(&bar[XB_TMO], 1u); break; } }
    }
    nloc = mine > 0u ? mine : 1u; nx = cnt > 0u ? cnt : 1u;
}
__device__ __forceinline__ void xcd_barrier(const XcdBarrier& b) {
    asm volatile("s_waitcnt vmcnt(0)" ::: "memory");
    __syncthreads();
    if (threadIdx.x == 0) {
        unsigned* bar = b.bar;
        __builtin_amdgcn_s_waitcnt(0);
        unsigned nloc = b.st[0], nx = b.st[1];
        if (nloc == 0u) { xcd_barrier_complete(bar, b.x, nloc, nx); b.st[0] = nloc; b.st[1] = nx; }
        const unsigned old = xb_add(&bar[XB_XSUB(b.x)], 1u);
        const unsigned gen = old / nloc;
        if (old + 1u == (gen + 1u) * nloc) {
            __builtin_amdgcn_fence(__ATOMIC_RELEASE, "agent");
            asm volatile("s_waitcnt vmcnt(0)" ::: "memory");
            const unsigned og = xb_add(&bar[XB_TOP], 1u);
            const unsigned tg = og / nx;
            if (og + 1u == (tg + 1u) * nx) xb_add(&bar[XB_TOPGEN], 1u);
            else XB_SPIN(xb_ld(&bar[XB_TOPGEN]) == tg, bar);
            __builtin_amdgcn_fence(__ATOMIC_ACQUIRE, "agent");
            xb_add(&bar[XB_XGEN(b.x)], 1u);
            asm volatile("s_waitcnt vmcnt(0)" ::: "memory");
        } else {
            XB_SPIN(xb_ld(&bar[XB_XGEN(b.x)]) == gen, bar);
            __builtin_amdgcn_fence(__ATOMIC_ACQUIRE, "agent");
            asm volatile("s_waitcnt vmcnt(0)" ::: "memory");
        }
    }
    __syncthreads();
}

struct Args { const float* in[30]; float* out; unsigned char* ws; int ph_lo, ph_hi; };
enum { I_X = 0, I_MEM, I_NMIX, I_WIN, I_CONVW, I_ARE, I_AIM, I_LOGDT, I_BRE, I_BIM, I_CRE, I_CIM, I_D, I_WGLU, I_NCO, I_NSO, I_WOUT, I_NX, I_NM, I_WQ, I_WKV, I_WO, I_NMOE, I_WR, I_BR, I_WGU, I_BGU, I_WDN, I_BDN, I_NF };

struct CvItem { const float* W; const float* scale; unsigned char* WT; int ldw, k0, n0, ldt, drow0, dk0, f8, rmap; };
__device__ __forceinline__ void cv_load(const CvItem& c, float (&v)[64], int lane) {
    const float* src = c.W + (size_t)c.k0 * c.ldw + c.n0 + lane;
#pragma unroll
    for (int i = 0; i < 64; ++i) v[i] = __builtin_nontemporal_load(src + (size_t)i * c.ldw);
}
__device__ __forceinline__ void cv_store(const CvItem& c, float (&v)[64], int lane, LAS unsigned char* scr) {
    if (c.scale) {
#pragma unroll
        for (int i = 0; i < 64; ++i) v[i] *= c.scale[c.k0 + i];
    }
    if (c.f8) {
#pragma unroll
        for (int q = 0; q < 4; ++q) { u32x4 o; o.x = pk4_fp8(v[16 * q] * W8S, v[16 * q + 1] * W8S, v[16 * q + 2] * W8S, v[16 * q + 3] * W8S); o.y = pk4_fp8(v[16 * q + 4] * W8S, v[16 * q + 5] * W8S, v[16 * q + 6] * W8S, v[16 * q + 7] * W8S);
            o.z = pk4_fp8(v[16 * q + 8] * W8S, v[16 * q + 9] * W8S, v[16 * q + 10] * W8S, v[16 * q + 11] * W8S); o.w = pk4_fp8(v[16 * q + 12] * W8S, v[16 * q + 13] * W8S, v[16 * q + 14] * W8S, v[16 * q + 15] * W8S);
            *(LAS u32x4*)(scr + lane * 80 + 16 * q) = o; }
        asm volatile("s_waitcnt lgkmcnt(0)" ::: "memory");
#pragma unroll
        for (int j = 0; j < 4; ++j) { const int row = 16 * j + (lane >> 2), ch = lane & 3; const u32x4 o = *(const LAS u32x4*)(scr + row * 80 + 16 * ch);
            const int drow = c.drow0 + (c.rmap ? 16 * (row >> 3) + (row & 7) : row);
            *(u32x4*)(c.WT + (size_t)drow * c.ldt + c.dk0 + 16 * ch) = o; }
    } else {
#pragma unroll
        for (int q = 0; q < 8; ++q) { u32x4 o; o.x = pk2(v[8 * q], v[8 * q + 1]); o.y = pk2(v[8 * q + 2], v[8 * q + 3]); o.z = pk2(v[8 * q + 4], v[8 * q + 5]); o.w = pk2(v[8 * q + 6], v[8 * q + 7]);
            *(LAS u32x4*)(scr + lane * 144 + 16 * q) = o; }
        asm volatile("s_waitcnt lgkmcnt(0)" ::: "memory");
#pragma unroll
        for (int j = 0; j < 8; ++j) { const int row = 8 * j + (lane >> 3), ch = lane & 7; const u32x4 o = *(const LAS u32x4*)(scr + row * 144 + 16 * ch);
            *(u32x4*)(c.WT + (size_t)(c.drow0 + row) * c.ldt + c.dk0 + 16 * ch) = o; }
    }
    asm volatile("s_waitcnt lgkmcnt(0)" ::: "memory");
}

__global__ void __launch_bounds__(NTHREADS, 2) mk_fwd(Args args) {
    extern __shared__ __attribute__((aligned(16))) unsigned char lds_raw[];
    LAS unsigned char* lds = (LAS unsigned char*)lds_raw;
    cg::grid_group grid = cg::this_grid();
    const int wave = __builtin_amdgcn_readfirstlane(threadIdx.x >> 6);
#define PH_IDS const int lane = lane_id_volatile(), tid = wave * 64 + lane; (void)lane; (void)tid
    const int G = gridDim.x, bx = blockIdx.x;
#define vcu ((G % 8 == 0) ? (bx % 8) * (G / 8) + bx / 8 : bx)
    unsigned char* const ws = args.ws;
#define PH_WS __attribute__((address_space(1))) unsigned char* ws_ = (__attribute__((address_space(1))) unsigned char*)args.ws; asm volatile("" : "+s"(ws_)); unsigned char* const ws = (unsigned char*)ws_
    const int lo = MK_PER_PHASE ? args.ph_lo : 0, hi = MK_PER_PHASE ? args.ph_hi : 12;
#ifndef PH_MASK
#define PH_MASK 0xfff
#endif
#define IN(k) (((PH_MASK >> (k)) & 1) && lo <= (k) && (k) < hi)
#if MK_USE_CG
#define SEAM(k) do { if (IN(k) && IN((k) + 1)) grid.sync(); STAMP(k); } while (0)
#else
#define SEAM(k) do { if (IN(k) && IN((k) + 1)) { XcdBarrier xb_; xb_.bar = (unsigned*)(ws + WS_BAR); xb_.x = xb_xcc_id(); xb_.st = (volatile LAS unsigned*)(lds + XL_OFF + XL_MISC); xcd_barrier(xb_); } STAMP(k); } while (0)
#endif
#if PROBE_PHASE >= 0 || PROBE_A >= 0
    unsigned long long* stamps = (unsigned long long*)(ws + WS_STAMP);
#define STAMP(k) do { if (bx == 0 && threadIdx.x == 0) stamps[(k) + 1] = __builtin_amdgcn_s_memrealtime(); } while (0)
    if (bx == 0 && threadIdx.x == 0) stamps[0] = __builtin_amdgcn_s_memrealtime();
#define STAMPX(i) do { if (bx == 0 && threadIdx.x == 0) stamps[(i)] = __builtin_amdgcn_s_memrealtime(); } while (0)
#else
#define STAMP(k) do { } while (0)
#define STAMPX(i) do { } while (0)
#endif
    volatile LAS unsigned* misc = (volatile LAS unsigned*)(lds + XL_OFF + XL_MISC);
    if (threadIdx.x == 0) { misc[0] = 0u; misc[1] = 0u; }
    __syncthreads();
    if (!MK_PER_PHASE && !MK_USE_CG) (void)xcd_barrier_post((unsigned*)(ws + WS_BAR), misc);
#define gw (vcu * NWAVES + wave)
#define NGW (G * NWAVES)
#define counts ((int*)(ws + WS_CNT))
#define rstd1 ((float*)(ws + WS_RSTD1))
#define ssqs ((float*)(ws + WS_SSQS))
#define ssq2 ((float*)(ws + WS_SSQ2))
#define ssq3 ((float*)(ws + WS_SSQ3))
#define gates ((float*)(ws + WS_GATES))
#define gatel ((float*)(ws + WS_GATEL))
#define rstdl ((float*)(ws + WS_RSTDL))
#define wrs ((float*)(ws + WS_WR))
#define tokl ((int*)(ws + WS_TOKL))
#define xb ((bf16_t*)(ws + WS_XB))
#define proj ((bf16_t*)(ws + WS_PROJ))
#define ug ((bf16_t*)(ws + WS_UG))
#define ycat ((bf16_t*)(ws + WS_YCAT))
#define ygelu ((bf16_t*)(ws + WS_YGELU))
#define x8 ((unsigned char*)(ws + WS_X1))
#define xh ((bf16_t*)(ws + WS_XH))
#define qo ((bf16_t*)(ws + WS_QO))
#define pbuf ((bf16_t*)(ws + WS_PBUF))
#define ob ((bf16_t*)(ws + WS_O))
#define act ((bf16_t*)(ws + WS_ACT))
#define slots ((bf16_t*)(ws + WS_SLOTS))
#define memn ((bf16_t*)(ws + WS_MEMN))
#define kmat ((bf16_t*)(ws + WS_KMAT))
#define vt ((bf16_t*)(ws + WS_VT))

#define CV_I_IN (16 * 32)
#define CV_I_GLU (8 * 8)
#define CV_I_OUT (16 * 16)
#define CV_I_Q (16 * 16)
#define CV_I_KV (16 * 32)
#define CV_I_O (16 * 16)
#define CV_I_GU (32 * 16 * 32)
#define CV_I_DN (32 * 16 * 16)
#define CV_NIT (CV_I_IN + CV_I_GLU + CV_I_OUT + CV_I_Q + CV_I_KV + CV_I_O + CV_I_GU + CV_I_DN)
#define CV_DECODE(c, it) do { int r = (it); \
                if (r < CV_I_GU) { const int e = r / 512, q = r % 512, kb = q / 32, nb = q % 32, n0 = nb * 64, j = n0 & 1023, lin = n0 >> 10; \
                    c = CvItem{args.in[I_WGU] + (size_t)e * 1024 * 2048, args.in[I_NMOE], ws + WS_WGU + (size_t)e * 2048 * 1024, 2048, kb * 64, n0, 1024, 256 * (j >> 7) + 8 * lin + 2 * (j & 127), kb * 64, 1, 1}; break; } r -= CV_I_GU; \
                if (r < CV_I_IN) { const int kb = r / 32, nb = r % 32; c = CvItem{args.in[I_WIN], args.in[I_NMIX], ws + WS_WIN, 2048, kb * 64, nb * 64, 2048, nb * 64, kb * 128, 0, 0}; break; } r -= CV_I_IN; \
                if (r < CV_I_GLU) { const int kb = r / 8, nb = r % 8; c = CvItem{args.in[I_WGLU], nullptr, ws + WS_WGLU, 512, kb * 64, nb * 64, 1024, nb * 64, kb * 128, 0, 0}; break; } r -= CV_I_GLU; \
                if (r < CV_I_OUT) { const int kb = r / 16, nb = r % 16, k0 = kb * 64;        \
                    c = CvItem{args.in[I_WOUT], (k0 < 512) ? args.in[I_NCO] : args.in[I_NSO] - 512, ws + WS_WOUT, 1024, k0, nb * 64, 2048, nb * 64, ((k0 + 512) & 1023) * 2, 0, 0}; break; } r -= CV_I_OUT; \
                if (r < CV_I_Q) { const int kb = r / 16, nb = r % 16; c = CvItem{args.in[I_WQ], args.in[I_NX], ws + WS_WQ, 1024, kb * 64, nb * 64, 1024, nb * 64, kb * 64, 1, 0}; break; } r -= CV_I_Q; \
                if (r < CV_I_KV) { const int kb = r / 32, nb = r % 32, n0 = nb * 64; c = CvItem{args.in[I_WKV], nullptr, ws + (n0 < 1024 ? WS_WK : WS_WV), 2048, kb * 64, n0, 2048, n0 & 1023, kb * 128, 0, 0}; break; } r -= CV_I_KV; \
                if (r < CV_I_O) { const int kb = r / 16, nb = r % 16; c = CvItem{args.in[I_WO], nullptr, ws + WS_WO, 1024, kb * 64, nb * 64, 1024, nb * 64, kb * 64, 1, 0}; break; } r -= CV_I_O; \
                { const int e = r / 256, q = r % 256, kb = q / 16, nb = q % 16; \
                    c = CvItem{args.in[I_WDN] + (size_t)e * 1024 * 1024, nullptr, ws + WS_WDN + (size_t)e * 1024 * 1024, 1024, kb * 64, nb * 64, 1024, nb * 64, kb * 64, 1, 0}; } } while (0)
#define CV_STREAM(first, step, lo, hi) do { float va[64], vb[64]; CvItem ca, cb; LAS unsigned char* cvscr = lds + wave * 10240; \
        int it = (lo) + (first); \
        if (it < (hi)) { CV_DECODE(ca, it); cv_load(ca, va, lane); } \
        while (it < (hi)) { \
            int it2 = it + (step); \
            if (it2 < (hi)) { CV_DECODE(cb, it2); cv_load(cb, vb, lane); } \
            cv_store(ca, va, lane, cvscr); \
            it = it2; if (it >= (hi)) break; \
            it2 = it + (step); \
            if (it2 < (hi)) { CV_DECODE(ca, it2); cv_load(ca, va, lane); } \
            cv_store(cb, vb, lane, cvscr); \
            it = it2; } } while (0)
    if (IN(0)) {
        PH_WS;
        PH_IDS;
        for (int i = bx * NTHREADS + tid; i < 3 * NTOK; i += G * NTHREADS) ssqs[i] = 0.f;
        if (bx == 0 && tid < NEXP) counts[tid] = 0;
        for (int i = bx * NTHREADS + tid; i < DM * NEXP; i += G * NTHREADS) wrs[i] = args.in[I_WR][i] * args.in[I_NMOE][i >> 5];
        for (int item = bx; item < 256; item += G) {
            const int g = item >> 3, part = item & 7;
            LAS float* Wp = (LAS float*)lds;
            LAS float* Bb = Wp + 65 * 128;
            LAS float* Cc = Bb + 64 * 32;
            const float dt = __expf(args.in[I_LOGDT][g]);
            __syncthreads();
            for (int i = tid; i < 65 * 64; i += NTHREADS) { const int p = i >> 6, j = i & 63; const float ar = args.in[I_ARE][g * 64 + j], aim = args.in[I_AIM][g * 64 + j];
                const float mag = expf((float)p * dt * ar); float sn, cs; sincosf((float)p * dt * aim, &sn, &cs); Wp[i * 2] = mag * cs; Wp[i * 2 + 1] = mag * sn; }
            for (int i = tid; i < 64 * 16; i += NTHREADS) { const int j = i >> 4; const float ar = args.in[I_ARE][g * 64 + j], aim = args.in[I_AIM][g * 64 + j];
                float sn, cs; sincosf(dt * aim, &sn, &cs); const float em1 = expm1f(dt * ar); float sh, ch; sincosf(0.5f * dt * aim, &sh, &ch);
                const float pre = em1 * cs - 2.0f * sh * sh, pim = (em1 + 1.0f) * sn, den = ar * ar + aim * aim;
                const float qre = (pre * ar + pim * aim) / den, qim = (pim * ar - pre * aim) / den;
                const float br = args.in[I_BRE][(size_t)g * 1024 + i], bi = args.in[I_BIM][(size_t)g * 1024 + i];
                Bb[i * 2] = qre * br - qim * bi; Bb[i * 2 + 1] = qre * bi + qim * br; }
            for (int i = tid; i < 16 * 64; i += NTHREADS) { Cc[i * 2] = args.in[I_CRE][(size_t)g * 1024 + i]; Cc[i * 2 + 1] = args.in[I_CIM][(size_t)g * 1024 + i]; }
            __syncthreads();
            unsigned char* tab = ws + WS_SSM + (size_t)g * SSM_STRIDE;
            if (part == 0 && tid < 64) { ((float*)tab)[tid * 2] = Wp[(64 * 64 + tid) * 2]; ((float*)tab)[tid * 2 + 1] = Wp[(64 * 64 + tid) * 2 + 1]; }
            bf16_t* Kt = (bf16_t*)(tab + SSM_KT); bf16_t* Pt = (bf16_t*)(tab + SSM_PT); bf16_t* Qt = (bf16_t*)(tab + SSM_QT);
            {
                const int lag = 8 * part + (tid >> 6), c = (tid >> 2) & 15, cp0 = (tid & 3) * 4; float s0 = 0.f, s1 = 0.f, s2 = 0.f, s3 = 0.f;
#pragma unroll 4
                for (int j = 0; j < 64; ++j) { const f32x2 w = *(const LAS f32x2*)(Wp + (lag * 64 + j) * 2), cc = *(const LAS f32x2*)(Cc + (c * 64 + j) * 2);
                    const float xr = cc[0] * w[0] - cc[1] * w[1], xi = cc[0] * w[1] + cc[1] * w[0];
                    const f32x4 b0 = *(const LAS f32x4*)(Bb + (j * 16 + cp0) * 2), b1 = *(const LAS f32x4*)(Bb + (j * 16 + cp0 + 2) * 2);
                    s0 += xr * b0[0] - xi * b0[1]; s1 += xr * b0[2] - xi * b0[3]; s2 += xr * b1[0] - xi * b1[1]; s3 += xr * b1[2] - xi * b1[3]; }
                *(u32x2*)(Kt + (size_t)lag * 256 + c * 16 + cp0) = (u32x2){pk2(s0, s1), pk2(s2, s3)};
            }
            {
                const int k = 2 * tid, sidx = k >> 4, cp = k & 15;
#pragma unroll 4
                for (int r = 0; r < 16; ++r) { const int n = 16 * part + r, ri = n >> 6, j = n & 63;
                    const f32x2 w = *(const LAS f32x2*)(Wp + ((63 - sidx) * 64 + j) * 2); const f32x4 b = *(const LAS f32x4*)(Bb + (j * 16 + cp) * 2);
                    const float v0 = ri ? (w[0] * b[1] + w[1] * b[0]) : (w[0] * b[0] - w[1] * b[1]), v1 = ri ? (w[0] * b[3] + w[1] * b[2]) : (w[0] * b[2] - w[1] * b[3]);
                    *(unsigned*)(Pt + (size_t)n * 1024 + k) = pk2(v0, v1); }
            }
            {
                const int n = 2 * (tid & 63), ri = n >> 6, j = n & 63;
#pragma unroll 4
                for (int r = 0; r < 16; ++r) { const int tc = 128 * part + (tid >> 6) + 8 * r, t = tc >> 4, c = tc & 15;
                    const f32x4 w = *(const LAS f32x4*)(Wp + ((t + 1) * 64 + j) * 2), cc = *(const LAS f32x4*)(Cc + (c * 64 + j) * 2);
                    const float v0 = ri ? -(cc[0] * w[1] + cc[1] * w[0]) : (cc[0] * w[0] - cc[1] * w[1]), v1 = ri ? -(cc[2] * w[3] + cc[3] * w[2]) : (cc[2] * w[2] - cc[3] * w[3]);
                    *(unsigned*)(Qt + (size_t)tc * 128 + n) = pk2(v0, v1); }
            }
        }
        STAMPX(30);
        for (int m4 = gw * 4; m4 < NTOK + NMEM; m4 += NGW * 4) {
            const bool isx = m4 < NTOK; const int r0 = isx ? m4 : m4 - NTOK;
            const f32x4* xr = (const f32x4*)((isx ? args.in[I_X] : args.in[I_MEM]) + (size_t)r0 * DM) + lane;
            f32x4 v[4][4];
#pragma unroll
            for (int q = 0; q < 4; ++q)
#pragma unroll
                for (int j = 0; j < 4; ++j) v[q][j] = __builtin_nontemporal_load(xr + q * 256 + 64 * j);
#pragma unroll
            for (int q = 0; q < 4; ++q) {
                float ss = 0.f;
#pragma unroll
                for (int j = 0; j < 4; ++j) ss += (v[q][j][0] * v[q][j][0] + v[q][j][1] * v[q][j][1]) + (v[q][j][2] * v[q][j][2] + v[q][j][3] * v[q][j][3]);
                const float rs = rsqrtf(wave_sum(ss) * (1.f / DM) + EPS);
                u32x2* o8 = (u32x2*)((isx ? xb : memn) + (size_t)(r0 + q) * DM) + lane;
                if (isx) { if (lane == 0) rstd1[r0 + q] = rs;
#pragma unroll
                    for (int j = 0; j < 4; ++j) o8[64 * j] = (u32x2){pk2(v[q][j][0], v[q][j][1]), pk2(v[q][j][2], v[q][j][3])}; }
                else {
#pragma unroll
                    for (int j = 0; j < 4; ++j) { const f32x4 g = ((const f32x4*)args.in[I_NM])[lane + 64 * j]; o8[64 * j] = (u32x2){pk2(v[q][j][0] * rs * g[0], v[q][j][1] * rs * g[1]), pk2(v[q][j][2] * rs * g[2], v[q][j][3] * rs * g[3])}; } }
            }
        }
        STAMPX(31);
        {
            __syncthreads();
            CV_STREAM(gw, NGW, 0, (G == 256) ? CV_NIT - CV_I_DN : CV_NIT);
        }
    }
    SEAM(0);
    if (IN(1)) {
        PH_WS;
        SchedP1 S{(const char*)xb, (const char*)(ws + WS_WIN), (const char*)memn, (const char*)(ws + WS_WK), (const char*)(ws + WS_WV), 2048u, 2048u, 1024, G, bx};
        EpiP1 E{rstd1, proj, ug, kmat, vt};
        g8::gemm_phase(lds, S, E, wave);
        if (G == 256 && bx >= 64) { PH_IDS; CV_STREAM((bx - 64) * NWAVES + wave, 192 * NWAVES, CV_NIT - CV_I_DN, CV_NIT); }
    }
    SEAM(1);
    if (IN(2)) {
        PH_WS;
        PH_IDS;
        constexpr int L_KT = 0, L_SPV = 32768, L_UH = 49152, UROW = 1040, L_STG = 115712;
        const int l15 = lane & 15, lq = lane >> 4;
        for (int it_ = vcu; it_ < BATCH * 32; it_ += G) {
            const int g = (it_ >> 5) * 4 + (it_ & 3), b = (it_ >> 2) & 7, item = b * 32 + g;
            const bf16_t* ugp = ug + (size_t)item * SEQ * 16;
            const unsigned char* tab = ws + WS_SSM + (size_t)g * SSM_STRIDE;
            const float* A64 = (const float*)tab; const bf16_t* Kt = (const bf16_t*)(tab + SSM_KT); const bf16_t* Pt = (const bf16_t*)(tab + SSM_PT); const bf16_t* Qt = (const bf16_t*)(tab + SSM_QT);
#define STAGE_U(p) do { _Pragma("unroll") for (int _i = 0; _i < 8; ++_i) { const int _c = wave * 8 + _i; \
                const u32x4 _v = *(const u32x4*)(ugp + ((size_t)_c * 64 + 32 * (p)) * 16 + lane * 8); *(LAS u32x4*)(lds + L_UH + _c * UROW + lane * 16) = _v; } } while (0)
#define UFRAG(mb, kk) (*(const LAS bf16x8*)(lds + L_UH + (16 * (mb) + l15) * UROW + (32 * (kk) + 8 * lq) * 2))
            f32x4 sacc[4];
#pragma unroll
            for (int mb = 0; mb < 4; ++mb) sacc[mb] = (f32x4){0.f, 0.f, 0.f, 0.f};
#pragma unroll 1
            for (int p = 0; p < 2; ++p) {
                bf16x8 pf[16];
#pragma unroll
                for (int kk = 0; kk < 16; ++kk) pf[kk] = *(const bf16x8*)(Pt + (size_t)(16 * wave + l15) * 1024 + 32 * (16 * p + kk) + 8 * lq);
                __syncthreads(); STAGE_U(p); __syncthreads();
#pragma unroll
                for (int kk = 0; kk < 16; ++kk) {
#pragma unroll
                    for (int mb = 0; mb < 4; ++mb) sacc[mb] = __builtin_amdgcn_mfma_f32_16x16x32_bf16(UFRAG(mb, kk), pf[kk], sacc[mb], 0, 0, 0);
                }
            }
            STAMPX(20);
            { LAS float* Sl = (LAS float*)(lds + L_KT);
#pragma unroll
              for (int mb = 0; mb < 4; ++mb)
#pragma unroll
                for (int r = 0; r < 4; ++r) Sl[(16 * mb + 4 * lq + r) * 128 + 16 * wave + l15] = sacc[mb][r]; }
            __syncthreads();
            if (wave == 0) {
                const LAS float* Sl = (const LAS float*)(lds + L_KT); LAS bf16_t* Sp = (LAS bf16_t*)(lds + L_SPV);
                const float ar = A64[lane * 2], ai = A64[lane * 2 + 1]; float sr = 0.f, si = 0.f;
#pragma unroll 2
                for (int c = 0; c < 64; ++c) { Sp[c * 128 + lane] = (bf16_t)f2bf(sr); Sp[c * 128 + 64 + lane] = (bf16_t)f2bf(si);
                    const float lr = Sl[c * 128 + lane], li = Sl[c * 128 + 64 + lane]; const float nr = ar * sr - ai * si + lr, ni = ar * si + ai * sr + li; sr = nr; si = ni; }
            }
            __syncthreads();
            { const u32x4* src = (const u32x4*)Kt;
#pragma unroll
              for (int i = 0; i < 4; ++i) *(LAS u32x4*)(lds + L_KT + (tid + i * NTHREADS) * 16) = src[tid + i * NTHREADS]; }
            __syncthreads();
            STAMPX(21);
            const f32x4 dv4 = *(const f32x4*)(args.in[I_D] + g * 16 + (lane & 3) * 4);
#pragma unroll 1
            for (int ig = 1; ig >= 0; --ig) {
                f32x4 acc[4][4];
#pragma unroll
                for (int i = 0; i < 4; ++i)
#pragma unroll
                    for (int mb = 0; mb < 4; ++mb) acc[i][mb] = (f32x4){0.f, 0.f, 0.f, 0.f};
                const int tb0 = wave + 32 * ig, tmax = tb0 + 24;
                bf16x8 qf[4][4];
#pragma unroll
                for (int kq = 0; kq < 4; ++kq)
#pragma unroll
                    for (int i = 0; i < 4; ++i) qf[kq][i] = *(const bf16x8*)(Qt + (size_t)((tb0 + 8 * i) * 16 + l15) * 128 + 32 * kq + 8 * lq);
#pragma unroll 1
                for (int p = ig; p >= 0; --p) {
                    if (ig == 1 && p == 0) { __syncthreads(); STAGE_U(0); __syncthreads(); }
#pragma unroll 1
                    for (int kk = 0; kk < 16; ++kk) {
                        const int s0 = 32 * p + 2 * kk; if (s0 > tmax) break;
                        bf16x8 af[4];
#pragma unroll
                        for (int mb = 0; mb < 4; ++mb) af[mb] = UFRAG(mb, kk);
                        const int s = s0 + (lq >> 1);
#pragma unroll
                        for (int i = 0; i < 4; ++i) { const int t = tb0 + 8 * i;
                            if (t >= s0) { const int lag = t - s; bf16x8 bfr = *(const LAS bf16x8*)(lds + L_KT + (((lag < 0 ? 0 : lag) * 16 + l15) * 16 + 8 * (lq & 1)) * 2);
                                if (lag < 0) bfr = (bf16x8){0, 0, 0, 0, 0, 0, 0, 0};
#pragma unroll
                                for (int mb = 0; mb < 4; ++mb) acc[i][mb] = __builtin_amdgcn_mfma_f32_16x16x32_bf16(af[mb], bfr, acc[i][mb], 0, 0, 0); } }
                    }
                }
#pragma unroll
                for (int kq = 0; kq < 4; ++kq) {
                    bf16x8 af[4];
#pragma unroll
                    for (int mb = 0; mb < 4; ++mb) af[mb] = *(const LAS bf16x8*)(lds + L_SPV + ((16 * mb + l15) * 128 + 32 * kq + 8 * lq) * 2);
#pragma unroll
                    for (int i = 0; i < 4; ++i) {
#pragma unroll
                        for (int mb = 0; mb < 4; ++mb) acc[i][mb] = __builtin_amdgcn_mfma_f32_16x16x32_bf16(af[mb], qf[kq][i], acc[i][mb], 0, 0, 0); }
                }
                LAS float* stg = (LAS float*)(lds + L_STG + wave * 2048);
#pragma unroll
                for (int i = 0; i < 4; ++i) { const int t = tb0 + 8 * i;
                    u32x2 uq[2][2];
#pragma unroll
                    for (int hf = 0; hf < 2; ++hf)
#pragma unroll
                        for (int it = 0; it < 2; ++it) uq[hf][it] = *(const u32x2*)(ugp + (size_t)((32 * hf + ((it * 64 + lane) >> 2)) * 64 + t) * 16 + (lane & 3) * 4);
#pragma unroll
                    for (int hf = 0; hf < 2; ++hf) {
#pragma unroll
                        for (int ml = 0; ml < 2; ++ml)
#pragma unroll
                            for (int r = 0; r < 4; ++r) stg[(16 * ml + 4 * lq + r) * 16 + l15] = acc[i][2 * hf + ml][r];
                        asm volatile("s_waitcnt lgkmcnt(0)" ::: "memory");
#pragma unroll
                        for (int it = 0; it < 2; ++it) { const int idx = it * 64 + lane, tt = (32 * hf + (idx >> 2)) * 64 + t, c4 = (idx & 3) * 4;
                            const f32x4 yv = *(const LAS f32x4*)(stg + idx * 4); const u32x2 uu = uq[hf][it];
                            const f32x2 ya = gelu_tanh2((f32x2){yv[0], yv[1]} + (f32x2){dv4[0], dv4[1]} * (f32x2){bflo(uu.x), bfhi(uu.x)}), yb = gelu_tanh2((f32x2){yv[2], yv[3]} + (f32x2){dv4[2], dv4[3]} * (f32x2){bflo(uu.y), bfhi(uu.y)});
                            *(u32x2*)(ygelu + (size_t)(b * SEQ + tt) * 512 + g * 16 + c4) = (u32x2){cvt_pk_bf16(ya[0], ya[1]), cvt_pk_bf16(yb[0], yb[1])}; }
                        asm volatile("s_waitcnt lgkmcnt(0)" ::: "memory");
                    }
                }
            }
#undef STAGE_U
#undef UFRAG
        }
        STAMPX(22);
        {
            const int ch = lane * 8;
            float w0[8], w1[8], w2[8];
#pragma unroll
            for (int i = 0; i < 8; ++i) { w0[i] = args.in[I_CONVW][ch + i]; w1[i] = args.in[I_CONVW][512 + ch + i]; w2[i] = args.in[I_CONVW][1024 + ch + i]; }
            for (int run = gw; run < NTOK / 16; run += NGW) {
                const int r0 = run * 16, tin = r0 & (SEQ - 1);
                float vm2[8], vm1[8];
#pragma unroll
                for (int i = 0; i < 8; ++i) { vm2[i] = 0.f; vm1[i] = 0.f; }
                if (tin > 0) {
#pragma unroll
                    for (int d = 2; d >= 1; --d) { const bf16_t* pr = proj + (size_t)(r0 - d) * 1536;
                        const u32x4 c4 = *(const u32x4*)(pr + 512 + ch), x4 = *(const u32x4*)(pr + 1024 + ch);
                        float v[8]; v[0] = bflo(c4.x) * bflo(x4.x); v[1] = bfhi(c4.x) * bfhi(x4.x); v[2] = bflo(c4.y) * bflo(x4.y); v[3] = bfhi(c4.y) * bfhi(x4.y);
                        v[4] = bflo(c4.z) * bflo(x4.z); v[5] = bfhi(c4.z) * bfhi(x4.z); v[6] = bflo(c4.w) * bflo(x4.w); v[7] = bfhi(c4.w) * bfhi(x4.w);
#pragma unroll
                        for (int i = 0; i < 8; ++i) { if (d == 2) vm2[i] = v[i]; else vm1[i] = v[i]; } }
                }
#pragma unroll 1
                for (int tb = 0; tb < 16; tb += 8) {
                    u32x4 b4[8], c4[8], x4[8];
#pragma unroll
                    for (int q = 0; q < 8; ++q) { const bf16_t* pr = proj + (size_t)(r0 + tb + q) * 1536; b4[q] = *(const u32x4*)(pr + ch); c4[q] = *(const u32x4*)(pr + 512 + ch); x4[q] = *(const u32x4*)(pr + 1024 + ch); }
#pragma unroll
                    for (int q = 0; q < 8; ++q) {
                        float v[8], bgv[8], y[8]; v[0] = bflo(c4[q].x) * bflo(x4[q].x); v[1] = bfhi(c4[q].x) * bfhi(x4[q].x); v[2] = bflo(c4[q].y) * bflo(x4[q].y); v[3] = bfhi(c4[q].y) * bfhi(x4[q].y);
                        v[4] = bflo(c4[q].z) * bflo(x4[q].z); v[5] = bfhi(c4[q].z) * bfhi(x4[q].z); v[6] = bflo(c4[q].w) * bflo(x4[q].w); v[7] = bfhi(c4[q].w) * bfhi(x4[q].w);
                        bgv[0] = bflo(b4[q].x); bgv[1] = bfhi(b4[q].x); bgv[2] = bflo(b4[q].y); bgv[3] = bfhi(b4[q].y); bgv[4] = bflo(b4[q].z); bgv[5] = bfhi(b4[q].z); bgv[6] = bflo(b4[q].w); bgv[7] = bfhi(b4[q].w);
                        float ss = 0.f;
#pragma unroll
                        for (int i = 0; i < 8; ++i) { y[i] = bgv[i] * (w0[i] * vm2[i] + w1[i] * vm1[i] + w2[i] * v[i]); ss += y[i] * y[i]; vm2[i] = vm1[i]; vm1[i] = v[i]; }
                        const float rs = rsqrtf(wave_sum(ss) * (1.f / 512.f) + EPS);
                        u32x4 o; o.x = pk2(y[0] * rs, y[1] * rs); o.y = pk2(y[2] * rs, y[3] * rs); o.z = pk2(y[4] * rs, y[5] * rs); o.w = pk2(y[6] * rs, y[7] * rs);
                        *(u32x4*)(ycat + (size_t)(r0 + tb + q) * 1024 + 512 + ch) = o;
                    }
                }
            }
        }
    }
    SEAM(2);
    if (IN(3)) {
        PH_WS;
        SchedDense S{(const char*)ygelu, (const char*)(ws + WS_WGLU), 1024u, 1024u, 512, NTOK / 256, 2, G, bx};
        EpiGlu E{ygelu, ycat, ssqs};
        g8::gemm_phase(lds, S, E, wave);
    }
    SEAM(3);
    if (IN(4)) {
        PH_WS;
        SchedDense S{(const char*)ycat, (const char*)(ws + WS_WOUT), 2048u, 2048u, 1024, NTOK / 256, 4, G, bx};
        EpiRes E{xb, xh, x8, ssq2, ssqs, 6, 1.0f};
        g8::gemm_phase(lds, S, E, wave);
    }
    SEAM(4);
    if (IN(5)) {
        PH_WS;
        SchedQ S{(const char*)x8, (const char*)(ws + WS_WQ), 1024u, 1024u, 512, G, bx};
        EpiQ E{ssq2, qo};
        g8::gemm_phase(lds, S, E, wave);
    }
    STAMP(5);
    if (IN(6)) {
        PH_WS;
        SchedAttn S{(const char*)qo, (const char*)kmat, (const char*)vt, (const char*)pbuf, 256u, 256u, 128, G, bx, (BATCH * 4 * 16) / G};
        EpiAttn E{pbuf, ob, bx};
        g8::gemm_phase(lds, S, E, wave);
    }
    SEAM(6);
    if (IN(7)) {
        PH_WS;
        SchedDenseT<true> S{(const char*)ob, (const char*)(ws + WS_WO), 1024u, 1024u, 512, NTOK / 256, 4, G, bx};
        EpiRes E{xh, xh, x8, ssq3, ssqs, -1, 1.0f / (O8S * W8S)};
        g8::gemm_phase(lds, S, E, wave);
    }
    SEAM(7);
    if (IN(8)) {
        PH_WS;
        PH_IDS;
        LAS float* Xs = (LAS float*)lds;
        LAS float* Ws = (LAS float*)(lds + 34816);
        LAS float* Lg = (LAS float*)(lds + 69632);
        LAS int* hist = (LAS int*)(lds + 86528);
        LAS int* hbase = (LAS int*)(lds + 86656);
        const int te = tid & 7, tt = (tid >> 3) & 15, ks = tid >> 7;
        for (int blk = vcu; blk < NTOK / 128; blk += G) {
            const int r0 = blk * 128;
            float ac[8][4];
#pragma unroll
            for (int a = 0; a < 8; ++a)
#pragma unroll
                for (int e = 0; e < 4; ++e) ac[a][e] = 0.f;
            if (tid < 32) hist[tid] = 0;
            u32x2 xa[4], xb_[4]; f32x4 wa, wb;
#define P8_LOAD(xr, wv, kc) do { _Pragma("unroll") for (int j = 0; j < 4; ++j) xr[j] = *(const u32x2*)(xh + (size_t)(r0 + (tid >> 4) + 32 * j) * DM + (kc) * 64 + 4 * (tid & 15)); \
                wv = *(const f32x4*)(wrs + (size_t)((kc) * 64 + (tid >> 3)) * 32 + 4 * (tid & 7)); } while (0)
#define P8_STEP(xr, wv, kc) do { __syncthreads(); \
                _Pragma("unroll") for (int j = 0; j < 4; ++j) *(LAS f32x4*)(Xs + ((tid >> 4) + 32 * j) * 68 + 4 * (tid & 15)) = (f32x4){bflo(xr[j].x), bfhi(xr[j].x), bflo(xr[j].y), bfhi(xr[j].y)}; \
                *(LAS f32x4*)(Ws + (tid >> 3) * 32 + 4 * (tid & 7)) = wv; \
                __syncthreads(); \
                if ((kc) + 2 < 16) P8_LOAD(xr, wv, (kc) + 2); \
                _Pragma("unroll 2") \
                for (int q = 0; q < 4; ++q) { const int k4 = 4 * ks + q; \
                    f32x4 xv[8], w4[4]; \
                _Pragma("unroll") \
                    for (int i = 0; i < 8; ++i) xv[i] = *(const LAS f32x4*)(Xs + (tt + 16 * i) * 68 + 4 * k4); \
                _Pragma("unroll") \
                    for (int kk = 0; kk < 4; ++kk) w4[kk] = *(const LAS f32x4*)(Ws + (4 * k4 + kk) * 32 + 4 * te); \
                _Pragma("unroll") \
                    for (int i = 0; i < 8; ++i) \
                _Pragma("unroll") \
                        for (int kk = 0; kk < 4; ++kk) \
                _Pragma("unroll") \
                            for (int e = 0; e < 4; ++e) ac[i][e] += xv[i][kk] * w4[kk][e]; } \
                } while (0)
            P8_LOAD(xa, wa, 0); P8_LOAD(xb_, wb, 1);
            for (int kc = 0; kc < 16; kc += 2) { P8_STEP(xa, wa, kc); P8_STEP(xb_, wb, kc + 1); }
#undef P8_STEP
#undef P8_LOAD
            __syncthreads();
            { LAS float* Lp = (LAS float*)lds;
#pragma unroll
              for (int i = 0; i < 8; ++i)
#pragma unroll
                for (int e = 0; e < 4; ++e) Lp[(ks * 128 + tt + 16 * i) * 33 + 4 * te + e] = ac[i][e]; }
            __syncthreads();
            for (int o = tid; o < 128 * 32; o += NTHREADS) { const int t = o >> 5, e = o & 31; const LAS float* Lp = (const LAS float*)lds;
                const float sum = (Lp[t * 33 + e] + Lp[(128 + t) * 33 + e]) + (Lp[(256 + t) * 33 + e] + Lp[(384 + t) * 33 + e]);
                Lg[t * 33 + e] = sum * rsqrtf(ssq3[r0 + t] * (1.0f / 1024.0f) + EPS) + args.in[I_BR][e]; }
            __syncthreads();
            int ei[4], lp[4]; float gv[4];
            if (tid < 128) {
                unsigned taken = 0u; float tv[4];
#pragma unroll
                for (int k = 0; k < 4; ++k) { float best = -3.0e38f; int bi = 0;
                    for (int e = 0; e < 32; ++e) { const float v = Lg[tid * 33 + e]; if (!((taken >> e) & 1u) && v > best) { best = v; bi = e; } }
                    taken |= 1u << bi; ei[k] = bi; tv[k] = best; }
                float sum = 0.f;
#pragma unroll
                for (int k = 0; k < 4; ++k) { gv[k] = __expf(tv[k] - tv[0]); sum += gv[k]; }
                const float inv = 1.0f / sum;
#pragma unroll
                for (int k = 0; k < 4; ++k) { gv[k] *= inv; lp[k] = __hip_atomic_fetch_add((LAS int*)(hist + ei[k]), 1, __ATOMIC_RELAXED, __HIP_MEMORY_SCOPE_WORKGROUP); }
            }
            __syncthreads();
            if (tid < 32) hbase[tid] = atomicAdd(counts + tid, hist[tid]);
            __syncthreads();
            if (tid < 128) {
                const int tok = r0 + tid; const float rs = rsqrtf(ssq3[tok] * (1.0f / 1024.0f) + EPS);
#pragma unroll
                for (int k = 0; k < 4; ++k) { const size_t idx = (size_t)ei[k] * ECAP + hbase[ei[k]] + lp[k]; tokl[idx] = tok * 4 + k; gatel[idx] = gv[k]; rstdl[idx] = rs; }
            }
            __syncthreads();
        }
    }
    SEAM(8);
    if (IN(9) || IN(10)) {
        PH_WS;
        PH_IDS;
        LAS int* tb = (LAS int*)(lds + XL_OFF + XL_TB); LAS int* cn = (LAS int*)(lds + XL_OFF + XL_CNT);
        __syncthreads();
        if (tid == 0) { int a = 0; for (int e = 0; e < NEXP; ++e) { const int c = ald(counts + e); cn[e] = c; tb[e] = a; a += (c + 255) >> 8; } tb[NEXP] = a; }
        __syncthreads();
        if (IN(9)) {
        PH_WS;
            SchedMoeT<true> S; S.tb = tb; S.cnt = cn; S.tl = tokl; S.A = (const char*)x8; S.B = (const char*)(ws + WS_WGU); S.lda2 = 1024u; S.ldb2 = 1024u; S.K = 512; S.nN = 8; S.G = G; S.c = bx; S.bstride = (size_t)2048 * 1024; S.gather = true;
            EpiMoe1 E{rstdl, args.in[I_BGU], act};
            g8::gemm_phase(lds, S, E, wave);
        }
    }
    SEAM(9);
    if (IN(10)) {
        PH_WS;
        LAS int* tb = (LAS int*)(lds + XL_OFF + XL_TB); LAS int* cn = (LAS int*)(lds + XL_OFF + XL_CNT);
        SchedMoeT<false> S; S.tb = tb; S.cnt = cn; S.tl = tokl; S.A = (const char*)act; S.B = (const char*)(ws + WS_WDN); S.lda2 = 1024u; S.ldb2 = 1024u; S.K = 512; S.nN = 4; S.G = G; S.c = bx; S.bstride = (size_t)1024 * 1024; S.gather = false;
        EpiMoe2 E{tokl, gatel, args.in[I_BDN], slots};
        g8::gemm_phase(lds, S, E, wave);
    }
    SEAM(10);
    if (IN(11)) {
        PH_WS;
        PH_IDS;
        for (int m = gw; m < NTOK; m += NGW) {
            f32x4 v[4];
            { const u32x2* xr = (const u32x2*)(xh + (size_t)m * DM) + lane;
#pragma unroll
              for (int j = 0; j < 4; ++j) { const u32x2 w = xr[64 * j]; v[j] = (f32x4){bflo(w.x), bfhi(w.x), bflo(w.y), bfhi(w.y)}; } }
            if (DBG_OUT == 0) {
#pragma unroll
                for (int k = 0; k < 4; ++k) { const unsigned* sr = (const unsigned*)((const unsigned char*)slots + (size_t)(m * 4 + k) * DM) + lane;
#pragma unroll
                    for (int j = 0; j < 4; ++j) { const int w = (int)sr[64 * j]; const f32x2 lo = __builtin_amdgcn_cvt_pk_f32_fp8(w, false), hi = __builtin_amdgcn_cvt_pk_f32_fp8(w, true);
                        v[j][0] += lo[0] * (1.0f / S8S); v[j][1] += lo[1] * (1.0f / S8S); v[j][2] += hi[0] * (1.0f / S8S); v[j][3] += hi[1] * (1.0f / S8S); } }
            }
            float ss = 0.f;
#pragma unroll
            for (int j = 0; j < 4; ++j) ss += (v[j][0] * v[j][0] + v[j][1] * v[j][1]) + (v[j][2] * v[j][2] + v[j][3] * v[j][3]);
            const float rs = rsqrtf(wave_sum(ss) * (1.f / DM) + EPS);
            f32x4* o = (f32x4*)(args.out + (size_t)m * DM) + lane;
#pragma unroll
            for (int j = 0; j < 4; ++j) { const f32x4 g = ((const f32x4*)args.in[I_NF])[lane + 64 * j]; o[64 * j] = v[j] * rs * g; }
        }
    }
#if PROBE_PHASE >= 0 || PROBE_A >= 0
    STAMP(11);
    if (bx == 0 && threadIdx.x == 0) {
        const int ia = (PROBE_A >= 0) ? PROBE_A : PROBE_PHASE, ib = (PROBE_A >= 0) ? PROBE_B : PROBE_PHASE + 1;
        const unsigned long long d = (stamps[ib] - stamps[ia]) * (unsigned long long)PROBE_MULT, t0 = __builtin_amdgcn_s_memrealtime();
        while (__builtin_amdgcn_s_memrealtime() - t0 < d) __builtin_amdgcn_s_sleep(16);
    }
#endif
#undef CV_STREAM
#undef CV_DECODE
#undef IN
#undef SEAM
#undef vcu
#undef gw
#undef NGW
#undef counts
#undef rstd1
#undef ssqs
#undef ssq2
#undef ssq3
#undef gates
#undef gatel
#undef rstdl
#undef wrs
#undef tokl
#undef xb
#undef proj
#undef ug
#undef ycat
#undef ygelu
#undef x8
#undef xh
#undef qo
#undef pbuf
#undef ob
#undef act
#undef slots
#undef memn
#undef kmat
#undef vt
}

extern "C" void kernel_launch(void* const* d_in, const int* in_sizes, int n_in, void* d_out, int out_size, void* d_ws, size_t ws_size, hipStream_t stream) {
    static int grid = 0;
    if (grid == 0) {
        if (n_in != 30 || in_sizes[0] != NTOK * DM || out_size != NTOK * DM || ws_size < WS_END) { fprintf(stderr, "kernel_launch: unexpected shapes (n_in %d, in0 %d, out %d, ws %zu < %zu); nothing launched\n", n_in, n_in > 0 ? in_sizes[0] : -1, out_size, ws_size, (size_t)WS_END); grid = -1; return; }
        int dev = 0, cus = 0, per_cu = 0;
        if (hipGetDevice(&dev) != hipSuccess || hipDeviceGetAttribute(&cus, hipDeviceAttributeMultiprocessorCount, dev) != hipSuccess) { grid = -1; return; }
        if (hipFuncSetAttribute((const void*)mk_fwd, hipFuncAttributeMaxDynamicSharedMemorySize, LDS_BYTES) != hipSuccess) { fprintf(stderr, "kernel_launch: hipFuncSetAttribute failed\n"); grid = -1; return; }
        if (hipOccupancyMaxActiveBlocksPerMultiprocessor(&per_cu, (const void*)mk_fwd, NTHREADS, LDS_BYTES) != hipSuccess || per_cu < 1) { fprintf(stderr, "kernel_launch: occupancy query says %d blocks per CU\n", per_cu); per_cu = 1; }
        (void)hipGetLastError();
        grid = cus;
        if (grid != 256) fprintf(stderr, "kernel_launch: %d CUs; the attention phase assumes 256\n", grid);
    }
    if (grid < 0) return;
    if (hipMemsetAsync((char*)d_ws + WS_BAR, 0, BAR_ZERO_BYTES, stream) != hipSuccess) { fprintf(stderr, "kernel_launch: hipMemsetAsync failed\n"); return; }
    Args a{};
    for (int i = 0; i < 30; ++i) a.in[i] = (const float*)d_in[i];
    a.out = (float*)d_out; a.ws = (unsigned char*)d_ws;
#if MK_PER_PHASE
    for (int ph = 0; ph < 12; ++ph) { a.ph_lo = ph; a.ph_hi = ph + 1; hipLaunchKernelGGL(mk_fwd, dim3(grid), dim3(NTHREADS), LDS_BYTES, stream, a); }
#else
    a.ph_lo = 0; a.ph_hi = 12;
    void* kargs[] = {&a};
    hipError_t e = hipLaunchCooperativeKernel((const void*)mk_fwd, dim3(grid), dim3(NTHREADS), kargs, LDS_BYTES, stream);
    if (e != hipSuccess) fprintf(stderr, "kernel_launch: cooperative launch failed: %s (grid %d)\n", hipGetErrorString(e), grid);
#endif
}
```

```cpp
#include <hip/hip_runtime.h>
#include <hip/hip_cooperative_groups.h>
#include <cstdio>
#include <cstdint>
#include <cmath>
namespace cg = cooperative_groups;

#ifndef MK_PER_PHASE
#define MK_PER_PHASE 0
#endif
#ifndef MK_USE_CG
#define MK_USE_CG 0
#endif
#ifndef PROBE_PHASE
#define PROBE_PHASE -1
#endif
#ifndef PROBE_EPI
#define PROBE_EPI -1
#endif
#ifndef PROBE_A
#define PROBE_A -1
#define PROBE_B -1
#endif
#ifndef PROBE_MULT
#define PROBE_MULT 1
#endif
#ifndef DBG_OUT
#define DBG_OUT 0
#endif

#define LAS __attribute__((address_space(3)))
typedef unsigned short bf16_t;
typedef short bf16x8 __attribute__((ext_vector_type(8)));
typedef float f32x4 __attribute__((ext_vector_type(4)));
typedef float f32x2 __attribute__((ext_vector_type(2)));
typedef unsigned u32x4 __attribute__((ext_vector_type(4)));
typedef unsigned u32x2 __attribute__((ext_vector_type(2)));
typedef int i32x4 __attribute__((ext_vector_type(4)));
typedef int i32x8 __attribute__((ext_vector_type(8)));

constexpr int NTHREADS = 512, NWAVES = 8;
constexpr int DM = 1024, BATCH = 8, SEQ = 4096, NTOK = BATCH * SEQ, MEMLEN = 256, NMEM = BATCH * MEMLEN;
constexpr int NEXP = 32, TOPK = 4, ECAP = NTOK;
constexpr int MAXTILES = (NTOK * TOPK) / 256 + NEXP;
constexpr float EPS = 1e-5f;
constexpr float X8S = 16.0f, W8S = 256.0f, A8S = 4.0f, O8S = 64.0f, S8S = 32.0f, Q8S = 64.0f, K8S = 16.0f, P8S = 256.0f;

constexpr size_t MiB = 1u << 20;
constexpr size_t WS_CNT = 0;
constexpr size_t WS_BAR = 256 * 1024, BAR_ZERO_BYTES = 16 * 1024;
constexpr size_t WS_STAMP = 512 * 1024;
constexpr size_t WS_RSTD1 = 1 * MiB;
constexpr size_t WS_SSQS = WS_RSTD1 + 128 * 1024;
constexpr size_t WS_SSQ2 = WS_SSQS + 128 * 1024;
constexpr size_t WS_SSQ3 = WS_SSQ2 + 128 * 1024;
constexpr size_t WS_GATES = 2 * MiB;
constexpr size_t WS_WR = 3 * MiB;
constexpr size_t WS_TOKL = 4 * MiB;
constexpr size_t WS_SSM = 8 * MiB;
constexpr size_t SSM_STRIDE = 576 * 1024, SSM_KT = 1024, SSM_PT = 64 * 1024, SSM_QT = 320 * 1024;
constexpr size_t WS_WIN = 26 * MiB, WS_WGLU = 30 * MiB, WS_WOUT = 31 * MiB, WS_WQ = 33 * MiB, WS_WK = 35 * MiB, WS_WV = 37 * MiB, WS_WO = 39 * MiB;
constexpr size_t WS_MEMN = 41 * MiB, WS_KMAT = 45 * MiB, WS_VT = 49 * MiB;
constexpr size_t WS_WGU = 56 * MiB, WS_WDN = 184 * MiB;
constexpr size_t WS_YGELU = 248 * MiB;
constexpr size_t WS_X1 = 280 * MiB;
constexpr size_t WS_ACT = 408 * MiB;
constexpr size_t WS_XB = 408 * MiB, WS_PROJ = 472 * MiB, WS_UG = 568 * MiB, WS_YCAT = 600 * MiB;
constexpr size_t WS_SLOTS = 680 * MiB;
constexpr size_t WS_XH = 312 * MiB  , WS_QO = 744 * MiB, WS_PBUF = 808 * MiB, WS_O = 872 * MiB;
constexpr size_t WS_GATEL = 936 * MiB, WS_RSTDL = 940 * MiB;
constexpr size_t WS_END = 944 * MiB;

constexpr int LDS_BYTES = 147456;
constexpr int XL_OFF = 131072;
constexpr int XL_PMAX = 0, XL_PSUM = 4096, XL_TB = 12288, XL_CNT = 12544, XL_MISC = 13312;

__device__ __forceinline__ float wave_sum(float v) {
#pragma unroll
    for (int o = 1; o < 64; o <<= 1) v += __shfl_xor(v, o);
    return v;
}
__device__ __forceinline__ unsigned f2bf(float f) { unsigned u = __builtin_bit_cast(unsigned, f); return (u + 0x7fffu + ((u >> 16) & 1u)) >> 16; }
__device__ __forceinline__ unsigned pk2(float lo, float hi) { return f2bf(lo) | (f2bf(hi) << 16); }
__device__ __forceinline__ unsigned cvt_pk_bf16(float lo, float hi) { unsigned r; asm volatile("v_cvt_pk_bf16_f32 %0, %1, %2" : "=v"(r) : "v"(lo), "v"(hi)); return r; }
__device__ __forceinline__ unsigned pk4_fp8(float a, float b, float c, float d) { int w = __builtin_amdgcn_cvt_pk_fp8_f32(a, b, 0, false); w = __builtin_amdgcn_cvt_pk_fp8_f32(c, d, w, true); return (unsigned)w; }
__device__ __forceinline__ float clamp448(float v) { return __builtin_amdgcn_fmed3f(v, -448.0f, 448.0f); }
__device__ __forceinline__ float bflo(unsigned w) { return __builtin_bit_cast(float, w << 16); }
__device__ __forceinline__ float bfhi(unsigned w) { return __builtin_bit_cast(float, w & 0xffff0000u); }
__device__ __forceinline__ float bf2f(bf16_t b) { return __builtin_bit_cast(float, (unsigned)b << 16); }
__device__ __forceinline__ float sigmoidf_(float x) { return __builtin_amdgcn_rcpf(1.0f + __builtin_amdgcn_exp2f(-1.4426950408889634f * x)); }
__device__ __forceinline__ f32x2 sigmoid2(f32x2 x) { f32x2 e = x * -1.4426950408889634f; e[0] = __builtin_amdgcn_exp2f(e[0]); e[1] = __builtin_amdgcn_exp2f(e[1]); f32x2 d = e + 1.0f; d[0] = __builtin_amdgcn_rcpf(d[0]); d[1] = __builtin_amdgcn_rcpf(d[1]); return d; }
__device__ __forceinline__ f32x2 gelu_tanh2(f32x2 y) { const f32x2 t = (y * y * 0.044715f + 1.0f) * y * (2.0f * 0.7978845608028654f); return y * sigmoid2(t); }
__device__ __forceinline__ float gelu_tanh(float y) { const float t = 0.7978845608028654f * (y + 0.044715f * y * y * y); return y * sigmoidf_(2.0f * t); }
__device__ __forceinline__ int ald(const int* p) { return __hip_atomic_load(p, __ATOMIC_RELAXED, __HIP_MEMORY_SCOPE_AGENT); }

namespace g8 {
constexpr int BM = 256, BK = 64, HALF = 128, HTB = HALF * BK * 2, NXCD = 8, WGM = 8;
__device__ __forceinline__ int lds_byte(int r, int c) { const int st = (r >> 4) * 2 + (c >> 5), rr = r & 15, cc = c & 31, ob = rr * 64 + cc * 2; return st * 1024 + (ob ^ (((ob >> 9) & 1) << 5)); }
__device__ __forceinline__ void stage_rc(int b, int& R, int& C) { const int st = b / 1024, sb = b % 1024, swz = sb ^ (((sb >> 9) & 1) << 5); R = (st >> 1) * 16 + swz / 64; C = (st & 1) * 32 + (swz % 64) / 2; }
__device__ __forceinline__ int perm32(int rho) { const int n = rho >> 4, i = rho & 15; return 8 * (i >> 2) + 4 * n + (i & 3); }

struct Unit { const char* A; const char* B; int pm, pn, e, aux, valid, job; };

__device__ __forceinline__ bool tile_order(int i, int G, int c, int nM, int nN, int& pm, int& pn) {
    const int nwg = nM * nN; const long L = (long)i * G + c; if (L >= nwg) return false;
    int wgid = (int)L; { const int q = nwg / NXCD, r = nwg % NXCD, xcd = wgid % NXCD, off = wgid / NXCD; wgid = (xcd < r ? xcd * (q + 1) : r * (q + 1) + (xcd - r) * q) + off; }
    const int nig = WGM * nN, gid = wgid / nig, fm = gid * WGM, gsz = (nM - fm) < WGM ? (nM - fm) : WGM;
    pm = fm + ((wgid % nig) % gsz); pn = (wgid % nig) / gsz; return true;
}

__device__ __forceinline__ int lane_id_volatile() { int l; asm volatile("v_mbcnt_lo_u32_b32 %0, -1, 0\n\tv_mbcnt_hi_u32_b32 %0, -1, %0" : "=v"(l)); return l; }
template <class Epi, class Sched>
__device__ __forceinline__ void gemm_phase(LAS unsigned char* lds, const Sched& S, const Epi& E, const int wid) {
    const int lane = lane_id_volatile(), tid = wid * 64 + lane, wr = wid >> 2, wc = wid & 3, fr = lane & 15, fq = lane >> 4;
    const int K = S.K, nt = K / BK;
    const unsigned lda2 = S.lda2, ldb2 = S.ldb2;
    unsigned voffB0, cb0;
    { int R, C; stage_rc(tid * 16, R, C); cb0 = (unsigned)C * 2u; const int Rb = 64 * (R >> 5) + 16 * ((R >> 2) & 3) + 4 * ((R >> 4) & 1) + (R & 3); voffB0 = (unsigned)Rb * ldb2 + cb0; }
    const size_t pstepA = (size_t)64 * lda2, pstepB = (size_t)128 * ldb2, hstepA = (size_t)HALF * lda2;
    const size_t kstep = (size_t)(BK * 2);
    const size_t hstepB = (size_t)8 * ldb2;
    const unsigned ldsw = (unsigned)wid * 1024u;
    const int aoff = lds_byte(wr * 64 + fr, fq * 8), boff = lds_byte(wc * 32 + fr, fq * 8);
#define G8_SA(b, h) (((b) * 2 + (h)) * HTB)
#define G8_SB(b, h) ((4 + (b) * 2 + (h)) * HTB)
#define G8_STAGE_B(bufoff, gbase) do { _Pragma("unroll") for (int _i = 0; _i < 2; ++_i) \
        __builtin_amdgcn_global_load_lds((const unsigned*)((const char*)(gbase) + _i * pstepB + voffB0), (LAS unsigned*)(lds + (bufoff) + ldsw + _i * 8192), 16, 0, 0); } while (0)
#define G8_STAGE_A(bufoff, gbase, o0, o1) do { \
        __builtin_amdgcn_global_load_lds((const unsigned*)((const char*)(gbase) + (o0)), (LAS unsigned*)(lds + (bufoff) + ldsw), 16, 0, 0); \
        __builtin_amdgcn_global_load_lds((const unsigned*)((const char*)(gbase) + (o1)), (LAS unsigned*)(lds + (bufoff) + ldsw + 8192), 16, 0, 0); } while (0)
#define G8_LDA(dst, b, h) do { _Pragma("unroll") for (int m = 0; m < 4; ++m) _Pragma("unroll") for (int k = 0; k < 2; ++k) dst[m][k] = *(const LAS bf16x8*)(lds + G8_SA(b, h) + aoff + m * 2048 + k * 1024); } while (0)
#define G8_LDB(dst, b, h) do { _Pragma("unroll") for (int n = 0; n < 2; ++n) _Pragma("unroll") for (int k = 0; k < 2; ++k) dst[n][k] = *(const LAS bf16x8*)(lds + G8_SB(b, h) + boff + n * 2048 + k * 1024); } while (0)
#define G8_MMA(ai, bj, At, Bt) do { __builtin_amdgcn_s_setprio(1); _Pragma("unroll") for (int m = 0; m < 4; ++m) _Pragma("unroll") for (int n = 0; n < 2; ++n) _Pragma("unroll") for (int k = 0; k < 2; ++k) \
        acc[ai][bj][m][n] = __builtin_amdgcn_mfma_f32_16x16x32_bf16(Bt[n][k], At[m][k], acc[ai][bj][m][n], 0, 0, 0); __builtin_amdgcn_s_setprio(0); } while (0)
#define G8_RD16(off) __builtin_bit_cast(i32x4, *(const LAS bf16x8*)(lds + (off)))
#define G8_LDA8(dst, b, h) do { _Pragma("unroll") for (int m = 0; m < 4; ++m) dst[m] = __builtin_shufflevector(G8_RD16(G8_SA(b, h) + aoff + m * 2048), G8_RD16(G8_SA(b, h) + aoff + m * 2048 + 1024), 0, 1, 2, 3, 4, 5, 6, 7); } while (0)
#define G8_LDB8(dst, b, h) do { _Pragma("unroll") for (int n = 0; n < 2; ++n) dst[n] = __builtin_shufflevector(G8_RD16(G8_SB(b, h) + boff + n * 2048), G8_RD16(G8_SB(b, h) + boff + n * 2048 + 1024), 0, 1, 2, 3, 4, 5, 6, 7); } while (0)
#define G8_MMA8(ai, bj, At, Bt) do { __builtin_amdgcn_s_setprio(1); _Pragma("unroll") for (int m = 0; m < 4; ++m) _Pragma("unroll") for (int n = 0; n < 2; ++n) \
        asm volatile("s_nop 1\n\tv_mfma_scale_f32_16x16x128_f8f6f4 %0, %1, %2, %0, %3, %3 op_sel_hi:[0,0,0]" : "+v"(acc[ai][bj][m][n]) : "v"(Bt[n]), "v"(At[m]), "v"(scl8)); __builtin_amdgcn_s_setprio(0); } while (0)
#define G8_MM(ai, bj, X) do { if constexpr (Sched::FP8) G8_MMA8(ai, bj, At8, X##8); else G8_MMA(ai, bj, At, X); } while (0)
#define G8_LA(b, h) do { if constexpr (Sched::FP8) G8_LDA8(At8, b, h); else G8_LDA(At, b, h); } while (0)
#define G8_LB(X, b, h) do { if constexpr (Sched::FP8) G8_LDB8(X##8, b, h); else G8_LDB(X, b, h); } while (0)
#define G8_WAIT_V(n) asm volatile("s_waitcnt vmcnt(" #n ")" ::: "memory")
#define G8_WAIT_L(n) asm volatile("s_waitcnt lgkmcnt(" #n ")" ::: "memory")
#define G8_BAR __builtin_amdgcn_s_barrier()
#define G8_SCHED __builtin_amdgcn_sched_barrier(0)
#define G8_SETOFF(o, u) do { const int _t = wid * 64 + lane_id_volatile(); _Pragma("unroll") for (int _i = 0; _i < 2; ++_i) { int _R, _C; stage_rc(_t * 16 + _i * 8192, _R, _C); \
        _Pragma("unroll") for (int _h = 0; _h < 2; ++_h) { if (Sched::GATHER) { const unsigned _tk = S.arow_tok(u, _h * HALF + _R); if (_i == 0) o[_h][0] = _tk; else o[_h][0] |= _tk << 16; } \
            else if (_h == 0 && _i == 0) o[0][0] = (unsigned)_R * lda2 + (unsigned)_C * 2u; } } } while (0)
#define G8_GOFF0(pk) (((pk) & 0xffffu) * lda2 + cb0)
#define G8_GOFF1(pk) (((pk) >> 16) * lda2 + cb0)
#define G8_STAGE_AH(bufoff, gbase, h, pk) do { if (Sched::GATHER) { G8_STAGE_A(bufoff, gbase, G8_GOFF0(pk), G8_GOFF1(pk)); } \
        else { G8_STAGE_A(bufoff, (const char*)(gbase) + (h) * hstepA, oa[0][0], pstepA + oa[0][0]); } } while (0)
    Unit cur, nxt; int ui = 0;
    if (!S.next(0, cur)) return;
    f32x4 acc[2][2][4][2];
#pragma unroll
    for (int a = 0; a < 2; ++a)
#pragma unroll
        for (int b = 0; b < 2; ++b)
#pragma unroll
            for (int m = 0; m < 4; ++m)
#pragma unroll
                for (int n = 0; n < 2; ++n) acc[a][b][m][n] = (f32x4){0.f, 0.f, 0.f, 0.f};
    bf16x8 At[4][2], B0[2][2], B1[2][2];
    i32x8 At8[4], B08[2], B18[2]; const int scl8 = 0x7F7F7F7F;
    unsigned oa[2][2], on[2][2];
    G8_SETOFF(oa, cur);
    const char* cA = cur.A; const char* cB = cur.B;
    G8_STAGE_B(G8_SB(0, 0), cB); G8_STAGE_B(G8_SB(0, 1), cB + hstepB); G8_STAGE_AH(G8_SA(0, 0), cA, 0, oa[0][0]); G8_STAGE_AH(G8_SA(0, 1), cA, 1, oa[1][0]);
    if (wr == 1) G8_BAR;
    G8_WAIT_V(2); G8_BAR;
    G8_STAGE_B(G8_SB(1, 0), cB + kstep); G8_STAGE_AH(G8_SA(1, 0), cA + kstep, 0, oa[0][0]); G8_STAGE_B(G8_SB(1, 1), cB + hstepB + kstep);
    G8_WAIT_V(6); G8_BAR;
    bool has_next = S.next(1, nxt);
    if (Sched::GATHER) { if (has_next) { G8_SETOFF(on, nxt); } else {
#pragma unroll
        for (int h = 0; h < 2; ++h) on[h][0] = oa[h][0]; } }
    for (;;) {
        const char* nA = has_next ? nxt.A : cA; const char* nB = has_next ? nxt.B : cB;
#pragma unroll 1
        for (int t = 0; t < nt; t += 2) {
            const bool last = (t == nt - 2);
            const char* a1 = cA + (size_t)(t + 1) * kstep;
            const char* a2 = last ? nA : cA + (size_t)(t + 2) * kstep; const char* b2 = last ? nB : cB + (size_t)(t + 2) * kstep;
            const char* a3 = a2 + kstep; const char* b3 = b2 + kstep;
            unsigned p0 = 0, p1 = 0;
            if (Sched::GATHER) { p0 = last ? on[0][0] : oa[0][0]; p1 = last ? on[1][0] : oa[1][0]; }
            G8_LB(B0, 0, 0); G8_LB(B1, 0, 1); G8_SCHED; G8_LA(0, 0); G8_STAGE_AH(G8_SA(1, 1), a1, 1, oa[1][0]);
            G8_WAIT_V(8); G8_WAIT_L(0); G8_BAR; G8_MM(0, 0, B0); G8_MM(0, 1, B1); G8_BAR; G8_SCHED;
            G8_LA(0, 1); G8_STAGE_B(G8_SB(0, 0), b2); G8_STAGE_B(G8_SB(0, 1), b2 + hstepB); G8_STAGE_AH(G8_SA(0, 0), a2, 0, p0);
            G8_WAIT_V(8); G8_WAIT_L(0); G8_BAR; G8_MM(1, 0, B0); G8_MM(1, 1, B1); G8_BAR; G8_SCHED;
            G8_LB(B0, 1, 0); G8_LB(B1, 1, 1); G8_SCHED; G8_LA(1, 0); G8_STAGE_AH(G8_SA(0, 1), a2, 1, p1);
            G8_WAIT_V(8); G8_WAIT_L(0); G8_BAR; G8_MM(0, 0, B0); G8_MM(0, 1, B1); G8_BAR; G8_SCHED;
            G8_LA(1, 1); G8_STAGE_B(G8_SB(1, 0), b3); G8_STAGE_B(G8_SB(1, 1), b3 + hstepB); G8_STAGE_AH(G8_SA(1, 0), a3, 0, p0);
            G8_WAIT_V(8); G8_WAIT_L(0); G8_BAR; G8_MM(1, 0, B0); G8_MM(1, 1, B1); G8_BAR; G8_SCHED;
            if (Epi::MID) { const int fr_e = lane_id_volatile() & 15; E.mid(acc, cur, t, wr, fr_e); }
        }
        if (wr == 0) G8_BAR;
        if constexpr (Sched::FP8) asm volatile("s_nop 15\n\ts_nop 15" ::: "memory");
        Unit n2; bool has2 = false; unsigned tk[2][2] = {{0u, 0u}, {0u, 0u}};
        if (has_next) { has2 = S.next(ui + 2, n2);
            if (Sched::GATHER && has2) { const int _t = wid * 64 + lane_id_volatile();
#pragma unroll
                for (int _i = 0; _i < 2; ++_i) { int _R, _C; stage_rc(_t * 16 + _i * 8192, _R, _C);
#pragma unroll
                    for (int _h = 0; _h < 2; ++_h) tk[_h][_i] = S.arow_tok(n2, _h * HALF + _R); } } }
        { const int l_e = lane_id_volatile(), fr_e = l_e & 15, fq_e = l_e >> 4;
          E(acc, cur, wr, wc, fr_e, fq_e, lds); if constexpr (Epi::PROBE2) { asm volatile("" ::: "memory"); const Epi E2 = E.probe_copy(); E2(acc, cur, wr, wc, fr_e, fq_e, lds); } }
        if (!has_next) break;
#pragma unroll
        for (int a = 0; a < 2; ++a)
#pragma unroll
            for (int b = 0; b < 2; ++b)
#pragma unroll
                for (int m = 0; m < 4; ++m)
#pragma unroll
                    for (int n = 0; n < 2; ++n) acc[a][b][m][n] = (f32x4){0.f, 0.f, 0.f, 0.f};
        cur = nxt; cA = nA; cB = nB; ++ui;
        if (Sched::GATHER) {
#pragma unroll
            for (int h = 0; h < 2; ++h) { oa[h][0] = on[h][0]; if (has2) on[h][0] = tk[h][0] | (tk[h][1] << 16); } }
        nxt = n2; has_next = has2;
        if (wr == 1) G8_BAR;
    }
    G8_WAIT_V(0);
    G8_BAR;
#undef G8_SA
#undef G8_SB
#undef G8_STAGE_A
#undef G8_STAGE_B
#undef G8_LDA
#undef G8_LDB
#undef G8_MMA
#undef G8_MMA8
#undef G8_MM
#undef G8_LA
#undef G8_LB
#undef G8_LDA8
#undef G8_LDB8
#undef G8_RD16
#undef G8_WAIT_V
#undef G8_WAIT_L
#undef G8_BAR
#undef G8_SCHED
#undef G8_SETOFF
#undef G8_GOFF0
#undef G8_GOFF1
#undef G8_STAGE_AH
}
}
using g8::Unit;
using g8::lane_id_volatile;

#define EPI_PROBE_COPY(T) __device__ __forceinline__ T probe_copy() const { return *this; }
#define EPI_ROWS(ai, m) _Pragma("unroll") for (int ai = 0; ai < 2; ++ai) _Pragma("unroll") for (int m = 0; m < 4; ++m)
__device__ __forceinline__ u32x4 pack8(const f32x4 a, const f32x4 b) { u32x4 w; w.x = cvt_pk_bf16(a[0], a[1]); w.y = cvt_pk_bf16(a[2], a[3]); w.z = cvt_pk_bf16(b[0], b[1]); w.w = cvt_pk_bf16(b[2], b[3]); return w; }
__device__ __forceinline__ float sq8(const f32x4 a, const f32x4 b) { return (a[0] * a[0] + a[1] * a[1]) + (a[2] * a[2] + a[3] * a[3]) + (b[0] * b[0] + b[1] * b[1]) + (b[2] * b[2] + b[3] * b[3]); }
__device__ __forceinline__ void row_atomic(float* p, float s, int fq) { s += __shfl_xor(s, 16); s += __shfl_xor(s, 32); if (fq == 0) atomicAdd(p, s); }

template <bool F8> struct SchedDenseT {
    static constexpr bool GATHER = false, FP8 = F8;
    const char* A; const char* B; unsigned lda2, ldb2; int K, nM, nN, G, c;
    __device__ __forceinline__ bool next(int i, Unit& u) const {
        int pm, pn; if (!g8::tile_order(i, G, c, nM, nN, pm, pn)) return false;
        u.pm = pm; u.pn = pn; u.A = A + (size_t)pm * 256 * lda2; u.B = B + (size_t)pn * 256 * ldb2; u.e = 0; u.aux = 0; u.valid = 256; u.job = 0; return true;
    }
    __device__ __forceinline__ unsigned arow_tok(const Unit&, int) const { return 0u; }
};
typedef SchedDenseT<false> SchedDense;
struct SchedP1 {
    static constexpr bool GATHER = false, FP8 = false;
    const char *xb, *win, *memn, *wk, *wv; unsigned lda2, ldb2; int K, G, c;
    __device__ __forceinline__ bool next(int i, Unit& u) const {
        const int L = i * G + c;
        u.e = 0; u.aux = 0; u.valid = 256;
        if (L < 1024) { int pm, pn; g8::tile_order(i, G, c, 128, 8, pm, pn); u.pm = pm; u.pn = pn; u.job = 0; u.A = xb + (size_t)pm * 256 * 2048; u.B = win + (size_t)pn * 256 * 2048; return true; }
        const int r = L - 1024;
        if (r < 32) { u.pm = r >> 2; u.pn = r & 3; u.job = 1; u.A = memn + (size_t)u.pm * 256 * 2048; u.B = wk + (size_t)u.pn * 256 * 2048; return true; }
        if (r < 64) { const int q = r - 32; u.pm = q >> 3; u.pn = q & 7; u.job = 2; u.A = wv + (size_t)u.pm * 256 * 2048; u.B = memn + (size_t)u.pn * 256 * 2048; return true; }
        return false;
    }
    __device__ __forceinline__ unsigned arow_tok(const Unit&, int) const { return 0u; }
};
struct SchedQ {
    static constexpr bool GATHER = false, FP8 = true;
    const char *A, *B; unsigned lda2, ldb2; int K, G, c;
    __device__ __forceinline__ bool next(int i, Unit& u) const {
        const int p = c + i * G; if (p >= BATCH * 4 * 16) return false;
        const int b = p >> 6, h = (p >> 4) & 3, qb = p & 15;
        u.pm = b * 16 + qb; u.pn = h; u.e = 0; u.aux = 0; u.valid = 256; u.job = 0; u.A = A + (size_t)u.pm * 256 * lda2; u.B = B + (size_t)h * 256 * ldb2; return true;
    }
    __device__ __forceinline__ unsigned arow_tok(const Unit&, int) const { return 0u; }
};
struct SchedAttn {
    static constexpr bool GATHER = false, FP8 = true;
    const char *q, *kmat, *vt, *pbuf; unsigned lda2, ldb2; int K, G, c, npair;
    __device__ __forceinline__ void pair_unit(int j, bool isO, Unit& u) const {
        const int p = c + j * G; const int b = p >> 6, h = (p >> 4) & 3, qb = p & 15;
        u.pm = b * 16 + qb; u.pn = h; u.e = j & 1; u.aux = 0; u.valid = 256; u.job = isO ? 1 : 0;
        if (!isO) { u.A = q + ((size_t)((b * 4 + h) * SEQ + qb * 256)) * 256; u.B = kmat + ((size_t)((b * 4 + h) * 256)) * 256; }
        else      { u.A = pbuf + ((size_t)(c * 2 + (j & 1))) * 256 * 256; u.B = vt + ((size_t)((b * 4 + h) * 256)) * 256; }
    }
    __device__ __forceinline__ bool next(int i, Unit& u) const {
        const int n = npair; if (i >= 2 * n) return false;
        if (i == 0) { pair_unit(0, false, u); return true; }
        const int k = (i - 1) >> 1;
        if (i & 1) { if (k + 1 < n) pair_unit(k + 1, false, u); else pair_unit(n - 1, true, u); }
        else pair_unit(k, true, u);
        return true;
    }
    __device__ __forceinline__ unsigned arow_tok(const Unit&, int) const { return 0u; }
};
struct SchedMoe {
    static constexpr bool GATHER_ = true;
    const LAS int* tb; const LAS int* cnt; const int* tl; const char* A; const char* B; unsigned lda2, ldb2; int K, nN, G, c; size_t bstride; bool gather;
};
template <bool GATH> struct SchedMoeT : SchedMoe {
    static constexpr bool GATHER = GATH, FP8 = true;
    __device__ __forceinline__ bool next(int i, Unit& u) const {
        const int nM = __builtin_amdgcn_readfirstlane(tb[NEXP]); int pm, pn; if (!g8::tile_order(i, G, c, nM, nN, pm, pn)) return false;
        int e = 0;
#pragma unroll
        for (int s = 16; s >= 1; s >>= 1) if (__builtin_amdgcn_readfirstlane(tb[e + s]) <= pm) e += s;
        u.pm = pm; u.pn = pn; u.e = e; u.aux = (pm - __builtin_amdgcn_readfirstlane(tb[e])) * 256; const int v = __builtin_amdgcn_readfirstlane(cnt[e]) - u.aux; u.valid = v < 256 ? v : 256; u.job = 0;
        u.A = GATH ? A : A + (size_t)pm * 256 * lda2; u.B = B + (size_t)e * bstride + (size_t)pn * 256 * ldb2; return true;
    }
    __device__ __forceinline__ unsigned arow_tok(const Unit& u, int r) const {
        return (unsigned)((r < u.valid) ? (tl[(size_t)u.e * ECAP + u.aux + r] >> 2) : 0);
    }
};

struct EpiP1 {
    static constexpr bool MID = false; static constexpr bool PROBE2 = false; EPI_PROBE_COPY(EpiP1)
    const float* rstd1; bf16_t *proj, *ug, *kmat, *vt;
    __device__ __forceinline__ void mid(f32x4 (&)[2][2][4][2], const Unit&, int, int, int) const {}
    __device__ __forceinline__ void operator()(const f32x4 (&acc)[2][2][4][2], const Unit& u, int wr, int wc, int fr, int fq, LAS unsigned char*) const {
        const int col0 = u.pn * 256 + wc * 64 + 16 * fq;
        float rs[2][4];
        EPI_ROWS(ai, m) rs[ai][m] = (u.job == 0) ? rstd1[u.pm * 256 + ai * 128 + wr * 64 + m * 16 + fr] : 1.0f;
        EPI_ROWS(ai, m) {
            const int row = u.pm * 256 + ai * 128 + wr * 64 + m * 16 + fr;
            const float sc = rs[ai][m];
#pragma unroll
            for (int bj = 0; bj < 2; ++bj) {
                const int col = col0 + bj * 8;
                if (u.job == 0) { const u32x4 w = pack8(acc[ai][bj][m][0] * sc, acc[ai][bj][m][1] * sc); bf16_t* dst;
                    if (u.pn < 6) dst = proj + (size_t)row * 1536 + col; else { const int cc = col - 1536; dst = ug + ((size_t)((row >> 12) * 32 + (cc >> 4)) * SEQ + (row & 4095)) * 16 + (cc & 15); }
                    *(u32x4*)dst = w; }
                else { const f32x4 a0 = acc[ai][bj][m][0] * K8S, a1 = acc[ai][bj][m][1] * K8S;
                    unsigned char* dst = (u.job == 1) ? (unsigned char*)kmat + ((size_t)((u.pm * 4 + u.pn) * 256 + (row & 255))) * 256 + (col & 255)
                                                      : (unsigned char*)vt + ((size_t)((u.pn * 4 + u.pm) * 256 + (row & 255))) * 256 + (col & 255);
                    *(u32x2*)dst = (u32x2){pk4_fp8(clamp448(a0[0]), clamp448(a0[1]), clamp448(a0[2]), clamp448(a0[3])), pk4_fp8(clamp448(a1[0]), clamp448(a1[1]), clamp448(a1[2]), clamp448(a1[3]))}; }
            }
        }
    }
};
struct EpiGlu {
    static constexpr bool MID = false; static constexpr bool PROBE2 = false; EPI_PROBE_COPY(EpiGlu)
    const bf16_t* ygelu; bf16_t* ycat; float* ssqs;
    __device__ __forceinline__ void mid(f32x4 (&)[2][2][4][2], const Unit&, int, int, int) const {}
    __device__ __forceinline__ void operator()(const f32x4 (&acc)[2][2][4][2], const Unit& u, int wr, int wc, int fr, int fq, LAS unsigned char*) const {
        const int col0 = u.pn * 256 + wc * 64 + 16 * fq;
#pragma unroll
        for (int ai = 0; ai < 2; ++ai) {
            u32x4 aw[4][2];
#pragma unroll
            for (int m = 0; m < 4; ++m)
#pragma unroll
                for (int bj = 0; bj < 2; ++bj) aw[m][bj] = *(const u32x4*)(ygelu + (size_t)(u.pm * 256 + ai * 128 + wr * 64 + m * 16 + fr) * 512 + col0 + bj * 8);
#pragma unroll
            for (int m = 0; m < 4; ++m) {
                const int row = u.pm * 256 + ai * 128 + wr * 64 + m * 16 + fr; float ss = 0.f;
#pragma unroll
                for (int bj = 0; bj < 2; ++bj) {
                    const u32x4 a = aw[m][bj];
                    f32x4 z0, z1; const f32x4 g0 = acc[ai][bj][m][0], g1 = acc[ai][bj][m][1];
                    { const f32x2 s0 = sigmoid2((f32x2){g0[0], g0[1]}) * (f32x2){bflo(a.x), bfhi(a.x)}, s1 = sigmoid2((f32x2){g0[2], g0[3]}) * (f32x2){bflo(a.y), bfhi(a.y)};
                      const f32x2 s2 = sigmoid2((f32x2){g1[0], g1[1]}) * (f32x2){bflo(a.z), bfhi(a.z)}, s3 = sigmoid2((f32x2){g1[2], g1[3]}) * (f32x2){bflo(a.w), bfhi(a.w)};
                      z0 = (f32x4){s0[0], s0[1], s1[0], s1[1]}; z1 = (f32x4){s2[0], s2[1], s3[0], s3[1]}; }
                    ss += sq8(z0, z1);
                    *(u32x4*)(ycat + (size_t)row * 1024 + col0 + bj * 8) = pack8(z0, z1);
                }
                row_atomic(ssqs + row, ss, fq);
            }
            asm volatile("" ::: "memory");
        }
    }
};
struct EpiRes {
    static constexpr bool MID = true; static constexpr bool PROBE2 = (PROBE_EPI == 4); __device__ __forceinline__ EpiRes probe_copy() const { EpiRes e = *this; e.ssq = ssq + 3 * NTOK; e.skip = (midt < 0); return e; }
    const bf16_t* xsrc; bf16_t* xh; unsigned char* x8; float* ssq; const float* ssqs; int midt; float accs; bool skip = false;
    __device__ __forceinline__ void mid(f32x4 (&acc)[2][2][4][2], const Unit& u, int t, int wr, int fr) const {
        if (t != midt) return;
        EPI_ROWS(ai, m) {
            const int row = u.pm * 256 + ai * 128 + wr * 64 + m * 16 + fr;
            const float sc = rsqrtf(ssqs[row] * (1.0f / 512.0f) + EPS);
#pragma unroll
            for (int bj = 0; bj < 2; ++bj)
#pragma unroll
                for (int n = 0; n < 2; ++n) acc[ai][bj][m][n] *= sc;
        }
    }
    __device__ __forceinline__ void operator()(const f32x4 (&acc)[2][2][4][2], const Unit& u, int wr, int wc, int fr, int fq, LAS unsigned char*) const {
        if (skip) return;
        const int col0 = u.pn * 256 + wc * 64 + 16 * fq;
#pragma unroll
        for (int ai = 0; ai < 2; ++ai) {
            u32x4 rw[4][2];
#pragma unroll
            for (int m = 0; m < 4; ++m)
#pragma unroll
                for (int bj = 0; bj < 2; ++bj) rw[m][bj] = *(const u32x4*)(xsrc + (size_t)(u.pm * 256 + ai * 128 + wr * 64 + m * 16 + fr) * 1024 + col0 + bj * 8);
#pragma unroll
            for (int m = 0; m < 4; ++m) {
                const int row = u.pm * 256 + ai * 128 + wr * 64 + m * 16 + fr; float ss = 0.f;
#pragma unroll
                for (int bj = 0; bj < 2; ++bj) {
                    const size_t off = (size_t)row * 1024 + col0 + bj * 8; const u32x4 w = rw[m][bj];
                    const f32x4 r0 = (f32x4){bflo(w.x), bfhi(w.x), bflo(w.y), bfhi(w.y)}, r1 = (f32x4){bflo(w.z), bfhi(w.z), bflo(w.w), bfhi(w.w)};
                    const f32x4 v0 = r0 + acc[ai][bj][m][0] * accs, v1 = r1 + acc[ai][bj][m][1] * accs;
                    ss += sq8(v0, v1);
                    *(u32x4*)(xh + off) = pack8(v0, v1);
                    *(u32x2*)(x8 + off) = (u32x2){pk4_fp8(clamp448(v0[0] * X8S), clamp448(v0[1] * X8S), clamp448(v0[2] * X8S), clamp448(v0[3] * X8S)), pk4_fp8(clamp448(v1[0] * X8S), clamp448(v1[1] * X8S), clamp448(v1[2] * X8S), clamp448(v1[3] * X8S))};
                }
                row_atomic(ssq + row, ss, fq);
            }
            asm volatile("" ::: "memory");
        }
    }
};
struct EpiQ {
    static constexpr bool MID = false; static constexpr bool PROBE2 = false; EPI_PROBE_COPY(EpiQ)
    const float* ssq2; bf16_t* q;
    __device__ __forceinline__ void mid(f32x4 (&)[2][2][4][2], const Unit&, int, int, int) const {}
    __device__ __forceinline__ void operator()(const f32x4 (&acc)[2][2][4][2], const Unit& u, int wr, int wc, int fr, int fq, LAS unsigned char*) const {
        const int col0 = u.pn * 256 + wc * 64 + 16 * fq;
        float sq[2][4];
        EPI_ROWS(ai, m) sq[ai][m] = ssq2[u.pm * 256 + ai * 128 + wr * 64 + m * 16 + fr];
        EPI_ROWS(ai, m) {
            const int row = u.pm * 256 + ai * 128 + wr * 64 + m * 16 + fr;
            const float sc = rsqrtf(sq[ai][m] * (1.0f / 1024.0f) + EPS) * (1.4426950408889634f / 16.0f) * (1.0f / (X8S * W8S));
#pragma unroll
            for (int bj = 0; bj < 2; ++bj) { const f32x4 a0 = acc[ai][bj][m][0] * (sc * Q8S), a1 = acc[ai][bj][m][1] * (sc * Q8S);
                *(u32x2*)((unsigned char*)q + ((size_t)(((row >> 12) * 4 + u.pn) * SEQ + (row & 4095))) * 256 + (col0 & 255) + bj * 8) = (u32x2){pk4_fp8(clamp448(a0[0]), clamp448(a0[1]), clamp448(a0[2]), clamp448(a0[3])), pk4_fp8(clamp448(a1[0]), clamp448(a1[1]), clamp448(a1[2]), clamp448(a1[3]))}; }
        }
    }
};
struct EpiAttn {
    static constexpr bool MID = false; static constexpr bool PROBE2 = false; EPI_PROBE_COPY(EpiAttn)
    bf16_t* pbuf; bf16_t* o; int c;
    __device__ __forceinline__ void mid(f32x4 (&)[2][2][4][2], const Unit&, int, int, int) const {}
    __device__ __forceinline__ void operator()(const f32x4 (&acc)[2][2][4][2], const Unit& u, int wr, int wc, int fr, int fq, LAS unsigned char* lds) const {
        LAS float* pmax = (LAS float*)(lds + XL_OFF + XL_PMAX);
        LAS float* psum = (LAS float*)(lds + XL_OFF + XL_PSUM) + u.e * 1024;
        if (u.job == 0) {
            EPI_ROWS(ai, m) {
                const int r = ai * 128 + wr * 64 + m * 16 + fr; float mx = -3.0e38f;
#pragma unroll
                for (int bj = 0; bj < 2; ++bj)
#pragma unroll
                    for (int n = 0; n < 2; ++n)
#pragma unroll
                        for (int i = 0; i < 4; ++i) mx = fmaxf(mx, acc[ai][bj][m][n][i]);
                mx = fmaxf(mx, __shfl_xor(mx, 16)); mx = fmaxf(mx, __shfl_xor(mx, 32));
                if (fq == 0) pmax[r * 4 + wc] = mx;
            }
            asm volatile("s_waitcnt lgkmcnt(0)" ::: "memory"); __builtin_amdgcn_s_barrier(); asm volatile("" ::: "memory");
            bf16_t* P = (bf16_t*)((unsigned char*)pbuf + (size_t)(c * 2 + u.e) * 256 * 256);
            EPI_ROWS(ai, m) {
                const int r = ai * 128 + wr * 64 + m * 16 + fr;
                const f32x4 pm4 = *(const LAS f32x4*)(pmax + r * 4);
                const float mx = fmaxf(fmaxf(pm4[0], pm4[1]), fmaxf(pm4[2], pm4[3])); float ss = 0.f;
#pragma unroll
                for (int bj = 0; bj < 2; ++bj) {
                    f32x4 p0, p1;
#pragma unroll
                    for (int i = 0; i < 4; ++i) { p0[i] = __builtin_amdgcn_exp2f((acc[ai][bj][m][0][i] - mx) * (1.0f / (Q8S * K8S))); p1[i] = __builtin_amdgcn_exp2f((acc[ai][bj][m][1][i] - mx) * (1.0f / (Q8S * K8S))); }
                    ss += (p0[0] + p0[1]) + (p0[2] + p0[3]) + (p1[0] + p1[1]) + (p1[2] + p1[3]);
                    *(u32x2*)((unsigned char*)P + (size_t)r * 256 + wc * 64 + 16 * fq + bj * 8) = (u32x2){pk4_fp8(p0[0] * P8S, p0[1] * P8S, p0[2] * P8S, p0[3] * P8S), pk4_fp8(p1[0] * P8S, p1[1] * P8S, p1[2] * P8S, p1[3] * P8S)};
                }
                ss += __shfl_xor(ss, 16); ss += __shfl_xor(ss, 32);
                if (fq == 0) psum[r * 4 + wc] = ss;
                asm volatile("" ::: "memory");
            }
            asm volatile("s_waitcnt vmcnt(0) lgkmcnt(0)" ::: "memory"); __builtin_amdgcn_s_barrier(); asm volatile("" ::: "memory");
        } else {
            const int b = u.pm >> 4, qb = u.pm & 15, h = u.pn;
            EPI_ROWS(ai, m) {
                const int r = ai * 128 + wr * 64 + m * 16 + fr;
                const f32x4 ps = *(const LAS f32x4*)(psum + r * 4);
                const float inv = (O8S / (P8S * K8S)) / ((ps[0] + ps[1]) + (ps[2] + ps[3]));
                unsigned char* dst = (unsigned char*)o + (size_t)(b * SEQ + qb * 256 + r) * 1024 + h * 256 + wc * 64 + 16 * fq;
#pragma unroll
                for (int bj = 0; bj < 2; ++bj) { const f32x4 a0 = acc[ai][bj][m][0] * inv, a1 = acc[ai][bj][m][1] * inv;
                    *(u32x2*)(dst + bj * 8) = (u32x2){pk4_fp8(clamp448(a0[0]), clamp448(a0[1]), clamp448(a0[2]), clamp448(a0[3])), pk4_fp8(clamp448(a1[0]), clamp448(a1[1]), clamp448(a1[2]), clamp448(a1[3]))}; }
            }
        }
    }
};
struct EpiMoe1 {
    static constexpr bool MID = false; static constexpr bool PROBE2 = (PROBE_EPI == 9); EPI_PROBE_COPY(EpiMoe1)
    const float* rstdl; const float* bgu; bf16_t* act;
    __device__ __forceinline__ void mid(f32x4 (&)[2][2][4][2], const Unit&, int, int, int) const {}
    __device__ __forceinline__ void operator()(const f32x4 (&acc)[2][2][4][2], const Unit& u, int wr, int wc, int fr, int fq, LAS unsigned char*) const {
        const int cj = u.pn * 128 + wc * 32 + 8 * fq;
        const float* bg = bgu + (size_t)u.e * 2048 + cj;
        float rs[2][4];
        EPI_ROWS(ai, m) { const int r = ai * 128 + wr * 64 + m * 16 + fr; rs[ai][m] = rstdl[(size_t)u.e * ECAP + u.aux + (r < u.valid ? r : 0)]; }
        const f32x4 bgv[2] = {*(const f32x4*)bg, *(const f32x4*)(bg + 4)}, blv[2] = {*(const f32x4*)(bg + 1024), *(const f32x4*)(bg + 1028)};
        EPI_ROWS(ai, m) {
            const int r = ai * 128 + wr * 64 + m * 16 + fr; const float sc = rs[ai][m] * (1.0f / (X8S * W8S));
            unsigned w[2];
#pragma unroll
            for (int n = 0; n < 2; ++n) { f32x2 o2[2];
#pragma unroll
                for (int h = 0; h < 2; ++h) {
                    const f32x2 ag = {acc[ai][0][m][n][2 * h], acc[ai][0][m][n][2 * h + 1]}, al = {acc[ai][1][m][n][2 * h], acc[ai][1][m][n][2 * h + 1]};
                    const f32x2 bg2 = {bgv[n][2 * h], bgv[n][2 * h + 1]}, bl2 = {blv[n][2 * h], blv[n][2 * h + 1]};
                    f32x2 g = ag * sc + bg2, l = al * sc + bl2;
                    g[0] = fminf(g[0], 7.0f); g[1] = fminf(g[1], 7.0f);
                    l[0] = __builtin_amdgcn_fmed3f(l[0], -7.0f, 7.0f); l[1] = __builtin_amdgcn_fmed3f(l[1], -7.0f, 7.0f);
                    f32x2 e = g * (-1.702f * 1.4426950408889634f);
                    e[0] = __builtin_amdgcn_exp2f(e[0]); e[1] = __builtin_amdgcn_exp2f(e[1]);
                    f32x2 d = e + 1.0f;
                    d[0] = __builtin_amdgcn_rcpf(d[0]); d[1] = __builtin_amdgcn_rcpf(d[1]);
                    o2[h] = (g * d) * (l * A8S + A8S);
                }
                w[n] = pk4_fp8(o2[0][0], o2[0][1], o2[1][0], o2[1][1]); }
            *(u32x2*)((unsigned char*)act + (size_t)(u.pm * 256 + r) * 1024 + cj) = (u32x2){w[0], w[1]};
        }
    }
};
struct EpiMoe2 {
    static constexpr bool MID = false; static constexpr bool PROBE2 = (PROBE_EPI == 10); EPI_PROBE_COPY(EpiMoe2)
    const int* tokl; const float* gatel; const float* bdn; bf16_t* slots;
    __device__ __forceinline__ void mid(f32x4 (&)[2][2][4][2], const Unit&, int, int, int) const {}
    __device__ __forceinline__ void operator()(const f32x4 (&acc)[2][2][4][2], const Unit& u, int wr, int wc, int fr, int fq, LAS unsigned char*) const {
        const int col0 = u.pn * 256 + wc * 64 + 16 * fq;
        const float* bp = bdn + (size_t)u.e * 1024 + col0;
        int sl[2][4]; float gt[2][4];
        EPI_ROWS(ai, m) { const int r = ai * 128 + wr * 64 + m * 16 + fr; const size_t idx = (size_t)u.e * ECAP + u.aux + (r < u.valid ? r : 0); sl[ai][m] = tokl[idx]; gt[ai][m] = gatel[idx]; }
        f32x4 bv[2][2];
#pragma unroll
        for (int bj = 0; bj < 2; ++bj) { bv[bj][0] = *(const f32x4*)(bp + bj * 8); bv[bj][1] = *(const f32x4*)(bp + bj * 8 + 4); }
        EPI_ROWS(ai, m) {
            const int r = ai * 128 + wr * 64 + m * 16 + fr;
            if (r < u.valid) {
                const int slot = sl[ai][m]; const float g = gt[ai][m];
#pragma unroll
                for (int bj = 0; bj < 2; ++bj) { const float gs = g * S8S; const f32x4 o0 = (acc[ai][bj][m][0] * (1.0f / (A8S * W8S)) + bv[bj][0]) * gs, o1 = (acc[ai][bj][m][1] * (1.0f / (A8S * W8S)) + bv[bj][1]) * gs;
                    *(u32x2*)((unsigned char*)slots + (size_t)slot * 1024 + col0 + bj * 8) = (u32x2){pk4_fp8(clamp448(o0[0]), clamp448(o0[1]), clamp448(o0[2]), clamp448(o0[3])), pk4_fp8(clamp448(o1[0]), clamp448(o1[1]), clamp448(o1[2]), clamp448(o1[3]))}; }
            }
        }
    }
};

#define XB_TMO      128
#define XB_XCNT(j)  (256  + 64 * (j))
#define XB_XSUB(j)  (1280 + 64 * (j))
#define XB_XGEN(j)  (2304 + 64 * (j))
#define XB_TOP      3328
#define XB_TOPGEN   3392
#define XCD_BAR_WORDS 3456
#define XB_SPIN_CAP (1u << 20)
__device__ __forceinline__ unsigned xb_ld(unsigned* p)              { return __hip_atomic_load(p, __ATOMIC_RELAXED, __HIP_MEMORY_SCOPE_AGENT); }
__device__ __forceinline__ unsigned xb_add(unsigned* p, unsigned v) { return __hip_atomic_fetch_add(p, v, __ATOMIC_RELAXED, __HIP_MEMORY_SCOPE_AGENT); }
__device__ __forceinline__ unsigned xb_xcc_id() { return (unsigned)__builtin_amdgcn_s_getreg((3 << 11) | 20) & 0xFu; }
#define XB_SPIN(cond, bar) do { unsigned _sp = 0; while (cond) { __builtin_amdgcn_s_sleep(1); \
    if ((++_sp & 255u) == 0u) { if (xb_ld(&(bar)[XB_TMO])) break; if (_sp > XB_SPIN_CAP) { atomicAdd(&(bar)[XB_TMO], 1u); break; } } } } while (0)
struct XcdBarrier { unsigned* bar; unsigned x; volatile LAS unsigned* st; };
__device__ __forceinline__ XcdBarrier xcd_barrier_post(unsigned* bar, volatile LAS unsigned* st) {
    XcdBarrier b; b.bar = bar; b.x = xb_xcc_id(); b.st = st;
    if (threadIdx.x == 0) (void)xb_add(&bar[XB_XCNT(b.x)], 1u);
    return b;
}
__device__ __forceinline__ void xcd_barrier_complete(unsigned* bar, unsigned x, unsigned& nloc, unsigned& nx) {
    const unsigned G = gridDim.x * gridDim.y * gridDim.z;
    unsigned sum, cnt, mine, sp = 0u;
    for (;;) {
        sum = 0u; cnt = 0u; mine = 0u;
#pragma unroll
        for (unsigned j = 0; j < 16; ++j) { const unsigned c = xb_ld(&bar[XB_XCNT(j)]); sum += c; cnt += (c > 0u) ? 1u : 0u; mine = (j == x) ? c : mine; }
        if (sum == G) break;
        __builtin_amdgcn_s_sleep(1);
        if ((++sp & 255u) == 0u) { if (xb_ld(&bar[XB_TMO])) break; if (sp > XB_SPIN_CAP) { atomicAdd(&bar[XB_TMO], 1u); break; } }
    }
    nloc = mine > 0u ? mine : 1u; nx = cnt > 0u ? cnt : 1u;
}
__device__ __forceinline__ void xcd_barrier(const XcdBarrier& b) {
    asm volatile("s_waitcnt vmcnt(0)" ::: "memory");
    __syncthreads();
    if (threadIdx.x == 0) {
        unsigned* bar = b.bar;
        __builtin_amdgcn_s_waitcnt(0);
        unsigned nloc = b.st[0], nx = b.st[1];
        if (nloc == 0u) { xcd_barrier_complete(bar, b.x, nloc, nx); b.st[0] = nloc; b.st[1] = nx; }
        const unsigned old = xb_add(&bar[XB_XSUB(b.x)], 1u);
        const unsigned gen = old / nloc;
        if (old + 1u == (gen + 1u) * nloc) {
            __builtin_amdgcn_fence(__ATOMIC_RELEASE, "agent");
            asm volatile("s_waitcnt vmcnt(0)" ::: "memory");
            const unsigned og = xb_add(&bar[XB_TOP], 1u);
            const unsigned tg = og / nx;
            if (og + 1u == (tg + 1u) * nx) xb_add(&bar[XB_TOPGEN], 1u);
            else XB_SPIN(xb_ld(&bar[XB_TOPGEN]) == tg, bar);
            __builtin_amdgcn_fence(__ATOMIC_ACQUIRE, "agent");
            xb_add(&bar[XB_XGEN(b.x)], 1u);
            asm volatile("s_waitcnt vmcnt(0)" ::: "memory");
        } else {
            XB_SPIN(xb_ld(&bar[XB_XGEN(b.x)]) == gen, bar);
            __builtin_amdgcn_fence(__ATOMIC_ACQUIRE, "agent");
            asm volatile("s_waitcnt vmcnt(0)" ::: "memory");
        }
    }
    __syncthreads();
}

struct Args { const float* in[30]; float* out; unsigned char* ws; int ph_lo, ph_hi; };
enum { I_X = 0, I_MEM, I_NMIX, I_WIN, I_CONVW, I_ARE, I_AIM, I_LOGDT, I_BRE, I_BIM, I_CRE, I_CIM, I_D, I_WGLU, I_NCO, I_NSO, I_WOUT, I_NX, I_NM, I_WQ, I_WKV, I_WO, I_NMOE, I_WR, I_BR, I_WGU, I_BGU, I_WDN, I_BDN, I_NF };

struct CvItem { const float* W; const float* scale; unsigned char* WT; int ldw, k0, n0, ldt, drow0, dk0, f8, rmap; };
__device__ __forceinline__ void cv_load(const CvItem& c, float (&v)[64], int lane) {
    const float* src = c.W + (size_t)c.k0 * c.ldw + c.n0 + lane;
#pragma unroll
    for (int i = 0; i < 64; ++i) v[i] = __builtin_nontemporal_load(src + (size_t)i * c.ldw);
}
__device__ __forceinline__ void cv_store(const CvItem& c, float (&v)[64], int lane, LAS unsigned char* scr) {
    if (c.scale) {
#pragma unroll
        for (int i = 0; i < 64; ++i) v[i] *= c.scale[c.k0 + i];
    }
    if (c.f8) {
#pragma unroll
        for (int q = 0; q < 4; ++q) { u32x4 o; o.x = pk4_fp8(v[16 * q] * W8S, v[16 * q + 1] * W8S, v[16 * q + 2] * W8S, v[16 * q + 3] * W8S); o.y = pk4_fp8(v[16 * q + 4] * W8S, v[16 * q + 5] * W8S, v[16 * q + 6] * W8S, v[16 * q + 7] * W8S);
            o.z = pk4_fp8(v[16 * q + 8] * W8S, v[16 * q + 9] * W8S, v[16 * q + 10] * W8S, v[16 * q + 11] * W8S); o.w = pk4_fp8(v[16 * q + 12] * W8S, v[16 * q + 13] * W8S, v[16 * q + 14] * W8S, v[16 * q + 15] * W8S);
            *(LAS u32x4*)(scr + lane * 80 + 16 * q) = o; }
        asm volatile("s_waitcnt lgkmcnt(0)" ::: "memory");
#pragma unroll
        for (int j = 0; j < 4; ++j) { const int row = 16 * j + (lane >> 2), ch = lane & 3; const u32x4 o = *(const LAS u32x4*)(scr + row * 80 + 16 * ch);
            const int drow = c.drow0 + (c.rmap ? 16 * (row >> 3) + (row & 7) : row);
            *(u32x4*)(c.WT + (size_t)drow * c.ldt + c.dk0 + 16 * ch) = o; }
    } else {
#pragma unroll
        for (int q = 0; q < 8; ++q) { u32x4 o; o.x = pk2(v[8 * q], v[8 * q + 1]); o.y = pk2(v[8 * q + 2], v[8 * q + 3]); o.z = pk2(v[8 * q + 4], v[8 * q + 5]); o.w = pk2(v[8 * q + 6], v[8 * q + 7]);
            *(LAS u32x4*)(scr + lane * 144 + 16 * q) = o; }
        asm volatile("s_waitcnt lgkmcnt(0)" ::: "memory");
#pragma unroll
        for (int j = 0; j < 8; ++j) { const int row = 8 * j + (lane >> 3), ch = lane & 7; const u32x4 o = *(const LAS u32x4*)(scr + row * 144 + 16 * ch);
            *(u32x4*)(c.WT + (size_t)(c.drow0 + row) * c.ldt + c.dk0 + 16 * ch) = o; }
    }
    asm volatile("s_waitcnt lgkmcnt(0)" ::: "memory");
}

__global__ void __launch_bounds__(NTHREADS, 2) mk_fwd(Args args) {
    extern __shared__ __attribute__((aligned(16))) unsigned char lds_raw[];
    LAS unsigned char* lds = (LAS unsigned char*)lds_raw;
    cg::grid_group grid = cg::this_grid();
    const int wave = __builtin_amdgcn_readfirstlane(threadIdx.x >> 6);
#define PH_IDS const int lane = lane_id_volatile(), tid = wave * 64 + lane; (void)lane; (void)tid
    const int G = gridDim.x, bx = blockIdx.x;
#define vcu ((G % 8 == 0) ? (bx % 8) * (G / 8) + bx / 8 : bx)
    unsigned char* const ws = args.ws;
#define PH_WS __attribute__((address_space(1))) unsigned char* ws_ = (__attribute__((address_space(1))) unsigned char*)args.ws; asm volatile("" : "+s"(ws_)); unsigned char* const ws = (unsigned char*)ws_
    const int lo = MK_PER_PHASE ? args.ph_lo : 0, hi = MK_PER_PHASE ? args.ph_hi : 12;
#ifndef PH_MASK
#define PH_MASK 0xfff
#endif
#define IN(k) (((PH_MASK >> (k)) & 1) && lo <= (k) && (k) < hi)
#if MK_USE_CG
#define SEAM(k) do { if (IN(k) && IN((k) + 1)) grid.sync(); STAMP(k); } while (0)
#else
#define SEAM(k) do { if (IN(k) && IN((k) + 1)) { XcdBarrier xb_; xb_.bar = (unsigned*)(ws + WS_BAR); xb_.x = xb_xcc_id(); xb_.st = (volatile LAS unsigned*)(lds + XL_OFF + XL_MISC); xcd_barrier(xb_); } STAMP(k); } while (0)
#endif
#if PROBE_PHASE >= 0 || PROBE_A >= 0
    unsigned long long* stamps = (unsigned long long*)(ws + WS_STAMP);
#define STAMP(k) do { if (bx == 0 && threadIdx.x == 0) stamps[(k) + 1] = __builtin_amdgcn_s_memrealtime(); } while (0)
    if (bx == 0 && threadIdx.x == 0) stamps[0] = __builtin_amdgcn_s_memrealtime();
#define STAMPX(i) do { if (bx == 0 && threadIdx.x == 0) stamps[(i)] = __builtin_amdgcn_s_memrealtime(); } while (0)
#else
#define STAMP(k) do { } while (0)
#define STAMPX(i) do { } while (0)
#endif
    volatile LAS unsigned* misc = (volatile LAS unsigned*)(lds + XL_OFF + XL_MISC);
    if (threadIdx.x == 0) { misc[0] = 0u; misc[1] = 0u; }
    __syncthreads();
    if (!MK_PER_PHASE && !MK_USE_CG) (void)xcd_barrier_post((unsigned*)(ws + WS_BAR), misc);
#define gw (vcu * NWAVES + wave)
#define NGW (G * NWAVES)
#define counts ((int*)(ws + WS_CNT))
#define rstd1 ((float*)(ws + WS_RSTD1))
#define ssqs ((float*)(ws + WS_SSQS))
#define ssq2 ((float*)(ws + WS_SSQ2))
#define ssq3 ((float*)(ws + WS_SSQ3))
#define gates ((float*)(ws + WS_GATES))
#define gatel ((float*)(ws + WS_GATEL))
#define rstdl ((float*)(ws + WS_RSTDL))
#define wrs ((float*)(ws + WS_WR))
#define tokl ((int*)(ws + WS_TOKL))
#define xb ((bf16_t*)(ws + WS_XB))
#define proj ((bf16_t*)(ws + WS_PROJ))
#define ug ((bf16_t*)(ws + WS_UG))
#define ycat ((bf16_t*)(ws + WS_YCAT))
#define ygelu ((bf16_t*)(ws + WS_YGELU))
#define x8 ((unsigned char*)(ws + WS_X1))
#define xh ((bf16_t*)(ws + WS_XH))
#define qo ((bf16_t*)(ws + WS_QO))
#define pbuf ((bf16_t*)(ws + WS_PBUF))
#define ob ((bf16_t*)(ws + WS_O))
#define act ((bf16_t*)(ws + WS_ACT))
#define slots ((bf16_t*)(ws + WS_SLOTS))
#define memn ((bf16_t*)(ws + WS_MEMN))
#define kmat ((bf16_t*)(ws + WS_KMAT))
#define vt ((bf16_t*)(ws + WS_VT))

#define CV_I_IN (16 * 32)
#define CV_I_GLU (8 * 8)
#define CV_I_OUT (16 * 16)
#define CV_I_Q (16 * 16)
#define CV_I_KV (16 * 32)
#define CV_I_O (16 * 16)
#define CV_I_GU (32 * 16 * 32)
#define CV_I_DN (32 * 16 * 16)
#define CV_NIT (CV_I_IN + CV_I_GLU + CV_I_OUT + CV_I_Q + CV_I_KV + CV_I_O + CV_I_GU + CV_I_DN)
#define CV_DN_A (CV_I_DN * 11 / 16)
#define CV_DECODE(c, it) do { int r = (it); \
                if (r < CV_I_GU) { const int e = r / 512, q = r % 512, kb = q / 32, nb = q % 32, n0 = nb * 64, j = n0 & 1023, lin = n0 >> 10; \
                    c = CvItem{args.in[I_WGU] + (size_t)e * 1024 * 2048, args.in[I_NMOE], ws + WS_WGU + (size_t)e * 2048 * 1024, 2048, kb * 64, n0, 1024, 256 * (j >> 7) + 8 * lin + 2 * (j & 127), kb * 64, 1, 1}; break; } r -= CV_I_GU; \
                if (r < CV_I_IN) { const int kb = r / 32, nb = r % 32; c = CvItem{args.in[I_WIN], args.in[I_NMIX], ws + WS_WIN, 2048, kb * 64, nb * 64, 2048, nb * 64, kb * 128, 0, 0}; break; } r -= CV_I_IN; \
                if (r < CV_I_GLU) { const int kb = r / 8, nb = r % 8; c = CvItem{args.in[I_WGLU], nullptr, ws + WS_WGLU, 512, kb * 64, nb * 64, 1024, nb * 64, kb * 128, 0, 0}; break; } r -= CV_I_GLU; \
                if (r < CV_I_OUT) { const int kb = r / 16, nb = r % 16, k0 = kb * 64;        \
                    c = CvItem{args.in[I_WOUT], (k0 < 512) ? args.in[I_NCO] : args.in[I_NSO] - 512, ws + WS_WOUT, 1024, k0, nb * 64, 2048, nb * 64, ((k0 + 512) & 1023) * 2, 0, 0}; break; } r -= CV_I_OUT; \
                if (r < CV_I_Q) { const int kb = r / 16, nb = r % 16; c = CvItem{args.in[I_WQ], args.in[I_NX], ws + WS_WQ, 1024, kb * 64, nb * 64, 1024, nb * 64, kb * 64, 1, 0}; break; } r -= CV_I_Q; \
                if (r < CV_I_KV) { const int kb = r / 32, nb = r % 32, n0 = nb * 64; c = CvItem{args.in[I_WKV], nullptr, ws + (n0 < 1024 ? WS_WK : WS_WV), 2048, kb * 64, n0, 2048, n0 & 1023, kb * 128, 0, 0}; break; } r -= CV_I_KV; \
                if (r < CV_I_O) { const int kb = r / 16, nb = r % 16; c = CvItem{args.in[I_WO], nullptr, ws + WS_WO, 1024, kb * 64, nb * 64, 1024, nb * 64, kb * 64, 1, 0}; break; } r -= CV_I_O; \
                { const int e = r / 256, q = r % 256, kb = q / 16, nb = q % 16; \
                    c = CvItem{args.in[I_WDN] + (size_t)e * 1024 * 1024, nullptr, ws + WS_WDN + (size_t)e * 1024 * 1024, 1024, kb * 64, nb * 64, 1024, nb * 64, kb * 64, 1, 0}; } } while (0)
#define CV_STREAM(first, step, lo, hi) do { float va[64], vb[64]; CvItem ca, cb; LAS unsigned char* cvscr = lds + wave * 10240; \
        int it = (lo) + (first); \
        if (it < (hi)) { CV_DECODE(ca, it); cv_load(ca, va, lane); } \
        while (it < (hi)) { \
            int it2 = it + (step); \
            if (it2 < (hi)) { CV_DECODE(cb, it2); cv_load(cb, vb, lane); } \
            cv_store(ca, va, lane, cvscr); \
            it = it2; if (it >= (hi)) break; \
            it2 = it + (step); \
            if (it2 < (hi)) { CV_DECODE(ca, it2); cv_load(ca, va, lane); } \
            cv_store(cb, vb, lane, cvscr); \
            it = it2; } } while (0)
    if (IN(0)) {
        PH_WS;
        PH_IDS;
        for (int i = bx * NTHREADS + tid; i < 3 * NTOK; i += G * NTHREADS) ssqs[i] = 0.f;
        if (bx == 0 && tid < NEXP) counts[tid] = 0;
        for (int i = bx * NTHREADS + tid; i < DM * NEXP; i += G * NTHREADS) wrs[i] = args.in[I_WR][i] * args.in[I_NMOE][i >> 5];
        for (int item = bx; item < 256; item += G) {
            const int g = item >> 3, part = item & 7;
            LAS float* Wp = (LAS float*)lds;
            LAS float* Bb = Wp + 65 * 128;
            LAS float* Cc = Bb + 64 * 32;
            const float dt = __expf(args.in[I_LOGDT][g]);
            __syncthreads();
            for (int i = tid; i < 65 * 64; i += NTHREADS) { const int p = i >> 6, j = i & 63; const float ar = args.in[I_ARE][g * 64 + j], aim = args.in[I_AIM][g * 64 + j];
                const float mag = expf((float)p * dt * ar); float sn, cs; sincosf((float)p * dt * aim, &sn, &cs); Wp[i * 2] = mag * cs; Wp[i * 2 + 1] = mag * sn; }
            for (int i = tid; i < 64 * 16; i += NTHREADS) { const int j = i >> 4; const float ar = args.in[I_ARE][g * 64 + j], aim = args.in[I_AIM][g * 64 + j];
                float sn, cs; sincosf(dt * aim, &sn, &cs); const float em1 = expm1f(dt * ar); float sh, ch; sincosf(0.5f * dt * aim, &sh, &ch);
                const float pre = em1 * cs - 2.0f * sh * sh, pim = (em1 + 1.0f) * sn, den = ar * ar + aim * aim;
                const float qre = (pre * ar + pim * aim) / den, qim = (pim * ar - pre * aim) / den;
                const float br = args.in[I_BRE][(size_t)g * 1024 + i], bi = args.in[I_BIM][(size_t)g * 1024 + i];
                Bb[i * 2] = qre * br - qim * bi; Bb[i * 2 + 1] = qre * bi + qim * br; }
            for (int i = tid; i < 16 * 64; i += NTHREADS) { Cc[i * 2] = args.in[I_CRE][(size_t)g * 1024 + i]; Cc[i * 2 + 1] = args.in[I_CIM][(size_t)g * 1024 + i]; }
            __syncthreads();
            unsigned char* tab = ws + WS_SSM + (size_t)g * SSM_STRIDE;
            if (part == 0 && tid < 64) { ((float*)tab)[tid * 2] = Wp[(64 * 64 + tid) * 2]; ((float*)tab)[tid * 2 + 1] = Wp[(64 * 64 + tid) * 2 + 1]; }
            bf16_t* Kt = (bf16_t*)(tab + SSM_KT); bf16_t* Pt = (bf16_t*)(tab + SSM_PT); bf16_t* Qt = (bf16_t*)(tab + SSM_QT);
            {
                const int lag = 8 * part + (tid >> 6), c = (tid >> 2) & 15, cp0 = (tid & 3) * 4; float s0 = 0.f, s1 = 0.f, s2 = 0.f, s3 = 0.f;
#pragma unroll 4
                for (int j = 0; j < 64; ++j) { const f32x2 w = *(const LAS f32x2*)(Wp + (lag * 64 + j) * 2), cc = *(const LAS f32x2*)(Cc + (c * 64 + j) * 2);
                    const float xr = cc[0] * w[0] - cc[1] * w[1], xi = cc[0] * w[1] + cc[1] * w[0];
                    const f32x4 b0 = *(const LAS f32x4*)(Bb + (j * 16 + cp0) * 2), b1 = *(const LAS f32x4*)(Bb + (j * 16 + cp0 + 2) * 2);
                    s0 += xr * b0[0] - xi * b0[1]; s1 += xr * b0[2] - xi * b0[3]; s2 += xr * b1[0] - xi * b1[1]; s3 += xr * b1[2] - xi * b1[3]; }
                *(u32x2*)(Kt + (size_t)lag * 256 + c * 16 + cp0) = (u32x2){pk2(s0, s1), pk2(s2, s3)};
            }
            {
                const int k = 2 * tid, sidx = k >> 4, cp = k & 15;
#pragma unroll 4
                for (int r = 0; r < 16; ++r) { const int n = 16 * part + r, ri = n >> 6, j = n & 63;
                    const f32x2 w = *(const LAS f32x2*)(Wp + ((63 - sidx) * 64 + j) * 2); const f32x4 b = *(const LAS f32x4*)(Bb + (j * 16 + cp) * 2);
                    const float v0 = ri ? (w[0] * b[1] + w[1] * b[0]) : (w[0] * b[0] - w[1] * b[1]), v1 = ri ? (w[0] * b[3] + w[1] * b[2]) : (w[0] * b[2] - w[1] * b[3]);
                    *(unsigned*)(Pt + (size_t)n * 1024 + k) = pk2(v0, v1); }
            }
            {
                const int n = 2 * (tid & 63), ri = n >> 6, j = n & 63;
#pragma unroll 4
                for (int r = 0; r < 16; ++r) { const int tc = 128 * part + (tid >> 6) + 8 * r, t = tc >> 4, c = tc & 15;
                    const f32x4 w = *(const LAS f32x4*)(Wp + ((t + 1) * 64 + j) * 2), cc = *(const LAS f32x4*)(Cc + (c * 64 + j) * 2);
                    const float v0 = ri ? -(cc[0] * w[1] + cc[1] * w[0]) : (cc[0] * w[0] - cc[1] * w[1]), v1 = ri ? -(cc[2] * w[3] + cc[3] * w[2]) : (cc[2] * w[2] - cc[3] * w[3]);
                    *(unsigned*)(Qt + (size_t)tc * 128 + n) = pk2(v0, v1); }
            }
        }
        STAMPX(30);
        for (int m4 = gw * 4; m4 < NTOK + NMEM; m4 += NGW * 4) {
            const bool isx = m4 < NTOK; const int r0 = isx ? m4 : m4 - NTOK;
            const f32x4* xr = (const f32x4*)((isx ? args.in[I_X] : args.in[I_MEM]) + (size_t)r0 * DM) + lane;
            f32x4 v[4][4];
#pragma unroll
            for (int q = 0; q < 4; ++q)
#pragma unroll
                for (int j = 0; j < 4; ++j) v[q][j] = __builtin_nontemporal_load(xr + q * 256 + 64 * j);
#pragma unroll
            for (int q = 0; q < 4; ++q) {
                float ss = 0.f;
#pragma unroll
                for (int j = 0; j < 4; ++j) ss += (v[q][j][0] * v[q][j][0] + v[q][j][1] * v[q][j][1]) + (v[q][j][2] * v[q][j][2] + v[q][j][3] * v[q][j][3]);
                const float rs = rsqrtf(wave_sum(ss) * (1.f / DM) + EPS);
                u32x2* o8 = (u32x2*)((isx ? xb : memn) + (size_t)(r0 + q) * DM) + lane;
                if (isx) { if (lane == 0) rstd1[r0 + q] = rs;
#pragma unroll
                    for (int j = 0; j < 4; ++j) o8[64 * j] = (u32x2){pk2(v[q][j][0], v[q][j][1]), pk2(v[q][j][2], v[q][j][3])}; }
                else {
#pragma unroll
                    for (int j = 0; j < 4; ++j) { const f32x4 g = ((const f32x4*)args.in[I_NM])[lane + 64 * j]; o8[64 * j] = (u32x2){pk2(v[q][j][0] * rs * g[0], v[q][j][1] * rs * g[1]), pk2(v[q][j][2] * rs * g[2], v[q][j][3] * rs * g[3])}; } }
            }
        }
        STAMPX(31);
        {
            __syncthreads();
            CV_STREAM(gw, NGW, 0, (G == 256) ? CV_NIT - CV_I_DN : CV_NIT);
        }
    }
    SEAM(0);
    if (IN(1)) {
        PH_WS;
        SchedP1 S{(const char*)xb, (const char*)(ws + WS_WIN), (const char*)memn, (const char*)(ws + WS_WK), (const char*)(ws + WS_WV), 2048u, 2048u, 1024, G, bx};
        EpiP1 E{rstd1, proj, ug, kmat, vt};
        g8::gemm_phase(lds, S, E, wave);
        if (G == 256 && bx >= 64) { PH_IDS; CV_STREAM((bx - 64) * NWAVES + wave, 192 * NWAVES, CV_NIT - CV_I_DN, CV_NIT - CV_I_DN + CV_DN_A); }
    }
    SEAM(1);
    if (IN(2)) {
        PH_WS;
        PH_IDS;
        constexpr int L_KT = 0, L_SPV = 32768, L_UH = 49152, UROW = 1040, L_STG = 115712;
        const int l15 = lane & 15, lq = lane >> 4;
        for (int it_ = vcu; it_ < BATCH * 32; it_ += G) {
            const int g = (it_ >> 5) * 4 + (it_ & 3), b = (it_ >> 2) & 7, item = b * 32 + g;
            const bf16_t* ugp = ug + (size_t)item * SEQ * 16;
            const unsigned char* tab = ws + WS_SSM + (size_t)g * SSM_STRIDE;
            const float* A64 = (const float*)tab; const bf16_t* Kt = (const bf16_t*)(tab + SSM_KT); const bf16_t* Pt = (const bf16_t*)(tab + SSM_PT); const bf16_t* Qt = (const bf16_t*)(tab + SSM_QT);
#define STAGE_U(p) do { _Pragma("unroll") for (int _i = 0; _i < 8; ++_i) { const int _c = wave * 8 + _i; \
                const u32x4 _v = *(const u32x4*)(ugp + ((size_t)_c * 64 + 32 * (p)) * 16 + lane * 8); *(LAS u32x4*)(lds + L_UH + _c * UROW + lane * 16) = _v; } } while (0)
#define UFRAG(mb, kk) (*(const LAS bf16x8*)(lds + L_UH + (16 * (mb) + l15) * UROW + (32 * (kk) + 8 * lq) * 2))
            f32x4 sacc[4];
#pragma unroll
            for (int mb = 0; mb < 4; ++mb) sacc[mb] = (f32x4){0.f, 0.f, 0.f, 0.f};
#pragma unroll 1
            for (int p = 0; p < 2; ++p) {
                bf16x8 pf[16];
#pragma unroll
                for (int kk = 0; kk < 16; ++kk) pf[kk] = *(const bf16x8*)(Pt + (size_t)(16 * wave + l15) * 1024 + 32 * (16 * p + kk) + 8 * lq);
                __syncthreads(); STAGE_U(p); __syncthreads();
#pragma unroll
                for (int kk = 0; kk < 16; ++kk) {
#pragma unroll
                    for (int mb = 0; mb < 4; ++mb) sacc[mb] = __builtin_amdgcn_mfma_f32_16x16x32_bf16(UFRAG(mb, kk), pf[kk], sacc[mb], 0, 0, 0);
                }
            }
            STAMPX(20);
            { LAS float* Sl = (LAS float*)(lds + L_KT);
#pragma unroll
              for (int mb = 0; mb < 4; ++mb)
#pragma unroll
                for (int r = 0; r < 4; ++r) Sl[(16 * mb + 4 * lq + r) * 128 + 16 * wave + l15] = sacc[mb][r]; }
            __syncthreads();
            if (wave == 0) {
                const LAS float* Sl = (const LAS float*)(lds + L_KT); LAS bf16_t* Sp = (LAS bf16_t*)(lds + L_SPV);
                const float ar = A64[lane * 2], ai = A64[lane * 2 + 1]; float sr = 0.f, si = 0.f;
#pragma unroll 2
                for (int c = 0; c < 64; ++c) { Sp[c * 128 + lane] = (bf16_t)f2bf(sr); Sp[c * 128 + 64 + lane] = (bf16_t)f2bf(si);
                    const float lr = Sl[c * 128 + lane], li = Sl[c * 128 + 64 + lane]; const float nr = ar * sr - ai * si + lr, ni = ar * si + ai * sr + li; sr = nr; si = ni; }
            }
            __syncthreads();
            { const u32x4* src = (const u32x4*)Kt;
#pragma unroll
              for (int i = 0; i < 4; ++i) *(LAS u32x4*)(lds + L_KT + (tid + i * NTHREADS) * 16) = src[tid + i * NTHREADS]; }
            __syncthreads();
            STAMPX(21);
            const f32x4 dv4 = *(const f32x4*)(args.in[I_D] + g * 16 + (lane & 3) * 4);
#pragma unroll 1
            for (int ig = 1; ig >= 0; --ig) {
                f32x4 acc[4][4];
#pragma unroll
                for (int i = 0; i < 4; ++i)
#pragma unroll
                    for (int mb = 0; mb < 4; ++mb) acc[i][mb] = (f32x4){0.f, 0.f, 0.f, 0.f};
                const int tb0 = wave + 32 * ig, tmax = tb0 + 24;
                bf16x8 qf[4][4];
#pragma unroll
                for (int kq = 0; kq < 4; ++kq)
#pragma unroll
                    for (int i = 0; i < 4; ++i) qf[kq][i] = *(const bf16x8*)(Qt + (size_t)((tb0 + 8 * i) * 16 + l15) * 128 + 32 * kq + 8 * lq);
#pragma unroll 1
                for (int p = ig; p >= 0; --p) {
                    if (ig == 1 && p == 0) { __syncthreads(); STAGE_U(0); __syncthreads(); }
#pragma unroll 1
                    for (int kk = 0; kk < 16; ++kk) {
                        const int s0 = 32 * p + 2 * kk; if (s0 > tmax) break;
                        bf16x8 af[4];
#pragma unroll
                        for (int mb = 0; mb < 4; ++mb) af[mb] = UFRAG(mb, kk);
                        const int s = s0 + (lq >> 1);
#pragma unroll
                        for (int i = 0; i < 4; ++i) { const int t = tb0 + 8 * i;
                            if (t >= s0) { const int lag = t - s; bf16x8 bfr = *(const LAS bf16x8*)(lds + L_KT + (((lag < 0 ? 0 : lag) * 16 + l15) * 16 + 8 * (lq & 1)) * 2);
                                if (lag < 0) bfr = (bf16x8){0, 0, 0, 0, 0, 0, 0, 0};
#pragma unroll
                                for (int mb = 0; mb < 4; ++mb) acc[i][mb] = __builtin_amdgcn_mfma_f32_16x16x32_bf16(af[mb], bfr, acc[i][mb], 0, 0, 0); } }
                    }
                }
#pragma unroll
                for (int kq = 0; kq < 4; ++kq) {
                    bf16x8 af[4];
#pragma unroll
                    for (int mb = 0; mb < 4; ++mb) af[mb] = *(const LAS bf16x8*)(lds + L_SPV + ((16 * mb + l15) * 128 + 32 * kq + 8 * lq) * 2);
#pragma unroll
                    for (int i = 0; i < 4; ++i) {
#pragma unroll
                        for (int mb = 0; mb < 4; ++mb) acc[i][mb] = __builtin_amdgcn_mfma_f32_16x16x32_bf16(af[mb], qf[kq][i], acc[i][mb], 0, 0, 0); }
                }
                LAS float* stg = (LAS float*)(lds + L_STG + wave * 2048);
#pragma unroll
                for (int i = 0; i < 4; ++i) { const int t = tb0 + 8 * i;
                    u32x2 uq[2][2];
#pragma unroll
                    for (int hf = 0; hf < 2; ++hf)
#pragma unroll
                        for (int it = 0; it < 2; ++it) uq[hf][it] = *(const u32x2*)(ugp + (size_t)((32 * hf + ((it * 64 + lane) >> 2)) * 64 + t) * 16 + (lane & 3) * 4);
#pragma unroll
                    for (int hf = 0; hf < 2; ++hf) {
#pragma unroll
                        for (int ml = 0; ml < 2; ++ml)
#pragma unroll
                            for (int r = 0; r < 4; ++r) stg[(16 * ml + 4 * lq + r) * 16 + l15] = acc[i][2 * hf + ml][r];
                        asm volatile("s_waitcnt lgkmcnt(0)" ::: "memory");
#pragma unroll
                        for (int it = 0; it < 2; ++it) { const int idx = it * 64 + lane, tt = (32 * hf + (idx >> 2)) * 64 + t, c4 = (idx & 3) * 4;
                            const f32x4 yv = *(const LAS f32x4*)(stg + idx * 4); const u32x2 uu = uq[hf][it];
                            const f32x2 ya = gelu_tanh2((f32x2){yv[0], yv[1]} + (f32x2){dv4[0], dv4[1]} * (f32x2){bflo(uu.x), bfhi(uu.x)}), yb = gelu_tanh2((f32x2){yv[2], yv[3]} + (f32x2){dv4[2], dv4[3]} * (f32x2){bflo(uu.y), bfhi(uu.y)});
                            *(u32x2*)(ygelu + (size_t)(b * SEQ + tt) * 512 + g * 16 + c4) = (u32x2){cvt_pk_bf16(ya[0], ya[1]), cvt_pk_bf16(yb[0], yb[1])}; }
                        asm volatile("s_waitcnt lgkmcnt(0)" ::: "memory");
                    }
                }
            }
#undef STAGE_U
#undef UFRAG
        }
        STAMPX(22);
        {
            const int ch = lane * 8;
            float w0[8], w1[8], w2[8];
#pragma unroll
            for (int i = 0; i < 8; ++i) { w0[i] = args.in[I_CONVW][ch + i]; w1[i] = args.in[I_CONVW][512 + ch + i]; w2[i] = args.in[I_CONVW][1024 + ch + i]; }
            for (int run = gw; run < NTOK / 16; run += NGW) {
                const int r0 = run * 16, tin = r0 & (SEQ - 1);
                float vm2[8], vm1[8];
#pragma unroll
                for (int i = 0; i < 8; ++i) { vm2[i] = 0.f; vm1[i] = 0.f; }
                if (tin > 0) {
#pragma unroll
                    for (int d = 2; d >= 1; --d) { const bf16_t* pr = proj + (size_t)(r0 - d) * 1536;
                        const u32x4 c4 = *(const u32x4*)(pr + 512 + ch), x4 = *(const u32x4*)(pr + 1024 + ch);
                        float v[8]; v[0] = bflo(c4.x) * bflo(x4.x); v[1] = bfhi(c4.x) * bfhi(x4.x); v[2] = bflo(c4.y) * bflo(x4.y); v[3] = bfhi(c4.y) * bfhi(x4.y);
                        v[4] = bflo(c4.z) * bflo(x4.z); v[5] = bfhi(c4.z) * bfhi(x4.z); v[6] = bflo(c4.w) * bflo(x4.w); v[7] = bfhi(c4.w) * bfhi(x4.w);
#pragma unroll
                        for (int i = 0; i < 8; ++i) { if (d == 2) vm2[i] = v[i]; else vm1[i] = v[i]; } }
                }
#pragma unroll 1
                for (int tb = 0; tb < 16; tb += 8) {
                    u32x4 b4[8], c4[8], x4[8];
#pragma unroll
                    for (int q = 0; q < 8; ++q) { const bf16_t* pr = proj + (size_t)(r0 + tb + q) * 1536; b4[q] = *(const u32x4*)(pr + ch); c4[q] = *(const u32x4*)(pr + 512 + ch); x4[q] = *(const u32x4*)(pr + 1024 + ch); }
#pragma unroll
                    for (int q = 0; q < 8; ++q) {
                        float v[8], bgv[8], y[8]; v[0] = bflo(c4[q].x) * bflo(x4[q].x); v[1] = bfhi(c4[q].x) * bfhi(x4[q].x); v[2] = bflo(c4[q].y) * bflo(x4[q].y); v[3] = bfhi(c4[q].y) * bfhi(x4[q].y);
                        v[4] = bflo(c4[q].z) * bflo(x4[q].z); v[5] = bfhi(c4[q].z) * bfhi(x4[q].z); v[6] = bflo(c4[q].w) * bflo(x4[q].w); v[7] = bfhi(c4[q].w) * bfhi(x4[q].w);
                        bgv[0] = bflo(b4[q].x); bgv[1] = bfhi(b4[q].x); bgv[2] = bflo(b4[q].y); bgv[3] = bfhi(b4[q].y); bgv[4] = bflo(b4[q].z); bgv[5] = bfhi(b4[q].z); bgv[6] = bflo(b4[q].w); bgv[7] = bfhi(b4[q].w);
                        float ss = 0.f;
#pragma unroll
                        for (int i = 0; i < 8; ++i) { y[i] = bgv[i] * (w0[i] * vm2[i] + w1[i] * vm1[i] + w2[i] * v[i]); ss += y[i] * y[i]; vm2[i] = vm1[i]; vm1[i] = v[i]; }
                        const float rs = rsqrtf(wave_sum(ss) * (1.f / 512.f) + EPS);
                        u32x4 o; o.x = pk2(y[0] * rs, y[1] * rs); o.y = pk2(y[2] * rs, y[3] * rs); o.z = pk2(y[4] * rs, y[5] * rs); o.w = pk2(y[6] * rs, y[7] * rs);
                        *(u32x4*)(ycat + (size_t)(r0 + tb + q) * 1024 + 512 + ch) = o;
                    }
                }
            }
        }
    }
    SEAM(2);
    if (IN(3)) {
        PH_WS;
        SchedDense S{(const char*)ygelu, (const char*)(ws + WS_WGLU), 1024u, 1024u, 512, NTOK / 256, 2, G, bx};
        EpiGlu E{ygelu, ycat, ssqs};
        g8::gemm_phase(lds, S, E, wave);
    }
    SEAM(3);
    if (IN(4)) {
        PH_WS;
        SchedDense S{(const char*)ycat, (const char*)(ws + WS_WOUT), 2048u, 2048u, 1024, NTOK / 256, 4, G, bx};
        EpiRes E{xb, xh, x8, ssq2, ssqs, 6, 1.0f};
        g8::gemm_phase(lds, S, E, wave);
    }
    SEAM(4);
    if (IN(5)) {
        PH_WS;
        SchedQ S{(const char*)x8, (const char*)(ws + WS_WQ), 1024u, 1024u, 512, G, bx};
        EpiQ E{ssq2, qo};
        g8::gemm_phase(lds, S, E, wave);
    }
    STAMP(5);
    if (IN(6)) {
        PH_WS;
        SchedAttn S{(const char*)qo, (const char*)kmat, (const char*)vt, (const char*)pbuf, 256u, 256u, 128, G, bx, (BATCH * 4 * 16) / G};
        EpiAttn E{pbuf, ob, bx};
        g8::gemm_phase(lds, S, E, wave);
    }
    SEAM(6);
    if (IN(7)) {
        PH_WS;
        SchedDenseT<true> S{(const char*)ob, (const char*)(ws + WS_WO), 1024u, 1024u, 512, NTOK / 256, 4, G, bx};
        EpiRes E{xh, xh, x8, ssq3, ssqs, -1, 1.0f / (O8S * W8S)};
        g8::gemm_phase(lds, S, E, wave);
    }
    SEAM(7);
    if (IN(8)) {
        PH_WS;
        PH_IDS;
        LAS float* Xs = (LAS float*)lds;
        LAS float* Ws = (LAS float*)(lds + 34816);
        LAS float* Lg = (LAS float*)(lds + 69632);
        LAS int* hist = (LAS int*)(lds + 86528);
        LAS int* hbase = (LAS int*)(lds + 86656);
        const int te = tid & 7, tt = (tid >> 3) & 15, ks = tid >> 7;
        for (int blk = vcu; blk < NTOK / 128; blk += G) {
            const int r0 = blk * 128;
            float ac[8][4];
#pragma unroll
            for (int a = 0; a < 8; ++a)
#pragma unroll
                for (int e = 0; e < 4; ++e) ac[a][e] = 0.f;
            if (tid < 32) hist[tid] = 0;
            u32x2 xa[4], xb_[4]; f32x4 wa, wb;
#define P8_LOAD(xr, wv, kc) do { _Pragma("unroll") for (int j = 0; j < 4; ++j) xr[j] = *(const u32x2*)(xh + (size_t)(r0 + (tid >> 4) + 32 * j) * DM + (kc) * 64 + 4 * (tid & 15)); \
                wv = *(const f32x4*)(wrs + (size_t)((kc) * 64 + (tid >> 3)) * 32 + 4 * (tid & 7)); } while (0)
#define P8_STEP(xr, wv, kc) do { __syncthreads(); \
                _Pragma("unroll") for (int j = 0; j < 4; ++j) *(LAS f32x4*)(Xs + ((tid >> 4) + 32 * j) * 68 + 4 * (tid & 15)) = (f32x4){bflo(xr[j].x), bfhi(xr[j].x), bflo(xr[j].y), bfhi(xr[j].y)}; \
                *(LAS f32x4*)(Ws + (tid >> 3) * 32 + 4 * (tid & 7)) = wv; \
                __syncthreads(); \
                if ((kc) + 2 < 16) P8_LOAD(xr, wv, (kc) + 2); \
                _Pragma("unroll 2") \
                for (int q = 0; q < 4; ++q) { const int k4 = 4 * ks + q; \
                    f32x4 xv[8], w4[4]; \
                _Pragma("unroll") \
                    for (int i = 0; i < 8; ++i) xv[i] = *(const LAS f32x4*)(Xs + (tt + 16 * i) * 68 + 4 * k4); \
                _Pragma("unroll") \
                    for (int kk = 0; kk < 4; ++kk) w4[kk] = *(const LAS f32x4*)(Ws + (4 * k4 + kk) * 32 + 4 * te); \
                _Pragma("unroll") \
                    for (int i = 0; i < 8; ++i) \
                _Pragma("unroll") \
                        for (int kk = 0; kk < 4; ++kk) \
                _Pragma("unroll") \
                            for (int e = 0; e < 4; ++e) ac[i][e] += xv[i][kk] * w4[kk][e]; } \
                } while (0)
            P8_LOAD(xa, wa, 0); P8_LOAD(xb_, wb, 1);
            for (int kc = 0; kc < 16; kc += 2) { P8_STEP(xa, wa, kc); P8_STEP(xb_, wb, kc + 1); }
#undef P8_STEP
#undef P8_LOAD
            __syncthreads();
            { LAS float* Lp = (LAS float*)lds;
#pragma unroll
              for (int i = 0; i < 8; ++i)
#pragma unroll
                for (int e = 0; e < 4; ++e) Lp[(ks * 128 + tt + 16 * i) * 33 + 4 * te + e] = ac[i][e]; }
            __syncthreads();
            for (int o = tid; o < 128 * 32; o += NTHREADS) { const int t = o >> 5, e = o & 31; const LAS float* Lp = (const LAS float*)lds;
                const float sum = (Lp[t * 33 + e] + Lp[(128 + t) * 33 + e]) + (Lp[(256 + t) * 33 + e] + Lp[(384 + t) * 33 + e]);
                Lg[t * 33 + e] = sum * rsqrtf(ssq3[r0 + t] * (1.0f / 1024.0f) + EPS) + args.in[I_BR][e]; }
            __syncthreads();
            int ei[4], lp[4]; float gv[4];
            if (tid < 128) {
                unsigned taken = 0u; float tv[4];
#pragma unroll
                for (int k = 0; k < 4; ++k) { float best = -3.0e38f; int bi = 0;
                    for (int e = 0; e < 32; ++e) { const float v = Lg[tid * 33 + e]; if (!((taken >> e) & 1u) && v > best) { best = v; bi = e; } }
                    taken |= 1u << bi; ei[k] = bi; tv[k] = best; }
                float sum = 0.f;
#pragma unroll
                for (int k = 0; k < 4; ++k) { gv[k] = __expf(tv[k] - tv[0]); sum += gv[k]; }
                const float inv = 1.0f / sum;
#pragma unroll
                for (int k = 0; k < 4; ++k) { gv[k] *= inv; lp[k] = __hip_atomic_fetch_add((LAS int*)(hist + ei[k]), 1, __ATOMIC_RELAXED, __HIP_MEMORY_SCOPE_WORKGROUP); }
            }
            __syncthreads();
            if (tid < 32) hbase[tid] = atomicAdd(counts + tid, hist[tid]);
            __syncthreads();
            if (tid < 128) {
                const int tok = r0 + tid; const float rs = rsqrtf(ssq3[tok] * (1.0f / 1024.0f) + EPS);
#pragma unroll
                for (int k = 0; k < 4; ++k) { const size_t idx = (size_t)ei[k] * ECAP + hbase[ei[k]] + lp[k]; tokl[idx] = tok * 4 + k; gatel[idx] = gv[k]; rstdl[idx] = rs; }
            }
            __syncthreads();
        }
    }
    SEAM(8);
    if (IN(9) || IN(10)) {
        PH_WS;
        PH_IDS;
        LAS int* tb = (LAS int*)(lds + XL_OFF + XL_TB); LAS int* cn = (LAS int*)(lds + XL_OFF + XL_CNT);
        __syncthreads();
        if (tid == 0) { int a = 0; for (int e = 0; e < NEXP; ++e) { const int c = ald(counts + e); cn[e] = c; tb[e] = a; a += (c + 255) >> 8; } tb[NEXP] = a; }
        __syncthreads();
        if (IN(9)) {
        PH_WS;
            SchedMoeT<true> S; S.tb = tb; S.cnt = cn; S.tl = tokl; S.A = (const char*)x8; S.B = (const char*)(ws + WS_WGU); S.lda2 = 1024u; S.ldb2 = 1024u; S.K = 512; S.nN = 8; S.G = G; S.c = bx; S.bstride = (size_t)2048 * 1024; S.gather = true;
            EpiMoe1 E{rstdl, args.in[I_BGU], act};
            g8::gemm_phase(lds, S, E, wave);
            if (G == 256) {
                const int nwg = __builtin_amdgcn_readfirstlane(tb[NEXP]) * 8, rem = nwg - ((nwg + 255) / 256 - 1) * 256, idleN = 256 - rem;
                const int part = (idleN >= 64) ? idleN : 256, me = (idleN >= 64) ? bx - rem : bx;
                if (me >= 0) CV_STREAM(me * NWAVES + wave, part * NWAVES, CV_NIT - CV_I_DN + CV_DN_A, CV_NIT);
            }
        }
    }
    SEAM(9);
    if (IN(10)) {
        PH_WS;
        LAS int* tb = (LAS int*)(lds + XL_OFF + XL_TB); LAS int* cn = (LAS int*)(lds + XL_OFF + XL_CNT);
        SchedMoeT<false> S; S.tb = tb; S.cnt = cn; S.tl = tokl; S.A = (const char*)act; S.B = (const char*)(ws + WS_WDN); S.lda2 = 1024u; S.ldb2 = 1024u; S.K = 512; S.nN = 4; S.G = G; S.c = bx; S.bstride = (size_t)1024 * 1024; S.gather = false;
        EpiMoe2 E{tokl, gatel, args.in[I_BDN], slots};
        g8::gemm_phase(lds, S, E, wave);
    }
    SEAM(10);
    if (IN(11)) {
        PH_WS;
        PH_IDS;
        for (int m = gw; m < NTOK; m += NGW) {
            f32x4 v[4];
            { const u32x2* xr = (const u32x2*)(xh + (size_t)m * DM) + lane;
#pragma unroll
              for (int j = 0; j < 4; ++j) { const u32x2 w = xr[64 * j]; v[j] = (f32x4){bflo(w.x), bfhi(w.x), bflo(w.y), bfhi(w.y)}; } }
            if (DBG_OUT == 0) {
#pragma unroll
                for (int k = 0; k < 4; ++k) { const unsigned* sr = (const unsigned*)((const unsigned char*)slots + (size_t)(m * 4 + k) * DM) + lane;
#pragma unroll
                    for (int j = 0; j < 4; ++j) { const int w = (int)sr[64 * j]; const f32x2 lo = __builtin_amdgcn_cvt_pk_f32_fp8(w, false), hi = __builtin_amdgcn_cvt_pk_f32_fp8(w, true);
                        v[j][0] += lo[0] * (1.0f / S8S); v[j][1] += lo[1] * (1.0f / S8S); v[j][2] += hi[0] * (1.0f / S8S); v[j][3] += hi[1] * (1.0f / S8S); } }
            }
            float ss = 0.f;
#pragma unroll
            for (int j = 0; j < 4; ++j) ss += (v[j][0] * v[j][0] + v[j][1] * v[j][1]) + (v[j][2] * v[j][2] + v[j][3] * v[j][3]);
            const float rs = rsqrtf(wave_sum(ss) * (1.f / DM) + EPS);
            f32x4* o = (f32x4*)(args.out + (size_t)m * DM) + lane;
#pragma unroll
            for (int j = 0; j < 4; ++j) { const f32x4 g = ((const f32x4*)args.in[I_NF])[lane + 64 * j]; o[64 * j] = v[j] * rs * g; }
        }
    }
#if PROBE_PHASE >= 0 || PROBE_A >= 0
    STAMP(11);
    if (bx == 0 && threadIdx.x == 0) {
        const int ia = (PROBE_A >= 0) ? PROBE_A : PROBE_PHASE, ib = (PROBE_A >= 0) ? PROBE_B : PROBE_PHASE + 1;
        const unsigned long long d = (stamps[ib] - stamps[ia]) * (unsigned long long)PROBE_MULT, t0 = __builtin_amdgcn_s_memrealtime();
        while (__builtin_amdgcn_s_memrealtime() - t0 < d) __builtin_amdgcn_s_sleep(16);
    }
#endif
#undef CV_STREAM
#undef CV_DECODE
#undef IN
#undef SEAM
#undef vcu
#undef gw
#undef NGW
#undef counts
#undef rstd1
#undef ssqs
#undef ssq2
#undef ssq3
#undef gates
#undef gatel
#undef rstdl
#undef wrs
#undef tokl
#undef xb
#undef proj
#undef ug
#undef ycat
#undef ygelu
#undef x8
#undef xh
#undef qo
#undef pbuf
#undef ob
#undef act
#undef slots
#undef memn
#undef kmat
#undef vt
}

extern "C" void kernel_launch(void* const* d_in, const int* in_sizes, int n_in, void* d_out, int out_size, void* d_ws, size_t ws_size, hipStream_t stream) {
    static int grid = 0;
    if (grid == 0) {
        if (n_in != 30 || in_sizes[0] != NTOK * DM || out_size != NTOK * DM || ws_size < WS_END) { fprintf(stderr, "kernel_launch: unexpected shapes (n_in %d, in0 %d, out %d, ws %zu < %zu); nothing launched\n", n_in, n_in > 0 ? in_sizes[0] : -1, out_size, ws_size, (size_t)WS_END); grid = -1; return; }
        int dev = 0, cus = 0, per_cu = 0;
        if (hipGetDevice(&dev) != hipSuccess || hipDeviceGetAttribute(&cus, hipDeviceAttributeMultiprocessorCount, dev) != hipSuccess) { grid = -1; return; }
        if (hipFuncSetAttribute((const void*)mk_fwd, hipFuncAttributeMaxDynamicSharedMemorySize, LDS_BYTES) != hipSuccess) { fprintf(stderr, "kernel_launch: hipFuncSetAttribute failed\n"); grid = -1; return; }
        if (hipOccupancyMaxActiveBlocksPerMultiprocessor(&per_cu, (const void*)mk_fwd, NTHREADS, LDS_BYTES) != hipSuccess || per_cu < 1) { fprintf(stderr, "kernel_launch: occupancy query says %d blocks per CU\n", per_cu); per_cu = 1; }
        (void)hipGetLastError();
        grid = cus;
        if (grid != 256) fprintf(stderr, "kernel_launch: %d CUs; the attention phase assumes 256\n", grid);
    }
    if (grid < 0) return;
    if (hipMemsetAsync((char*)d_ws + WS_BAR, 0, BAR_ZERO_BYTES, stream) != hipSuccess) { fprintf(stderr, "kernel_launch: hipMemsetAsync failed\n"); return; }
    Args a{};
    for (int i = 0; i < 30; ++i) a.in[i] = (const float*)d_in[i];
    a.out = (float*)d_out; a.ws = (unsigned char*)d_ws;
#if MK_PER_PHASE
    for (int ph = 0; ph < 12; ++ph) { a.ph_lo = ph; a.ph_hi = ph + 1; hipLaunchKernelGGL(mk_fwd, dim3(grid), dim3(NTHREADS), LDS_BYTES, stream, a); }
#else
    a.ph_lo = 0; a.ph_hi = 12;
    void* kargs[] = {&a};
    hipError_t e = hipLaunchCooperativeKernel((const void*)mk_fwd, dim3(grid), dim3(NTHREADS), kargs, LDS_BYTES, stream);
    if (e != hipSuccess) fprintf(stderr, "kernel_launch: cooperative launch failed: %s (grid %d)\n", hipGetErrorString(e), grid);
#endif
}
```

```cpp
#include <hip/hip_runtime.h>
#include <hip/hip_cooperative_groups.h>
#include <cstdio>
#include <cstdint>
#include <cmath>
namespace cg = cooperative_groups;

#ifndef MK_PER_PHASE
#define MK_PER_PHASE 0
#endif
#ifndef MK_USE_CG
#define MK_USE_CG 0
#endif
#ifndef PROBE_PHASE
#define PROBE_PHASE -1
#endif
#ifndef PROBE_EPI
#define PROBE_EPI -1
#endif
#ifndef PROBE_A
#define PROBE_A -1
#define PROBE_B -1
#endif
#ifndef PROBE_MULT
#define PROBE_MULT 1
#endif
#ifndef DBG_OUT
#define DBG_OUT 0
#endif

#define LAS __attribute__((address_space(3)))
typedef unsigned short bf16_t;
typedef short bf16x8 __attribute__((ext_vector_type(8)));
typedef float f32x4 __attribute__((ext_vector_type(4)));
typedef float f32x2 __attribute__((ext_vector_type(2)));
typedef unsigned u32x4 __attribute__((ext_vector_type(4)));
typedef unsigned u32x2 __attribute__((ext_vector_type(2)));
typedef int i32x4 __attribute__((ext_vector_type(4)));
typedef int i32x8 __attribute__((ext_vector_type(8)));

constexpr int NTHREADS = 512, NWAVES = 8;
constexpr int DM = 1024, BATCH = 8, SEQ = 4096, NTOK = BATCH * SEQ, MEMLEN = 256, NMEM = BATCH * MEMLEN;
constexpr int NEXP = 32, TOPK = 4, ECAP = NTOK;
constexpr int MAXTILES = (NTOK * TOPK) / 256 + NEXP;
constexpr float EPS = 1e-5f;
constexpr float X8S = 16.0f, W8S = 256.0f, A8S = 4.0f, O8S = 64.0f, S8S = 32.0f, Q8S = 64.0f, K8S = 16.0f, P8S = 256.0f;

constexpr size_t MiB = 1u << 20;
constexpr size_t WS_CNT = 0;
constexpr size_t WS_BAR = 256 * 1024, BAR_ZERO_BYTES = 16 * 1024;
constexpr size_t WS_STAMP = 512 * 1024;
constexpr size_t WS_RSTD1 = 1 * MiB;
constexpr size_t WS_SSQS = WS_RSTD1 + 128 * 1024;
constexpr size_t WS_SSQ2 = WS_SSQS + 128 * 1024;
constexpr size_t WS_SSQ3 = WS_SSQ2 + 128 * 1024;
constexpr size_t WS_GATES = 2 * MiB;
constexpr size_t WS_WR = 3 * MiB;
constexpr size_t WS_TOKL = 4 * MiB;
constexpr size_t WS_SSM = 8 * MiB;
constexpr size_t SSM_STRIDE = 576 * 1024, SSM_KT = 1024, SSM_PT = 64 * 1024, SSM_QT = 320 * 1024;
constexpr size_t WS_WIN = 26 * MiB, WS_WGLU = 30 * MiB, WS_WOUT = 31 * MiB, WS_WQ = 33 * MiB, WS_WK = 35 * MiB, WS_WV = 37 * MiB, WS_WO = 39 * MiB;
constexpr size_t WS_MEMN = 41 * MiB, WS_KMAT = 45 * MiB, WS_VT = 49 * MiB;
constexpr size_t WS_WGU = 56 * MiB, WS_WDN = 184 * MiB;
constexpr size_t WS_YGELU = 248 * MiB;
constexpr size_t WS_X1 = 280 * MiB;
constexpr size_t WS_ACT = 408 * MiB;
constexpr size_t WS_XB = 408 * MiB, WS_PROJ = 472 * MiB, WS_UG = 568 * MiB, WS_YCAT = 600 * MiB;
constexpr size_t WS_SLOTS = 680 * MiB;
constexpr size_t WS_XH = 312 * MiB  , WS_QO = 744 * MiB, WS_PBUF = 808 * MiB, WS_O = 872 * MiB;
constexpr size_t WS_GATEL = 936 * MiB, WS_RSTDL = 940 * MiB;
constexpr size_t WS_END = 944 * MiB;

constexpr int LDS_BYTES = 147456;
constexpr int XL_OFF = 131072;
constexpr int XL_PMAX = 0, XL_PSUM = 4096, XL_TB = 12288, XL_CNT = 12544, XL_MISC = 13312;

template <int CTRL> __device__ __forceinline__ float dpp_mov(float x) { return __builtin_bit_cast(float, __builtin_amdgcn_mov_dpp(__builtin_bit_cast(int, x), CTRL, 0xf, 0xf, true)); }
__device__ __forceinline__ float wave_sum(float v) {
    v += dpp_mov<0xB1>(v); v += dpp_mov<0x4E>(v); v += dpp_mov<0x124>(v); v += dpp_mov<0x128>(v);
    auto s = __builtin_amdgcn_permlane16_swap(__float_as_uint(v), __float_as_uint(v), false, false); v = __uint_as_float(s[0]) + __uint_as_float(s[1]);
    auto t = __builtin_amdgcn_permlane32_swap(__float_as_uint(v), __float_as_uint(v), false, false); return __uint_as_float(t[0]) + __uint_as_float(t[1]);
}
__device__ __forceinline__ unsigned f2bf(float f) { unsigned u = __builtin_bit_cast(unsigned, f); return (u + 0x7fffu + ((u >> 16) & 1u)) >> 16; }
__device__ __forceinline__ unsigned pk2(float lo, float hi) { return f2bf(lo) | (f2bf(hi) << 16); }
__device__ __forceinline__ unsigned cvt_pk_bf16(float lo, float hi) { unsigned r; asm volatile("v_cvt_pk_bf16_f32 %0, %1, %2" : "=v"(r) : "v"(lo), "v"(hi)); return r; }
__device__ __forceinline__ unsigned pk4_fp8(float a, float b, float c, float d) { int w = __builtin_amdgcn_cvt_pk_fp8_f32(a, b, 0, false); w = __builtin_amdgcn_cvt_pk_fp8_f32(c, d, w, true); return (unsigned)w; }
__device__ __forceinline__ float clamp448(float v) { return __builtin_amdgcn_fmed3f(v, -448.0f, 448.0f); }
__device__ __forceinline__ float bflo(unsigned w) { return __builtin_bit_cast(float, w << 16); }
__device__ __forceinline__ float bfhi(unsigned w) { return __builtin_bit_cast(float, w & 0xffff0000u); }
__device__ __forceinline__ float bf2f(bf16_t b) { return __builtin_bit_cast(float, (unsigned)b << 16); }
__device__ __forceinline__ float sigmoidf_(float x) { return __builtin_amdgcn_rcpf(1.0f + __builtin_amdgcn_exp2f(-1.4426950408889634f * x)); }
__device__ __forceinline__ f32x2 sigmoid2(f32x2 x) { f32x2 e = x * -1.4426950408889634f; e[0] = __builtin_amdgcn_exp2f(e[0]); e[1] = __builtin_amdgcn_exp2f(e[1]); f32x2 d = e + 1.0f; d[0] = __builtin_amdgcn_rcpf(d[0]); d[1] = __builtin_amdgcn_rcpf(d[1]); return d; }
__device__ __forceinline__ f32x2 gelu_tanh2(f32x2 y) { const f32x2 t = (y * y * 0.044715f + 1.0f) * y * (2.0f * 0.7978845608028654f); return y * sigmoid2(t); }
__device__ __forceinline__ float gelu_tanh(float y) { const float t = 0.7978845608028654f * (y + 0.044715f * y * y * y); return y * sigmoidf_(2.0f * t); }
__device__ __forceinline__ int ald(const int* p) { return __hip_atomic_load(p, __ATOMIC_RELAXED, __HIP_MEMORY_SCOPE_AGENT); }

namespace g8 {
constexpr int BM = 256, BK = 64, HALF = 128, HTB = HALF * BK * 2, NXCD = 8, WGM = 8;
__device__ __forceinline__ int lds_byte(int r, int c) { const int st = (r >> 4) * 2 + (c >> 5), rr = r & 15, cc = c & 31, ob = rr * 64 + cc * 2; return st * 1024 + (ob ^ (((ob >> 9) & 1) << 5)); }
__device__ __forceinline__ void stage_rc(int b, int& R, int& C) { const int st = b / 1024, sb = b % 1024, swz = sb ^ (((sb >> 9) & 1) << 5); R = (st >> 1) * 16 + swz / 64; C = (st & 1) * 32 + (swz % 64) / 2; }
__device__ __forceinline__ int perm32(int rho) { const int n = rho >> 4, i = rho & 15; return 8 * (i >> 2) + 4 * n + (i & 3); }

struct Unit { const char* A; const char* B; int pm, pn, e, aux, valid, job; };

__device__ __forceinline__ bool tile_order(int i, int G, int c, int nM, int nN, int& pm, int& pn) {
    const int nwg = nM * nN; const long L = (long)i * G + c; if (L >= nwg) return false;
    int wgid = (int)L; { const int q = nwg / NXCD, r = nwg % NXCD, xcd = wgid % NXCD, off = wgid / NXCD; wgid = (xcd < r ? xcd * (q + 1) : r * (q + 1) + (xcd - r) * q) + off; }
    const int nig = WGM * nN, gid = wgid / nig, fm = gid * WGM, gsz = (nM - fm) < WGM ? (nM - fm) : WGM;
    pm = fm + ((wgid % nig) % gsz); pn = (wgid % nig) / gsz; return true;
}

__device__ __forceinline__ int lane_id_volatile() { int l; asm volatile("v_mbcnt_lo_u32_b32 %0, -1, 0\n\tv_mbcnt_hi_u32_b32 %0, -1, %0" : "=v"(l)); return l; }
template <class Epi, class Sched>
__device__ __forceinline__ void gemm_phase(LAS unsigned char* lds, const Sched& S, const Epi& E, const int wid) {
    const int lane = lane_id_volatile(), tid = wid * 64 + lane, wr = wid >> 2, wc = wid & 3, fr = lane & 15, fq = lane >> 4;
    const int K = S.K, nt = K / BK;
    const unsigned lda2 = S.lda2, ldb2 = S.ldb2;
    unsigned voffB0, cb0;
    { int R, C; stage_rc(tid * 16, R, C); cb0 = (unsigned)C * 2u; const int Rb = 64 * (R >> 5) + 16 * ((R >> 2) & 3) + 4 * ((R >> 4) & 1) + (R & 3); voffB0 = (unsigned)Rb * ldb2 + cb0; }
    const size_t pstepA = (size_t)64 * lda2, pstepB = (size_t)128 * ldb2, hstepA = (size_t)HALF * lda2;
    const size_t kstep = (size_t)(BK * 2);
    const size_t hstepB = (size_t)8 * ldb2;
    const unsigned ldsw = (unsigned)wid * 1024u;
    const int aoff = lds_byte(wr * 64 + fr, fq * 8), boff = lds_byte(wc * 32 + fr, fq * 8);
#define G8_SA(b, h) (((b) * 2 + (h)) * HTB)
#define G8_SB(b, h) ((4 + (b) * 2 + (h)) * HTB)
#define G8_STAGE_B(bufoff, gbase) do { _Pragma("unroll") for (int _i = 0; _i < 2; ++_i) \
        __builtin_amdgcn_global_load_lds((const unsigned*)((const char*)(gbase) + _i * pstepB + voffB0), (LAS unsigned*)(lds + (bufoff) + ldsw + _i * 8192), 16, 0, 0); } while (0)
#define G8_STAGE_A(bufoff, gbase, o0, o1) do { \
        __builtin_amdgcn_global_load_lds((const unsigned*)((const char*)(gbase) + (o0)), (LAS unsigned*)(lds + (bufoff) + ldsw), 16, 0, 0); \
        __builtin_amdgcn_global_load_lds((const unsigned*)((const char*)(gbase) + (o1)), (LAS unsigned*)(lds + (bufoff) + ldsw + 8192), 16, 0, 0); } while (0)
#define G8_LDA(dst, b, h) do { _Pragma("unroll") for (int m = 0; m < 4; ++m) _Pragma("unroll") for (int k = 0; k < 2; ++k) dst[m][k] = *(const LAS bf16x8*)(lds + G8_SA(b, h) + aoff + m * 2048 + k * 1024); } while (0)
#define G8_LDB(dst, b, h) do { _Pragma("unroll") for (int n = 0; n < 2; ++n) _Pragma("unroll") for (int k = 0; k < 2; ++k) dst[n][k] = *(const LAS bf16x8*)(lds + G8_SB(b, h) + boff + n * 2048 + k * 1024); } while (0)
#define G8_MMA(ai, bj, At, Bt) do { __builtin_amdgcn_s_setprio(1); _Pragma("unroll") for (int m = 0; m < 4; ++m) _Pragma("unroll") for (int n = 0; n < 2; ++n) _Pragma("unroll") for (int k = 0; k < 2; ++k) \
        acc[ai][bj][m][n] = __builtin_amdgcn_mfma_f32_16x16x32_bf16(Bt[n][k], At[m][k], acc[ai][bj][m][n], 0, 0, 0); __builtin_amdgcn_s_setprio(0); } while (0)
#define G8_RD16(off) __builtin_bit_cast(i32x4, *(const LAS bf16x8*)(lds + (off)))
#define G8_LDA8(dst, b, h) do { _Pragma("unroll") for (int m = 0; m < 4; ++m) dst[m] = __builtin_shufflevector(G8_RD16(G8_SA(b, h) + aoff + m * 2048), G8_RD16(G8_SA(b, h) + aoff + m * 2048 + 1024), 0, 1, 2, 3, 4, 5, 6, 7); } while (0)
#define G8_LDB8(dst, b, h) do { _Pragma("unroll") for (int n = 0; n < 2; ++n) dst[n] = __builtin_shufflevector(G8_RD16(G8_SB(b, h) + boff + n * 2048), G8_RD16(G8_SB(b, h) + boff + n * 2048 + 1024), 0, 1, 2, 3, 4, 5, 6, 7); } while (0)
#define G8_MMA8(ai, bj, At, Bt) do { __builtin_amdgcn_s_setprio(1); _Pragma("unroll") for (int m = 0; m < 4; ++m) _Pragma("unroll") for (int n = 0; n < 2; ++n) \
        asm volatile("s_nop 1\n\tv_mfma_scale_f32_16x16x128_f8f6f4 %0, %1, %2, %0, %3, %3 op_sel_hi:[0,0,0]" : "+v"(acc[ai][bj][m][n]) : "v"(Bt[n]), "v"(At[m]), "v"(scl8)); __builtin_amdgcn_s_setprio(0); } while (0)
#define G8_MM(ai, bj, X) do { if constexpr (Sched::FP8) G8_MMA8(ai, bj, At8, X##8); else G8_MMA(ai, bj, At, X); } while (0)
#define G8_LA(b, h) do { if constexpr (Sched::FP8) G8_LDA8(At8, b, h); else G8_LDA(At, b, h); } while (0)
#define G8_LB(X, b, h) do { if constexpr (Sched::FP8) G8_LDB8(X##8, b, h); else G8_LDB(X, b, h); } while (0)
#define G8_WAIT_V(n) asm volatile("s_waitcnt vmcnt(" #n ")" ::: "memory")
#define G8_WAIT_L(n) asm volatile("s_waitcnt lgkmcnt(" #n ")" ::: "memory")
#define G8_BAR __builtin_amdgcn_s_barrier()
#define G8_SCHED __builtin_amdgcn_sched_barrier(0)
#define G8_SETOFF(o, u) do { const int _t = wid * 64 + lane_id_volatile(); unsigned _w[2][2] = {{0u, 0u}, {0u, 0u}}; _Pragma("unroll") for (int _i = 0; _i < 2; ++_i) { int _R, _C; stage_rc(_t * 16 + _i * 8192, _R, _C); \
        _Pragma("unroll") for (int _h = 0; _h < 2; ++_h) { if (Sched::GATHER) _w[_h][_i] = S.arow_raw(u, _h * HALF + _R); \
            else if (_h == 0 && _i == 0) o[0][0] = (unsigned)_R * lda2 + (unsigned)_C * 2u; } } \
        if (Sched::GATHER) { asm volatile("" : "+v"(_w[0][0]), "+v"(_w[0][1]), "+v"(_w[1][0]), "+v"(_w[1][1]));     \
            _Pragma("unroll") for (int _h = 0; _h < 2; ++_h) o[_h][0] = (_w[_h][0] >> 2) | ((_w[_h][1] >> 2) << 16); } } while (0)
#define G8_GOFF0(pk) (((pk) & 0xffffu) * lda2 + cb0)
#define G8_GOFF1(pk) (((pk) >> 16) * lda2 + cb0)
#define G8_STAGE_AH(bufoff, gbase, h, pk) do { if (Sched::GATHER) { G8_STAGE_A(bufoff, gbase, G8_GOFF0(pk), G8_GOFF1(pk)); } \
        else { G8_STAGE_A(bufoff, (const char*)(gbase) + (h) * hstepA, oa[0][0], pstepA + oa[0][0]); } } while (0)
    Unit cur, nxt; int ui = 0;
    if (!S.next(0, cur)) return;
    f32x4 acc[2][2][4][2];
#pragma unroll
    for (int a = 0; a < 2; ++a)
#pragma unroll
        for (int b = 0; b < 2; ++b)
#pragma unroll
            for (int m = 0; m < 4; ++m)
#pragma unroll
                for (int n = 0; n < 2; ++n) acc[a][b][m][n] = (f32x4){0.f, 0.f, 0.f, 0.f};
    bf16x8 At[4][2], B0[2][2], B1[2][2];
    i32x8 At8[4], B08[2], B18[2]; const int scl8 = 0x7F7F7F7F;
    unsigned oa[2][2], on[2][2];
    G8_SETOFF(oa, cur);
    const char* cA = cur.A; const char* cB = cur.B;
    if (Epi::MID) { const int t_ = wid * 64 + lane_id_volatile(); E.mid_store(E.mid_load(cur, t_), t_, lds); }
    G8_STAGE_B(G8_SB(0, 0), cB); G8_STAGE_B(G8_SB(0, 1), cB + hstepB); G8_STAGE_AH(G8_SA(0, 0), cA, 0, oa[0][0]); G8_STAGE_AH(G8_SA(0, 1), cA, 1, oa[1][0]);
    if (wr == 1) G8_BAR;
    G8_WAIT_V(2); G8_BAR;
    G8_STAGE_B(G8_SB(1, 0), cB + kstep); G8_STAGE_AH(G8_SA(1, 0), cA + kstep, 0, oa[0][0]); G8_STAGE_B(G8_SB(1, 1), cB + hstepB + kstep);
    G8_WAIT_V(6); G8_BAR;
    bool has_next = S.next(1, nxt);
    if (Sched::GATHER) { if (has_next) { G8_SETOFF(on, nxt); } else {
#pragma unroll
        for (int h = 0; h < 2; ++h) on[h][0] = oa[h][0]; } }
    for (;;) {
        const char* nA = has_next ? nxt.A : cA; const char* nB = has_next ? nxt.B : cB;
#pragma unroll 1
        for (int t = 0; t < nt; t += 2) {
            const bool last = (t == nt - 2);
            const char* a1 = cA + (size_t)(t + 1) * kstep;
            const char* a2 = last ? nA : cA + (size_t)(t + 2) * kstep; const char* b2 = last ? nB : cB + (size_t)(t + 2) * kstep;
            const char* a3 = a2 + kstep; const char* b3 = b2 + kstep;
            unsigned p0 = 0, p1 = 0;
            if (Sched::GATHER) { p0 = last ? on[0][0] : oa[0][0]; p1 = last ? on[1][0] : oa[1][0]; }
            G8_LB(B0, 0, 0); G8_LB(B1, 0, 1); G8_SCHED; G8_LA(0, 0); G8_STAGE_AH(G8_SA(1, 1), a1, 1, oa[1][0]);
            G8_WAIT_V(8); G8_WAIT_L(0); G8_BAR; G8_MM(0, 0, B0); G8_MM(0, 1, B1); G8_BAR; G8_SCHED;
            G8_LA(0, 1); G8_STAGE_B(G8_SB(0, 0), b2); G8_STAGE_B(G8_SB(0, 1), b2 + hstepB); G8_STAGE_AH(G8_SA(0, 0), a2, 0, p0);
            G8_WAIT_V(8); G8_WAIT_L(0); G8_BAR; G8_MM(1, 0, B0); G8_MM(1, 1, B1); G8_BAR; G8_SCHED;
            G8_LB(B0, 1, 0); G8_LB(B1, 1, 1); G8_SCHED; G8_LA(1, 0); G8_STAGE_AH(G8_SA(0, 1), a2, 1, p1);
            G8_WAIT_V(8); G8_WAIT_L(0); G8_BAR; G8_MM(0, 0, B0); G8_MM(0, 1, B1); G8_BAR; G8_SCHED;
            G8_LA(1, 1); G8_STAGE_B(G8_SB(1, 0), b3); G8_STAGE_B(G8_SB(1, 1), b3 + hstepB); G8_STAGE_AH(G8_SA(1, 0), a3, 0, p0);
            G8_WAIT_V(8); G8_WAIT_L(0); G8_BAR; G8_MM(1, 0, B0); G8_MM(1, 1, B1); G8_BAR; G8_SCHED;
            if (Epi::MID) { const int fr_e = lane_id_volatile() & 15; E.mid(acc, cur, t, wr, fr_e, lds); }
        }
        if (wr == 0) G8_BAR;
        if constexpr (Sched::FP8) asm volatile("s_nop 15\n\ts_nop 15" ::: "memory");
        Unit n2; bool has2 = false; unsigned tk[2][2] = {{0u, 0u}, {0u, 0u}};
        if (has_next) { has2 = S.next(ui + 2, n2);
            if (Sched::GATHER && has2) { const int _t = wid * 64 + lane_id_volatile();
#pragma unroll
                for (int _i = 0; _i < 2; ++_i) { int _R, _C; stage_rc(_t * 16 + _i * 8192, _R, _C);
#pragma unroll
                    for (int _h = 0; _h < 2; ++_h) tk[_h][_i] = S.arow_raw(n2, _h * HALF + _R); } } }
        float midv = 0.f; if (Epi::MID && has_next) midv = E.mid_load(nxt, wid * 64 + lane_id_volatile());
        { const int l_e = lane_id_volatile(), fr_e = l_e & 15, fq_e = l_e >> 4;
          E(acc, cur, wr, wc, fr_e, fq_e, lds); if constexpr (Epi::PROBE2) { asm volatile("" ::: "memory"); const Epi E2 = E.probe_copy(); E2(acc, cur, wr, wc, fr_e, fq_e, lds); } }
        if (!has_next) break;
        if (Epi::MID) { asm volatile("" : "+v"(midv) :: "memory"); E.mid_store(midv, wid * 64 + lane_id_volatile(), lds); }
        if (Sched::GATHER) asm volatile("" : "+v"(tk[0][0]), "+v"(tk[0][1]), "+v"(tk[1][0]), "+v"(tk[1][1]) :: "memory");
#pragma unroll
        for (int a = 0; a < 2; ++a)
#pragma unroll
            for (int b = 0; b < 2; ++b)
#pragma unroll
                for (int m = 0; m < 4; ++m)
#pragma unroll
                    for (int n = 0; n < 2; ++n) acc[a][b][m][n] = (f32x4){0.f, 0.f, 0.f, 0.f};
        cur = nxt; cA = nA; cB = nB; ++ui;
        if (Sched::GATHER) {
#pragma unroll
            for (int h = 0; h < 2; ++h) { oa[h][0] = on[h][0]; if (has2) on[h][0] = (tk[h][0] >> 2) | ((tk[h][1] >> 2) << 16); } }
        nxt = n2; has_next = has2;
        if (wr == 1) G8_BAR;
    }
    G8_WAIT_V(0);
    G8_BAR;
#undef G8_SA
#undef G8_SB
#undef G8_STAGE_A
#undef G8_STAGE_B
#undef G8_LDA
#undef G8_LDB
#undef G8_MMA
#undef G8_MMA8
#undef G8_MM
#undef G8_LA
#undef G8_LB
#undef G8_LDA8
#undef G8_LDB8
#undef G8_RD16
#undef G8_WAIT_V
#undef G8_WAIT_L
#undef G8_BAR
#undef G8_SCHED
#undef G8_SETOFF
#undef G8_GOFF0
#undef G8_GOFF1
#undef G8_STAGE_AH
}
}
using g8::Unit;
using g8::lane_id_volatile;

#define EPI_PROBE_COPY(T) __device__ __forceinline__ T probe_copy() const { return *this; }
#define EPI_ROWS(ai, m) _Pragma("unroll") for (int ai = 0; ai < 2; ++ai) _Pragma("unroll") for (int m = 0; m < 4; ++m)
__device__ __forceinline__ u32x4 pack8(const f32x4 a, const f32x4 b) { u32x4 w; w.x = cvt_pk_bf16(a[0], a[1]); w.y = cvt_pk_bf16(a[2], a[3]); w.z = cvt_pk_bf16(b[0], b[1]); w.w = cvt_pk_bf16(b[2], b[3]); return w; }
__device__ __forceinline__ float sq8(const f32x4 a, const f32x4 b) {
    f32x2 t = (f32x2){a[0], a[1]} * (f32x2){a[0], a[1]};
    t = __builtin_elementwise_fma((f32x2){a[2], a[3]}, (f32x2){a[2], a[3]}, t); t = __builtin_elementwise_fma((f32x2){b[0], b[1]}, (f32x2){b[0], b[1]}, t); t = __builtin_elementwise_fma((f32x2){b[2], b[3]}, (f32x2){b[2], b[3]}, t);
    return t[0] + t[1]; }
__device__ __forceinline__ float xq_sum(float x) {
    auto s = __builtin_amdgcn_permlane16_swap(__float_as_uint(x), __float_as_uint(x), false, false); x = __uint_as_float(s[0]) + __uint_as_float(s[1]);
    auto t = __builtin_amdgcn_permlane32_swap(__float_as_uint(x), __float_as_uint(x), false, false); return __uint_as_float(t[0]) + __uint_as_float(t[1]); }
__device__ __forceinline__ float xq_max(float x) {
    auto s = __builtin_amdgcn_permlane16_swap(__float_as_uint(x), __float_as_uint(x), false, false); x = fmaxf(__uint_as_float(s[0]), __uint_as_float(s[1]));
    auto t = __builtin_amdgcn_permlane32_swap(__float_as_uint(x), __float_as_uint(x), false, false); return fmaxf(__uint_as_float(t[0]), __uint_as_float(t[1])); }
#define ROW4_OF(g) ((((g) & 1) << 1) | ((g) >> 1))
__device__ __forceinline__ float row4_sum(float s0, float s1, float s2, float s3) {
    auto a = __builtin_amdgcn_permlane32_swap(__float_as_uint(s0), __float_as_uint(s1), false, false); const float c = __uint_as_float(a[0]) + __uint_as_float(a[1]);
    auto b = __builtin_amdgcn_permlane32_swap(__float_as_uint(s2), __float_as_uint(s3), false, false); const float d = __uint_as_float(b[0]) + __uint_as_float(b[1]);
    auto e = __builtin_amdgcn_permlane16_swap(__float_as_uint(c), __float_as_uint(d), false, false); return __uint_as_float(e[0]) + __uint_as_float(e[1]); }

template <bool F8> struct SchedDenseT {
    static constexpr bool GATHER = false, FP8 = F8;
    const char* A; const char* B; unsigned lda2, ldb2; int K, nM, nN, G, c;
    __device__ __forceinline__ bool next(int i, Unit& u) const {
        int pm, pn; if (!g8::tile_order(i, G, c, nM, nN, pm, pn)) return false;
        u.pm = pm; u.pn = pn; u.A = A + (size_t)pm * 256 * lda2; u.B = B + (size_t)pn * 256 * ldb2; u.e = 0; u.aux = 0; u.valid = 256; u.job = 0; return true;
    }
    __device__ __forceinline__ unsigned arow_tok(const Unit&, int) const { return 0u; }
    __device__ __forceinline__ unsigned arow_raw(const Unit&, int) const { return 0u; }
};
typedef SchedDenseT<false> SchedDense;
struct SchedP1 {
    static constexpr bool GATHER = false, FP8 = false;
    const char *xb, *win, *memn, *wk, *wv; unsigned lda2, ldb2; int K, G, c;
    __device__ __forceinline__ bool next(int i, Unit& u) const {
        const int L = i * G + c;
        u.e = 0; u.aux = 0; u.valid = 256;
        if (L < 1024) { int pm, pn; g8::tile_order(i, G, c, 128, 8, pm, pn); u.pm = pm; u.pn = pn; u.job = 0; u.A = xb + (size_t)pm * 256 * 2048; u.B = win + (size_t)pn * 256 * 2048; return true; }
        const int r = L - 1024;
        if (r < 32) { u.pm = r >> 2; u.pn = r & 3; u.job = 1; u.A = memn + (size_t)u.pm * 256 * 2048; u.B = wk + (size_t)u.pn * 256 * 2048; return true; }
        if (r < 64) { const int q = r - 32; u.pm = q >> 3; u.pn = q & 7; u.job = 2; u.A = wv + (size_t)u.pm * 256 * 2048; u.B = memn + (size_t)u.pn * 256 * 2048; return true; }
        return false;
    }
    __device__ __forceinline__ unsigned arow_tok(const Unit&, int) const { return 0u; }
    __device__ __forceinline__ unsigned arow_raw(const Unit&, int) const { return 0u; }
};
struct SchedQ {
    static constexpr bool GATHER = false, FP8 = true;
    const char *A, *B; unsigned lda2, ldb2; int K, G, c;
    __device__ __forceinline__ bool next(int i, Unit& u) const {
        const int p = (G == 256) ? (c & 7) * 64 + (c >> 3) + 32 * i : c + i * G; if (i * G + c >= BATCH * 4 * 16) return false;
        const int b = p >> 6, h = (p >> 4) & 3, qb = p & 15;
        u.pm = b * 16 + qb; u.pn = h; u.e = 0; u.aux = 0; u.valid = 256; u.job = 0; u.A = A + (size_t)u.pm * 256 * lda2; u.B = B + (size_t)h * 256 * ldb2; return true;
    }
    __device__ __forceinline__ unsigned arow_tok(const Unit&, int) const { return 0u; }
    __device__ __forceinline__ unsigned arow_raw(const Unit&, int) const { return 0u; }
};
struct SchedAttn {
    static constexpr bool GATHER = false, FP8 = true;
    const char *q, *kmat, *vt, *pbuf; unsigned lda2, ldb2; int K, G, c, npair;
    __device__ __forceinline__ void pair_unit(int j, bool isO, Unit& u) const {
        const int p = (G == 256) ? (c & 7) * 64 + (c >> 3) + 32 * j : c + j * G; const int b = p >> 6, h = (p >> 4) & 3, qb = p & 15;
        u.pm = b * 16 + qb; u.pn = h; u.e = j & 1; u.aux = 0; u.valid = 256; u.job = isO ? 1 : 0;
        if (!isO) { u.A = q + ((size_t)((b * 4 + h) * SEQ + qb * 256)) * 256; u.B = kmat + ((size_t)((b * 4 + h) * 256)) * 256; }
        else      { u.A = pbuf + ((size_t)(c * 2 + (j & 1))) * 256 * 256; u.B = vt + ((size_t)((b * 4 + h) * 256)) * 256; }
    }
    __device__ __forceinline__ bool next(int i, Unit& u) const {
        const int n = npair; if (i >= 2 * n) return false;
        if (i == 0) { pair_unit(0, false, u); return true; }
        const int k = (i - 1) >> 1;
        if (i & 1) { if (k + 1 < n) pair_unit(k + 1, false, u); else pair_unit(n - 1, true, u); }
        else pair_unit(k, true, u);
        return true;
    }
    __device__ __forceinline__ unsigned arow_tok(const Unit&, int) const { return 0u; }
    __device__ __forceinline__ unsigned arow_raw(const Unit&, int) const { return 0u; }
};
struct SchedMoe {
    static constexpr bool GATHER_ = true;
    const LAS int* tb; const LAS int* cnt; const LAS unsigned char* et; const LAS int* ul; const int* tl; const char* A; const char* B; unsigned lda2, ldb2; int K, nN, G, c; size_t bstride; bool gather;
};
template <bool GATH> struct SchedMoeT : SchedMoe {
    static constexpr bool GATHER = GATH, FP8 = true;
    __device__ __forceinline__ bool next(int i, Unit& u) const {
        const int w_ = __builtin_amdgcn_readfirstlane(ul[i]); if (w_ < 0) return false;
        const int pm = w_ & 0xffff, pn = w_ >> 16;
        const int e = __builtin_amdgcn_readfirstlane((int)et[pm]);
        u.pm = pm; u.pn = pn; u.e = e; u.aux = (pm - __builtin_amdgcn_readfirstlane(tb[e])) * 256; const int v = __builtin_amdgcn_readfirstlane(cnt[e]) - u.aux; u.valid = v < 256 ? v : 256; u.job = 0;
        u.A = GATH ? A : A + (size_t)pm * 256 * lda2; u.B = B + (size_t)e * bstride + (size_t)pn * 256 * ldb2; return true;
    }
    __device__ __forceinline__ unsigned arow_tok(const Unit& u, int r) const {
        return (unsigned)(tl[(size_t)u.e * ECAP + u.aux + (r < u.valid ? r : u.valid - 1)] >> 2);
    }
    __device__ __forceinline__ unsigned arow_raw(const Unit& u, int r) const { return (unsigned)tl[(size_t)u.e * ECAP + u.aux + (r < u.valid ? r : u.valid - 1)]; }

};

struct EpiP1 {
    static constexpr bool MID = false; static constexpr bool PROBE2 = false; EPI_PROBE_COPY(EpiP1)
    const float* rstd1; bf16_t *proj, *ug, *kmat, *vt;
    __device__ __forceinline__ void mid(f32x4 (&)[2][2][4][2], const Unit&, int, int, int, LAS unsigned char*) const {}
    __device__ __forceinline__ float mid_load(const Unit&, int) const { return 0.f; }
    __device__ __forceinline__ void mid_store(float, int, LAS unsigned char*) const {}
    __device__ __forceinline__ void operator()(const f32x4 (&acc)[2][2][4][2], const Unit& u, int wr, int wc, int fr, int fq, LAS unsigned char*) const {
        const int col0 = u.pn * 256 + wc * 64 + 16 * fq;
        float rs[2][4];
        EPI_ROWS(ai, m) rs[ai][m] = (u.job == 0) ? rstd1[u.pm * 256 + ai * 128 + wr * 64 + m * 16 + fr] : 1.0f;
        EPI_ROWS(ai, m) {
            const int row = u.pm * 256 + ai * 128 + wr * 64 + m * 16 + fr;
            const float sc = rs[ai][m]; unsigned w8[4] = {0u, 0u, 0u, 0u};
#pragma unroll
            for (int bj = 0; bj < 2; ++bj) {
                const int col = col0 + bj * 8;
                if (u.job == 0) { const u32x4 w = pack8(acc[ai][bj][m][0] * sc, acc[ai][bj][m][1] * sc); bf16_t* dst;
                    if (u.pn < 6) dst = proj + (size_t)row * 1536 + col; else { const int cc = col - 1536; dst = ug + ((size_t)((row >> 12) * 32 + (cc >> 4)) * SEQ + (row & 4095)) * 16 + (cc & 15); }
                    *(u32x4*)dst = w; }
                else { const f32x4 a0 = acc[ai][bj][m][0] * K8S, a1 = acc[ai][bj][m][1] * K8S;
                    w8[2 * bj] = pk4_fp8(clamp448(a0[0]), clamp448(a0[1]), clamp448(a0[2]), clamp448(a0[3])); w8[2 * bj + 1] = pk4_fp8(clamp448(a1[0]), clamp448(a1[1]), clamp448(a1[2]), clamp448(a1[3])); }
            }
            if (u.job != 0) {
                unsigned char* dst = (u.job == 1) ? (unsigned char*)kmat + ((size_t)((u.pm * 4 + u.pn) * 256 + (row & 255))) * 256 + (col0 & 255)
                                                  : (unsigned char*)vt + ((size_t)((u.pn * 4 + u.pm) * 256 + (row & 255))) * 256 + (col0 & 255);
                *(u32x4*)dst = (u32x4){w8[0], w8[1], w8[2], w8[3]}; }
        }
    }
};
struct EpiGlu {
    static constexpr bool MID = false; static constexpr bool PROBE2 = false; EPI_PROBE_COPY(EpiGlu)
    const bf16_t* ygelu; bf16_t* ycat; float* ssqs;
    __device__ __forceinline__ void mid(f32x4 (&)[2][2][4][2], const Unit&, int, int, int, LAS unsigned char*) const {}
    __device__ __forceinline__ float mid_load(const Unit&, int) const { return 0.f; }
    __device__ __forceinline__ void mid_store(float, int, LAS unsigned char*) const {}
    __device__ __forceinline__ void operator()(const f32x4 (&acc)[2][2][4][2], const Unit& u, int wr, int wc, int fr, int fq, LAS unsigned char*) const {
        const int col0 = u.pn * 256 + wc * 64 + 16 * fq;
#pragma unroll
        for (int ai = 0; ai < 2; ++ai) {
            u32x4 aw[4][2];
#pragma unroll
            for (int m = 0; m < 4; ++m)
#pragma unroll
                for (int bj = 0; bj < 2; ++bj) aw[m][bj] = *(const u32x4*)(ygelu + (size_t)(u.pm * 256 + ai * 128 + wr * 64 + m * 16 + fr) * 512 + col0 + bj * 8);
            float ssr[4];
#pragma unroll
            for (int m = 0; m < 4; ++m) {
                const int row = u.pm * 256 + ai * 128 + wr * 64 + m * 16 + fr; float ss = 0.f;
#pragma unroll
                for (int bj = 0; bj < 2; ++bj) {
                    const u32x4 a = aw[m][bj];
                    f32x4 z0, z1; const f32x4 g0 = acc[ai][bj][m][0], g1 = acc[ai][bj][m][1];
                    { const f32x2 s0 = sigmoid2((f32x2){g0[0], g0[1]}) * (f32x2){bflo(a.x), bfhi(a.x)}, s1 = sigmoid2((f32x2){g0[2], g0[3]}) * (f32x2){bflo(a.y), bfhi(a.y)};
                      const f32x2 s2 = sigmoid2((f32x2){g1[0], g1[1]}) * (f32x2){bflo(a.z), bfhi(a.z)}, s3 = sigmoid2((f32x2){g1[2], g1[3]}) * (f32x2){bflo(a.w), bfhi(a.w)};
                      z0 = (f32x4){s0[0], s0[1], s1[0], s1[1]}; z1 = (f32x4){s2[0], s2[1], s3[0], s3[1]}; }
                    ss += sq8(z0, z1);
                    *(u32x4*)(ycat + (size_t)row * 1024 + col0 + bj * 8) = pack8(z0, z1);
                }
                ssr[m] = ss;
            }
            atomicAdd(ssqs + u.pm * 256 + ai * 128 + wr * 64 + ROW4_OF(fq) * 16 + fr, row4_sum(ssr[0], ssr[1], ssr[2], ssr[3]));
            asm volatile("" ::: "memory");
        }
    }
};
struct EpiRes {
    static constexpr bool MID = true; static constexpr bool PROBE2 = (PROBE_EPI == 4); __device__ __forceinline__ EpiRes probe_copy() const { EpiRes e = *this; e.ssq = ssq + 3 * NTOK; e.skip = (midt < 0); return e; }
    const bf16_t* xsrc; bf16_t* xh; unsigned char* x8; float* ssq; const float* ssqs; int midt; float accs; bool skip = false;
    __device__ __forceinline__ float mid_load(const Unit& u, int tidw) const { return (midt >= 0 && tidw < 256) ? ssqs[u.pm * 256 + tidw] : 0.f; }
    __device__ __forceinline__ void mid_store(float v, int tidw, LAS unsigned char* lds) const { if (midt >= 0 && tidw < 256) ((LAS float*)(lds + XL_OFF + XL_PMAX))[tidw] = rsqrtf(v * (1.0f / 512.0f) + EPS); }
    __device__ __forceinline__ void mid(f32x4 (&acc)[2][2][4][2], const Unit& u, int t, int wr, int fr, LAS unsigned char* lds) const {
        if (t != midt) return;
        const LAS float* tab = (const LAS float*)(lds + XL_OFF + XL_PMAX);
        EPI_ROWS(ai, m) {
            const float sc = tab[ai * 128 + wr * 64 + m * 16 + fr];
#pragma unroll
            for (int bj = 0; bj < 2; ++bj)
#pragma unroll
                for (int n = 0; n < 2; ++n) acc[ai][bj][m][n] *= sc;
        }
    }
    __device__ __forceinline__ void operator()(const f32x4 (&acc)[2][2][4][2], const Unit& u, int wr, int wc, int fr, int fq, LAS unsigned char*) const {
        if (skip) return;
        const int col0 = u.pn * 256 + wc * 64 + 16 * fq;
#pragma unroll
        for (int ai = 0; ai < 2; ++ai) {
            u32x4 rw[4][2];
#pragma unroll
            for (int m = 0; m < 4; ++m)
#pragma unroll
                for (int bj = 0; bj < 2; ++bj) rw[m][bj] = *(const u32x4*)(xsrc + (size_t)(u.pm * 256 + ai * 128 + wr * 64 + m * 16 + fr) * 1024 + col0 + bj * 8);
            float ssr[4];
#pragma unroll
            for (int m = 0; m < 4; ++m) {
                const int row = u.pm * 256 + ai * 128 + wr * 64 + m * 16 + fr; float ss = 0.f; unsigned w8[4];
#pragma unroll
                for (int bj = 0; bj < 2; ++bj) {
                    const size_t off = (size_t)row * 1024 + col0 + bj * 8; const u32x4 w = rw[m][bj];
                    const f32x4 r0 = (f32x4){bflo(w.x), bfhi(w.x), bflo(w.y), bfhi(w.y)}, r1 = (f32x4){bflo(w.z), bfhi(w.z), bflo(w.w), bfhi(w.w)};
                    const f32x4 v0 = r0 + acc[ai][bj][m][0] * accs, v1 = r1 + acc[ai][bj][m][1] * accs;
                    ss += sq8(v0, v1);
                    *(u32x4*)(xh + off) = pack8(v0, v1);
                    const f32x2 a0 = (f32x2){v0[0], v0[1]} * X8S, a1 = (f32x2){v0[2], v0[3]} * X8S, a2 = (f32x2){v1[0], v1[1]} * X8S, a3 = (f32x2){v1[2], v1[3]} * X8S;
                    w8[2 * bj] = pk4_fp8(clamp448(a0[0]), clamp448(a0[1]), clamp448(a1[0]), clamp448(a1[1])); w8[2 * bj + 1] = pk4_fp8(clamp448(a2[0]), clamp448(a2[1]), clamp448(a3[0]), clamp448(a3[1]));
                }
                *(u32x4*)(x8 + (size_t)row * 1024 + col0) = (u32x4){w8[0], w8[1], w8[2], w8[3]};
                ssr[m] = ss;
            }
            atomicAdd(ssq + u.pm * 256 + ai * 128 + wr * 64 + ROW4_OF(fq) * 16 + fr, row4_sum(ssr[0], ssr[1], ssr[2], ssr[3]));
            asm volatile("" ::: "memory");
        }
    }
};
struct EpiQ {
    static constexpr bool MID = false; static constexpr bool PROBE2 = false; EPI_PROBE_COPY(EpiQ)
    const float* ssq2; bf16_t* q;
    __device__ __forceinline__ void mid(f32x4 (&)[2][2][4][2], const Unit&, int, int, int, LAS unsigned char*) const {}
    __device__ __forceinline__ float mid_load(const Unit&, int) const { return 0.f; }
    __device__ __forceinline__ void mid_store(float, int, LAS unsigned char*) const {}
    __device__ __forceinline__ void operator()(const f32x4 (&acc)[2][2][4][2], const Unit& u, int wr, int wc, int fr, int fq, LAS unsigned char*) const {
        const int col0 = u.pn * 256 + wc * 64 + 16 * fq;
        float sq[2][4];
        EPI_ROWS(ai, m) sq[ai][m] = ssq2[u.pm * 256 + ai * 128 + wr * 64 + m * 16 + fr];
        EPI_ROWS(ai, m) {
            const int row = u.pm * 256 + ai * 128 + wr * 64 + m * 16 + fr;
            const float sc = rsqrtf(sq[ai][m] * (1.0f / 1024.0f) + EPS) * (1.4426950408889634f / 16.0f) * (1.0f / (X8S * W8S));
            unsigned w8[4];
#pragma unroll
            for (int bj = 0; bj < 2; ++bj) { const f32x4 a0 = acc[ai][bj][m][0] * (sc * Q8S), a1 = acc[ai][bj][m][1] * (sc * Q8S);
                w8[2 * bj] = pk4_fp8(clamp448(a0[0]), clamp448(a0[1]), clamp448(a0[2]), clamp448(a0[3])); w8[2 * bj + 1] = pk4_fp8(clamp448(a1[0]), clamp448(a1[1]), clamp448(a1[2]), clamp448(a1[3])); }
            *(u32x4*)((unsigned char*)q + ((size_t)(((row >> 12) * 4 + u.pn) * SEQ + (row & 4095))) * 256 + (col0 & 255)) = (u32x4){w8[0], w8[1], w8[2], w8[3]};
        }
    }
};
struct EpiAttn {
    static constexpr bool MID = false; static constexpr bool PROBE2 = false; EPI_PROBE_COPY(EpiAttn)
    bf16_t* pbuf; bf16_t* o; int c;
    __device__ __forceinline__ void mid(f32x4 (&)[2][2][4][2], const Unit&, int, int, int, LAS unsigned char*) const {}
    __device__ __forceinline__ float mid_load(const Unit&, int) const { return 0.f; }
    __device__ __forceinline__ void mid_store(float, int, LAS unsigned char*) const {}
    __device__ __forceinline__ void operator()(const f32x4 (&acc)[2][2][4][2], const Unit& u, int wr, int wc, int fr, int fq, LAS unsigned char* lds) const {
        LAS float* pmax = (LAS float*)(lds + XL_OFF + XL_PMAX);
        LAS float* psum = (LAS float*)(lds + XL_OFF + XL_PSUM) + u.e * 1024;
        if (u.job == 0) {
            EPI_ROWS(ai, m) {
                const int r = ai * 128 + wr * 64 + m * 16 + fr; float mx = -3.0e38f;
#pragma unroll
                for (int bj = 0; bj < 2; ++bj)
#pragma unroll
                    for (int n = 0; n < 2; ++n)
#pragma unroll
                        for (int i = 0; i < 4; ++i) mx = fmaxf(mx, acc[ai][bj][m][n][i]);
                mx = xq_max(mx);
                if (fq == 0) pmax[r * 4 + wc] = mx;
            }
            asm volatile("s_waitcnt lgkmcnt(0)" ::: "memory"); __builtin_amdgcn_s_barrier(); asm volatile("" ::: "memory");
            bf16_t* P = (bf16_t*)((unsigned char*)pbuf + (size_t)(c * 2 + u.e) * 256 * 256);
            f32x4 pm4a[2][4];
            EPI_ROWS(ai, m) pm4a[ai][m] = *(const LAS f32x4*)(pmax + (ai * 128 + wr * 64 + m * 16 + fr) * 4);
            EPI_ROWS(ai, m) {
                const int r = ai * 128 + wr * 64 + m * 16 + fr;
                const f32x4 pm4 = pm4a[ai][m];
                const float mx = fmaxf(fmaxf(pm4[0], pm4[1]), fmaxf(pm4[2], pm4[3])); float ss = 0.f; unsigned w8[4];
#pragma unroll
                for (int bj = 0; bj < 2; ++bj) {
                    f32x4 p0, p1;
#pragma unroll
                    for (int i = 0; i < 4; ++i) { p0[i] = __builtin_amdgcn_exp2f((acc[ai][bj][m][0][i] - mx) * (1.0f / (Q8S * K8S))); p1[i] = __builtin_amdgcn_exp2f((acc[ai][bj][m][1][i] - mx) * (1.0f / (Q8S * K8S))); }
                    ss += (p0[0] + p0[1]) + (p0[2] + p0[3]) + (p1[0] + p1[1]) + (p1[2] + p1[3]);
                    w8[2 * bj] = pk4_fp8(p0[0] * P8S, p0[1] * P8S, p0[2] * P8S, p0[3] * P8S); w8[2 * bj + 1] = pk4_fp8(p1[0] * P8S, p1[1] * P8S, p1[2] * P8S, p1[3] * P8S);
                }
                *(u32x4*)((unsigned char*)P + (size_t)r * 256 + wc * 64 + 16 * fq) = (u32x4){w8[0], w8[1], w8[2], w8[3]};
                ss = xq_sum(ss);
                if (fq == 0) psum[r * 4 + wc] = ss;
                asm volatile("" ::: "memory");
            }
            asm volatile("s_waitcnt vmcnt(0) lgkmcnt(0)" ::: "memory"); __builtin_amdgcn_s_barrier(); asm volatile("" ::: "memory");
        } else {
            const int b = u.pm >> 4, qb = u.pm & 15, h = u.pn;
            f32x4 psa[2][4];
            EPI_ROWS(ai, m) psa[ai][m] = *(const LAS f32x4*)(psum + (ai * 128 + wr * 64 + m * 16 + fr) * 4);
            EPI_ROWS(ai, m) {
                const int r = ai * 128 + wr * 64 + m * 16 + fr;
                const f32x4 ps = psa[ai][m];
                const float inv = (O8S / (P8S * K8S)) / ((ps[0] + ps[1]) + (ps[2] + ps[3]));
                unsigned char* dst = (unsigned char*)o + (size_t)(b * SEQ + qb * 256 + r) * 1024 + h * 256 + wc * 64 + 16 * fq;
                unsigned w8[4];
#pragma unroll
                for (int bj = 0; bj < 2; ++bj) { const f32x4 a0 = acc[ai][bj][m][0] * inv, a1 = acc[ai][bj][m][1] * inv;
                    w8[2 * bj] = pk4_fp8(clamp448(a0[0]), clamp448(a0[1]), clamp448(a0[2]), clamp448(a0[3])); w8[2 * bj + 1] = pk4_fp8(clamp448(a1[0]), clamp448(a1[1]), clamp448(a1[2]), clamp448(a1[3])); }
                *(u32x4*)dst = (u32x4){w8[0], w8[1], w8[2], w8[3]};
            }
        }
    }
};
struct EpiMoe1 {
    static constexpr bool MID = false; static constexpr bool PROBE2 = (PROBE_EPI == 9); EPI_PROBE_COPY(EpiMoe1)
    const float* rstdl; const float* bgu; bf16_t* act;
    __device__ __forceinline__ void mid(f32x4 (&)[2][2][4][2], const Unit&, int, int, int, LAS unsigned char*) const {}
    __device__ __forceinline__ float mid_load(const Unit&, int) const { return 0.f; }
    __device__ __forceinline__ void mid_store(float, int, LAS unsigned char*) const {}
    __device__ __forceinline__ void operator()(const f32x4 (&acc)[2][2][4][2], const Unit& u, int wr, int wc, int fr, int fq, LAS unsigned char*) const {
        const int cj = u.pn * 128 + wc * 32 + 8 * fq;
        const float* bg = bgu + (size_t)u.e * 2048 + cj;
        float rs[2][4];
        EPI_ROWS(ai, m) { const int r = ai * 128 + wr * 64 + m * 16 + fr; rs[ai][m] = rstdl[(size_t)u.e * ECAP + u.aux + (r < u.valid ? r : 0)]; }
        f32x4 bgv[2] = {*(const f32x4*)bg, *(const f32x4*)(bg + 4)}, blv[2] = {*(const f32x4*)(bg + 1024), *(const f32x4*)(bg + 1028)};
        asm volatile("" : "+v"(rs[0][0]), "+v"(rs[0][1]), "+v"(rs[0][2]), "+v"(rs[0][3]), "+v"(rs[1][0]), "+v"(rs[1][1]), "+v"(rs[1][2]), "+v"(rs[1][3]), "+v"(bgv[0]), "+v"(bgv[1]), "+v"(blv[0]), "+v"(blv[1]));
        blv[0] = blv[0] * A8S + A8S; blv[1] = blv[1] * A8S + A8S;
#pragma unroll
        for (int ai = 0; ai < 2; ++ai)
#pragma unroll
        for (int mp = 0; mp < 2; ++mp) {
            unsigned w[2][2];
#pragma unroll
            for (int q = 0; q < 2; ++q) { const int m = 2 * mp + q; const float sc = rs[ai][m] * (1.0f / (X8S * W8S));
#pragma unroll
            for (int n = 0; n < 2; ++n) { f32x2 o2[2];
#pragma unroll
                for (int h = 0; h < 2; ++h) {
                    const f32x2 ag = {acc[ai][0][m][n][2 * h], acc[ai][0][m][n][2 * h + 1]}, al = {acc[ai][1][m][n][2 * h], acc[ai][1][m][n][2 * h + 1]};
                    const f32x2 bg2 = {bgv[n][2 * h], bgv[n][2 * h + 1]}, bl2 = {blv[n][2 * h], blv[n][2 * h + 1]};
                    f32x2 g = ag * sc + bg2, l = al * (sc * A8S) + bl2;
                    g[0] = fminf(g[0], 7.0f); g[1] = fminf(g[1], 7.0f);
                    l[0] = __builtin_amdgcn_fmed3f(l[0], -6.0f * A8S, 8.0f * A8S); l[1] = __builtin_amdgcn_fmed3f(l[1], -6.0f * A8S, 8.0f * A8S);
                    f32x2 e = g * (-1.702f * 1.4426950408889634f);
                    e[0] = __builtin_amdgcn_exp2f(e[0]); e[1] = __builtin_amdgcn_exp2f(e[1]);
                    f32x2 d = e + 1.0f;
                    d[0] = __builtin_amdgcn_rcpf(d[0]); d[1] = __builtin_amdgcn_rcpf(d[1]);
                    o2[h] = (g * d) * l;
                }
                w[q][n] = pk4_fp8(o2[0][0], o2[0][1], o2[1][0], o2[1][1]); } }
            auto x0 = __builtin_amdgcn_permlane16_swap(w[0][0], w[1][0], false, false); auto x1 = __builtin_amdgcn_permlane16_swap(w[0][1], w[1][1], false, false);
            const int r = ai * 128 + wr * 64 + (2 * mp + (fq & 1)) * 16 + fr;
            *(u32x4*)((unsigned char*)act + (size_t)(u.pm * 256 + r) * 1024 + cj - 8 * (fq & 1)) = (u32x4){x0[0], x1[0], x0[1], x1[1]};
        }
    }
};
struct EpiMoe2 {
    static constexpr bool MID = false; static constexpr bool PROBE2 = (PROBE_EPI == 10); EPI_PROBE_COPY(EpiMoe2)
    const int* tokl; const float* gatel; const float* bdn; bf16_t* slots;
    __device__ __forceinline__ void mid(f32x4 (&)[2][2][4][2], const Unit&, int, int, int, LAS unsigned char*) const {}
    __device__ __forceinline__ float mid_load(const Unit&, int) const { return 0.f; }
    __device__ __forceinline__ void mid_store(float, int, LAS unsigned char*) const {}
    __device__ __forceinline__ void operator()(const f32x4 (&acc)[2][2][4][2], const Unit& u, int wr, int wc, int fr, int fq, LAS unsigned char*) const {
        const int col0 = u.pn * 256 + wc * 64 + 16 * fq;
        const float* bp = bdn + (size_t)u.e * 1024 + col0;
        int sl[2][4]; float gt[2][4];
        EPI_ROWS(ai, m) { const int r = ai * 128 + wr * 64 + m * 16 + fr; const size_t idx = (size_t)u.e * ECAP + u.aux + (r < u.valid ? r : 0); sl[ai][m] = tokl[idx]; gt[ai][m] = gatel[idx]; }
        f32x4 bv[2][2];
#pragma unroll
        for (int bj = 0; bj < 2; ++bj) { bv[bj][0] = *(const f32x4*)(bp + bj * 8); bv[bj][1] = *(const f32x4*)(bp + bj * 8 + 4); }
        asm volatile("" : "+v"(sl[0][0]), "+v"(sl[0][1]), "+v"(sl[0][2]), "+v"(sl[0][3]), "+v"(sl[1][0]), "+v"(sl[1][1]), "+v"(sl[1][2]), "+v"(sl[1][3]),
                          "+v"(gt[0][0]), "+v"(gt[0][1]), "+v"(gt[0][2]), "+v"(gt[0][3]), "+v"(gt[1][0]), "+v"(gt[1][1]), "+v"(gt[1][2]), "+v"(gt[1][3]), "+v"(bv[0][0]), "+v"(bv[0][1]), "+v"(bv[1][0]), "+v"(bv[1][1]));
        EPI_ROWS(ai, m) {
            const int r = ai * 128 + wr * 64 + m * 16 + fr;
            {
                const int slot = (r < u.valid) ? sl[ai][m] : (int)((WS_O - WS_SLOTS) / 1024) + r; const float g = gt[ai][m];
                unsigned w8[4];
#pragma unroll
                for (int bj = 0; bj < 2; ++bj) { const float gs = g * S8S; const f32x4 o0 = (acc[ai][bj][m][0] * (1.0f / (A8S * W8S)) + bv[bj][0]) * gs, o1 = (acc[ai][bj][m][1] * (1.0f / (A8S * W8S)) + bv[bj][1]) * gs;
                    w8[2 * bj] = pk4_fp8(clamp448(o0[0]), clamp448(o0[1]), clamp448(o0[2]), clamp448(o0[3])); w8[2 * bj + 1] = pk4_fp8(clamp448(o1[0]), clamp448(o1[1]), clamp448(o1[2]), clamp448(o1[3])); }
                *(u32x4*)((unsigned char*)slots + (size_t)slot * 1024 + col0) = (u32x4){w8[0], w8[1], w8[2], w8[3]};
            }
        }
    }
};

#define XB_TMO      128
#define XB_XCNT(j)  (256  + 64 * (j))
#define XB_XSUB(j)  (1280 + 64 * (j))
#define XB_XGEN(j)  (2304 + 64 * (j))
#define XB_TOP      3328
#define XB_TOPGEN   3392
#define XCD_BAR_WORDS 3456
#define XB_RANK(j)  (3520 + 16 * (j))
#define XB_SPIN_CAP (1u << 20)
__device__ __forceinline__ unsigned xb_ld(unsigned* p)              { return __hip_atomic_load(p, __ATOMIC_RELAXED, __HIP_MEMORY_SCOPE_AGENT); }
__device__ __forceinline__ unsigned xb_add(unsigned* p, unsigned v) { return __hip_atomic_fetch_add(p, v, __ATOMIC_RELAXED, __HIP_MEMORY_SCOPE_AGENT); }
__device__ __forceinline__ unsigned xb_xcc_id() { return (unsigned)__builtin_amdgcn_s_getreg((3 << 11) | 20) & 0xFu; }
#define XB_SPIN(cond, bar) do { unsigned _sp = 0; while (cond) { __builtin_amdgcn_s_sleep(1); \
    if ((++_sp & 255u) == 0u) { if (xb_ld(&(bar)[XB_TMO])) break; if (_sp > XB_SPIN_CAP) { atomicAdd(&(bar)[XB_TMO], 1u); break; } } } } while (0)
struct XcdBarrier { unsigned* bar; unsigned x; volatile LAS unsigned* st; };
__device__ __forceinline__ XcdBarrier xcd_barrier_post(unsigned* bar, volatile LAS unsigned* st) {
    XcdBarrier b; b.bar = bar; b.x = xb_xcc_id(); b.st = st;
    if (threadIdx.x == 0) (void)xb_add(&bar[XB_XCNT(b.x)], 1u);
    return b;
}
__device__ __forceinline__ void xcd_barrier_complete(unsigned* bar, unsigned x, unsigned& nloc, unsigned& nx, unsigned& even32) {
    const unsigned G = gridDim.x * gridDim.y * gridDim.z;
    unsigned sum, cnt, mine, sp = 0u, n32;
    for (;;) {
        sum = 0u; cnt = 0u; mine = 0u; n32 = 0u;
#pragma unroll
        for (unsigned j = 0; j < 16; ++j) { const unsigned c = xb_ld(&bar[XB_XCNT(j)]); sum += c; cnt += (c > 0u) ? 1u : 0u; mine = (j == x) ? c : mine; n32 += (j < 8u && c == 32u) ? 1u : 0u; }
        if (sum == G) break;
        __builtin_amdgcn_s_sleep(1);
        if ((++sp & 255u) == 0u) { if (xb_ld(&bar[XB_TMO])) break; if (sp > XB_SPIN_CAP) { atomicAdd(&bar[XB_TMO], 1u); break; } }
    }
    nloc = mine > 0u ? mine : 1u; nx = cnt > 0u ? cnt : 1u; even32 = (sum == G && G == 256u && n32 == 8u) ? 1u : 0u;
}
__device__ __forceinline__ void xcd_barrier(const XcdBarrier& b, const bool local = false) {
    asm volatile("s_waitcnt vmcnt(0)" ::: "memory");
    __syncthreads();
    if (threadIdx.x == 0) {
        unsigned* bar = b.bar;
        __builtin_amdgcn_s_waitcnt(0);
        unsigned nloc = b.st[0], nx = b.st[1];
        if (nloc == 0u) { unsigned e32; xcd_barrier_complete(bar, b.x, nloc, nx, e32); b.st[0] = nloc; b.st[1] = nx; b.st[3] = e32; }
        const unsigned old = xb_add(&bar[XB_XSUB(b.x)], 1u);
        const unsigned gen = old / nloc;
        if (old + 1u == (gen + 1u) * nloc) {
            if (!local) {
                __builtin_amdgcn_fence(__ATOMIC_RELEASE, "agent");
                asm volatile("s_waitcnt vmcnt(0)" ::: "memory");
                const unsigned og = xb_add(&bar[XB_TOP], 1u);
                const unsigned tg = og / nx;
                if (og + 1u == (tg + 1u) * nx) xb_add(&bar[XB_TOPGEN], 1u);
                else XB_SPIN(xb_ld(&bar[XB_TOPGEN]) == tg, bar);
            }
            __builtin_amdgcn_fence(__ATOMIC_ACQUIRE, "agent");
            xb_add(&bar[XB_XGEN(b.x)], 1u);
            asm volatile("s_waitcnt vmcnt(0)" ::: "memory");
        } else {
            XB_SPIN(xb_ld(&bar[XB_XGEN(b.x)]) == gen, bar);
            __builtin_amdgcn_fence(__ATOMIC_ACQUIRE, "agent");
            asm volatile("s_waitcnt vmcnt(0)" ::: "memory");
        }
    }
    __syncthreads();
}

struct Args { const float* in[30]; float* out; unsigned char* ws; int ph_lo, ph_hi; };
enum { I_X = 0, I_MEM, I_NMIX, I_WIN, I_CONVW, I_ARE, I_AIM, I_LOGDT, I_BRE, I_BIM, I_CRE, I_CIM, I_D, I_WGLU, I_NCO, I_NSO, I_WOUT, I_NX, I_NM, I_WQ, I_WKV, I_WO, I_NMOE, I_WR, I_BR, I_WGU, I_BGU, I_WDN, I_BDN, I_NF };

struct CvItem { const float* W; const float* scale; unsigned char* WT; int ldw, k0, n0, ldt, drow0, dk0, f8, rmap; };
__device__ __forceinline__ void cv_load(const CvItem& c, float (&v)[64], int lane) {
    const float* src = c.W + (size_t)c.k0 * c.ldw + c.n0 + lane;
#pragma unroll
    for (int i = 0; i < 64; ++i) v[i] = __builtin_nontemporal_load(src + (size_t)i * c.ldw);
}
__device__ __forceinline__ void cv_store(const CvItem& c, float (&v)[64], int lane, LAS unsigned char* scr) {
    if (c.scale) {
#pragma unroll
        for (int i = 0; i < 64; ++i) v[i] *= c.scale[c.k0 + i];
    }
    if (c.f8) {
#pragma unroll
        for (int q = 0; q < 4; ++q) { u32x4 o; o.x = pk4_fp8(v[16 * q] * W8S, v[16 * q + 1] * W8S, v[16 * q + 2] * W8S, v[16 * q + 3] * W8S); o.y = pk4_fp8(v[16 * q + 4] * W8S, v[16 * q + 5] * W8S, v[16 * q + 6] * W8S, v[16 * q + 7] * W8S);
            o.z = pk4_fp8(v[16 * q + 8] * W8S, v[16 * q + 9] * W8S, v[16 * q + 10] * W8S, v[16 * q + 11] * W8S); o.w = pk4_fp8(v[16 * q + 12] * W8S, v[16 * q + 13] * W8S, v[16 * q + 14] * W8S, v[16 * q + 15] * W8S);
            *(LAS u32x4*)(scr + lane * 80 + 16 * q) = o; }
        asm volatile("s_waitcnt lgkmcnt(0)" ::: "memory");
#pragma unroll
        for (int j = 0; j < 4; ++j) { const int row = 16 * j + (lane >> 2), ch = lane & 3; const u32x4 o = *(const LAS u32x4*)(scr + row * 80 + 16 * ch);
            const int drow = c.drow0 + (c.rmap ? 16 * (row >> 3) + (row & 7) : row);
            *(u32x4*)(c.WT + (size_t)drow * c.ldt + c.dk0 + 16 * ch) = o; }
    } else {
#pragma unroll
        for (int q = 0; q < 8; ++q) { u32x4 o; o.x = pk2(v[8 * q], v[8 * q + 1]); o.y = pk2(v[8 * q + 2], v[8 * q + 3]); o.z = pk2(v[8 * q + 4], v[8 * q + 5]); o.w = pk2(v[8 * q + 6], v[8 * q + 7]);
            *(LAS u32x4*)(scr + lane * 144 + 16 * q) = o; }
        asm volatile("s_waitcnt lgkmcnt(0)" ::: "memory");
#pragma unroll
        for (int j = 0; j < 8; ++j) { const int row = 8 * j + (lane >> 3), ch = lane & 7; const u32x4 o = *(const LAS u32x4*)(scr + row * 144 + 16 * ch);
            *(u32x4*)(c.WT + (size_t)(c.drow0 + row) * c.ldt + c.dk0 + 16 * ch) = o; }
    }
    asm volatile("s_waitcnt lgkmcnt(0)" ::: "memory");
}

__global__ void __launch_bounds__(NTHREADS, 2) mk_fwd(Args args) {
    extern __shared__ __attribute__((aligned(16))) unsigned char lds_raw[];
    LAS unsigned char* lds = (LAS unsigned char*)lds_raw;
    cg::grid_group grid = cg::this_grid();
    const int wave = __builtin_amdgcn_readfirstlane(threadIdx.x >> 6);
#define PH_IDS const int lane = lane_id_volatile(), tid = wave * 64 + lane; (void)lane; (void)tid
    const int G = gridDim.x, bx = blockIdx.x;
#define vcu ((G % 8 == 0) ? (bx % 8) * (G / 8) + bx / 8 : bx)
    unsigned char* const ws = args.ws;
#define PH_WS __attribute__((address_space(1))) unsigned char* ws_ = (__attribute__((address_space(1))) unsigned char*)args.ws; asm volatile("" : "+s"(ws_)); unsigned char* const ws = (unsigned char*)ws_
    const int lo = MK_PER_PHASE ? args.ph_lo : 0, hi = MK_PER_PHASE ? args.ph_hi : 12;
#ifndef PH_MASK
#define PH_MASK 0xfff
#endif
#define IN(k) (((PH_MASK >> (k)) & 1) && lo <= (k) && (k) < hi)
#if MK_USE_CG
#define SEAM(k) do { if (IN(k) && IN((k) + 1)) grid.sync(); STAMP(k); } while (0)
#define SEAM_L(k) SEAM(k)
#else
#define SEAM(k) do { if (IN(k) && IN((k) + 1)) { XcdBarrier xb_; xb_.bar = (unsigned*)(ws + WS_BAR); xb_.x = xb_xcc_id(); xb_.st = (volatile LAS unsigned*)(lds + XL_OFF + XL_MISC); xcd_barrier(xb_); } STAMP(k); } while (0)
#define SEAM_L(k) do { if (IN(k) && IN((k) + 1)) { XcdBarrier xb_; xb_.bar = (unsigned*)(ws + WS_BAR); xb_.x = xb_xcc_id(); xb_.st = (volatile LAS unsigned*)(lds + XL_OFF + XL_MISC); xcd_barrier(xb_, lok); } STAMP(k); } while (0)
#endif
#if PROBE_PHASE >= 0 || PROBE_A >= 0
    unsigned long long* stamps = (unsigned long long*)(ws + WS_STAMP);
#define STAMP(k) do { if (bx == 0 && threadIdx.x == 0) stamps[(k) + 1] = __builtin_amdgcn_s_memrealtime(); } while (0)
    if (bx == 0 && threadIdx.x == 0) stamps[0] = __builtin_amdgcn_s_memrealtime();
#define STAMPX(i) do { if (bx == 0 && threadIdx.x == 0) stamps[(i)] = __builtin_amdgcn_s_memrealtime(); } while (0)
#else
#define STAMP(k) do { } while (0)
#define STAMPX(i) do { } while (0)
#endif
    volatile LAS unsigned* misc = (volatile LAS unsigned*)(lds + XL_OFF + XL_MISC);
    if (threadIdx.x == 0) { misc[0] = 0u; misc[1] = 0u; misc[2] = 0u; misc[3] = 0u;
        if (!MK_PER_PHASE && !MK_USE_CG) misc[2] = xb_add((unsigned*)(ws + WS_BAR) + XB_RANK(xb_xcc_id()), 1u); }
    __syncthreads();
    if (!MK_PER_PHASE && !MK_USE_CG) (void)xcd_barrier_post((unsigned*)(ws + WS_BAR), misc);
    int vbx = bx; bool lok = false;
#define gw (vcu * NWAVES + wave)
#define NGW (G * NWAVES)
#define counts ((int*)(ws + WS_CNT))
#define rstd1 ((float*)(ws + WS_RSTD1))
#define ssqs ((float*)(ws + WS_SSQS))
#define ssq2 ((float*)(ws + WS_SSQ2))
#define ssq3 ((float*)(ws + WS_SSQ3))
#define gates ((float*)(ws + WS_GATES))
#define gatel ((float*)(ws + WS_GATEL))
#define rstdl ((float*)(ws + WS_RSTDL))
#define wrt ((bf16_t*)(ws + WS_WR))
#define tokl ((int*)(ws + WS_TOKL))
#define xb ((bf16_t*)(ws + WS_XB))
#define proj ((bf16_t*)(ws + WS_PROJ))
#define ug ((bf16_t*)(ws + WS_UG))
#define ycat ((bf16_t*)(ws + WS_YCAT))
#define ygelu ((bf16_t*)(ws + WS_YGELU))
#define x8 ((unsigned char*)(ws + WS_X1))
#define xh ((bf16_t*)(ws + WS_XH))
#define qo ((bf16_t*)(ws + WS_QO))
#define pbuf ((bf16_t*)(ws + WS_PBUF))
#define ob ((bf16_t*)(ws + WS_O))
#define act ((bf16_t*)(ws + WS_ACT))
#define slots ((bf16_t*)(ws + WS_SLOTS))
#define memn ((bf16_t*)(ws + WS_MEMN))
#define kmat ((bf16_t*)(ws + WS_KMAT))
#define vt ((bf16_t*)(ws + WS_VT))

#define CV_I_IN (16 * 32)
#define CV_I_GLU (8 * 8)
#define CV_I_OUT (16 * 16)
#define CV_I_Q (16 * 16)
#define CV_I_KV (16 * 32)
#define CV_I_O (16 * 16)
#define CV_I_GU (32 * 16 * 32)
#define CV_I_DN (32 * 16 * 16)
#define CV_NIT (CV_I_IN + CV_I_GLU + CV_I_OUT + CV_I_Q + CV_I_KV + CV_I_O + CV_I_GU + CV_I_DN)
#define CV_DN_A (CV_I_DN * 11 / 16)
#define CV_DECODE(c, it) do { int r = (it); \
                if (r < CV_I_GU) { const int e = r / 512, q = r % 512, kb = q / 32, nb = q % 32, n0 = nb * 64, j = n0 & 1023, lin = n0 >> 10; \
                    c = CvItem{args.in[I_WGU] + (size_t)e * 1024 * 2048, args.in[I_NMOE], ws + WS_WGU + (size_t)e * 2048 * 1024, 2048, kb * 64, n0, 1024, 256 * (j >> 7) + 8 * lin + 2 * (j & 127), kb * 64, 1, 1}; break; } r -= CV_I_GU; \
                if (r < CV_I_IN) { const int kb = r / 32, nb = r % 32; c = CvItem{args.in[I_WIN], args.in[I_NMIX], ws + WS_WIN, 2048, kb * 64, nb * 64, 2048, nb * 64, kb * 128, 0, 0}; break; } r -= CV_I_IN; \
                if (r < CV_I_GLU) { const int kb = r / 8, nb = r % 8; c = CvItem{args.in[I_WGLU], nullptr, ws + WS_WGLU, 512, kb * 64, nb * 64, 1024, nb * 64, kb * 128, 0, 0}; break; } r -= CV_I_GLU; \
                if (r < CV_I_OUT) { const int kb = r / 16, nb = r % 16, k0 = kb * 64;        \
                    c = CvItem{args.in[I_WOUT], (k0 < 512) ? args.in[I_NCO] : args.in[I_NSO] - 512, ws + WS_WOUT, 1024, k0, nb * 64, 2048, nb * 64, ((k0 + 512) & 1023) * 2, 0, 0}; break; } r -= CV_I_OUT; \
                if (r < CV_I_Q) { const int kb = r / 16, nb = r % 16; c = CvItem{args.in[I_WQ], args.in[I_NX], ws + WS_WQ, 1024, kb * 64, nb * 64, 1024, nb * 64, kb * 64, 1, 0}; break; } r -= CV_I_Q; \
                if (r < CV_I_KV) { const int kb = r / 32, nb = r % 32, n0 = nb * 64; c = CvItem{args.in[I_WKV], nullptr, ws + (n0 < 1024 ? WS_WK : WS_WV), 2048, kb * 64, n0, 2048, n0 & 1023, kb * 128, 0, 0}; break; } r -= CV_I_KV; \
                if (r < CV_I_O) { const int kb = r / 16, nb = r % 16; c = CvItem{args.in[I_WO], nullptr, ws + WS_WO, 1024, kb * 64, nb * 64, 1024, nb * 64, kb * 64, 1, 0}; break; } r -= CV_I_O; \
                { const int e = r / 256, q = r % 256, kb = q / 16, nb = q % 16; \
                    c = CvItem{args.in[I_WDN] + (size_t)e * 1024 * 1024, nullptr, ws + WS_WDN + (size_t)e * 1024 * 1024, 1024, kb * 64, nb * 64, 1024, nb * 64, kb * 64, 1, 0}; } } while (0)
#define CV_STREAM(first, step, lo, hi) do { float va[64], vb[64]; CvItem ca, cb; LAS unsigned char* cvscr = lds + wave * 10240; \
        int it = (lo) + (first); \
        if (it < (hi)) { CV_DECODE(ca, it); cv_load(ca, va, lane); } \
        while (it < (hi)) { \
            int it2 = it + (step); \
            if (it2 < (hi)) { CV_DECODE(cb, it2); cv_load(cb, vb, lane); } \
            cv_store(ca, va, lane, cvscr); \
            it = it2; if (it >= (hi)) break; \
            it2 = it + (step); \
            if (it2 < (hi)) { CV_DECODE(ca, it2); cv_load(ca, va, lane); } \
            cv_store(cb, vb, lane, cvscr); \
            it = it2; } } while (0)
    if (IN(0)) {
        PH_WS;
        PH_IDS;
        for (int i = bx * NTHREADS + tid; i < 3 * NTOK; i += G * NTHREADS) ssqs[i] = 0.f;
        if (bx == 0 && tid < NEXP) counts[tid] = 0;
        for (int i = bx * NTHREADS + tid; i < DM * NEXP; i += G * NTHREADS) { const int k = i >> 5, e = i & 31; const float w = args.in[I_WR][i] * args.in[I_NMOE][k];
            const unsigned h = f2bf(w); wrt[e * 1024 + k] = (bf16_t)h; wrt[32 * 1024 + e * 1024 + k] = (bf16_t)f2bf(w - __builtin_bit_cast(float, h << 16)); }
        for (int item = bx; item < 256; item += G) {
            const int g = item >> 3, part = item & 7;
            LAS float* Wp = (LAS float*)lds;
            LAS float* Bb = Wp + 65 * 128;
            LAS float* Cc = Bb + 64 * 32;
            const float dt = __expf(args.in[I_LOGDT][g]);
            __syncthreads();
            {
                const int j = tid & 63, pb = tid >> 6; const float ar = args.in[I_ARE][g * 64 + j], aim = args.in[I_AIM][g * 64 + j];
                const float m1 = expf(dt * ar); float s1, c1; sincosf(dt * aim, &s1, &c1); const float are = m1 * c1, aie = m1 * s1;
                const float pp = (float)(8 * pb), mb = expf(pp * dt * ar); float sb, cb; sincosf(pp * dt * aim, &sb, &cb); float wr_ = mb * cb, wi_ = mb * sb;
#pragma unroll
                for (int k = 0; k < 8; ++k) { Wp[((8 * pb + k) * 64 + j) * 2] = wr_; Wp[((8 * pb + k) * 64 + j) * 2 + 1] = wi_; const float nr = wr_ * are - wi_ * aie, ni = wr_ * aie + wi_ * are; wr_ = nr; wi_ = ni; }
                if (pb == 7) { Wp[(64 * 64 + j) * 2] = wr_; Wp[(64 * 64 + j) * 2 + 1] = wi_; } }
            for (int i = tid; i < 64 * 16; i += NTHREADS) { const int j = i >> 4; const float ar = args.in[I_ARE][g * 64 + j], aim = args.in[I_AIM][g * 64 + j];
                float sn, cs; sincosf(dt * aim, &sn, &cs); const float em1 = expm1f(dt * ar); float sh, ch; sincosf(0.5f * dt * aim, &sh, &ch);
                const float pre = em1 * cs - 2.0f * sh * sh, pim = (em1 + 1.0f) * sn, den = ar * ar + aim * aim;
                const float qre = (pre * ar + pim * aim) / den, qim = (pim * ar - pre * aim) / den;
                const float br = args.in[I_BRE][(size_t)g * 1024 + i], bi = args.in[I_BIM][(size_t)g * 1024 + i];
                Bb[i * 2] = qre * br - qim * bi; Bb[i * 2 + 1] = qre * bi + qim * br; }
            for (int i = tid; i < 16 * 64; i += NTHREADS) { Cc[i * 2] = args.in[I_CRE][(size_t)g * 1024 + i]; Cc[i * 2 + 1] = args.in[I_CIM][(size_t)g * 1024 + i]; }
            __syncthreads();
            unsigned char* tab = ws + WS_SSM + (size_t)g * SSM_STRIDE;
            if (part == 0 && tid < 64) { ((float*)tab)[tid * 2] = Wp[(64 * 64 + tid) * 2]; ((float*)tab)[tid * 2 + 1] = Wp[(64 * 64 + tid) * 2 + 1]; }
            bf16_t* Kt = (bf16_t*)(tab + SSM_KT); bf16_t* Pt = (bf16_t*)(tab + SSM_PT); bf16_t* Qt = (bf16_t*)(tab + SSM_QT);
            {
                const int lag = 8 * part + (tid >> 6), c = (tid >> 2) & 15, cp0 = (tid & 3) * 4; float s0 = 0.f, s1 = 0.f, s2 = 0.f, s3 = 0.f;
#pragma unroll 4
                for (int j = 0; j < 64; ++j) { const f32x2 w = *(const LAS f32x2*)(Wp + (lag * 64 + j) * 2), cc = *(const LAS f32x2*)(Cc + (c * 64 + j) * 2);
                    const float xr = cc[0] * w[0] - cc[1] * w[1], xi = cc[0] * w[1] + cc[1] * w[0];
                    const f32x4 b0 = *(const LAS f32x4*)(Bb + (j * 16 + cp0) * 2), b1 = *(const LAS f32x4*)(Bb + (j * 16 + cp0 + 2) * 2);
                    s0 += xr * b0[0] - xi * b0[1]; s1 += xr * b0[2] - xi * b0[3]; s2 += xr * b1[0] - xi * b1[1]; s3 += xr * b1[2] - xi * b1[3]; }
                *(u32x2*)(Kt + (size_t)lag * 256 + c * 16 + cp0) = (u32x2){pk2(s0, s1), pk2(s2, s3)};
            }
            {
                const int k = 2 * tid, sidx = k >> 4, cp = k & 15;
#pragma unroll 4
                for (int r = 0; r < 16; ++r) { const int n = 16 * part + r, ri = n >> 6, j = n & 63;
                    const f32x2 w = *(const LAS f32x2*)(Wp + ((63 - sidx) * 64 + j) * 2); const f32x4 b = *(const LAS f32x4*)(Bb + (j * 16 + cp) * 2);
                    const float v0 = ri ? (w[0] * b[1] + w[1] * b[0]) : (w[0] * b[0] - w[1] * b[1]), v1 = ri ? (w[0] * b[3] + w[1] * b[2]) : (w[0] * b[2] - w[1] * b[3]);
                    *(unsigned*)(Pt + (size_t)n * 1024 + k) = pk2(v0, v1); }
            }
            {
                const int n = 2 * (tid & 63), ri = n >> 6, j = n & 63;
#pragma unroll 4
                for (int r = 0; r < 16; ++r) { const int tc = 128 * part + (tid >> 6) + 8 * r, t = tc >> 4, c = tc & 15;
                    const f32x4 w = *(const LAS f32x4*)(Wp + ((t + 1) * 64 + j) * 2), cc = *(const LAS f32x4*)(Cc + (c * 64 + j) * 2);
                    const float v0 = ri ? -(cc[0] * w[1] + cc[1] * w[0]) : (cc[0] * w[0] - cc[1] * w[1]), v1 = ri ? -(cc[2] * w[3] + cc[3] * w[2]) : (cc[2] * w[2] - cc[3] * w[3]);
                    *(unsigned*)(Qt + (size_t)tc * 128 + n) = pk2(v0, v1); }
            }
        }
        STAMPX(30);
#define ROWS_LD(V, m4_) do { const bool isx_ = (m4_) < NTOK; const int r0_ = isx_ ? (m4_) : (m4_) - NTOK; const f32x4* xr = (const f32x4*)((isx_ ? args.in[I_X] : args.in[I_MEM]) + (size_t)r0_ * DM) + lane; \
            _Pragma("unroll") for (int q = 0; q < 4; ++q) _Pragma("unroll") for (int j = 0; j < 4; ++j) V[q][j] = __builtin_nontemporal_load(xr + q * 256 + 64 * j); } while (0)
#define ROWS_DO(V, m4_) do { const bool isx = (m4_) < NTOK; const int r0 = isx ? (m4_) : (m4_) - NTOK; \
            _Pragma("unroll") for (int q = 0; q < 4; ++q) { \
                float ss = 0.f; \
                _Pragma("unroll") for (int j = 0; j < 4; ++j) ss += (V[q][j][0] * V[q][j][0] + V[q][j][1] * V[q][j][1]) + (V[q][j][2] * V[q][j][2] + V[q][j][3] * V[q][j][3]); \
                const float rs = rsqrtf(wave_sum(ss) * (1.f / DM) + EPS); \
                u32x2* o8 = (u32x2*)((isx ? xb : memn) + (size_t)(r0 + q) * DM) + lane; \
                if (isx) { if (lane == 0) rstd1[r0 + q] = rs; \
                    _Pragma("unroll") for (int j = 0; j < 4; ++j) o8[64 * j] = (u32x2){pk2(V[q][j][0], V[q][j][1]), pk2(V[q][j][2], V[q][j][3])}; } \
                else { \
                    _Pragma("unroll") for (int j = 0; j < 4; ++j) { const f32x4 g = ((const f32x4*)args.in[I_NM])[lane + 64 * j]; o8[64 * j] = (u32x2){pk2(V[q][j][0] * rs * g[0], V[q][j][1] * rs * g[1]), pk2(V[q][j][2] * rs * g[2], V[q][j][3] * rs * g[3])}; } } \
            } } while (0)
        { f32x4 va[4][4], vb[4][4]; int m4 = gw * 4;
          if (m4 < NTOK + NMEM) { ROWS_LD(va, m4);
            for (;;) {
                int m4n = m4 + NGW * 4; if (m4n < NTOK + NMEM) ROWS_LD(vb, m4n);
                ROWS_DO(va, m4);
                if (m4n >= NTOK + NMEM) break; m4 = m4n;
                m4n = m4 + NGW * 4; if (m4n < NTOK + NMEM) ROWS_LD(va, m4n);
                ROWS_DO(vb, m4);
                if (m4n >= NTOK + NMEM) break; m4 = m4n; } } }
#undef ROWS_LD
#undef ROWS_DO
        STAMPX(31);
        {
            __syncthreads();
            CV_STREAM(gw, NGW, 0, (G == 256) ? CV_NIT - CV_I_DN : CV_NIT);
        }
    }
    SEAM(0);
    if (!MK_PER_PHASE && !MK_USE_CG && IN(0) && IN(1)) { const unsigned e32 = misc[3], rk = misc[2], xc = xb_xcc_id();
        if (__builtin_amdgcn_readfirstlane(e32) != 0u && __builtin_amdgcn_readfirstlane(rk) < 32u && xc < 8u) { vbx = __builtin_amdgcn_readfirstlane((int)(rk * 8u + xc)); lok = true; } }
    if (IN(1)) {
        PH_WS;
        SchedP1 S{(const char*)xb, (const char*)(ws + WS_WIN), (const char*)memn, (const char*)(ws + WS_WK), (const char*)(ws + WS_WV), 2048u, 2048u, 1024, G, bx};
        EpiP1 E{rstd1, proj, ug, kmat, vt};
        g8::gemm_phase(lds, S, E, wave);
        if (G == 256 && bx >= 64) { PH_IDS; CV_STREAM((bx - 64) * NWAVES + wave, 192 * NWAVES, CV_NIT - CV_I_DN, CV_NIT - CV_I_DN + CV_DN_A); }
    }
    SEAM(1);
    if (IN(2)) {
        PH_WS;
        PH_IDS;
        constexpr int L_KT = 0, L_SPV = 32768, L_UH = 49152, UROW = 1040, L_STG = 115712;
        const int l15 = lane & 15, lq = lane >> 4;
        for (int it_ = vcu; it_ < BATCH * 32; it_ += G) {
            const int g = (it_ >> 5) * 4 + (it_ & 3), b = (it_ >> 2) & 7, item = b * 32 + g;
            const bf16_t* ugp = ug + (size_t)item * SEQ * 16;
            const unsigned char* tab = ws + WS_SSM + (size_t)g * SSM_STRIDE;
            const float* A64 = (const float*)tab; const bf16_t* Kt = (const bf16_t*)(tab + SSM_KT); const bf16_t* Pt = (const bf16_t*)(tab + SSM_PT); const bf16_t* Qt = (const bf16_t*)(tab + SSM_QT);
#define STAGE_U(p) do { u32x4 _v[8]; _Pragma("unroll") for (int _i = 0; _i < 8; ++_i) _v[_i] = *(const u32x4*)(ugp + ((size_t)(wave * 8 + _i) * 64 + 32 * (p)) * 16 + lane * 8); \
                asm volatile("" : "+v"(_v[0]), "+v"(_v[1]), "+v"(_v[2]), "+v"(_v[3]), "+v"(_v[4]), "+v"(_v[5]), "+v"(_v[6]), "+v"(_v[7]));     \
                _Pragma("unroll") for (int _i = 0; _i < 8; ++_i) *(LAS u32x4*)(lds + L_UH + (wave * 8 + _i) * UROW + lane * 16) = _v[_i]; } while (0)
#define UFRAG(mb, kk) (*(const LAS bf16x8*)(lds + L_UH + (16 * (mb) + l15) * UROW + (32 * (kk) + 8 * lq) * 2))
            f32x4 sacc[4];
#pragma unroll
            for (int mb = 0; mb < 4; ++mb) sacc[mb] = (f32x4){0.f, 0.f, 0.f, 0.f};
#pragma unroll 1
            for (int p = 0; p < 2; ++p) {
                bf16x8 pf[16];
#pragma unroll
                for (int kk = 0; kk < 16; ++kk) pf[kk] = *(const bf16x8*)(Pt + (size_t)(16 * wave + l15) * 1024 + 32 * (16 * p + kk) + 8 * lq);
                __syncthreads(); STAGE_U(p); __syncthreads();
#pragma unroll
                for (int kk = 0; kk < 16; ++kk) {
#pragma unroll
                    for (int mb = 0; mb < 4; ++mb) sacc[mb] = __builtin_amdgcn_mfma_f32_16x16x32_bf16(UFRAG(mb, kk), pf[kk], sacc[mb], 0, 0, 0);
                }
            }
            STAMPX(20);
            { LAS float* Sl = (LAS float*)(lds + L_KT);
#pragma unroll
              for (int mb = 0; mb < 4; ++mb)
#pragma unroll
                for (int r = 0; r < 4; ++r) Sl[(16 * mb + 4 * lq + r) * 128 + 16 * wave + l15] = sacc[mb][r]; }
            __syncthreads();
            if (wave == 0) {
                const LAS float* Sl = (const LAS float*)(lds + L_KT); LAS bf16_t* Sp = (LAS bf16_t*)(lds + L_SPV);
                const float ar = A64[lane * 2], ai = A64[lane * 2 + 1]; float sr = 0.f, si = 0.f;
#pragma unroll 1
                for (int c0 = 0; c0 < 64; c0 += 16) { float lr[16], li[16];
#pragma unroll
                    for (int j = 0; j < 16; ++j) { lr[j] = Sl[(c0 + j) * 128 + lane]; li[j] = Sl[(c0 + j) * 128 + 64 + lane]; }
#pragma unroll
                    for (int j = 0; j < 16; ++j) { const int c = c0 + j; Sp[c * 128 + lane] = (bf16_t)f2bf(sr); Sp[c * 128 + 64 + lane] = (bf16_t)f2bf(si);
                        const float nr = ar * sr - ai * si + lr[j], ni = ar * si + ai * sr + li[j]; sr = nr; si = ni; } }
            }
            __syncthreads();
            { const u32x4* src = (const u32x4*)Kt;
#pragma unroll
              for (int i = 0; i < 4; ++i) *(LAS u32x4*)(lds + L_KT + (tid + i * NTHREADS) * 16) = src[tid + i * NTHREADS]; }
            __syncthreads();
            STAMPX(21);
            const f32x4 dv4 = *(const f32x4*)(args.in[I_D] + g * 16 + (lane & 3) * 4);
#pragma unroll 1
            for (int ig = 1; ig >= 0; --ig) {
                f32x4 acc[4][4];
#pragma unroll
                for (int i = 0; i < 4; ++i)
#pragma unroll
                    for (int mb = 0; mb < 4; ++mb) acc[i][mb] = (f32x4){0.f, 0.f, 0.f, 0.f};
                const int tb0 = wave + 32 * ig, tmax = tb0 + 24;
                bf16x8 qf[4][4];
#pragma unroll
                for (int kq = 0; kq < 4; ++kq)
#pragma unroll
                    for (int i = 0; i < 4; ++i) qf[kq][i] = *(const bf16x8*)(Qt + (size_t)((tb0 + 8 * i) * 16 + l15) * 128 + 32 * kq + 8 * lq);
#pragma unroll 1
                for (int p = ig; p >= 0; --p) {
                    if (ig == 1 && p == 0) { __syncthreads(); STAGE_U(0); __syncthreads(); }
#pragma unroll 1
                    for (int kk = 0; kk < 16; ++kk) {
                        const int s0 = 32 * p + 2 * kk; if (s0 > tmax) break;
                        bf16x8 af[4];
#pragma unroll
                        for (int mb = 0; mb < 4; ++mb) af[mb] = UFRAG(mb, kk);
                        const int s = s0 + (lq >> 1);
#pragma unroll
                        for (int i = 0; i < 4; ++i) { const int t = tb0 + 8 * i;
                            if (t >= s0) { const int lag = t - s; bf16x8 bfr = *(const LAS bf16x8*)(lds + L_KT + (((lag < 0 ? 0 : lag) * 16 + l15) * 16 + 8 * (lq & 1)) * 2);
                                if (lag < 0) bfr = (bf16x8){0, 0, 0, 0, 0, 0, 0, 0};
#pragma unroll
                                for (int mb = 0; mb < 4; ++mb) acc[i][mb] = __builtin_amdgcn_mfma_f32_16x16x32_bf16(af[mb], bfr, acc[i][mb], 0, 0, 0); } }
                    }
                }
#pragma unroll
                for (int kq = 0; kq < 4; ++kq) {
                    bf16x8 af[4];
#pragma unroll
                    for (int mb = 0; mb < 4; ++mb) af[mb] = *(const LAS bf16x8*)(lds + L_SPV + ((16 * mb + l15) * 128 + 32 * kq + 8 * lq) * 2);
#pragma unroll
                    for (int i = 0; i < 4; ++i) {
#pragma unroll
                        for (int mb = 0; mb < 4; ++mb) acc[i][mb] = __builtin_amdgcn_mfma_f32_16x16x32_bf16(af[mb], qf[kq][i], acc[i][mb], 0, 0, 0); }
                }
                LAS float* stg = (LAS float*)(lds + L_STG + wave * 2048);
#pragma unroll
                for (int i = 0; i < 4; ++i) { const int t = tb0 + 8 * i;
                    u32x2 uq[2][2];
#pragma unroll
                    for (int hf = 0; hf < 2; ++hf)
#pragma unroll
                        for (int it = 0; it < 2; ++it) uq[hf][it] = *(const u32x2*)(ugp + (size_t)((32 * hf + ((it * 64 + lane) >> 2)) * 64 + t) * 16 + (lane & 3) * 4);
#pragma unroll
                    for (int hf = 0; hf < 2; ++hf) {
#pragma unroll
                        for (int ml = 0; ml < 2; ++ml)
#pragma unroll
                            for (int r = 0; r < 4; ++r) stg[(16 * ml + 4 * lq + r) * 16 + l15] = acc[i][2 * hf + ml][r];
                        asm volatile("s_waitcnt lgkmcnt(0)" ::: "memory");
#pragma unroll
                        for (int it = 0; it < 2; ++it) { const int idx = it * 64 + lane, tt = (32 * hf + (idx >> 2)) * 64 + t, c4 = (idx & 3) * 4;
                            const f32x4 yv = *(const LAS f32x4*)(stg + idx * 4); const u32x2 uu = uq[hf][it];
                            const f32x2 ya = gelu_tanh2((f32x2){yv[0], yv[1]} + (f32x2){dv4[0], dv4[1]} * (f32x2){bflo(uu.x), bfhi(uu.x)}), yb = gelu_tanh2((f32x2){yv[2], yv[3]} + (f32x2){dv4[2], dv4[3]} * (f32x2){bflo(uu.y), bfhi(uu.y)});
                            *(u32x2*)(ygelu + (size_t)(b * SEQ + tt) * 512 + g * 16 + c4) = (u32x2){cvt_pk_bf16(ya[0], ya[1]), cvt_pk_bf16(yb[0], yb[1])}; }
                        asm volatile("s_waitcnt lgkmcnt(0)" ::: "memory");
                    }
                }
            }
#undef STAGE_U
#undef UFRAG
        }
        STAMPX(22);
        {
            const int ch = lane * 8;
            float w0[8], w1[8], w2[8];
#pragma unroll
            for (int i = 0; i < 8; ++i) { w0[i] = args.in[I_CONVW][ch + i]; w1[i] = args.in[I_CONVW][512 + ch + i]; w2[i] = args.in[I_CONVW][1024 + ch + i]; }
            for (int run = gw; run < NTOK / 16; run += NGW) {
                const int r0 = run * 16, tin = r0 & (SEQ - 1);
                float vm2[8], vm1[8];
#pragma unroll
                for (int i = 0; i < 8; ++i) { vm2[i] = 0.f; vm1[i] = 0.f; }
                if (tin > 0) {
#pragma unroll
                    for (int d = 2; d >= 1; --d) { const bf16_t* pr = proj + (size_t)(r0 - d) * 1536;
                        const u32x4 c4 = *(const u32x4*)(pr + 512 + ch), x4 = *(const u32x4*)(pr + 1024 + ch);
                        float v[8]; v[0] = bflo(c4.x) * bflo(x4.x); v[1] = bfhi(c4.x) * bfhi(x4.x); v[2] = bflo(c4.y) * bflo(x4.y); v[3] = bfhi(c4.y) * bfhi(x4.y);
                        v[4] = bflo(c4.z) * bflo(x4.z); v[5] = bfhi(c4.z) * bfhi(x4.z); v[6] = bflo(c4.w) * bflo(x4.w); v[7] = bfhi(c4.w) * bfhi(x4.w);
#pragma unroll
                        for (int i = 0; i < 8; ++i) { if (d == 2) vm2[i] = v[i]; else vm1[i] = v[i]; } }
                }
#pragma unroll 1
                for (int tb = 0; tb < 16; tb += 8) {
                    u32x4 b4[8], c4[8], x4[8];
#pragma unroll
                    for (int q = 0; q < 8; ++q) { const bf16_t* pr = proj + (size_t)(r0 + tb + q) * 1536; b4[q] = *(const u32x4*)(pr + ch); c4[q] = *(const u32x4*)(pr + 512 + ch); x4[q] = *(const u32x4*)(pr + 1024 + ch); }
#pragma unroll
                    for (int q = 0; q < 8; ++q) {
                        float v[8], bgv[8], y[8]; v[0] = bflo(c4[q].x) * bflo(x4[q].x); v[1] = bfhi(c4[q].x) * bfhi(x4[q].x); v[2] = bflo(c4[q].y) * bflo(x4[q].y); v[3] = bfhi(c4[q].y) * bfhi(x4[q].y);
                        v[4] = bflo(c4[q].z) * bflo(x4[q].z); v[5] = bfhi(c4[q].z) * bfhi(x4[q].z); v[6] = bflo(c4[q].w) * bflo(x4[q].w); v[7] = bfhi(c4[q].w) * bfhi(x4[q].w);
                        bgv[0] = bflo(b4[q].x); bgv[1] = bfhi(b4[q].x); bgv[2] = bflo(b4[q].y); bgv[3] = bfhi(b4[q].y); bgv[4] = bflo(b4[q].z); bgv[5] = bfhi(b4[q].z); bgv[6] = bflo(b4[q].w); bgv[7] = bfhi(b4[q].w);
                        float ss = 0.f;
#pragma unroll
                        for (int i = 0; i < 8; ++i) { y[i] = bgv[i] * (w0[i] * vm2[i] + w1[i] * vm1[i] + w2[i] * v[i]); ss += y[i] * y[i]; vm2[i] = vm1[i]; vm1[i] = v[i]; }
                        const float rs = rsqrtf(wave_sum(ss) * (1.f / 512.f) + EPS);
                        u32x4 o; o.x = pk2(y[0] * rs, y[1] * rs); o.y = pk2(y[2] * rs, y[3] * rs); o.z = pk2(y[4] * rs, y[5] * rs); o.w = pk2(y[6] * rs, y[7] * rs);
                        *(u32x4*)(ycat + (size_t)(r0 + tb + q) * 1024 + 512 + ch) = o;
                    }
                }
            }
        }
    }
    SEAM(2);
    if (IN(3)) {
        PH_WS;
        SchedDense S{(const char*)ygelu, (const char*)(ws + WS_WGLU), 1024u, 1024u, 512, NTOK / 256, 2, G, vbx};
        EpiGlu E{ygelu, ycat, ssqs};
        g8::gemm_phase(lds, S, E, wave);
    }
    SEAM_L(3);
    if (IN(4)) {
        PH_WS;
        SchedDense S{(const char*)ycat, (const char*)(ws + WS_WOUT), 2048u, 2048u, 1024, NTOK / 256, 4, G, vbx};
        EpiRes E{xb, xh, x8, ssq2, ssqs, 6, 1.0f};
        g8::gemm_phase(lds, S, E, wave);
    }
    SEAM_L(4);
    if (IN(5)) {
        PH_WS;
        SchedQ S{(const char*)x8, (const char*)(ws + WS_WQ), 1024u, 1024u, 512, G, vbx};
        EpiQ E{ssq2, qo};
        g8::gemm_phase(lds, S, E, wave);
    }
    STAMP(5);
    if (IN(6)) {
        PH_WS;
        SchedAttn S{(const char*)qo, (const char*)kmat, (const char*)vt, (const char*)pbuf, 256u, 256u, 128, G, vbx, (BATCH * 4 * 16) / G};
        EpiAttn E{pbuf, ob, vbx};
        g8::gemm_phase(lds, S, E, wave);
    }
    SEAM_L(6);
    if (IN(7)) {
        PH_WS;
        SchedDenseT<true> S{(const char*)ob, (const char*)(ws + WS_WO), 1024u, 1024u, 512, NTOK / 256, 4, G, vbx};
        EpiRes E{xh, xh, x8, ssq3, ssqs, -1, 1.0f / (O8S * W8S)};
        g8::gemm_phase(lds, S, E, wave);
    }
    SEAM_L(7);
    if (IN(8)) {
        PH_WS;
        PH_IDS;
        LAS float* Lg = (LAS float*)lds;
        LAS int* hist = (LAS int*)(lds + 132096);
        LAS int* hbase = (LAS int*)(lds + 132224);
        const int l15 = lane & 15, lq = lane >> 4;
        for (int blk = ((G % 8 == 0) ? (vbx % 8) * (G / 8) + vbx / 8 : vbx); blk < NTOK / 128; blk += G) {
            const int r0 = blk * 128;
            if (tid < 32) hist[tid] = 0;
            const bf16_t* ap = xh + (size_t)(r0 + 16 * wave + l15) * DM + 32 * lq;
            bf16x8 af[4][4];
#pragma unroll
            for (int s = 0; s < 4; ++s)
#pragma unroll
                for (int j = 0; j < 4; ++j) af[s][j] = *(const bf16x8*)(ap + 128 * s + 8 * j);
#pragma unroll
            for (int b4 = 0; b4 < 4; ++b4) {
                u32x4 t4[4];
#pragma unroll
                for (int i = 0; i < 4; ++i) t4[i] = *(const u32x4*)((const unsigned char*)wrt + (size_t)((4 * b4 + i) * 512 + tid) * 16);
#pragma unroll
                for (int i = 0; i < 4; ++i) { const int c = (4 * b4 + i) * 512 + tid; *(LAS u32x4*)(lds + (c >> 7) * 2064 + (c & 127) * 16) = t4[i]; }
            }
            __syncthreads();
            f32x4 acc[2][2];
#pragma unroll
            for (int nb = 0; nb < 2; ++nb) { acc[nb][0] = (f32x4){0.f, 0.f, 0.f, 0.f}; acc[nb][1] = (f32x4){0.f, 0.f, 0.f, 0.f}; }
            const LAS unsigned char* bp = lds + l15 * 2064 + lq * 64;
#pragma unroll
            for (int kb = 0; kb < 8; ++kb) {
#pragma unroll
                for (int j = 0; j < 4; ++j)
#pragma unroll
                    for (int nb = 0; nb < 2; ++nb) {
                        const bf16x8 bh = *(const LAS bf16x8*)(bp + nb * 16 * 2064 + kb * 256 + j * 16);
                        const bf16x8 bl = *(const LAS bf16x8*)(bp + 32 * 2064 + nb * 16 * 2064 + kb * 256 + j * 16);
                        acc[nb][0] = __builtin_amdgcn_mfma_f32_16x16x32_bf16(af[kb & 3][j], bh, acc[nb][0], 0, 0, 0);
                        acc[nb][1] = __builtin_amdgcn_mfma_f32_16x16x32_bf16(af[kb & 3][j], bl, acc[nb][1], 0, 0, 0);
                    }
                if (kb + 4 < 8) {
#pragma unroll
                    for (int j = 0; j < 4; ++j) af[kb & 3][j] = *(const bf16x8*)(ap + 128 * (kb + 4) + 8 * j);
                }
            }
            __syncthreads();
#pragma unroll
            for (int r = 0; r < 4; ++r) { const int t = 16 * wave + 4 * lq + r; const float rs = rsqrtf(ssq3[r0 + t] * (1.0f / 1024.0f) + EPS);
#pragma unroll
                for (int nb = 0; nb < 2; ++nb) Lg[t * 33 + 16 * nb + l15] = (acc[nb][0][r] + acc[nb][1][r]) * rs + args.in[I_BR][16 * nb + l15]; }
            __syncthreads();
            int ei[4], lp[4]; float gv[4];
            if (tid < 128) {
                unsigned taken = 0u; float tv[4];
#pragma unroll
                for (int k = 0; k < 4; ++k) { float best = -3.0e38f; int bi = 0;
                    for (int e = 0; e < 32; ++e) { const float v = Lg[tid * 33 + e]; if (!((taken >> e) & 1u) && v > best) { best = v; bi = e; } }
                    taken |= 1u << bi; ei[k] = bi; tv[k] = best; }
                float sum = 0.f;
#pragma unroll
                for (int k = 0; k < 4; ++k) { gv[k] = __expf(tv[k] - tv[0]); sum += gv[k]; }
                const float inv = 1.0f / sum;
#pragma unroll
                for (int k = 0; k < 4; ++k) { gv[k] *= inv; lp[k] = __hip_atomic_fetch_add((LAS int*)(hist + ei[k]), 1, __ATOMIC_RELAXED, __HIP_MEMORY_SCOPE_WORKGROUP); }
            }
            __syncthreads();
            if (tid < 32) hbase[tid] = atomicAdd(counts + tid, hist[tid]);
            __syncthreads();
            if (tid < 128) {
                const int tok = r0 + tid; const float rs = rsqrtf(ssq3[tok] * (1.0f / 1024.0f) + EPS);
#pragma unroll
                for (int k = 0; k < 4; ++k) { const size_t idx = (size_t)ei[k] * ECAP + hbase[ei[k]] + lp[k]; tokl[idx] = tok * 4 + k; gatel[idx] = gv[k]; rstdl[idx] = rs; }
            }
            __syncthreads();
        }
    }
    SEAM(8);
    if (IN(9) || IN(10)) {
        PH_WS;
        PH_IDS;
        LAS int* tb = (LAS int*)(lds + XL_OFF + XL_TB); LAS int* cn = (LAS int*)(lds + XL_OFF + XL_CNT);
        __syncthreads();
        if (wave == 0) {
            const int c = (lane < NEXP) ? ald(counts + lane) : 0; const int v = (c + 255) >> 8; int sum = v;
#pragma unroll
            for (int o = 1; o < NEXP; o <<= 1) { const int t = __shfl_up(sum, o); if (lane >= o) sum += t; }
            if (lane < NEXP) { cn[lane] = c; tb[lane] = sum - v; }
            if (lane == NEXP - 1) tb[NEXP] = sum;
        }
        __syncthreads();
        { LAS unsigned char* etw = lds + XL_OFF + XL_CNT + 128;
          for (int pm = tid; pm < tb[NEXP]; pm += NTHREADS) { int e = 0;
#pragma unroll
              for (int s = 16; s >= 1; s >>= 1) if (tb[e + s] <= pm) e += s;
              etw[pm] = (unsigned char)e; } }
#define MOE_UNIT_LIST(nN_, REV_) do { LAS int* ulw = (LAS int*)(lds + XL_OFF + XL_CNT + 128 + 544); if (tid < 24) { int pm_, pn_; const int nwg_ = tb[NEXP] * (nN_), ncu_ = (bx < nwg_) ? (nwg_ - 1 - bx) / G + 1 : 0; \
        const int i_ = (REV_) ? ncu_ - 1 - tid : tid; ulw[tid] = (tid < ncu_ && g8::tile_order(i_, G, bx, tb[NEXP], (nN_), pm_, pn_)) ? (pm_ | (pn_ << 16)) : -1; } } while (0)
        if (IN(9)) MOE_UNIT_LIST(8, false);
        __syncthreads();
        if (IN(9)) {
        PH_WS;
            SchedMoeT<true> S; S.tb = tb; S.cnt = cn; S.et = lds + XL_OFF + XL_CNT + 128; S.ul = (const LAS int*)(lds + XL_OFF + XL_CNT + 128 + 544); S.tl = tokl; S.A = (const char*)x8; S.B = (const char*)(ws + WS_WGU); S.lda2 = 1024u; S.ldb2 = 1024u; S.K = 512; S.nN = 8; S.G = G; S.c = bx; S.bstride = (size_t)2048 * 1024; S.gather = true;
            EpiMoe1 E{rstdl, args.in[I_BGU], act};
            g8::gemm_phase(lds, S, E, wave);
            if (G == 256) {
                const int nwg = __builtin_amdgcn_readfirstlane(tb[NEXP]) * 8, rem = nwg - ((nwg + 255) / 256 - 1) * 256, idleN = 256 - rem;
                const int part = (idleN >= 64) ? idleN : 256, me = (idleN >= 64) ? bx - rem : bx;
                if (me >= 0) CV_STREAM(me * NWAVES + wave, part * NWAVES, CV_NIT - CV_I_DN + CV_DN_A, CV_NIT);
            }
        }
    }
    SEAM(9);
    if (IN(10)) {
        PH_WS;
        LAS int* tb = (LAS int*)(lds + XL_OFF + XL_TB); LAS int* cn = (LAS int*)(lds + XL_OFF + XL_CNT);
        { PH_IDS; MOE_UNIT_LIST(4, true); __syncthreads(); }
        SchedMoeT<false> S; S.tb = tb; S.cnt = cn; S.et = lds + XL_OFF + XL_CNT + 128; S.ul = (const LAS int*)(lds + XL_OFF + XL_CNT + 128 + 544); S.tl = tokl; S.A = (const char*)act; S.B = (const char*)(ws + WS_WDN); S.lda2 = 1024u; S.ldb2 = 1024u; S.K = 512; S.nN = 4; S.G = G; S.c = bx; S.bstride = (size_t)1024 * 1024; S.gather = false;
        EpiMoe2 E{tokl, gatel, args.in[I_BDN], slots};
        g8::gemm_phase(lds, S, E, wave);
    }
    SEAM(10);
    if (IN(11)) {
        PH_WS;
        PH_IDS;
        f32x4 gnf[4];
#pragma unroll
        for (int j = 0; j < 4; ++j) gnf[j] = ((const f32x4*)args.in[I_NF])[lane + 64 * j];
        for (int m0 = gw; m0 < NTOK; m0 += 2 * NGW) {
            u32x2 xw[2][4]; u32x4 sw[2][4];
#pragma unroll
            for (int q = 0; q < 2; ++q) { const int m = (m0 + q * NGW < NTOK) ? m0 + q * NGW : m0;
                const u32x2* xr = (const u32x2*)(xh + (size_t)m * DM) + lane;
#pragma unroll
                for (int j = 0; j < 4; ++j) xw[q][j] = xr[64 * j];
                if (DBG_OUT == 0) {
#pragma unroll
                    for (int k = 0; k < 4; ++k) { const unsigned* sr = (const unsigned*)((const unsigned char*)slots + (size_t)(m * 4 + k) * DM) + lane;
#pragma unroll
                        for (int j = 0; j < 4; ++j) sw[q][k][j] = sr[64 * j]; } } }
            asm volatile("" : "+v"(xw[0][0]), "+v"(xw[0][1]), "+v"(xw[0][2]), "+v"(xw[0][3]), "+v"(xw[1][0]), "+v"(xw[1][1]), "+v"(xw[1][2]), "+v"(xw[1][3]),
                              "+v"(sw[0][0]), "+v"(sw[0][1]), "+v"(sw[0][2]), "+v"(sw[0][3]), "+v"(sw[1][0]), "+v"(sw[1][1]), "+v"(sw[1][2]), "+v"(sw[1][3]));
#pragma unroll
            for (int q = 0; q < 2; ++q) { const int m = m0 + q * NGW; if (m >= NTOK) break;
                f32x4 v[4];
#pragma unroll
                for (int j = 0; j < 4; ++j) { const u32x2 w = xw[q][j]; v[j] = (f32x4){bflo(w.x), bfhi(w.x), bflo(w.y), bfhi(w.y)}; }
                if (DBG_OUT == 0) {
#pragma unroll
                    for (int k = 0; k < 4; ++k)
#pragma unroll
                        for (int j = 0; j < 4; ++j) { const int w = (int)sw[q][k][j]; const f32x2 lo = __builtin_amdgcn_cvt_pk_f32_fp8(w, false), hi = __builtin_amdgcn_cvt_pk_f32_fp8(w, true);
                            v[j][0] += lo[0] * (1.0f / S8S); v[j][1] += lo[1] * (1.0f / S8S); v[j][2] += hi[0] * (1.0f / S8S); v[j][3] += hi[1] * (1.0f / S8S); }
                }
                float ss = 0.f;
#pragma unroll
                for (int j = 0; j < 4; ++j) ss += (v[j][0] * v[j][0] + v[j][1] * v[j][1]) + (v[j][2] * v[j][2] + v[j][3] * v[j][3]);
                const float rs = rsqrtf(wave_sum(ss) * (1.f / DM) + EPS);
                f32x4* o = (f32x4*)(args.out + (size_t)m * DM) + lane;
#pragma unroll
                for (int j = 0; j < 4; ++j) o[64 * j] = v[j] * rs * gnf[j];
            }
        }
    }
#if PROBE_PHASE >= 0 || PROBE_A >= 0
    STAMP(11);
    if (bx == 0 && threadIdx.x == 0) {
        const int ia = (PROBE_A >= 0) ? PROBE_A : PROBE_PHASE, ib = (PROBE_A >= 0) ? PROBE_B : PROBE_PHASE + 1;
        const unsigned long long d = (stamps[ib] - stamps[ia]) * (unsigned long long)PROBE_MULT, t0 = __builtin_amdgcn_s_memrealtime();
        while (__builtin_amdgcn_s_memrealtime() - t0 < d) __builtin_amdgcn_s_sleep(16);
    }
#endif
#undef CV_STREAM
#undef CV_DECODE
#undef IN
#undef SEAM
#undef vcu
#undef gw
#undef NGW
#undef counts
#undef rstd1
#undef ssqs
#undef ssq2
#undef ssq3
#undef gates
#undef gatel
#undef rstdl
#undef wrt
#undef tokl
#undef xb
#undef proj
#undef ug
#undef ycat
#undef ygelu
#undef x8
#undef xh
#undef qo
#undef pbuf
#undef ob
#undef act
#undef slots
#undef memn
#undef kmat
#undef vt
}

extern "C" void kernel_launch(void* const* d_in, const int* in_sizes, int n_in, void* d_out, int out_size, void* d_ws, size_t ws_size, hipStream_t stream) {
    static int grid = 0;
    if (grid == 0) {
        if (n_in != 30 || in_sizes[0] != NTOK * DM || out_size != NTOK * DM || ws_size < WS_END) { fprintf(stderr, "kernel_launch: unexpected shapes (n_in %d, in0 %d, out %d, ws %zu < %zu); nothing launched\n", n_in, n_in > 0 ? in_sizes[0] : -1, out_size, ws_size, (size_t)WS_END); grid = -1; return; }
        int dev = 0, cus = 0, per_cu = 0;
        if (hipGetDevice(&dev) != hipSuccess || hipDeviceGetAttribute(&cus, hipDeviceAttributeMultiprocessorCount, dev) != hipSuccess) { grid = -1; return; }
        if (hipFuncSetAttribute((const void*)mk_fwd, hipFuncAttributeMaxDynamicSharedMemorySize, LDS_BYTES) != hipSuccess) { fprintf(stderr, "kernel_launch: hipFuncSetAttribute failed\n"); grid = -1; return; }
        if (hipOccupancyMaxActiveBlocksPerMultiprocessor(&per_cu, (const void*)mk_fwd, NTHREADS, LDS_BYTES) != hipSuccess || per_cu < 1) { fprintf(stderr, "kernel_launch: occupancy query says %d blocks per CU\n", per_cu); per_cu = 1; }
        (void)hipGetLastError();
        grid = cus;
        if (grid != 256) fprintf(stderr, "kernel_launch: %d CUs; the attention phase assumes 256\n", grid);
    }
    if (grid < 0) return;
    if (hipMemsetAsync((char*)d_ws + WS_BAR, 0, BAR_ZERO_BYTES, stream) != hipSuccess) { fprintf(stderr, "kernel_launch: hipMemsetAsync failed\n"); return; }
    Args a{};
    for (int i = 0; i < 30; ++i) a.in[i] = (const float*)d_in[i];
    a.out = (float*)d_out; a.ws = (unsigned char*)d_ws;
#if MK_PER_PHASE
    for (int ph = 0; ph < 12; ++ph) { a.ph_lo = ph; a.ph_hi = ph + 1; hipLaunchKernelGGL(mk_fwd, dim3(grid), dim3(NTHREADS), LDS_BYTES, stream, a); }
#else
    a.ph_lo = 0; a.ph_hi = 12;
    void* kargs[] = {&a};
    hipError_t e = hipLaunchCooperativeKernel((const void*)mk_fwd, dim3(grid), dim3(NTHREADS), kargs, LDS_BYTES, stream);
    if (e != hipSuccess) fprintf(stderr, "kernel_launch: cooperative launch failed: %s (grid %d)\n", hipGetErrorString(e), grid);
#endif
}
```
